# Optimizing an MI355X kernel written in HIP

```python
import jax
import jax.numpy as jnp
from jax import lax
import numpy as np

D_MODEL = 1024
BATCH = 16
SEQ = 2048
DEPTH = 4

GRID_W = 64
CTX_LEN = 256
D_A = D_MODEL // 2
D_B = D_MODEL // 2
HEAD_B = 64
H_B = D_B // HEAD_B
R_W = 64
R_A = 64
R_G = 128
N_GROUPS = 4
EXP_PER_GROUP = 8
N_EXPERTS = N_GROUPS * EXP_PER_GROUP
TOP_K = 2
D_FF_EXPERT = D_MODEL // 2
MOE_BLOCK = 128
NORM_EPS = 1e-6
GN_EPS = 64e-5
RW_COLS = 3 * D_B + 2 * R_W + 2 * R_A + R_G
RW_START = 3 * D_A
N_IN = RW_START + RW_COLS + 2 * D_MODEL
IN_SPLITS = (D_A, 2 * D_A, RW_START, RW_START + RW_COLS, RW_START + RW_COLS + D_MODEL)
RW_SPLITS = (D_B, 2 * D_B, 3 * D_B, 3 * D_B + R_W, 3 * D_B + 2 * R_W,
             3 * D_B + 2 * R_W + R_A, 3 * D_B + 2 * R_W + 2 * R_A)

kernel_name = "hybrid_conv_rwkv7_hmoe_diffusion_trunk"


def _rmsnorm(x, g):
    xf = x.astype(jnp.float32)
    y = xf * lax.rsqrt(jnp.mean(xf * xf, axis=-1, keepdims=True) + NORM_EPS)
    return y.astype(x.dtype) * g


def _dwconv3(u, w, axis):
    pad = [(0, 0)] * u.ndim
    pad[axis] = (1, 1)
    up = jnp.pad(u, pad)
    n = u.shape[axis]
    sl = lambda i: lax.slice_in_dim(up, i, i + n, axis=axis)
    return sl(0) * w[0] + sl(1) * w[1] + sl(2) * w[2]


def _conv_grid(u, w):
    bsz, s, ch = u.shape
    rows = s // GRID_W
    g = u.reshape(bsz, rows, GRID_W, ch)
    half = ch // 2
    horiz = _dwconv3(g[..., :half], w[:, :half], axis=2)
    vert = _dwconv3(g[..., half:], w[:, half:], axis=1)
    return jnp.concatenate([horiz, vert], axis=-1).reshape(bsz, s, ch)


def _token_shift(z, mu):
    zp = jnp.pad(z, ((0, 0), (1, 1), (0, 0)))
    return z + mu * (0.5 * (zp[:, :-2] + zp[:, 2:]) - z)


def _rwkv_prep(zrw, lp):
    bsz, t, _ = zrw.shape
    hd = lambda u: u.astype(jnp.float32).reshape(bsz, t, H_B, HEAD_B)
    r, k, v, zwf, zwb, zaf, zab, zg = jnp.split(zrw, RW_SPLITS, axis=-1)
    kk = hd(k * lp["k_k"])
    kk = kk * lax.rsqrt(jnp.sum(kk * kk, axis=-1, keepdims=True) + 1e-12)
    k_a = lp["k_a"].astype(jnp.float32).reshape(H_B, HEAD_B)
    kh = hd(k)
    dirs = []
    for d, (zw, za) in enumerate(((zwf, zaf), (zwb, zab))):
        wl = -jax.nn.softplus(-hd(lp["w0"][d] + jnp.tanh(zw) @ lp["w_up"][d])) - 0.5
        a = jax.nn.sigmoid(hd(lp["a0"][d] + za @ lp["a_up"][d]))
        kd = kh * (1.0 + (a - 1.0) * k_a)
        dirs.append((jnp.exp(-jnp.exp(wl)), kd, kk * a))
    return hd(r), hd(v), kk, dirs, zg


def _wkv_scan(s0, r, decay, k, v, kk, b, reverse):
    def step(s, inp):
        w_t, k_t, v_t, kk_t, b_t = inp[:5]
        sa = jnp.einsum("bhvk,bhk->bhv", s, kk_t)
        s = (s * w_t[:, :, None, :] - sa[..., None] * b_t[:, :, None, :]
             + v_t[..., None] * k_t[:, :, None, :])
        if r is None:
            return s, None
        return s, jnp.einsum("bhvk,bhk->bhv", s, inp[5])
    seqs = (decay, k, v, kk, b) + (() if r is None else (r,))
    xs = tuple(jnp.swapaxes(u, 0, 1) for u in seqs)
    s_fin, ys = lax.scan(step, s0, xs, reverse=reverse)
    return s_fin, (None if r is None else jnp.swapaxes(ys, 0, 1))


def _rwkv_readout(y, r, v, kds, zg, lp):
    bsz, t = y.shape[:2]
    mu = jnp.mean(y, axis=-1, keepdims=True)
    var = jnp.mean(jnp.square(y - mu), axis=-1, keepdims=True)
    yn = ((y - mu) * lax.rsqrt(var + GN_EPS)).reshape(bsz, t, D_B) * lp["lnx_g"] + lp["lnx_b"]
    rk = lp["r_k"].astype(jnp.float32)
    bonus = sum(jnp.sum(r * kd * rk, axis=-1, keepdims=True) for kd in kds) * v
    g = jax.nn.sigmoid(zg) @ lp["g_up"]
    out = ((yn + bonus.reshape(bsz, t, D_B)) * g).astype(zg.dtype)
    return out @ lp["w_b_out"]


def _token_mixer(h_lat, h_ctx, lp, with_ctx_out):
    bsz = h_lat.shape[0]
    bg, cg, ha, rw, ga, gb = jnp.split(h_lat @ lp["w_in"], IN_SPLITS, axis=-1)
    if with_ctx_out:
        bgc, cgc, hac, rwc, gac, gbc = jnp.split(h_ctx @ lp["w_in"], IN_SPLITS, axis=-1)
    else:
        rwc = h_ctx @ lp["w_in"][:, RW_START:RW_START + RW_COLS]
    r_l, v_l, kk_l, dirs_l, zg_l = _rwkv_prep(_token_shift(rw, lp["shift_mu"]), lp)
    r_c, v_c, kk_c, dirs_c, zg_c = _rwkv_prep(_token_shift(rwc, lp["shift_mu"]), lp)
    s0 = jnp.zeros((bsz, H_B, HEAD_B, HEAD_B), jnp.float32)
    y_l = 0.0
    y_c = 0.0
    for d in range(2):
        dec_c, k_c, b_c = dirs_c[d]
        s_c, yc_d = _wkv_scan(s0, r_c if with_ctx_out else None, dec_c, k_c, v_c, kk_c, b_c, d == 1)
        dec_l, k_l, b_l = dirs_l[d]
        _, yl_d = _wkv_scan(s_c, r_l, dec_l, k_l, v_l, kk_l, b_l, d == 1)
        y_l = y_l + yl_d
        if with_ctx_out:
            y_c = y_c + yc_d
    ya = (bg * _conv_grid(cg * ha, lp["conv_w"])) @ lp["w_a_out"]
    yb = _rwkv_readout(y_l, r_l, v_l, [dl[1] for dl in dirs_l], zg_l, lp)
    y_lat = (jax.nn.sigmoid(ga) * ya + jax.nn.sigmoid(gb) * yb) @ lp["w_o"]
    if not with_ctx_out:
        return y_lat, None
    yac = (bgc * _dwconv3(cgc * hac, lp["conv_w"], axis=1)) @ lp["w_a_out"]
    ybc = _rwkv_readout(y_c, r_c, v_c, [dc[1] for dc in dirs_c], zg_c, lp)
    y_ctx = (jax.nn.sigmoid(gac) * yac + jax.nn.sigmoid(gbc) * ybc) @ lp["w_o"]
    return y_lat, y_ctx


def _hier_moe(h, lp):
    n, dm = h.shape
    lg = (h @ lp["router_g"] + lp["router_g_b"]).astype(jnp.float32)
    p_g = jax.nn.softmax(lg, axis=-1)
    g_sel = jnp.argmax(lg, axis=-1).astype(jnp.int32)
    le = (h @ lp["router_e"] + lp["router_e_b"]).astype(jnp.float32).reshape(n, N_GROUPS, EXP_PER_GROUP)
    le = jnp.take_along_axis(le, jnp.broadcast_to(g_sel[:, None, None], (n, 1, EXP_PER_GROUP)), axis=1)[:, 0]
    top_p, top_i = lax.top_k(jax.nn.softmax(le, axis=-1), TOP_K)
    gate = jnp.max(p_g, axis=-1, keepdims=True) * top_p / jnp.sum(top_p, axis=-1, keepdims=True)
    expert = (g_sel[:, None] * EXP_PER_GROUP + top_i).reshape(-1).astype(jnp.int32)
    m = n * TOP_K
    token = jnp.repeat(jnp.arange(n, dtype=jnp.int32), TOP_K)
    order = jnp.argsort(expert)
    e_sorted = expert[order]
    counts = jnp.bincount(expert, length=N_EXPERTS)
    padded = (counts + MOE_BLOCK - 1) // MOE_BLOCK * MOE_BLOCK
    pad_end = jnp.cumsum(padded)
    dest = (pad_end - padded)[e_sorted] + jnp.arange(m) - (jnp.cumsum(counts) - counts)[e_sorted]
    n_blocks = -(-m // MOE_BLOCK) + N_EXPERTS
    slot_tok = jnp.full((n_blocks * MOE_BLOCK,), n, jnp.int32).at[dest].set(token[order])
    slot_gate = jnp.zeros((n_blocks * MOE_BLOCK,), jnp.float32).at[dest].set(gate.reshape(-1)[order])
    block_exp = jnp.minimum(
        jnp.searchsorted(pad_end, jnp.arange(n_blocks) * MOE_BLOCK, side="right"), N_EXPERTS - 1)
    h_pad = jnp.concatenate([h, jnp.zeros((1, dm), h.dtype)], axis=0)

    def expert_block(args):
        tok, e = args
        xb = h_pad[tok]
        hid = jax.nn.silu(xb @ lp["exp_w1"][e]) * (xb @ lp["exp_w3"][e])
        return hid @ lp["exp_w2"][e]

    yb = lax.map(expert_block, (slot_tok.reshape(n_blocks, MOE_BLOCK), block_exp))
    yb = yb.reshape(-1, dm) * slot_gate[:, None].astype(h.dtype)
    return jnp.zeros((n + 1, dm), h.dtype).at[slot_tok].add(yb)[:n]


def setup_inputs(seed: int = 0) -> dict:
    key = jax.random.key(seed)
    ks = iter(jax.random.split(key, 40))
    nrm = lambda shape, s: jax.random.normal(next(ks), shape, jnp.float32) * s
    L, D = DEPTH, D_MODEL
    return {
        "x": nrm((BATCH, SEQ, D), 1.0),
        "c": nrm((BATCH, D), 1.0),
        "ctx": nrm((BATCH, CTX_LEN, D), 1.0),
        "c_ctx": nrm((D,), 1.0),
        "w_mod": nrm((L, D, 6 * D), 0.5 * D ** -0.5),
        "b_mod": nrm((L, 6 * D), 0.02),
        "norm1_g": 1.0 + nrm((L, D), 0.02),
        "norm2_g": 1.0 + nrm((L, D), 0.02),
        "w_in": nrm((L, D, N_IN), D ** -0.5),
        "shift_mu": jax.random.uniform(next(ks), (L, RW_COLS), jnp.float32),
        "conv_w": nrm((L, 3, D_A), 3 ** -0.5),
        "w_up": nrm((L, 2, R_W, D_B), 0.1 * R_W ** -0.5),
        "w0": jax.random.uniform(next(ks), (L, 2, D_B), jnp.float32, -6.5, -1.5),
        "a_up": nrm((L, 2, R_A, D_B), 0.5 * R_A ** -0.5),
        "a0": nrm((L, 2, D_B), 0.1),
        "g_up": nrm((L, R_G, D_B), R_G ** -0.5),
        "k_k": 0.85 + nrm((L, D_B), 0.02),
        "k_a": 1.0 + nrm((L, D_B), 0.02),
        "r_k": nrm((L, H_B, HEAD_B), 0.1),
        "lnx_g": 1.0 + nrm((L, D_B), 0.02),
        "lnx_b": nrm((L, D_B), 0.02),
        "w_a_out": nrm((L, D_A, D), D_A ** -0.5),
        "w_b_out": nrm((L, D_B, D), D_B ** -0.5),
        "w_o": nrm((L, D, D), D ** -0.5),
        "router_g": nrm((L, D, N_GROUPS), D ** -0.5),
        "router_g_b": nrm((L, N_GROUPS), 0.01),
        "router_e": nrm((L, D, N_EXPERTS), D ** -0.5),
        "router_e_b": nrm((L, N_EXPERTS), 0.01),
        "exp_w1": nrm((L, N_EXPERTS, D, D_FF_EXPERT), D ** -0.5),
        "exp_w3": nrm((L, N_EXPERTS, D, D_FF_EXPERT), D ** -0.5),
        "exp_w2": nrm((L, N_EXPERTS, D_FF_EXPERT, D), D_FF_EXPERT ** -0.5),
        "final_g": 1.0 + nrm((D,), 0.02),
    }


def reference(x, c, ctx, c_ctx, w_mod, b_mod, norm1_g, norm2_g, w_in, shift_mu, conv_w,
              w_up, w0, a_up, a0, g_up, k_k, k_a, r_k, lnx_g, lnx_b, w_a_out, w_b_out, w_o,
              router_g, router_g_b, router_e, router_e_b, exp_w1, exp_w3, exp_w2, final_g):
    dt = x.dtype
    dm = x.shape[-1]
    xc = ctx
    s_lat = jax.nn.silu(c)
    s_ctx = jax.nn.silu(c_ctx)
    for layer in range(DEPTH):
        last = layer == DEPTH - 1
        lp = {
            "w_in": w_in[layer], "shift_mu": shift_mu[layer], "conv_w": conv_w[layer],
            "w_up": w_up[layer], "w0": w0[layer], "a_up": a_up[layer], "a0": a0[layer],
            "g_up": g_up[layer], "k_k": k_k[layer], "k_a": k_a[layer], "r_k": r_k[layer],
            "lnx_g": lnx_g[layer], "lnx_b": lnx_b[layer], "w_a_out": w_a_out[layer],
            "w_b_out": w_b_out[layer], "w_o": w_o[layer],
            "router_g": router_g[layer], "router_g_b": router_g_b[layer],
            "router_e": router_e[layer], "router_e_b": router_e_b[layer],
            "exp_w1": exp_w1[layer], "exp_w3": exp_w3[layer], "exp_w2": exp_w2[layer],
        }
        sh1, sc1, g1, sh2, sc2, g2 = [m[:, None, :] for m in jnp.split(s_lat @ w_mod[layer] + b_mod[layer], 6, axis=-1)]
        ch1, cs1, cg1, ch2, cs2, cg2 = jnp.split(s_ctx @ w_mod[layer] + b_mod[layer], 6, axis=-1)
        h_lat = _rmsnorm(x, norm1_g[layer]) * (1.0 + sc1) + sh1
        h_ctx = _rmsnorm(xc, norm1_g[layer]) * (1.0 + cs1) + ch1
        y_lat, y_ctx = _token_mixer(h_lat, h_ctx, lp, not last)
        x = x + (g1 * y_lat).astype(dt)
        h2_lat = _rmsnorm(x, norm2_g[layer]) * (1.0 + sc2) + sh2
        if last:
            y2 = _hier_moe(h2_lat.reshape(-1, dm), lp).reshape(x.shape)
            x = x + (g2 * y2).astype(dt)
        else:
            xc = xc + (cg1 * y_ctx).astype(dt)
            h2_ctx = _rmsnorm(xc, norm2_g[layer]) * (1.0 + cs2) + ch2
            nc = h2_ctx.shape[0] * h2_ctx.shape[1]
            y2 = _hier_moe(jnp.concatenate([h2_ctx.reshape(-1, dm), h2_lat.reshape(-1, dm)], axis=0), lp)
            xc = xc + (cg2 * y2[:nc].reshape(xc.shape)).astype(dt)
            x = x + (g2 * y2[nc:].reshape(x.shape)).astype(dt)
    return _rmsnorm(x, final_g)
```

```cpp
#include <hip/hip_runtime.h>
#include <cstdio>
#include <cstdint>

#ifndef MK_ONE_LAUNCH
#define MK_ONE_LAUNCH 1
#endif
#ifndef GEMM_IMPL
#define GEMM_IMPL 1
#endif

#ifndef PHASE_MASK
#define PHASE_MASK 0xffff
#endif
#define PH_EN(p) (((PHASE_MASK) >> (p)) & 1)
#define LAS __attribute__((address_space(3)))
typedef unsigned short bf16_t;
typedef short bf16x8 __attribute__((ext_vector_type(8)));
typedef float f32x4 __attribute__((ext_vector_type(4)));
typedef unsigned u32x4 __attribute__((ext_vector_type(4)));
typedef unsigned u32x2 __attribute__((ext_vector_type(2)));

constexpr int D = 1024, NBATCH = 16, SEQ = 2048, DEPTH = 4, CTXL = 256;
constexpr int NCTX = NBATCH * CTXL;
constexpr int NLAT = NBATCH * SEQ;
constexpr int NT = NCTX + NLAT;
constexpr int DH = 512;
constexpr int NIN = 5504, ZLD = 5632;
constexpr int ZC_BG = 0, ZC_CG = 512, ZC_HA = 1024, ZC_RW = 1536, ZC_GA = 3456, ZC_GB = 4480;
constexpr int RWC = 1920;
constexpr int NE = 32, DFF = 512;
constexpr int MAXTILES = 320;
constexpr int NMOD = 6 * D;
constexpr float NORM_EPS = 1e-6f, GN_EPS = 64e-5f;

constexpr size_t MiB = 1u << 20;
constexpr size_t WS_CTL = 0, CTL_ZERO_BYTES = 1 * MiB;
constexpr size_t WS_MOD = 1 * MiB;
constexpr size_t WS_RE = 3 * MiB;
constexpr size_t WS_RG = WS_RE + (size_t)NT * 8;
constexpr size_t WS_RP = WS_RG + (size_t)NT * 8;
constexpr size_t WS_RS = WS_RP + (size_t)NT * 8;
constexpr size_t WS_BONUS = 5 * MiB;
constexpr size_t WS_X = 8 * MiB;
constexpr size_t WS_WIN = 152 * MiB;
constexpr size_t WS_WA = 163 * MiB;
constexpr size_t WS_WB = 164 * MiB;
constexpr size_t WS_WO = 165 * MiB;
constexpr size_t WS_W13 = 167 * MiB;
constexpr size_t WS_W2 = 231 * MiB;
constexpr size_t WS_Z = 264 * MiB;
constexpr size_t WS_XS = WS_Z;
constexpr size_t WS_HID = WS_Z + 160 * MiB;
constexpr size_t WS_SI = 660 * MiB;
constexpr size_t SI_SZ = 36 * MiB;
constexpr size_t WS_R = WS_SI, WS_V = WS_SI + SI_SZ, WS_KK = WS_SI + 2 * SI_SZ, WS_LW0 = WS_SI + 3 * SI_SZ, WS_LW1 = WS_SI + 4 * SI_SZ,
                 WS_KD0 = WS_SI + 5 * SI_SZ, WS_KD1 = WS_SI + 6 * SI_SZ, WS_B0 = WS_SI + 7 * SI_SZ, WS_B1 = WS_SI + 8 * SI_SZ;
constexpr size_t WS_UA = WS_KK, WS_UB = WS_LW0;
constexpr size_t WS_YS = WS_SI;
constexpr size_t WS_Y0 = 984 * MiB, WS_Y1 = 1020 * MiB;
constexpr size_t WS_END = 1056 * MiB;
constexpr size_t DO_H = 0, DO_G = 72 * MiB;
static_assert(WS_Z + (size_t)NT * ZLD * 2 <= WS_SI && WS_HID + (size_t)MAXTILES * 256 * DFF * 2 <= WS_SI && WS_B1 + SI_SZ <= WS_Y0 && WS_YS + (size_t)MAXTILES * 256 * D * 2 <= WS_Y0, "ws map");
static_assert((size_t)NT * DH * 2 == SI_SZ && WS_X + (size_t)NT * D * 4 <= WS_WIN && WS_W2 + 32 * MiB <= WS_Z, "ws map 2");
constexpr int CW_CNT = 1024;
constexpr int CW_BAR = 4096;

constexpr int LDS_BYTES = 147456;
constexpr int LDS_CTL = 131072;
constexpr int LC_BARW = LDS_CTL;
constexpr int LC_SEG = LDS_CTL + 64;
constexpr int LC_CNTS = LDS_CTL + 256;
constexpr int LC_TILEE = LDS_CTL + 512;

__device__ __forceinline__ float bf2f(unsigned b) { return __uint_as_float(b << 16); }
__device__ __forceinline__ unsigned f2bf(float f) { unsigned u = __float_as_uint(f); return (u + 0x7fffu + ((u >> 16) & 1u)) >> 16; }
__device__ __forceinline__ unsigned pk2(float lo, float hi) { return f2bf(lo) | (f2bf(hi) << 16); }
__device__ __forceinline__ float wave_sum(float v) {
#pragma unroll
    for (int o = 1; o < 64; o <<= 1) v += __shfl_xor(v, o);
    return v;
}
__device__ __forceinline__ float sigmoidf_(float x) { return 1.0f / (1.0f + __expf(-x)); }
__device__ __forceinline__ float siluf_(float x) { return x / (1.0f + __expf(-x)); }

#define XB_TMO      128
#define XB_XCNT(j)  (256  + 64 * (j))
#define XB_XSUB(j)  (1280 + 64 * (j))
#define XB_XGEN(j)  (2304 + 64 * (j))
#define XB_TOP      3328
#define XB_TOPGEN   3392
#define XCD_BAR_WORDS 3456
#define XB_SPIN_CAP (1u << 22)

__device__ __forceinline__ unsigned xb_ld(unsigned* p)              { return __hip_atomic_load(p, __ATOMIC_RELAXED, __HIP_MEMORY_SCOPE_AGENT); }
__device__ __forceinline__ unsigned xb_add(unsigned* p, unsigned v) { return __hip_atomic_fetch_add(p, v, __ATOMIC_RELAXED, __HIP_MEMORY_SCOPE_AGENT); }
__device__ __forceinline__ unsigned xb_xcc_id() { return (unsigned)__builtin_amdgcn_s_getreg((3 << 11) | 20) & 0xFu; }
#define XB_SPIN(cond, bar) do { unsigned _sp = 0; while (cond) { __builtin_amdgcn_s_sleep(1); \
    if ((++_sp & 255u) == 0u) { if (xb_ld(&(bar)[XB_TMO])) break; if (_sp > XB_SPIN_CAP) { atomicAdd(&(bar)[XB_TMO], 1u); break; } } } } while (0)

struct XcdBarrier { unsigned* bar; unsigned x; volatile LAS unsigned* st; };

__device__ __forceinline__ XcdBarrier xcd_barrier_post(unsigned* bar, volatile LAS unsigned* st) {
    XcdBarrier b; b.bar = bar; b.x = xb_xcc_id(); b.st = st;
    if (threadIdx.x == 0) (void)xb_add(&bar[XB_XCNT(b.x)], 1u);
    return b;
}
__device__ __forceinline__ void xcd_barrier_complete(unsigned* bar, unsigned x, unsigned& nloc, unsigned& nx) {
    const unsigned G = gridDim.x * gridDim.y * gridDim.z;
    unsigned sum, cnt, mine, sp = 0u;
    for (;;) {
        sum = 0u; cnt = 0u; mine = 0u;
#pragma unroll
        for (unsigned j = 0; j < 16; ++j) { const unsigned c = xb_ld(&bar[XB_XCNT(j)]); sum += c; cnt += (c > 0u) ? 1u : 0u; mine = (j == x) ? c : mine; }
        if (sum == G) break;
        __builtin_amdgcn_s_sleep(1);
        if ((++sp & 255u) == 0u) { if (xb_ld(&bar[XB_TMO])) break; if (sp > XB_SPIN_CAP) { atomicAdd(&bar[XB_TMO], 1u); break; } }
    }
    nloc = mine > 0u ? mine : 1u; nx = cnt > 0u ? cnt : 1u;
}
__device__ __forceinline__ void xcd_barrier(const XcdBarrier& b) {
    asm volatile("s_waitcnt vmcnt(0)" ::: "memory");
    __syncthreads();
    if (threadIdx.x == 0) {
        unsigned* bar = b.bar;
        __builtin_amdgcn_s_waitcnt(0);
        unsigned nloc = b.st[0], nx = b.st[1];
        if (nloc == 0u) { xcd_barrier_complete(bar, b.x, nloc, nx); b.st[0] = nloc; b.st[1] = nx; }
        const unsigned old = xb_add(&bar[XB_XSUB(b.x)], 1u);
        const unsigned gen = old / nloc;
        if (old + 1u == (gen + 1u) * nloc) {
            __builtin_amdgcn_fence(__ATOMIC_RELEASE, "agent");
            asm volatile("s_waitcnt vmcnt(0)" ::: "memory");
            const unsigned og = xb_add(&bar[XB_TOP], 1u);
            const unsigned tg = og / nx;
            if (og + 1u == (tg + 1u) * nx) xb_add(&bar[XB_TOPGEN], 1u);
            else XB_SPIN(xb_ld(&bar[XB_TOPGEN]) == tg, bar);
            __builtin_amdgcn_fence(__ATOMIC_ACQUIRE, "agent");
            xb_add(&bar[XB_XGEN(b.x)], 1u);
            asm volatile("s_waitcnt vmcnt(0)" ::: "memory");
        } else {
            XB_SPIN(xb_ld(&bar[XB_XGEN(b.x)]) == gen, bar);
            __builtin_amdgcn_fence(__ATOMIC_ACQUIRE, "agent");
            asm volatile("s_waitcnt vmcnt(0)" ::: "memory");
        }
    }
    __syncthreads();
}

struct Unit { int pm, pn, bs; };
struct Gemm { const bf16_t* A; const bf16_t* Bt; int M, N, K; size_t bstride; };
constexpr int NXCD = 8, WGM = 8;
struct StaticOrder {
    int nM, nN, nwg, G, c;
    __device__ __forceinline__ void init(int M, int N, int G_, int c_) { nM = M / 256; nN = N / 256; nwg = nM * nN; G = G_; c = c_; }
    __device__ __forceinline__ bool next(int i, Unit& u) const {
        const long L = (long)i * G + c; if (L >= nwg) return false;
        int wgid = (int)L; { const int q = nwg / NXCD, r = nwg % NXCD, xcd = wgid % NXCD, off = wgid / NXCD; wgid = (xcd < r ? xcd * (q + 1) : r * (q + 1) + (xcd - r) * q) + off; }
        const int nig = WGM * nN, gid = wgid / nig, fm = gid * WGM, gsz = (nM - fm) < WGM ? (nM - fm) : WGM;
        u.pm = fm + ((wgid % nig) % gsz); u.pn = (wgid % nig) / gsz; u.bs = 0; return true;
    }
};
struct MoeOrder {
    int ntiles, G, c; const LAS int* tile_e;
    __device__ __forceinline__ bool next(int i, Unit& u) const {
        const int L = i * G + c; if (L >= ntiles * 4) return false;
        u.pm = L >> 2; u.pn = L & 3; u.bs = __builtin_amdgcn_readfirstlane(tile_e[u.pm]); return true;
    }
};

#if GEMM_IMPL == 0
template <class Epi, class Sched>
__device__ __forceinline__ void gemm_phase(LAS unsigned char* lds, const Gemm g, const Sched& S, const Epi& E) {
    LAS float* As = (LAS float*)lds;
    LAS float* Bs = As + 16 * 260;
    const int tid = threadIdx.x, ty = tid >> 4, tx = tid & 15, lr = tid >> 1, lh = tid & 1;
    Unit u;
    for (int it = 0; S.next(it, u); ++it) {
        float acc[8][16];
#pragma unroll
        for (int i = 0; i < 8; ++i)
#pragma unroll
            for (int j = 0; j < 16; ++j) acc[i][j] = 0.f;
        const bf16_t* Ap = g.A + ((size_t)u.pm * 256 + lr) * g.K + lh * 8;
        const bf16_t* Bp = g.Bt + (size_t)u.bs * g.bstride + ((size_t)u.pn * 256 + lr) * g.K + lh * 8;
        for (int k0 = 0; k0 < g.K; k0 += 16) {
            const u32x4 av = *(const u32x4*)(Ap + k0), bv = *(const u32x4*)(Bp + k0);
            __syncthreads();
#pragma unroll
            for (int j = 0; j < 4; ++j) {
                As[(lh * 8 + 2 * j) * 260 + lr] = bf2f(av[j] & 0xffffu); As[(lh * 8 + 2 * j + 1) * 260 + lr] = bf2f(av[j] >> 16);
                Bs[(lh * 8 + 2 * j) * 260 + lr] = bf2f(bv[j] & 0xffffu); Bs[(lh * 8 + 2 * j + 1) * 260 + lr] = bf2f(bv[j] >> 16);
            }
            __syncthreads();
#pragma unroll 4
            for (int kk = 0; kk < 16; ++kk) {
                float a[8], b[16];
                const f32x4 a0 = *(const LAS f32x4*)(As + kk * 260 + ty * 8), a1 = *(const LAS f32x4*)(As + kk * 260 + ty * 8 + 4);
                a[0] = a0[0]; a[1] = a0[1]; a[2] = a0[2]; a[3] = a0[3]; a[4] = a1[0]; a[5] = a1[1]; a[6] = a1[2]; a[7] = a1[3];
#pragma unroll
                for (int q = 0; q < 4; ++q) { const f32x4 bq = *(const LAS f32x4*)(Bs + kk * 260 + tx * 4 + 64 * q); b[4 * q] = bq[0]; b[4 * q + 1] = bq[1]; b[4 * q + 2] = bq[2]; b[4 * q + 3] = bq[3]; }
#pragma unroll
                for (int i = 0; i < 8; ++i)
#pragma unroll
                    for (int j = 0; j < 16; ++j) acc[i][j] = fmaf(a[i], b[j], acc[i][j]);
            }
        }
#pragma unroll
        for (int i = 0; i < 8; ++i)
#pragma unroll
            for (int q = 0; q < 4; ++q)
                E.elem4(u.pm * 256 + ty * 8 + i, u.pn * 256 + tx * 4 + 64 * q, (f32x4){acc[i][4 * q], acc[i][4 * q + 1], acc[i][4 * q + 2], acc[i][4 * q + 3]});
    }
    __syncthreads();
}
#else
namespace pg8 {
constexpr int BM = 256, BK = 64, HALF = 128, HTB = HALF * BK * 2, STAGE_BYTES = 8 * HTB;
__device__ __forceinline__ int lds_byte(int r, int c) { const int st = (r >> 4) * 2 + (c >> 5), rr = r & 15, cc = c & 31, ob = rr * 64 + cc * 2; return st * 1024 + (ob ^ (((ob >> 9) & 1) << 5)); }
__device__ __forceinline__ void stage_rc(int b, int& R, int& C) { const int st = b / 1024, sb = b % 1024, swz = sb ^ (((sb >> 9) & 1) << 5); R = (st >> 1) * 16 + swz / 64; C = (st & 1) * 32 + (swz % 64) / 2; }
}
template <class Epi, class Sched>
__device__ __forceinline__ void gemm_phase(LAS unsigned char* lds, const Gemm g, const Sched& S, const Epi& E) {
    using namespace pg8;
    int tid_ = threadIdx.x; asm volatile("" : "+v"(tid_));
    const int tid = tid_, wid = __builtin_amdgcn_readfirstlane(tid >> 6), lane = tid & 63, wr = wid >> 2, wc = wid & 3, fr = lane & 15, fq = lane >> 4;
    const int K = g.K, nt = K / BK;
    unsigned voffA[2];
#pragma unroll
    for (int i = 0; i < 2; ++i) { int R, C; stage_rc(tid * 16 + i * 8192, R, C); voffA[i] = (unsigned)(R * K + C) * 2u; }
    const size_t kstep = (size_t)(BK * 2);
    const size_t hstep = (size_t)HALF * K * 2;
    const size_t tstep = 2 * hstep;
    const unsigned ldsw = (unsigned)wid * 1024u;
    const int aoff = lds_byte(wr * 64 + fr, fq * 8), boff = lds_byte(wc * 32 + fr, fq * 8);
#define PG8_SA(b, h) (((b) * 2 + (h)) * HTB)
#define PG8_SB(b, h) ((4 + (b) * 2 + (h)) * HTB)
#define PG8_STAGE(bufoff, gbase, voff) do { _Pragma("unroll") for (int _i = 0; _i < 2; ++_i) \
        __builtin_amdgcn_global_load_lds((const unsigned*)((const char*)(gbase) + (voff)[_i]), (LAS unsigned*)(lds + (bufoff) + ldsw + _i * 8192), 16, 0, 0); } while (0)
#define PG8_LDA(dst, b, h) do { _Pragma("unroll") for (int m = 0; m < 4; ++m) _Pragma("unroll") for (int k = 0; k < 2; ++k) dst[m][k] = *(const LAS bf16x8*)(lds + PG8_SA(b, h) + aoff + m * 2048 + k * 1024); } while (0)
#define PG8_LDB(dst, b, h) do { _Pragma("unroll") for (int n = 0; n < 2; ++n) _Pragma("unroll") for (int k = 0; k < 2; ++k) dst[n][k] = *(const LAS bf16x8*)(lds + PG8_SB(b, h) + boff + n * 2048 + k * 1024); } while (0)
#define PG8_MMA(ai, bj, At, Bt) do { __builtin_amdgcn_s_setprio(1); _Pragma("unroll") for (int m = 0; m < 4; ++m) _Pragma("unroll") for (int n = 0; n < 2; ++n) _Pragma("unroll") for (int k = 0; k < 2; ++k) \
        acc[ai][bj][m][n] = __builtin_amdgcn_mfma_f32_16x16x32_bf16(Bt[n][k], At[m][k], acc[ai][bj][m][n], 0, 0, 0); __builtin_amdgcn_s_setprio(0); } while (0)
#define PG8_WAIT_V(n) asm volatile("s_waitcnt vmcnt(" #n ")" ::: "memory")
#define PG8_WAIT_L(n) asm volatile("s_waitcnt lgkmcnt(" #n ")" ::: "memory")
#define PG8_BAR __builtin_amdgcn_s_barrier()
#define PG8_SCHED __builtin_amdgcn_sched_barrier(0)
    Unit cur, nxt; int ui = 0;
    if (S.next(0, cur)) {
    f32x4 acc[2][2][4][2];
#pragma unroll
    for (int a = 0; a < 2; ++a)
#pragma unroll
        for (int b = 0; b < 2; ++b)
#pragma unroll
            for (int m = 0; m < 4; ++m)
#pragma unroll
                for (int n = 0; n < 2; ++n) acc[a][b][m][n] = (f32x4){0.f, 0.f, 0.f, 0.f};
    bf16x8 At[4][2], B0[2][2], B1[2][2];
    const char* cA = (const char*)g.A + (size_t)cur.pm * tstep; const char* cB = (const char*)(g.Bt + (size_t)cur.bs * g.bstride) + (size_t)cur.pn * tstep;
    PG8_STAGE(PG8_SB(0, 0), cB, voffA); PG8_STAGE(PG8_SA(0, 0), cA, voffA); PG8_STAGE(PG8_SB(0, 1), cB + hstep, voffA); PG8_STAGE(PG8_SA(0, 1), cA + hstep, voffA);
    if (wr == 1) PG8_BAR;
    PG8_WAIT_V(4); PG8_BAR;
    PG8_STAGE(PG8_SB(1, 0), cB + kstep, voffA); PG8_STAGE(PG8_SA(1, 0), cA + kstep, voffA); PG8_STAGE(PG8_SB(1, 1), cB + hstep + kstep, voffA);
    PG8_WAIT_V(6); PG8_BAR;
    for (;;) {
        const bool has_next = S.next(ui + 1, nxt);
        const char* nA = has_next ? (const char*)g.A + (size_t)nxt.pm * tstep : cA; const char* nB = has_next ? (const char*)(g.Bt + (size_t)nxt.bs * g.bstride) + (size_t)nxt.pn * tstep : cB;
        for (int t = 0; t < nt; t += 2) {
            const bool last = (t == nt - 2);
            const char* a1 = cA + (size_t)(t + 1) * kstep;
            const char* a2 = last ? nA : cA + (size_t)(t + 2) * kstep; const char* b2 = last ? nB : cB + (size_t)(t + 2) * kstep;
            const char* a3 = a2 + kstep; const char* b3 = b2 + kstep;
            PG8_LDB(B0, 0, 0); PG8_SCHED; PG8_LDA(At, 0, 0); PG8_STAGE(PG8_SA(1, 1), a1 + hstep, voffA);
            PG8_WAIT_L(8); PG8_BAR; PG8_WAIT_L(0); PG8_MMA(0, 0, At, B0); PG8_BAR; PG8_SCHED;
            PG8_LDB(B1, 0, 1); PG8_STAGE(PG8_SB(0, 0), b2, voffA);
            PG8_BAR; PG8_WAIT_L(0); PG8_MMA(0, 1, At, B1); PG8_BAR;
            PG8_LDA(At, 0, 1); PG8_STAGE(PG8_SA(0, 0), a2, voffA);
            PG8_BAR; PG8_WAIT_L(0); PG8_MMA(1, 0, At, B0); PG8_BAR; PG8_SCHED;
            PG8_STAGE(PG8_SB(0, 1), b2 + hstep, voffA);
            PG8_WAIT_V(6); PG8_BAR; PG8_MMA(1, 1, At, B1); PG8_BAR;
            PG8_LDB(B0, 1, 0); PG8_SCHED; PG8_LDA(At, 1, 0); PG8_STAGE(PG8_SA(0, 1), a2 + hstep, voffA);
            PG8_WAIT_L(8); PG8_BAR; PG8_WAIT_L(0); PG8_MMA(0, 0, At, B0); PG8_BAR; PG8_SCHED;
            PG8_LDB(B1, 1, 1); PG8_STAGE(PG8_SB(1, 0), b3, voffA);
            PG8_BAR; PG8_WAIT_L(0); PG8_MMA(0, 1, At, B1); PG8_BAR;
            PG8_LDA(At, 1, 1); PG8_STAGE(PG8_SA(1, 0), a3, voffA);
            PG8_BAR; PG8_WAIT_L(0); PG8_MMA(1, 0, At, B0); PG8_BAR; PG8_SCHED;
            PG8_STAGE(PG8_SB(1, 1), b3 + hstep, voffA);
            PG8_WAIT_V(6); PG8_BAR; PG8_MMA(1, 1, At, B1); PG8_BAR;
        }
        {
            const int row0 = cur.pm * 256 + wr * 64 + fr, col0 = cur.pn * 256 + wc * 32 + 4 * fq;
#pragma unroll
            for (int ai = 0; ai < 2; ++ai)
#pragma unroll
                for (int m = 0; m < 4; ++m)
#pragma unroll
                    for (int bj = 0; bj < 2; ++bj)
#pragma unroll
                        for (int n = 0; n < 2; ++n) E.elem4(row0 + ai * 128 + m * 16, col0 + bj * 128 + n * 16, acc[ai][bj][m][n]);
        }
        if (!has_next) break;
#pragma unroll
        for (int a = 0; a < 2; ++a)
#pragma unroll
            for (int b = 0; b < 2; ++b)
#pragma unroll
                for (int m = 0; m < 4; ++m)
#pragma unroll
                    for (int n = 0; n < 2; ++n) acc[a][b][m][n] = (f32x4){0.f, 0.f, 0.f, 0.f};
        cur = nxt; cA = nA; cB = nB; ++ui;
    }
    PG8_WAIT_V(0);
    if (wr == 0) PG8_BAR;
    PG8_BAR;
    }
#undef PG8_SA
#undef PG8_SB
#undef PG8_STAGE
#undef PG8_LDA
#undef PG8_LDB
#undef PG8_MMA
#undef PG8_WAIT_V
#undef PG8_WAIT_L
#undef PG8_BAR
#undef PG8_SCHED
    __syncthreads();
}
#endif

struct EpiStoreBf16 {
    bf16_t* O; int ldc;
    __device__ __forceinline__ void elem4(int row, int col, f32x4 v) const {
        u32x2 w; w.x = pk2(v[0], v[1]); w.y = pk2(v[2], v[3]);
        *(u32x2*)(O + (size_t)row * ldc + col) = w;
    }
};
template <bool ACCUM> struct EpiGate {
    bf16_t* MG; const bf16_t* Z; int gcol;
    __device__ __forceinline__ void elem4(int row, int col, f32x4 v) const {
        const u32x2 gz = *(const u32x2*)(Z + (size_t)row * ZLD + gcol + col);
        float o0 = sigmoidf_(bf2f(gz.x & 0xffffu)) * v[0], o1 = sigmoidf_(bf2f(gz.x >> 16)) * v[1], o2 = sigmoidf_(bf2f(gz.y & 0xffffu)) * v[2], o3 = sigmoidf_(bf2f(gz.y >> 16)) * v[3];
        bf16_t* p = MG + (size_t)row * D + col;
        if (ACCUM) { const u32x2 old = *(const u32x2*)p; o0 += bf2f(old.x & 0xffffu); o1 += bf2f(old.x >> 16); o2 += bf2f(old.y & 0xffffu); o3 += bf2f(old.y >> 16); }
        u32x2 w; w.x = pk2(o0, o1); w.y = pk2(o2, o3); *(u32x2*)p = w;
    }
};
struct EpiResid {
    float* X; const float* modg;
    __device__ __forceinline__ void elem4(int row, int col, f32x4 v) const {
        const int mj = row < NCTX ? 16 : ((row - NCTX) >> 11);
        const f32x4 gv = *(const f32x4*)(modg + (size_t)mj * NMOD + col);
        f32x4* p = (f32x4*)(X + (size_t)row * D + col);
        f32x4 x = *p; x[0] += gv[0] * v[0]; x[1] += gv[1] * v[1]; x[2] += gv[2] * v[2]; x[3] += gv[3] * v[3]; *p = x;
    }
};
struct EpiSwiGLU {
    bf16_t* HID;
    __device__ __forceinline__ void elem4(int row, int col, f32x4 v) const {
        *(unsigned*)(HID + (size_t)row * DFF + (col >> 1)) = pk2(siluf_(v[0]) * v[2], siluf_(v[1]) * v[3]);
    }
};

struct Args { const float* in[32]; float* out; unsigned char* ws; int ph_lo, ph_hi; };
typedef const __attribute__((address_space(4))) Args* KArgs;
__device__ __forceinline__ KArgs kargs() { KArgs p = (KArgs)__builtin_amdgcn_kernarg_segment_ptr(); asm volatile("" : "+s"(p)); return p; }
struct Frame {
    LAS unsigned char* lds;
    int tid, lane, wave, G, bid;
    KArgs ka; float* out; unsigned char* ws;
    __device__ __forceinline__ const float* inp(int i) const { return ka->in[i]; }
};
__device__ __forceinline__ Frame make_frame() {
    extern __shared__ __attribute__((aligned(16))) unsigned char lds_raw[];
    Frame F; F.lds = (LAS unsigned char*)lds_raw; { int t = threadIdx.x; asm volatile("" : "+v"(t)); F.tid = t; } F.lane = F.tid & 63; F.wave = __builtin_amdgcn_readfirstlane(F.tid >> 6);
    { int g_ = gridDim.x, b_ = blockIdx.x; asm volatile("" : "+s"(g_), "+s"(b_)); F.G = g_; F.bid = b_; } F.ka = kargs(); F.out = F.ka->out; F.ws = F.ka->ws; return F;
}
#define IN_X 0
#define IN_C 1
#define IN_CTX 2
#define IN_CCTX 3
#define IN_WMOD 4
#define IN_BMOD 5
#define IN_N1G 6
#define IN_N2G 7
#define IN_WIN 8
#define IN_SHMU 9
#define IN_CONVW 10
#define IN_WUP 11
#define IN_W0 12
#define IN_AUP 13
#define IN_A0 14
#define IN_GUP 15
#define IN_KK 16
#define IN_KA 17
#define IN_RK 18
#define IN_LNG 19
#define IN_LNB 20
#define IN_WAO 21
#define IN_WBO 22
#define IN_WO 23
#define IN_RG 24
#define IN_RGB 25
#define IN_RE 26
#define IN_REB 27
#define IN_W1 28
#define IN_W3 29
#define IN_W2 30
#define IN_FG 31

__device__ __forceinline__ void phase_prologue() {
    Frame F = make_frame();
    {
        const f32x4* sc = (const f32x4*)F.inp(IN_CTX); const f32x4* sx = (const f32x4*)F.inp(IN_X); f32x4* X = (f32x4*)(F.ws + WS_X);
        const size_t n4c = (size_t)NCTX * D / 4, n4 = (size_t)NT * D / 4;
        for (size_t i = (size_t)F.bid * 512 + F.tid; i < n4; i += (size_t)F.G * 512) X[i] = i < n4c ? sc[i] : sx[i - n4c];
    }
    if (F.bid * 512 < DEPTH * NMOD) {
        LAS float* st = (LAS float*)F.lds;
        for (int i = F.tid; i < 17 * 1024; i += 512) { const int j = i >> 10, k = i & 1023; const float cv = j < 16 ? F.inp(IN_C)[j * 1024 + k] : F.inp(IN_CCTX)[k]; st[k * 20 + j] = siluf_(cv); }
        __syncthreads();
        for (int cidx = F.bid * 512 + F.tid; cidx < DEPTH * NMOD; cidx += F.G * 512) {
            const int l = cidx / NMOD, n = cidx % NMOD;
            const float* w = F.inp(IN_WMOD) + (size_t)l * D * NMOD + n;
            float acc[17]; const float b = F.inp(IN_BMOD)[l * NMOD + n];
#pragma unroll
            for (int j = 0; j < 17; ++j) acc[j] = b;
#pragma unroll 4
            for (int k = 0; k < 1024; ++k) {
                const float wv = w[(size_t)k * NMOD];
#pragma unroll
                for (int j = 0; j < 17; ++j) acc[j] = fmaf(st[k * 20 + j], wv, acc[j]);
            }
            float* mod = (float*)(F.ws + WS_MOD) + (size_t)l * 17 * NMOD + n;
#pragma unroll
            for (int j = 0; j < 17; ++j) mod[(size_t)j * NMOD] = acc[j];
        }
        __syncthreads();
    }
}

__device__ __forceinline__ void conv_item(const float* src0, const float* src1, int ldsrc, int nvalid, int mode, bf16_t* dst, int K, int item, LAS float* scr, int lane) {
    const int nkb = K / 64, kb = item % nkb, jb = item / nkb, k0 = 64 * kb, j0 = 32 * jb;
    const int jj = j0 + (lane & 31);
    const float* colp;
    if (mode == 0) colp = jj < nvalid ? src0 + jj : nullptr;
    else colp = ((jj & 2) ? src1 : src0) + 2 * (jj >> 2) + (jj & 1);
#pragma unroll 8
    for (int i = 0; i < 32; ++i) { const int kk = 2 * i + (lane >> 5); scr[kk * 33 + (lane & 31)] = colp ? colp[(size_t)(k0 + kk) * ldsrc] : 0.f; }
    asm volatile("s_waitcnt lgkmcnt(0)" ::: "memory");
    const int c = lane & 7;
#pragma unroll
    for (int j = 0; j < 4; ++j) { const int n = (lane >> 3) + 8 * j; const LAS float* s = scr + (8 * c) * 33 + n;
        u32x4 o; o.x = pk2(s[0 * 33], s[1 * 33]); o.y = pk2(s[2 * 33], s[3 * 33]); o.z = pk2(s[4 * 33], s[5 * 33]); o.w = pk2(s[6 * 33], s[7 * 33]);
        *(u32x4*)(dst + (size_t)(j0 + n) * K + k0 + 8 * c) = o; }
    asm volatile("s_waitcnt lgkmcnt(0)" ::: "memory");
}
__device__ __forceinline__ void convert_layer_weights(Frame& F, int l) {
    LAS float* scr = (LAS float*)(F.lds + F.wave * 8704);
    const int gw = F.bid * 8 + F.wave, NGW = F.G * 8;
    constexpr int I_IN = (1024 / 64) * (ZLD / 32), I_A = (512 / 64) * (1024 / 32), I_O = (1024 / 64) * (1024 / 32), I_13 = (1024 / 64) * (1024 / 32), I_2 = (512 / 64) * (1024 / 32);
    constexpr int NITEMS = I_IN + 2 * I_A + I_O + NE * I_13 + NE * I_2;
    for (int it = gw; it < NITEMS; it += NGW) {
        int r = it;
        if (r < I_IN) { conv_item(F.inp(IN_WIN) + (size_t)l * D * NIN, nullptr, NIN, NIN, 0, (bf16_t*)(F.ws + WS_WIN), 1024, r, scr, F.lane); continue; } r -= I_IN;
        if (r < I_A) { conv_item(F.inp(IN_WAO) + (size_t)l * DH * D, nullptr, D, D, 0, (bf16_t*)(F.ws + WS_WA), 512, r, scr, F.lane); continue; } r -= I_A;
        if (r < I_A) { conv_item(F.inp(IN_WBO) + (size_t)l * DH * D, nullptr, D, D, 0, (bf16_t*)(F.ws + WS_WB), 512, r, scr, F.lane); continue; } r -= I_A;
        if (r < I_O) { conv_item(F.inp(IN_WO) + (size_t)l * D * D, nullptr, D, D, 0, (bf16_t*)(F.ws + WS_WO), 1024, r, scr, F.lane); continue; } r -= I_O;
        if (r < NE * I_13) { const int e = r / I_13, ri = r % I_13; const size_t so = ((size_t)l * NE + e) * D * DFF;
            conv_item(F.inp(IN_W1) + so, F.inp(IN_W3) + so, DFF, 0, 1, (bf16_t*)(F.ws + WS_W13) + (size_t)e * 1024 * 1024, 1024, ri, scr, F.lane); continue; } r -= NE * I_13;
        { const int e = r / I_2, ri = r % I_2; const size_t so = ((size_t)l * NE + e) * DFF * D;
            conv_item(F.inp(IN_W2) + so, nullptr, D, D, 0, (bf16_t*)(F.ws + WS_W2) + (size_t)e * 1024 * 512, 512, ri, scr, F.lane); }
    }
}

__device__ __forceinline__ void phase_norm1(int l) {
    asm volatile("" : "+s"(l)); Frame F = make_frame();
    convert_layer_weights(F, l);
    const int gw = F.bid * 8 + F.wave, NGW = F.G * 8;
    const float* X = (const float*)(F.ws + WS_X); bf16_t* H = (bf16_t*)((unsigned char*)F.out + DO_H);
    const float* g1n = F.inp(IN_N1G) + l * D;
    for (int row = gw; row < NT; row += NGW) {
        const int mj = row < NCTX ? 16 : ((row - NCTX) >> 11);
        const float* mod = (const float*)(F.ws + WS_MOD) + ((size_t)l * 17 + mj) * NMOD;
        f32x4 v[4]; float ss = 0.f;
#pragma unroll
        for (int j = 0; j < 4; ++j) { v[j] = *(const f32x4*)(X + (size_t)row * D + 4 * F.lane + 256 * j); ss += v[j][0] * v[j][0] + v[j][1] * v[j][1] + v[j][2] * v[j][2] + v[j][3] * v[j][3]; }
        const float rs = rsqrtf(wave_sum(ss) * (1.0f / D) + NORM_EPS);
#pragma unroll
        for (int j = 0; j < 4; ++j) {
            const int c = 4 * F.lane + 256 * j;
            const f32x4 gg = *(const f32x4*)(g1n + c), sh = *(const f32x4*)(mod + c), sc = *(const f32x4*)(mod + 1024 + c);
            float o[4];
#pragma unroll
            for (int q = 0; q < 4; ++q) o[q] = v[j][q] * rs * gg[q] * (1.0f + sc[q]) + sh[q];
            u32x2 w; w.x = pk2(o[0], o[1]); w.y = pk2(o[2], o[3]);
            *(u32x2*)(H + (size_t)row * D + c) = w;
        }
    }
}

__device__ __forceinline__ float shifted(const bf16_t* Z, int row, int tseq, int T, int col, float mu) {
    const bf16_t* p = Z + (size_t)row * ZLD + ZC_RW + col;
    const float z = bf2f(p[0]);
    const float zm = tseq > 0 ? bf2f(p[-ZLD]) : 0.f;
    const float zp = tseq < T - 1 ? bf2f(p[ZLD]) : 0.f;
    return z + mu * (0.5f * (zm + zp) - z);
}
constexpr int PTT = 16;
__device__ __forceinline__ void phase_prep(int l) {
    asm volatile("" : "+s"(l)); Frame F = make_frame();
    LAS float* act = (LAS float*)F.lds;
    const bf16_t* Z = (const bf16_t*)(F.ws + WS_Z);
    const float* mu = F.inp(IN_SHMU) + l * RWC;
    const int n = F.tid, h = n >> 6;
    const float kkw = F.inp(IN_KK)[l * DH + n], kaw = F.inp(IN_KA)[l * DH + n], rkw = F.inp(IN_RK)[l * DH + n];
    const float w0f = F.inp(IN_W0)[(l * 2 + 0) * DH + n], w0b = F.inp(IN_W0)[(l * 2 + 1) * DH + n];
    const float a0f = F.inp(IN_A0)[(l * 2 + 0) * DH + n], a0b = F.inp(IN_A0)[(l * 2 + 1) * DH + n];
    const float* wupf = F.inp(IN_WUP) + (size_t)(l * 2 + 0) * 64 * DH + n; const float* wupb = F.inp(IN_WUP) + (size_t)(l * 2 + 1) * 64 * DH + n;
    const float* aupf = F.inp(IN_AUP) + (size_t)(l * 2 + 0) * 64 * DH + n; const float* aupb = F.inp(IN_AUP) + (size_t)(l * 2 + 1) * 64 * DH + n;
    const float* gup = F.inp(IN_GUP) + (size_t)l * 128 * DH + n;
    const float mur = mu[n], muk = mu[512 + n], muv = mu[1024 + n];
    bf16_t* R = (bf16_t*)(F.ws + WS_R); bf16_t* V = (bf16_t*)(F.ws + WS_V); bf16_t* KKo = (bf16_t*)(F.ws + WS_KK);
    bf16_t* LW0 = (bf16_t*)(F.ws + WS_LW0); bf16_t* LW1 = (bf16_t*)(F.ws + WS_LW1); bf16_t* KD0 = (bf16_t*)(F.ws + WS_KD0); bf16_t* KD1 = (bf16_t*)(F.ws + WS_KD1);
    bf16_t* B0 = (bf16_t*)(F.ws + WS_B0); bf16_t* B1 = (bf16_t*)(F.ws + WS_B1); bf16_t* Go = (bf16_t*)((unsigned char*)F.out + DO_G);
    float* BON = (float*)(F.ws + WS_BONUS);
    for (int tile = F.bid; tile < NT / PTT; tile += F.G) {
        const int row0 = tile * PTT;
        const bool isctx = row0 < NCTX; const int T = isctx ? CTXL : SEQ; const int t0 = isctx ? (row0 & (CTXL - 1)) : ((row0 - NCTX) & (SEQ - 1));
        __syncthreads();
        for (int idx = F.tid; idx < PTT * 384; idx += 512) {
            const int t = idx / 384, j = idx % 384;
            const float zs = shifted(Z, row0 + t, t0 + t, T, 1536 + j, mu[1536 + j]);
            act[idx] = j < 128 ? tanhf(zs) : (j < 256 ? zs : sigmoidf_(zs));
        }
        __syncthreads();
        float lwf[PTT], lwb[PTT], af[PTT], ab[PTT], gv[PTT];
#pragma unroll
        for (int t = 0; t < PTT; ++t) { lwf[t] = w0f; lwb[t] = w0b; af[t] = a0f; ab[t] = a0b; gv[t] = 0.f; }
        for (int j = 0; j < 64; ++j) {
            const float u0 = wupf[(size_t)j * DH], u1 = wupb[(size_t)j * DH], u2 = aupf[(size_t)j * DH], u3 = aupb[(size_t)j * DH];
#pragma unroll
            for (int t = 0; t < PTT; ++t) { lwf[t] = fmaf(act[t * 384 + j], u0, lwf[t]); lwb[t] = fmaf(act[t * 384 + 64 + j], u1, lwb[t]); af[t] = fmaf(act[t * 384 + 128 + j], u2, af[t]); ab[t] = fmaf(act[t * 384 + 192 + j], u3, ab[t]); }
        }
        for (int j = 0; j < 128; ++j) {
            const float u = gup[(size_t)j * DH];
#pragma unroll
            for (int t = 0; t < PTT; ++t) gv[t] = fmaf(act[t * 384 + 256 + j], u, gv[t]);
        }
#pragma unroll
        for (int t = 0; t < PTT; ++t) {
            const int row = row0 + t;
            const float r = shifted(Z, row, t0 + t, T, n, mur), k = shifted(Z, row, t0 + t, T, 512 + n, muk), v = shifted(Z, row, t0 + t, T, 1024 + n, muv);
            const float ku = k * kkw;
            const float ss = wave_sum(ku * ku);
            const float kk = ku * rsqrtf(ss + 1e-12f);
            float bon = 0.f;
            const size_t o = (size_t)row * DH + n;
            {
                const float x = -lwf[t];
                const float wl = -(fmaxf(x, 0.f) + log1pf(__expf(-fabsf(x)))) - 0.5f;
                const float a = sigmoidf_(af[t]);
                const float kd = k * (1.0f + (a - 1.0f) * kaw);
                LW0[o] = (bf16_t)f2bf(-__expf(wl)); KD0[o] = (bf16_t)f2bf(kd); B0[o] = (bf16_t)f2bf(kk * a);
                bon += r * kd * rkw;
            }
            {
                const float x = -lwb[t];
                const float wl = -(fmaxf(x, 0.f) + log1pf(__expf(-fabsf(x)))) - 0.5f;
                const float a = sigmoidf_(ab[t]);
                const float kd = k * (1.0f + (a - 1.0f) * kaw);
                LW1[o] = (bf16_t)f2bf(-__expf(wl)); KD1[o] = (bf16_t)f2bf(kd); B1[o] = (bf16_t)f2bf(kk * a);
                bon += r * kd * rkw;
            }
            bon = wave_sum(bon);
            R[o] = (bf16_t)f2bf(r); V[o] = (bf16_t)f2bf(v); KKo[o] = (bf16_t)f2bf(kk); Go[o] = (bf16_t)f2bf(gv[t]);
            if (F.lane == 0) BON[(size_t)row * 8 + h] = bon;
        }
    }
    __syncthreads();
}

struct ScanIn { u32x4 kk, lw, kd, b, r; unsigned short v; };
__device__ __forceinline__ int scan_row(int b, int dir, int i) {
    if (i < CTXL) return b * CTXL + (dir ? CTXL - 1 - i : i);
    const int j = i - CTXL; return NCTX + b * SEQ + (dir ? SEQ - 1 - j : j);
}
__device__ __forceinline__ void unpack8(const u32x4 p, float (&o)[8]) {
#pragma unroll
    for (int j = 0; j < 4; ++j) { o[2 * j] = bf2f(p[j] & 0xffffu); o[2 * j + 1] = bf2f(p[j] >> 16); }
}
__device__ __forceinline__ void phase_scan(int l) {
    asm volatile("" : "+s"(l)); Frame F = make_frame();
    const int v = F.tid >> 3, kg = F.tid & 7;
    const bf16_t* R = (const bf16_t*)(F.ws + WS_R); const bf16_t* V = (const bf16_t*)(F.ws + WS_V); const bf16_t* KK = (const bf16_t*)(F.ws + WS_KK);
    for (int task = F.bid; task < NBATCH * 8 * 2; task += F.G) {
        const int dir = task & 1, h = (task >> 1) & 7, b = task >> 4;
        const bf16_t* LW = (const bf16_t*)(F.ws + (dir ? WS_LW1 : WS_LW0)); const bf16_t* KD = (const bf16_t*)(F.ws + (dir ? WS_KD1 : WS_KD0)); const bf16_t* Bm = (const bf16_t*)(F.ws + (dir ? WS_B1 : WS_B0));
        bf16_t* Y = (bf16_t*)(F.ws + (dir ? WS_Y1 : WS_Y0));
        float S[8];
#pragma unroll
        for (int j = 0; j < 8; ++j) S[j] = 0.f;
        const int NSTEP = CTXL + SEQ;
        ScanIn nx;
        { const size_t o = (size_t)scan_row(b, dir, 0) * DH + 64 * h; nx.kk = *(const u32x4*)(KK + o + 8 * kg); nx.lw = *(const u32x4*)(LW + o + 8 * kg); nx.kd = *(const u32x4*)(KD + o + 8 * kg); nx.b = *(const u32x4*)(Bm + o + 8 * kg); nx.r = *(const u32x4*)(R + o + 8 * kg); nx.v = V[o + v]; }
        for (int i = 0; i < NSTEP; ++i) {
            const ScanIn cu = nx;
            const int row = scan_row(b, dir, i);
            if (i + 1 < NSTEP) { const size_t o = (size_t)scan_row(b, dir, i + 1) * DH + 64 * h; nx.kk = *(const u32x4*)(KK + o + 8 * kg); nx.lw = *(const u32x4*)(LW + o + 8 * kg); nx.kd = *(const u32x4*)(KD + o + 8 * kg); nx.b = *(const u32x4*)(Bm + o + 8 * kg); nx.r = *(const u32x4*)(R + o + 8 * kg); nx.v = V[o + v]; }
            float kk[8], lw[8], kd[8], bb[8], rr[8];
            unpack8(cu.kk, kk); unpack8(cu.lw, lw); unpack8(cu.kd, kd); unpack8(cu.b, bb); unpack8(cu.r, rr);
            const float vv = bf2f(cu.v);
            float sa = 0.f;
#pragma unroll
            for (int j = 0; j < 8; ++j) sa = fmaf(S[j], kk[j], sa);
            sa += __shfl_xor(sa, 1); sa += __shfl_xor(sa, 2); sa += __shfl_xor(sa, 4);
            float y = 0.f;
#pragma unroll
            for (int j = 0; j < 8; ++j) { S[j] = S[j] * __expf(lw[j]) - sa * bb[j] + vv * kd[j]; y = fmaf(S[j], rr[j], y); }
            y += __shfl_xor(y, 1); y += __shfl_xor(y, 2); y += __shfl_xor(y, 4);
            if (kg == 0) Y[(size_t)row * DH + 64 * h + v] = (bf16_t)f2bf(y);
        }
    }
}

__device__ __forceinline__ void phase_mix(int l) {
    asm volatile("" : "+s"(l)); Frame F = make_frame();
    const int n = F.tid;
    const bf16_t* Z = (const bf16_t*)(F.ws + WS_Z);
    const float* cw = F.inp(IN_CONVW) + (size_t)l * 3 * DH;
    const float cw0 = cw[n], cw1 = cw[DH + n], cw2 = cw[2 * DH + n];
    const float lg = F.inp(IN_LNG)[l * DH + n], lb = F.inp(IN_LNB)[l * DH + n];
    const bf16_t* Y0 = (const bf16_t*)(F.ws + WS_Y0); const bf16_t* Y1 = (const bf16_t*)(F.ws + WS_Y1); const bf16_t* V = (const bf16_t*)(F.ws + WS_V);
    const bf16_t* Gi = (const bf16_t*)((unsigned char*)F.out + DO_G); const float* BON = (const float*)(F.ws + WS_BONUS);
    bf16_t* UA = (bf16_t*)(F.ws + WS_UA); bf16_t* UB = (bf16_t*)(F.ws + WS_UB);
    for (int row = F.bid; row < NT; row += F.G) {
        int delta; bool hasp, hasn;
        if (row < NCTX) { const int t = row & (CTXL - 1); delta = 1; hasp = t > 0; hasn = t < CTXL - 1; }
        else { const int s = (row - NCTX) & (SEQ - 1);
            if (n < 256) { const int gc = s & 63; delta = 1; hasp = gc > 0; hasn = gc < 63; }
            else { const int gr = s >> 6; delta = 64; hasp = gr > 0; hasn = gr < 31; } }
        const bf16_t* zr = Z + (size_t)row * ZLD;
        const float u0 = bf2f(zr[ZC_CG + n]) * bf2f(zr[ZC_HA + n]);
        const float um = hasp ? bf2f(zr[ZC_CG + n - (ptrdiff_t)delta * ZLD]) * bf2f(zr[ZC_HA + n - (ptrdiff_t)delta * ZLD]) : 0.f;
        const float up = hasn ? bf2f(zr[ZC_CG + n + (ptrdiff_t)delta * ZLD]) * bf2f(zr[ZC_HA + n + (ptrdiff_t)delta * ZLD]) : 0.f;
        const float cv = um * cw0 + u0 * cw1 + up * cw2;
        const size_t o = (size_t)row * DH + n;
        UA[o] = (bf16_t)f2bf(bf2f(zr[ZC_BG + n]) * cv);
        const float y = bf2f(Y0[o]) + bf2f(Y1[o]);
        const float mu = wave_sum(y) * (1.0f / 64.0f); const float dv = y - mu; const float var = wave_sum(dv * dv) * (1.0f / 64.0f);
        const float yn = dv * rsqrtf(var + GN_EPS) * lg + lb;
        const float bon = BON[(size_t)row * 8 + (n >> 6)];
        UB[o] = (bf16_t)f2bf((yn + bon * bf2f(V[o])) * bf2f(Gi[o]));
    }
}

__device__ __forceinline__ void phase_norm2(int l) {
    asm volatile("" : "+s"(l)); Frame F = make_frame();
    const int gw = F.bid * 8 + F.wave, NGW = F.G * 8;
    const float* X = (const float*)(F.ws + WS_X); bf16_t* H = (bf16_t*)((unsigned char*)F.out + DO_H);
    const float* g2n = F.inp(IN_N2G) + l * D;
    const float* rgw = F.inp(IN_RG) + (size_t)l * D * 4; const float* rgb = F.inp(IN_RGB) + l * 4;
    const float* rew = F.inp(IN_RE) + (size_t)l * D * NE; const float* reb = F.inp(IN_REB) + l * NE;
    int* RE = (int*)(F.ws + WS_RE); float* RG = (float*)(F.ws + WS_RG); int* RP = (int*)(F.ws + WS_RP);
    unsigned* CNT = (unsigned*)(F.ws + WS_CTL) + CW_CNT + l * 64;
    for (int row = gw; row < NT; row += NGW) {
        const int mj = row < NCTX ? 16 : ((row - NCTX) >> 11);
        const float* mod = (const float*)(F.ws + WS_MOD) + ((size_t)l * 17 + mj) * NMOD;
        f32x4 v[4]; float ss = 0.f;
#pragma unroll
        for (int j = 0; j < 4; ++j) { v[j] = *(const f32x4*)(X + (size_t)row * D + 4 * F.lane + 256 * j); ss += v[j][0] * v[j][0] + v[j][1] * v[j][1] + v[j][2] * v[j][2] + v[j][3] * v[j][3]; }
        const float rs = rsqrtf(wave_sum(ss) * (1.0f / D) + NORM_EPS);
        float hv[16]; float pg[4] = {0.f, 0.f, 0.f, 0.f};
#pragma unroll
        for (int j = 0; j < 4; ++j) {
            const int c = 4 * F.lane + 256 * j;
            const f32x4 gg = *(const f32x4*)(g2n + c), sh = *(const f32x4*)(mod + 3072 + c), sc = *(const f32x4*)(mod + 4096 + c);
#pragma unroll
            for (int q = 0; q < 4; ++q) { const float o = v[j][q] * rs * gg[q] * (1.0f + sc[q]) + sh[q]; hv[4 * j + q] = o;
                const f32x4 rw = *(const f32x4*)(rgw + (size_t)(c + q) * 4); pg[0] = fmaf(o, rw[0], pg[0]); pg[1] = fmaf(o, rw[1], pg[1]); pg[2] = fmaf(o, rw[2], pg[2]); pg[3] = fmaf(o, rw[3], pg[3]); }
            u32x2 w; w.x = pk2(hv[4 * j], hv[4 * j + 1]); w.y = pk2(hv[4 * j + 2], hv[4 * j + 3]);
            *(u32x2*)(H + (size_t)row * D + c) = w;
        }
        float lgv[4];
#pragma unroll
        for (int g = 0; g < 4; ++g) lgv[g] = wave_sum(pg[g]) + rgb[g];
        int gs = 0; float lmax = lgv[0];
#pragma unroll
        for (int g = 1; g < 4; ++g) if (lgv[g] > lmax) { lmax = lgv[g]; gs = g; }
        float den = 0.f;
#pragma unroll
        for (int g = 0; g < 4; ++g) den += __expf(lgv[g] - lmax);
        const float pgmax = 1.0f / den;
        float pe[8] = {0.f, 0.f, 0.f, 0.f, 0.f, 0.f, 0.f, 0.f};
#pragma unroll
        for (int j = 0; j < 4; ++j)
#pragma unroll
            for (int q = 0; q < 4; ++q) { const int k = 4 * F.lane + 256 * j + q; const float o = hv[4 * j + q];
                const f32x4 r0 = *(const f32x4*)(rew + (size_t)k * NE + gs * 8), r1 = *(const f32x4*)(rew + (size_t)k * NE + gs * 8 + 4);
                pe[0] = fmaf(o, r0[0], pe[0]); pe[1] = fmaf(o, r0[1], pe[1]); pe[2] = fmaf(o, r0[2], pe[2]); pe[3] = fmaf(o, r0[3], pe[3]);
                pe[4] = fmaf(o, r1[0], pe[4]); pe[5] = fmaf(o, r1[1], pe[5]); pe[6] = fmaf(o, r1[2], pe[6]); pe[7] = fmaf(o, r1[3], pe[7]); }
        float le[8];
#pragma unroll
        for (int e = 0; e < 8; ++e) le[e] = wave_sum(pe[e]) + reb[gs * 8 + e];
        int i1 = 0; float m1 = le[0];
#pragma unroll
        for (int e = 1; e < 8; ++e) if (le[e] > m1) { m1 = le[e]; i1 = e; }
        int i2 = -1; float m2 = -3.0e38f;
#pragma unroll
        for (int e = 0; e < 8; ++e) if (e != i1 && le[e] > m2) { m2 = le[e]; i2 = e; }
        const float dd = __expf(m2 - m1);
        const float gate1 = pgmax / (1.0f + dd), gate2 = pgmax * dd / (1.0f + dd);
        if (F.lane == 0) {
            const int e1 = gs * 8 + i1, e2 = gs * 8 + i2;
            const unsigned p1 = atomicAdd(CNT + e1, 1u), p2 = atomicAdd(CNT + e2, 1u);
            RE[2 * row] = e1; RE[2 * row + 1] = e2; RG[2 * row] = gate1; RG[2 * row + 1] = gate2; RP[2 * row] = (int)p1; RP[2 * row + 1] = (int)p2;
        }
    }
}

__device__ __forceinline__ void moe_tables(Frame& F, int l) {
    LAS int* seg = (LAS int*)(F.lds + LC_SEG); LAS int* cnts = (LAS int*)(F.lds + LC_CNTS); LAS int* tile_e = (LAS int*)(F.lds + LC_TILEE);
    const unsigned* CNT = (const unsigned*)(F.ws + WS_CTL) + CW_CNT + l * 64;
    __syncthreads();
    if (F.tid == 0) {
        int s = 0;
#pragma unroll 1
        for (int e = 0; e < NE; ++e) { const int c = (int)__hip_atomic_load(CNT + e, __ATOMIC_RELAXED, __HIP_MEMORY_SCOPE_AGENT); cnts[e] = c; seg[e] = s; const int nt = (c + 255) >> 8;
#pragma unroll 1
            for (int t = 0; t < nt; ++t) tile_e[(s >> 8) + t] = e;
            s += nt << 8; }
        seg[32] = s; seg[33] = s >> 8;
    }
    __syncthreads();
}
__device__ __forceinline__ void phase_dispatch(int l) {
    asm volatile("" : "+s"(l)); Frame F = make_frame();
    moe_tables(F, l);
    const LAS int* seg = (const LAS int*)(F.lds + LC_SEG); const LAS int* cnts = (const LAS int*)(F.lds + LC_CNTS);
    const int gw = F.bid * 8 + F.wave, NGW = F.G * 8;
    const int* RE = (const int*)(F.ws + WS_RE); const int* RP = (const int*)(F.ws + WS_RP); int* RS = (int*)(F.ws + WS_RS);
    const bf16_t* H = (const bf16_t*)((unsigned char*)F.out + DO_H); bf16_t* XS = (bf16_t*)(F.ws + WS_XS);
    for (int item = gw; item < NT * 2; item += NGW) {
        const int row = item >> 1; const int e = RE[item], pos = RP[item]; const int slot = seg[e] + pos;
        if (F.lane == 0) RS[item] = slot;
        const u32x4* src = (const u32x4*)(H + (size_t)row * D); u32x4* dst = (u32x4*)(XS + (size_t)slot * D);
        dst[F.lane] = src[F.lane]; dst[64 + F.lane] = src[64 + F.lane];
    }
#pragma unroll 1
    for (int e = 0; e < NE; ++e) {
        const int c = cnts[e], padded = (c + 255) & ~255;
        for (int p = c + gw; p < padded; p += NGW) { u32x4* dst = (u32x4*)(XS + (size_t)(seg[e] + p) * D); dst[F.lane] = (u32x4){0u, 0u, 0u, 0u}; dst[64 + F.lane] = (u32x4){0u, 0u, 0u, 0u}; }
    }
}

__device__ __forceinline__ void phase_combine(int l) {
    asm volatile("" : "+s"(l)); Frame F = make_frame();
    const int gw = F.bid * 8 + F.wave, NGW = F.G * 8;
    float* X = (float*)(F.ws + WS_X); const bf16_t* YS = (const bf16_t*)(F.ws + WS_YS);
    const int* RS = (const int*)(F.ws + WS_RS); const float* RG = (const float*)(F.ws + WS_RG);
    for (int row = gw; row < NT; row += NGW) {
        const int mj = row < NCTX ? 16 : ((row - NCTX) >> 11);
        const float* g2 = (const float*)(F.ws + WS_MOD) + ((size_t)l * 17 + mj) * NMOD + 5120;
        const int s0 = RS[2 * row], s1 = RS[2 * row + 1]; const float ga = RG[2 * row], gb = RG[2 * row + 1];
#pragma unroll
        for (int j = 0; j < 4; ++j) {
            const int c = 4 * F.lane + 256 * j;
            const u32x2 y0 = *(const u32x2*)(YS + (size_t)s0 * D + c), y1 = *(const u32x2*)(YS + (size_t)s1 * D + c);
            const f32x4 gg = *(const f32x4*)(g2 + c);
            f32x4* p = (f32x4*)(X + (size_t)row * D + c); f32x4 x = *p;
            x[0] += gg[0] * (ga * bf2f(y0.x & 0xffffu) + gb * bf2f(y1.x & 0xffffu));
            x[1] += gg[1] * (ga * bf2f(y0.x >> 16) + gb * bf2f(y1.x >> 16));
            x[2] += gg[2] * (ga * bf2f(y0.y & 0xffffu) + gb * bf2f(y1.y & 0xffffu));
            x[3] += gg[3] * (ga * bf2f(y0.y >> 16) + gb * bf2f(y1.y >> 16));
            *p = x;
        }
    }
}

__device__ __forceinline__ void phase_final() {
    Frame F = make_frame();
    const int gw = F.bid * 8 + F.wave, NGW = F.G * 8;
    const float* X = (const float*)(F.ws + WS_X); const float* fg = F.inp(IN_FG);
    for (int r = gw; r < NLAT; r += NGW) {
        const float* xr = X + (size_t)(NCTX + r) * D;
        f32x4 v[4]; float ss = 0.f;
#pragma unroll
        for (int j = 0; j < 4; ++j) { v[j] = *(const f32x4*)(xr + 4 * F.lane + 256 * j); ss += v[j][0] * v[j][0] + v[j][1] * v[j][1] + v[j][2] * v[j][2] + v[j][3] * v[j][3]; }
        const float rs = rsqrtf(wave_sum(ss) * (1.0f / D) + NORM_EPS);
#pragma unroll
        for (int j = 0; j < 4; ++j) { const int c = 4 * F.lane + 256 * j; const f32x4 gg = *(const f32x4*)(fg + c);
            f32x4 o; o[0] = v[j][0] * rs * gg[0]; o[1] = v[j][1] * rs * gg[1]; o[2] = v[j][2] * rs * gg[2]; o[3] = v[j][3] * rs * gg[3];
            *(f32x4*)(F.out + (size_t)r * D + c) = o; }
    }
}

constexpr int NPL = 13;
constexpr int NPH = 1 + DEPTH * NPL + 1;
__device__ __forceinline__ void seam() {
    Frame F = make_frame();
    XcdBarrier bar; bar.bar = (unsigned*)(F.ws + WS_CTL) + CW_BAR; bar.x = xb_xcc_id(); bar.st = (volatile LAS unsigned*)(F.lds + LC_BARW);
    xcd_barrier(bar);
}
__global__ void __launch_bounds__(512, 2) mk_fwd(Args args_unused) {
    {
        Frame F = make_frame();
        for (int u = F.tid; u < (LDS_BYTES - LDS_CTL) / 4; u += 512) ((LAS unsigned*)(F.lds + LDS_CTL))[u] = 0u;
        __syncthreads();
        if (F.ka->ph_hi - F.ka->ph_lo > 1) (void)xcd_barrier_post((unsigned*)(F.ws + WS_CTL) + CW_BAR, (volatile LAS unsigned*)(F.lds + LC_BARW));
    }
#define IN(k) (kargs()->ph_lo <= (k) && (k) < kargs()->ph_hi)
#define SEAM(k) do { if (IN(k) && IN((k) + 1)) seam(); } while (0)
    int ph = 0;
    if (PH_EN(13) && IN(ph)) phase_prologue();
    SEAM(ph); ++ph;
    for (int l = 0; l < DEPTH; ++l) {
        if (PH_EN(0) && IN(ph)) phase_norm1(l);
        SEAM(ph); ++ph;
        if (PH_EN(1) && IN(ph)) { Frame F = make_frame(); Gemm g{(const bf16_t*)((unsigned char*)F.out + DO_H), (const bf16_t*)(F.ws + WS_WIN), NT, ZLD, D, 0}; StaticOrder S; S.init(NT, ZLD, F.G, F.bid); EpiStoreBf16 E{(bf16_t*)(F.ws + WS_Z), ZLD}; gemm_phase(F.lds, g, S, E); }
        SEAM(ph); ++ph;
        if (PH_EN(2) && IN(ph)) phase_prep(l);
        SEAM(ph); ++ph;
        if (PH_EN(3) && IN(ph)) phase_scan(l);
        SEAM(ph); ++ph;
        if (PH_EN(4) && IN(ph)) phase_mix(l);
        SEAM(ph); ++ph;
        if (PH_EN(5) && IN(ph)) { Frame F = make_frame(); Gemm g{(const bf16_t*)(F.ws + WS_UA), (const bf16_t*)(F.ws + WS_WA), NT, D, DH, 0}; StaticOrder S; S.init(NT, D, F.G, F.bid); EpiGate<false> E{(bf16_t*)((unsigned char*)F.out + DO_H), (const bf16_t*)(F.ws + WS_Z), ZC_GA}; gemm_phase(F.lds, g, S, E); }
        SEAM(ph); ++ph;
        if (PH_EN(6) && IN(ph)) { Frame F = make_frame(); Gemm g{(const bf16_t*)(F.ws + WS_UB), (const bf16_t*)(F.ws + WS_WB), NT, D, DH, 0}; StaticOrder S; S.init(NT, D, F.G, F.bid); EpiGate<true> E{(bf16_t*)((unsigned char*)F.out + DO_H), (const bf16_t*)(F.ws + WS_Z), ZC_GB}; gemm_phase(F.lds, g, S, E); }
        SEAM(ph); ++ph;
        if (PH_EN(7) && IN(ph)) { int ll = l; asm volatile("" : "+s"(ll)); Frame F = make_frame(); Gemm g{(const bf16_t*)((unsigned char*)F.out + DO_H), (const bf16_t*)(F.ws + WS_WO), NT, D, D, 0}; StaticOrder S; S.init(NT, D, F.G, F.bid);
            EpiResid E{(float*)(F.ws + WS_X), (const float*)(F.ws + WS_MOD) + (size_t)ll * 17 * NMOD + 2048}; gemm_phase(F.lds, g, S, E); }
        SEAM(ph); ++ph;
        if (PH_EN(8) && IN(ph)) phase_norm2(l);
        SEAM(ph); ++ph;
        if (PH_EN(9) && IN(ph)) phase_dispatch(l);
        SEAM(ph); ++ph;
        if (PH_EN(10) && IN(ph)) { int ll = l; asm volatile("" : "+s"(ll)); Frame F = make_frame(); moe_tables(F, ll); MoeOrder S{__builtin_amdgcn_readfirstlane(((const LAS int*)(F.lds + LC_SEG))[33]), F.G, F.bid, (const LAS int*)(F.lds + LC_TILEE)};
            Gemm g{(const bf16_t*)(F.ws + WS_XS), (const bf16_t*)(F.ws + WS_W13), MAXTILES * 256, D, D, (size_t)1024 * 1024}; EpiSwiGLU E{(bf16_t*)(F.ws + WS_HID)}; gemm_phase(F.lds, g, S, E); }
        SEAM(ph); ++ph;
        if (PH_EN(11) && IN(ph)) { int ll = l; asm volatile("" : "+s"(ll)); Frame F = make_frame(); moe_tables(F, ll); MoeOrder S{__builtin_amdgcn_readfirstlane(((const LAS int*)(F.lds + LC_SEG))[33]), F.G, F.bid, (const LAS int*)(F.lds + LC_TILEE)};
            Gemm g{(const bf16_t*)(F.ws + WS_HID), (const bf16_t*)(F.ws + WS_W2), MAXTILES * 256, D, DFF, (size_t)1024 * 512}; EpiStoreBf16 E{(bf16_t*)(F.ws + WS_YS), D}; gemm_phase(F.lds, g, S, E); }
        SEAM(ph); ++ph;
        if (PH_EN(12) && IN(ph)) phase_combine(l);
        SEAM(ph); ++ph;
    }
    if (PH_EN(14) && IN(ph)) phase_final();
#undef IN
#undef SEAM
}

extern "C" void kernel_launch(void* const* d_in, const int* in_sizes, int n_in, void* d_out, int out_size, void* d_ws, size_t ws_size, hipStream_t stream) {
    static int grid = 0;
    if (grid == 0) {
        if (n_in != 32 || out_size != NLAT * D || ws_size < WS_END) { fprintf(stderr, "kernel_launch: unexpected shapes (n_in %d, out %d, ws %zu < %zu)\n", n_in, out_size, ws_size, (size_t)WS_END); grid = -1; return; }
        int dev = 0, cus = 0, per_cu = 0;
        if (hipGetDevice(&dev) != hipSuccess || hipDeviceGetAttribute(&cus, hipDeviceAttributeMultiprocessorCount, dev) != hipSuccess) { grid = -1; return; }
        if (hipFuncSetAttribute((const void*)mk_fwd, hipFuncAttributeMaxDynamicSharedMemorySize, LDS_BYTES) != hipSuccess) { fprintf(stderr, "kernel_launch: hipFuncSetAttribute failed\n"); grid = -1; return; }
        if (hipOccupancyMaxActiveBlocksPerMultiprocessor(&per_cu, (const void*)mk_fwd, 512, LDS_BYTES) != hipSuccess || per_cu < 1) { fprintf(stderr, "kernel_launch: occupancy query says %d\n", per_cu); }
        (void)hipGetLastError();
        grid = cus;
    }
    if (grid < 0) return;
    if (hipMemsetAsync((char*)d_ws + WS_CTL, 0, CTL_ZERO_BYTES, stream) != hipSuccess) return;
    Args a{};
    for (int i = 0; i < 32; ++i) a.in[i] = (const float*)d_in[i];
    a.out = (float*)d_out; a.ws = (unsigned char*)d_ws;
#if MK_ONE_LAUNCH
    a.ph_lo = 0; a.ph_hi = NPH;
    hipLaunchKernelGGL(mk_fwd, dim3(grid), dim3(512), LDS_BYTES, stream, a);
#else
    for (int p = 0; p < NPH; ++p) { a.ph_lo = p; a.ph_hi = p + 1; hipLaunchKernelGGL(mk_fwd, dim3(grid), dim3(512), LDS_BYTES, stream, a); }
#endif
}
```

```cpp
#include <hip/hip_runtime.h>
#include <cstdio>
#include <cstdint>

#ifndef MK_ONE_LAUNCH
#define MK_ONE_LAUNCH 1
#endif
#ifndef GEMM_IMPL
#define GEMM_IMPL 1
#endif

#ifndef PHASE_MASK
#define PHASE_MASK 0xffff
#endif
#define PH_EN(p) (((PHASE_MASK) >> (p)) & 1)
#ifndef DUP_MASK
#define DUP_MASK 0
#endif
#define DUP_N(p) (1 + (((DUP_MASK) >> (p)) & 1))
#define LAS __attribute__((address_space(3)))
typedef unsigned short bf16_t;
typedef short bf16x8 __attribute__((ext_vector_type(8)));
typedef float f32x4 __attribute__((ext_vector_type(4)));
typedef unsigned u32x4 __attribute__((ext_vector_type(4)));
typedef unsigned u32x2 __attribute__((ext_vector_type(2)));

constexpr int D = 1024, NBATCH = 16, SEQ = 2048, DEPTH = 4, CTXL = 256;
constexpr int NCTX = NBATCH * CTXL;
constexpr int NLAT = NBATCH * SEQ;
constexpr int NT = NCTX + NLAT;
constexpr int DH = 512;
constexpr int NIN = 5504, ZLD = 5632;
constexpr int ZC_BG = 0, ZC_CG = 512, ZC_HA = 1024, ZC_RW = 1536, ZC_GA = 3456, ZC_GB = 4480;
constexpr int RWC = 1920;
constexpr int NE = 32, DFF = 512;
constexpr int MAXTILES = 320;
constexpr int NMOD = 6 * D;
constexpr float NORM_EPS = 1e-6f, GN_EPS = 64e-5f;

constexpr size_t MiB = 1u << 20;
constexpr size_t WS_CTL = 0, CTL_ZERO_BYTES = 1 * MiB;
constexpr size_t WS_MOD = 1 * MiB;
constexpr size_t WS_RE = 3 * MiB;
constexpr size_t WS_RG = WS_RE + (size_t)NT * 8;
constexpr size_t WS_RP = WS_RG + (size_t)NT * 8;
constexpr size_t WS_RS = WS_RP + (size_t)NT * 8;
constexpr size_t WS_BH = 4 * MiB + 256 * 1024;
constexpr size_t WS_RB = 4 * MiB + 384 * 1024;
constexpr size_t WS_WC = 6 * MiB + 256 * 1024;
constexpr size_t WS_BONUS = 5 * MiB;
constexpr size_t WS_X = 8 * MiB;
constexpr size_t WS_WIN = 152 * MiB;
constexpr size_t WS_WA = 163 * MiB;
constexpr size_t WS_WB = 164 * MiB;
constexpr size_t WS_WO = 165 * MiB;
constexpr size_t WS_W13 = 167 * MiB;
constexpr size_t WS_W2 = 231 * MiB;
constexpr size_t WS_Z = 264 * MiB;
constexpr size_t WS_XS = WS_Z;
constexpr size_t WS_HID = WS_Z + 160 * MiB;
constexpr size_t WS_SI = 660 * MiB;
constexpr size_t SI_SZ = 36 * MiB;
constexpr size_t WS_R = WS_SI, WS_V = WS_SI + SI_SZ, WS_KK = WS_SI + 2 * SI_SZ, WS_LW0 = WS_SI + 3 * SI_SZ, WS_LW1 = WS_SI + 4 * SI_SZ,
                 WS_KD0 = WS_SI + 5 * SI_SZ, WS_KD1 = WS_SI + 6 * SI_SZ, WS_B0 = WS_SI + 7 * SI_SZ, WS_B1 = WS_SI + 8 * SI_SZ;
constexpr size_t WS_UA = WS_KK, WS_UB = WS_LW0;
constexpr size_t WS_YS = WS_SI;
constexpr size_t WS_Y0 = 984 * MiB, WS_Y1 = 1020 * MiB;
constexpr size_t WS_END = 1056 * MiB;
constexpr size_t DO_H = 0, DO_G = 72 * MiB;
static_assert(WS_Z + (size_t)NT * ZLD * 2 <= WS_SI && WS_HID + (size_t)MAXTILES * 256 * DFF * 2 <= WS_SI && WS_B1 + SI_SZ <= WS_Y0 && WS_YS + (size_t)MAXTILES * 256 * D * 2 <= WS_Y0, "ws map");
static_assert((size_t)NT * DH * 2 == SI_SZ && WS_X + (size_t)NT * D * 4 <= WS_WIN && WS_W2 + 32 * MiB <= WS_Z, "ws map 2");
constexpr int CW_CNT = 1024;
constexpr int CW_BAR = 4096;

constexpr int LDS_BYTES = 163840;
constexpr int LDS_CTL = 155648;
constexpr int LC_BARW = LDS_CTL;
constexpr int LC_SEG = LDS_CTL + 64;
constexpr int LC_CNTS = LDS_CTL + 256;
constexpr int LC_TILEE = LDS_CTL + 512;
constexpr int LC_BBASE = LDS_CTL + 2048;
constexpr int LC_RED = LDS_CTL + 4096;

__device__ __forceinline__ float bf2f(unsigned b) { return __uint_as_float(b << 16); }
__device__ __forceinline__ unsigned f2bf(float f) { unsigned u = __float_as_uint(f); return (u + 0x7fffu + ((u >> 16) & 1u)) >> 16; }
__device__ __forceinline__ unsigned pk2(float lo, float hi) { return f2bf(lo) | (f2bf(hi) << 16); }
__device__ __forceinline__ float wave_sum(float v) {
#pragma unroll
    for (int o = 1; o < 64; o <<= 1) v += __shfl_xor(v, o);
    return v;
}
__device__ __forceinline__ float sigmoidf_(float x) { return 1.0f / (1.0f + __expf(-x)); }
__device__ __forceinline__ float siluf_(float x) { return x / (1.0f + __expf(-x)); }

#define XB_TMO      128
#define XB_XCNT(j)  (256  + 64 * (j))
#define XB_XSUB(j)  (1280 + 64 * (j))
#define XB_XGEN(j)  (2304 + 64 * (j))
#define XB_TOP      3328
#define XB_TOPGEN   3392
#define XCD_BAR_WORDS 3456
#define XB_SPIN_CAP (1u << 22)

__device__ __forceinline__ unsigned xb_ld(unsigned* p)              { return __hip_atomic_load(p, __ATOMIC_RELAXED, __HIP_MEMORY_SCOPE_AGENT); }
__device__ __forceinline__ unsigned xb_add(unsigned* p, unsigned v) { return __hip_atomic_fetch_add(p, v, __ATOMIC_RELAXED, __HIP_MEMORY_SCOPE_AGENT); }
__device__ __forceinline__ unsigned xb_xcc_id() { return (unsigned)__builtin_amdgcn_s_getreg((3 << 11) | 20) & 0xFu; }
#define XB_SPIN(cond, bar) do { unsigned _sp = 0; while (cond) { __builtin_amdgcn_s_sleep(1); \
    if ((++_sp & 255u) == 0u) { if (xb_ld(&(bar)[XB_TMO])) break; if (_sp > XB_SPIN_CAP) { atomicAdd(&(bar)[XB_TMO], 1u); break; } } } } while (0)

struct XcdBarrier { unsigned* bar; unsigned x; volatile LAS unsigned* st; };

__device__ __forceinline__ XcdBarrier xcd_barrier_post(unsigned* bar, volatile LAS unsigned* st) {
    XcdBarrier b; b.bar = bar; b.x = xb_xcc_id(); b.st = st;
    if (threadIdx.x == 0) (void)xb_add(&bar[XB_XCNT(b.x)], 1u);
    return b;
}
__device__ __forceinline__ void xcd_barrier_complete(unsigned* bar, unsigned x, unsigned& nloc, unsigned& nx) {
    const unsigned G = gridDim.x * gridDim.y * gridDim.z;
    unsigned sum, cnt, mine, sp = 0u;
    for (;;) {
        sum = 0u; cnt = 0u; mine = 0u;
#pragma unroll
        for (unsigned j = 0; j < 16; ++j) { const unsigned c = xb_ld(&bar[XB_XCNT(j)]); sum += c; cnt += (c > 0u) ? 1u : 0u; mine = (j == x) ? c : mine; }
        if (sum == G) break;
        __builtin_amdgcn_s_sleep(1);
        if ((++sp & 255u) == 0u) { if (xb_ld(&bar[XB_TMO])) break; if (sp > XB_SPIN_CAP) { atomicAdd(&bar[XB_TMO], 1u); break; } }
    }
    nloc = mine > 0u ? mine : 1u; nx = cnt > 0u ? cnt : 1u;
}
__device__ __forceinline__ void xcd_barrier(const XcdBarrier& b) {
    asm volatile("s_waitcnt vmcnt(0)" ::: "memory");
    __syncthreads();
    if (threadIdx.x == 0) {
        unsigned* bar = b.bar;
        __builtin_amdgcn_s_waitcnt(0);
        unsigned nloc = b.st[0], nx = b.st[1];
        if (nloc == 0u) { xcd_barrier_complete(bar, b.x, nloc, nx); b.st[0] = nloc; b.st[1] = nx; }
        const unsigned old = xb_add(&bar[XB_XSUB(b.x)], 1u);
        const unsigned gen = old / nloc;
        if (old + 1u == (gen + 1u) * nloc) {
            __builtin_amdgcn_fence(__ATOMIC_RELEASE, "agent");
            asm volatile("s_waitcnt vmcnt(0)" ::: "memory");
            const unsigned og = xb_add(&bar[XB_TOP], 1u);
            const unsigned tg = og / nx;
            if (og + 1u == (tg + 1u) * nx) xb_add(&bar[XB_TOPGEN], 1u);
            else XB_SPIN(xb_ld(&bar[XB_TOPGEN]) == tg, bar);
            __builtin_amdgcn_fence(__ATOMIC_ACQUIRE, "agent");
            xb_add(&bar[XB_XGEN(b.x)], 1u);
            asm volatile("s_waitcnt vmcnt(0)" ::: "memory");
        } else {
            XB_SPIN(xb_ld(&bar[XB_XGEN(b.x)]) == gen, bar);
            __builtin_amdgcn_fence(__ATOMIC_ACQUIRE, "agent");
            asm volatile("s_waitcnt vmcnt(0)" ::: "memory");
        }
    }
    __syncthreads();
}

struct Unit { int pm, pn, bs; };
struct Gemm { const bf16_t* A; const bf16_t* Bt; int M, N, K; size_t bstride; };
constexpr int NXCD = 8, WGM = 8;
struct StaticOrder {
    int nM, nN, nwg, G, c;
    __device__ __forceinline__ void init(int M, int N, int G_, int c_) { nM = M / 256; nN = N / 256; nwg = nM * nN; G = G_; c = c_; }
    __device__ __forceinline__ bool next(int i, Unit& u) const {
        const long L = (long)i * G + c; if (L >= nwg) return false;
        int wgid = (int)L; { const int q = nwg / NXCD, r = nwg % NXCD, xcd = wgid % NXCD, off = wgid / NXCD; wgid = (xcd < r ? xcd * (q + 1) : r * (q + 1) + (xcd - r) * q) + off; }
        const int nig = WGM * nN, gid = wgid / nig, fm = gid * WGM, gsz = (nM - fm) < WGM ? (nM - fm) : WGM;
        u.pm = fm + ((wgid % nig) % gsz); u.pn = (wgid % nig) / gsz; u.bs = 0; return true;
    }
};
struct MoeOrder {
    int ntiles, G, c; const LAS int* tile_e;
    __device__ __forceinline__ bool next(int i, Unit& u) const {
        const int L = i * G + c; if (L >= ntiles * 4) return false;
        u.pm = L >> 2; u.pn = L & 3; u.bs = __builtin_amdgcn_readfirstlane(tile_e[u.pm]); return true;
    }
};

#if GEMM_IMPL == 0
template <class Epi, class Sched>
__device__ __forceinline__ void gemm_phase(LAS unsigned char* lds, const Gemm g, const Sched& S, const Epi& E) {
    LAS float* As = (LAS float*)lds;
    LAS float* Bs = As + 16 * 260;
    const int tid = threadIdx.x, ty = tid >> 4, tx = tid & 15, lr = tid >> 1, lh = tid & 1;
    Unit u;
    for (int it = 0; S.next(it, u); ++it) {
        float acc[8][16];
#pragma unroll
        for (int i = 0; i < 8; ++i)
#pragma unroll
            for (int j = 0; j < 16; ++j) acc[i][j] = 0.f;
        const bf16_t* Ap = g.A + ((size_t)u.pm * 256 + lr) * g.K + lh * 8;
        const bf16_t* Bp = g.Bt + (size_t)u.bs * g.bstride + ((size_t)u.pn * 256 + lr) * g.K + lh * 8;
        for (int k0 = 0; k0 < g.K; k0 += 16) {
            const u32x4 av = *(const u32x4*)(Ap + k0), bv = *(const u32x4*)(Bp + k0);
            __syncthreads();
#pragma unroll
            for (int j = 0; j < 4; ++j) {
                As[(lh * 8 + 2 * j) * 260 + lr] = bf2f(av[j] & 0xffffu); As[(lh * 8 + 2 * j + 1) * 260 + lr] = bf2f(av[j] >> 16);
                Bs[(lh * 8 + 2 * j) * 260 + lr] = bf2f(bv[j] & 0xffffu); Bs[(lh * 8 + 2 * j + 1) * 260 + lr] = bf2f(bv[j] >> 16);
            }
            __syncthreads();
#pragma unroll 4
            for (int kk = 0; kk < 16; ++kk) {
                float a[8], b[16];
                const f32x4 a0 = *(const LAS f32x4*)(As + kk * 260 + ty * 8), a1 = *(const LAS f32x4*)(As + kk * 260 + ty * 8 + 4);
                a[0] = a0[0]; a[1] = a0[1]; a[2] = a0[2]; a[3] = a0[3]; a[4] = a1[0]; a[5] = a1[1]; a[6] = a1[2]; a[7] = a1[3];
#pragma unroll
                for (int q = 0; q < 4; ++q) { const f32x4 bq = *(const LAS f32x4*)(Bs + kk * 260 + tx * 4 + 64 * q); b[4 * q] = bq[0]; b[4 * q + 1] = bq[1]; b[4 * q + 2] = bq[2]; b[4 * q + 3] = bq[3]; }
#pragma unroll
                for (int i = 0; i < 8; ++i)
#pragma unroll
                    for (int j = 0; j < 16; ++j) acc[i][j] = fmaf(a[i], b[j], acc[i][j]);
            }
        }
#pragma unroll
        for (int i = 0; i < 8; ++i)
#pragma unroll
            for (int q = 0; q < 4; ++q)
                E.elem4(u.pm * 256 + ty * 8 + i, u.pn * 256 + tx * 4 + 64 * q, (f32x4){acc[i][4 * q], acc[i][4 * q + 1], acc[i][4 * q + 2], acc[i][4 * q + 3]});
    }
    __syncthreads();
}
#else
namespace pg8 {
constexpr int BM = 256, BK = 64, HALF = 128, HTB = HALF * BK * 2, STAGE_BYTES = 8 * HTB;
__device__ __forceinline__ int lds_byte(int r, int c) { const int st = (r >> 4) * 2 + (c >> 5), rr = r & 15, cc = c & 31, ob = rr * 64 + cc * 2; return st * 1024 + (ob ^ (((ob >> 9) & 1) << 5)); }
__device__ __forceinline__ void stage_rc(int b, int& R, int& C) { const int st = b / 1024, sb = b % 1024, swz = sb ^ (((sb >> 9) & 1) << 5); R = (st >> 1) * 16 + swz / 64; C = (st & 1) * 32 + (swz % 64) / 2; }
}
template <class Epi, class Sched>
__device__ __forceinline__ void gemm_phase(LAS unsigned char* lds, const Gemm g, const Sched& S, const Epi& E) {
    using namespace pg8;
    int tid_ = threadIdx.x; asm volatile("" : "+v"(tid_));
    const int tid = tid_, wid = __builtin_amdgcn_readfirstlane(tid >> 6), lane = tid & 63, wr = wid >> 2, wc = wid & 3, fr = lane & 15, fq = lane >> 4;
    const int K = g.K, nt = K / BK;
    unsigned voffA[2];
#pragma unroll
    for (int i = 0; i < 2; ++i) { int R, C; stage_rc(tid * 16 + i * 8192, R, C); voffA[i] = (unsigned)(R * K + C) * 2u; }
    const size_t kstep = (size_t)(BK * 2);
    const size_t hstep = (size_t)HALF * K * 2;
    const size_t tstep = 2 * hstep;
    const unsigned ldsw = (unsigned)wid * 1024u;
    const int aoff = lds_byte(wr * 64 + fr, fq * 8), boff = lds_byte(wc * 32 + fr, fq * 8);
#define PG8_SA(b, h) (((b) * 2 + (h)) * HTB)
#define PG8_SB(b, h) ((4 + (b) * 2 + (h)) * HTB)
#define PG8_STAGE(bufoff, gbase, voff) do { _Pragma("unroll") for (int _i = 0; _i < 2; ++_i) \
        __builtin_amdgcn_global_load_lds((const unsigned*)((const char*)(gbase) + (voff)[_i]), (LAS unsigned*)(lds + (bufoff) + ldsw + _i * 8192), 16, 0, 0); } while (0)
#define PG8_LDA(dst, b, h) do { _Pragma("unroll") for (int m = 0; m < 4; ++m) _Pragma("unroll") for (int k = 0; k < 2; ++k) dst[m][k] = *(const LAS bf16x8*)(lds + PG8_SA(b, h) + aoff + m * 2048 + k * 1024); } while (0)
#define PG8_LDB(dst, b, h) do { _Pragma("unroll") for (int n = 0; n < 2; ++n) _Pragma("unroll") for (int k = 0; k < 2; ++k) dst[n][k] = *(const LAS bf16x8*)(lds + PG8_SB(b, h) + boff + n * 2048 + k * 1024); } while (0)
#define PG8_MMA(ai, bj, At, Bt) do { __builtin_amdgcn_s_setprio(1); _Pragma("unroll") for (int m = 0; m < 4; ++m) _Pragma("unroll") for (int n = 0; n < 2; ++n) _Pragma("unroll") for (int k = 0; k < 2; ++k) \
        acc[ai][bj][m][n] = __builtin_amdgcn_mfma_f32_16x16x32_bf16(Bt[n][k], At[m][k], acc[ai][bj][m][n], 0, 0, 0); __builtin_amdgcn_s_setprio(0); } while (0)
#define PG8_WAIT_V(n) asm volatile("s_waitcnt vmcnt(" #n ")" ::: "memory")
#define PG8_WAIT_L(n) asm volatile("s_waitcnt lgkmcnt(" #n ")" ::: "memory")
#define PG8_BAR __builtin_amdgcn_s_barrier()
#define PG8_SCHED __builtin_amdgcn_sched_barrier(0)
    Unit cur, nxt; int ui = 0;
    if (S.next(0, cur)) {
    f32x4 acc[2][2][4][2];
#pragma unroll
    for (int a = 0; a < 2; ++a)
#pragma unroll
        for (int b = 0; b < 2; ++b)
#pragma unroll
            for (int m = 0; m < 4; ++m)
#pragma unroll
                for (int n = 0; n < 2; ++n) acc[a][b][m][n] = (f32x4){0.f, 0.f, 0.f, 0.f};
    bf16x8 At[4][2], B0[2][2], B1[2][2];
    const char* cA = (const char*)g.A + (size_t)cur.pm * tstep; const char* cB = (const char*)(g.Bt + (size_t)cur.bs * g.bstride) + (size_t)cur.pn * tstep;
    PG8_STAGE(PG8_SB(0, 0), cB, voffA); PG8_STAGE(PG8_SA(0, 0), cA, voffA); PG8_STAGE(PG8_SB(0, 1), cB + hstep, voffA); PG8_STAGE(PG8_SA(0, 1), cA + hstep, voffA);
    if (wr == 1) PG8_BAR;
    PG8_WAIT_V(4); PG8_BAR;
    PG8_STAGE(PG8_SB(1, 0), cB + kstep, voffA); PG8_STAGE(PG8_SA(1, 0), cA + kstep, voffA); PG8_STAGE(PG8_SB(1, 1), cB + hstep + kstep, voffA);
    PG8_WAIT_V(6); PG8_BAR;
    for (;;) {
        const bool has_next = S.next(ui + 1, nxt);
        const char* nA = has_next ? (const char*)g.A + (size_t)nxt.pm * tstep : cA; const char* nB = has_next ? (const char*)(g.Bt + (size_t)nxt.bs * g.bstride) + (size_t)nxt.pn * tstep : cB;
        for (int t = 0; t < nt; t += 2) {
            const bool last = (t == nt - 2);
            const char* a1 = cA + (size_t)(t + 1) * kstep;
            const char* a2 = last ? nA : cA + (size_t)(t + 2) * kstep; const char* b2 = last ? nB : cB + (size_t)(t + 2) * kstep;
            const char* a3 = a2 + kstep; const char* b3 = b2 + kstep;
            PG8_LDB(B0, 0, 0); PG8_SCHED; PG8_LDA(At, 0, 0); PG8_STAGE(PG8_SA(1, 1), a1 + hstep, voffA);
            PG8_WAIT_L(8); PG8_BAR; PG8_WAIT_L(0); PG8_MMA(0, 0, At, B0); PG8_BAR; PG8_SCHED;
            PG8_LDB(B1, 0, 1); PG8_STAGE(PG8_SB(0, 0), b2, voffA);
            PG8_BAR; PG8_WAIT_L(0); PG8_MMA(0, 1, At, B1); PG8_BAR;
            PG8_LDA(At, 0, 1); PG8_STAGE(PG8_SA(0, 0), a2, voffA);
            PG8_BAR; PG8_WAIT_L(0); PG8_MMA(1, 0, At, B0); PG8_BAR; PG8_SCHED;
            PG8_STAGE(PG8_SB(0, 1), b2 + hstep, voffA);
            PG8_WAIT_V(6); PG8_BAR; PG8_MMA(1, 1, At, B1); PG8_BAR;
            PG8_LDB(B0, 1, 0); PG8_SCHED; PG8_LDA(At, 1, 0); PG8_STAGE(PG8_SA(0, 1), a2 + hstep, voffA);
            PG8_WAIT_L(8); PG8_BAR; PG8_WAIT_L(0); PG8_MMA(0, 0, At, B0); PG8_BAR; PG8_SCHED;
            PG8_LDB(B1, 1, 1); PG8_STAGE(PG8_SB(1, 0), b3, voffA);
            PG8_BAR; PG8_WAIT_L(0); PG8_MMA(0, 1, At, B1); PG8_BAR;
            PG8_LDA(At, 1, 1); PG8_STAGE(PG8_SA(1, 0), a3, voffA);
            PG8_BAR; PG8_WAIT_L(0); PG8_MMA(1, 0, At, B0); PG8_BAR; PG8_SCHED;
            PG8_STAGE(PG8_SB(1, 1), b3 + hstep, voffA);
            PG8_WAIT_V(6); PG8_BAR; PG8_MMA(1, 1, At, B1); PG8_BAR;
        }
        {
            const int row0 = cur.pm * 256 + wr * 64 + fr, col0 = cur.pn * 256 + wc * 32 + 4 * fq;
#pragma unroll
            for (int ai = 0; ai < 2; ++ai)
#pragma unroll
                for (int m = 0; m < 4; ++m)
#pragma unroll
                    for (int bj = 0; bj < 2; ++bj)
#pragma unroll
                        for (int n = 0; n < 2; ++n) E.elem4(row0 + ai * 128 + m * 16, col0 + bj * 128 + n * 16, acc[ai][bj][m][n]);
        }
        if (!has_next) break;
#pragma unroll
        for (int a = 0; a < 2; ++a)
#pragma unroll
            for (int b = 0; b < 2; ++b)
#pragma unroll
                for (int m = 0; m < 4; ++m)
#pragma unroll
                    for (int n = 0; n < 2; ++n) acc[a][b][m][n] = (f32x4){0.f, 0.f, 0.f, 0.f};
        cur = nxt; cA = nA; cB = nB; ++ui;
    }
    PG8_WAIT_V(0);
    if (wr == 0) PG8_BAR;
    PG8_BAR;
    }
#undef PG8_SA
#undef PG8_SB
#undef PG8_STAGE
#undef PG8_LDA
#undef PG8_LDB
#undef PG8_MMA
#undef PG8_WAIT_V
#undef PG8_WAIT_L
#undef PG8_BAR
#undef PG8_SCHED
    __syncthreads();
}
#endif

struct EpiStoreBf16 {
    bf16_t* O; int ldc;
    __device__ __forceinline__ void elem4(int row, int col, f32x4 v) const {
        u32x2 w; w.x = pk2(v[0], v[1]); w.y = pk2(v[2], v[3]);
        *(u32x2*)(O + (size_t)row * ldc + col) = w;
    }
};
template <bool ACCUM> struct EpiGate {
    bf16_t* MG; const bf16_t* Z; int gcol;
    __device__ __forceinline__ void elem4(int row, int col, f32x4 v) const {
        const u32x2 gz = *(const u32x2*)(Z + (size_t)row * ZLD + gcol + col);
        float o0 = sigmoidf_(bf2f(gz.x & 0xffffu)) * v[0], o1 = sigmoidf_(bf2f(gz.x >> 16)) * v[1], o2 = sigmoidf_(bf2f(gz.y & 0xffffu)) * v[2], o3 = sigmoidf_(bf2f(gz.y >> 16)) * v[3];
        bf16_t* p = MG + (size_t)row * D + col;
        if (ACCUM) { const u32x2 old = *(const u32x2*)p; o0 += bf2f(old.x & 0xffffu); o1 += bf2f(old.x >> 16); o2 += bf2f(old.y & 0xffffu); o3 += bf2f(old.y >> 16); }
        u32x2 w; w.x = pk2(o0, o1); w.y = pk2(o2, o3); *(u32x2*)p = w;
    }
};
struct EpiResid {
    float* X; const float* modg;
    __device__ __forceinline__ void elem4(int row, int col, f32x4 v) const {
        const int mj = row < NCTX ? 16 : ((row - NCTX) >> 11);
        const f32x4 gv = *(const f32x4*)(modg + (size_t)mj * NMOD + col);
        f32x4* p = (f32x4*)(X + (size_t)row * D + col);
        f32x4 x = *p; x[0] += gv[0] * v[0]; x[1] += gv[1] * v[1]; x[2] += gv[2] * v[2]; x[3] += gv[3] * v[3]; *p = x;
    }
};
struct EpiSwiGLU {
    bf16_t* HID;
    __device__ __forceinline__ void elem4(int row, int col, f32x4 v) const {
        *(unsigned*)(HID + (size_t)row * DFF + (col >> 1)) = pk2(siluf_(v[0]) * v[2], siluf_(v[1]) * v[3]);
    }
};

struct Args { const float* in[32]; float* out; unsigned char* ws; int ph_lo, ph_hi; };
typedef const __attribute__((address_space(4))) Args* KArgs;
__device__ __forceinline__ KArgs kargs() { KArgs p = (KArgs)__builtin_amdgcn_kernarg_segment_ptr(); asm volatile("" : "+s"(p)); return p; }
struct Frame {
    LAS unsigned char* lds;
    int tid, lane, wave, G, bid;
    KArgs ka; float* out; unsigned char* ws;
    __device__ __forceinline__ const float* inp(int i) const { return ka->in[i]; }
};
__device__ __forceinline__ Frame make_frame() {
    extern __shared__ __attribute__((aligned(16))) unsigned char lds_raw[];
    Frame F; F.lds = (LAS unsigned char*)lds_raw; { int t = threadIdx.x; asm volatile("" : "+v"(t)); F.tid = t; } F.lane = F.tid & 63; F.wave = __builtin_amdgcn_readfirstlane(F.tid >> 6);
    { int g_ = gridDim.x, b_ = blockIdx.x; asm volatile("" : "+s"(g_), "+s"(b_)); F.G = g_; F.bid = b_; } F.ka = kargs(); F.out = F.ka->out; F.ws = F.ka->ws; return F;
}
#define IN_X 0
#define IN_C 1
#define IN_CTX 2
#define IN_CCTX 3
#define IN_WMOD 4
#define IN_BMOD 5
#define IN_N1G 6
#define IN_N2G 7
#define IN_WIN 8
#define IN_SHMU 9
#define IN_CONVW 10
#define IN_WUP 11
#define IN_W0 12
#define IN_AUP 13
#define IN_A0 14
#define IN_GUP 15
#define IN_KK 16
#define IN_KA 17
#define IN_RK 18
#define IN_LNG 19
#define IN_LNB 20
#define IN_WAO 21
#define IN_WBO 22
#define IN_WO 23
#define IN_RG 24
#define IN_RGB 25
#define IN_RE 26
#define IN_REB 27
#define IN_W1 28
#define IN_W3 29
#define IN_W2 30
#define IN_FG 31

__device__ __forceinline__ void phase_prologue() {
    Frame F = make_frame();
    {
        const f32x4* sc = (const f32x4*)F.inp(IN_CTX); const f32x4* sx = (const f32x4*)F.inp(IN_X); f32x4* X = (f32x4*)(F.ws + WS_X);
        const size_t n4c = (size_t)NCTX * D / 4, n4 = (size_t)NT * D / 4;
        for (size_t i = (size_t)F.bid * 512 + F.tid; i < n4; i += (size_t)F.G * 512) X[i] = i < n4c ? sc[i] : sx[i - n4c];
    }
    {
        float* WC = (float*)(F.ws + WS_WC); float* RB = (float*)(F.ws + WS_RB);
        for (int i = F.bid * 512 + F.tid; i < DEPTH * 1024 * 48; i += F.G * 512) { const int c = i % 48, lk = i / 48;
            WC[i] = c < 32 ? F.inp(IN_RE)[(size_t)lk * 32 + c] : (c < 36 ? F.inp(IN_RG)[(size_t)lk * 4 + (c - 32)] : 0.f); }
        if (F.bid == 0 && F.tid < DEPTH * 48) { const int c = F.tid % 48, l = F.tid / 48; RB[F.tid] = c < 32 ? F.inp(IN_REB)[l * 32 + c] : (c < 36 ? F.inp(IN_RGB)[l * 4 + (c - 32)] : 0.f); }
    }
    if (F.bid * 512 < DEPTH * NMOD) {
        LAS float* st = (LAS float*)F.lds;
        for (int i = F.tid; i < 17 * 1024; i += 512) { const int j = i >> 10, k = i & 1023; const float cv = j < 16 ? F.inp(IN_C)[j * 1024 + k] : F.inp(IN_CCTX)[k]; st[k * 20 + j] = siluf_(cv); }
        __syncthreads();
        for (int cidx = F.bid * 512 + F.tid; cidx < DEPTH * NMOD; cidx += F.G * 512) {
            const int l = cidx / NMOD, n = cidx % NMOD;
            const float* w = F.inp(IN_WMOD) + (size_t)l * D * NMOD + n;
            float acc[17]; const float b = F.inp(IN_BMOD)[l * NMOD + n];
#pragma unroll
            for (int j = 0; j < 17; ++j) acc[j] = b;
#pragma unroll 4
            for (int k = 0; k < 1024; ++k) {
                const float wv = w[(size_t)k * NMOD];
#pragma unroll
                for (int j = 0; j < 17; ++j) acc[j] = fmaf(st[k * 20 + j], wv, acc[j]);
            }
            float* mod = (float*)(F.ws + WS_MOD) + (size_t)l * 17 * NMOD + n;
#pragma unroll
            for (int j = 0; j < 17; ++j) mod[(size_t)j * NMOD] = acc[j];
        }
        __syncthreads();
    }
}

__device__ __forceinline__ void conv_item(const float* src0, const float* src1, int ldsrc, int nvalid, int mode, bf16_t* dst, int K, int item, LAS float* scr, int lane) {
    const int nkb = K / 64, kb = item % nkb, jb = item / nkb, k0 = 64 * kb, j0 = 32 * jb;
    const int jj = j0 + (lane & 31);
    const float* colp;
    if (mode == 0) colp = jj < nvalid ? src0 + jj : nullptr;
    else colp = ((jj & 2) ? src1 : src0) + 2 * (jj >> 2) + (jj & 1);
#pragma unroll 8
    for (int i = 0; i < 32; ++i) { const int kk = 2 * i + (lane >> 5); scr[kk * 33 + (lane & 31)] = colp ? colp[(size_t)(k0 + kk) * ldsrc] : 0.f; }
    asm volatile("s_waitcnt lgkmcnt(0)" ::: "memory");
    const int c = lane & 7;
#pragma unroll
    for (int j = 0; j < 4; ++j) { const int n = (lane >> 3) + 8 * j; const LAS float* s = scr + (8 * c) * 33 + n;
        u32x4 o; o.x = pk2(s[0 * 33], s[1 * 33]); o.y = pk2(s[2 * 33], s[3 * 33]); o.z = pk2(s[4 * 33], s[5 * 33]); o.w = pk2(s[6 * 33], s[7 * 33]);
        *(u32x4*)(dst + (size_t)(j0 + n) * K + k0 + 8 * c) = o; }
    asm volatile("s_waitcnt lgkmcnt(0)" ::: "memory");
}
__device__ __forceinline__ void convert_layer_weights(Frame& F, int l) {
    LAS float* scr = (LAS float*)(F.lds + F.wave * 8704);
    const int gw = F.bid * 8 + F.wave, NGW = F.G * 8;
    constexpr int I_IN = (1024 / 64) * (ZLD / 32), I_A = (512 / 64) * (1024 / 32), I_O = (1024 / 64) * (1024 / 32), I_13 = (1024 / 64) * (1024 / 32), I_2 = (512 / 64) * (1024 / 32);
    constexpr int NITEMS = I_IN + 2 * I_A + I_O + NE * I_13 + NE * I_2;
    for (int it = gw; it < NITEMS; it += NGW) {
        int r = it;
        if (r < I_IN) { conv_item(F.inp(IN_WIN) + (size_t)l * D * NIN, nullptr, NIN, NIN, 0, (bf16_t*)(F.ws + WS_WIN), 1024, r, scr, F.lane); continue; } r -= I_IN;
        if (r < I_A) { conv_item(F.inp(IN_WAO) + (size_t)l * DH * D, nullptr, D, D, 0, (bf16_t*)(F.ws + WS_WA), 512, r, scr, F.lane); continue; } r -= I_A;
        if (r < I_A) { conv_item(F.inp(IN_WBO) + (size_t)l * DH * D, nullptr, D, D, 0, (bf16_t*)(F.ws + WS_WB), 512, r, scr, F.lane); continue; } r -= I_A;
        if (r < I_O) { conv_item(F.inp(IN_WO) + (size_t)l * D * D, nullptr, D, D, 0, (bf16_t*)(F.ws + WS_WO), 1024, r, scr, F.lane); continue; } r -= I_O;
        if (r < NE * I_13) { const int e = r / I_13, ri = r % I_13; const size_t so = ((size_t)l * NE + e) * D * DFF;
            conv_item(F.inp(IN_W1) + so, F.inp(IN_W3) + so, DFF, 0, 1, (bf16_t*)(F.ws + WS_W13) + (size_t)e * 1024 * 1024, 1024, ri, scr, F.lane); continue; } r -= NE * I_13;
        { const int e = r / I_2, ri = r % I_2; const size_t so = ((size_t)l * NE + e) * DFF * D;
            conv_item(F.inp(IN_W2) + so, nullptr, D, D, 0, (bf16_t*)(F.ws + WS_W2) + (size_t)e * 1024 * 512, 512, ri, scr, F.lane); }
    }
}

__device__ __forceinline__ void phase_norm1(int l) {
    asm volatile("" : "+s"(l)); Frame F = make_frame();
    convert_layer_weights(F, l);
    const int gw = F.bid * 8 + F.wave, NGW = F.G * 8;
    const float* X = (const float*)(F.ws + WS_X); bf16_t* H = (bf16_t*)((unsigned char*)F.out + DO_H);
    const float* g1n = F.inp(IN_N1G) + l * D;
    for (int row = gw; row < NT; row += NGW) {
        const int mj = row < NCTX ? 16 : ((row - NCTX) >> 11);
        const float* mod = (const float*)(F.ws + WS_MOD) + ((size_t)l * 17 + mj) * NMOD;
        f32x4 v[4]; float ss = 0.f;
#pragma unroll
        for (int j = 0; j < 4; ++j) { v[j] = *(const f32x4*)(X + (size_t)row * D + 4 * F.lane + 256 * j); ss += v[j][0] * v[j][0] + v[j][1] * v[j][1] + v[j][2] * v[j][2] + v[j][3] * v[j][3]; }
        const float rs = rsqrtf(wave_sum(ss) * (1.0f / D) + NORM_EPS);
#pragma unroll
        for (int j = 0; j < 4; ++j) {
            const int c = 4 * F.lane + 256 * j;
            const f32x4 gg = *(const f32x4*)(g1n + c), sh = *(const f32x4*)(mod + c), sc = *(const f32x4*)(mod + 1024 + c);
            float o[4];
#pragma unroll
            for (int q = 0; q < 4; ++q) o[q] = v[j][q] * rs * gg[q] * (1.0f + sc[q]) + sh[q];
            u32x2 w; w.x = pk2(o[0], o[1]); w.y = pk2(o[2], o[3]);
            *(u32x2*)(H + (size_t)row * D + c) = w;
        }
    }
}

constexpr int PW_S64 = 144, PW_S128 = 272;
constexpr int PW_G = 4 * 64 * PW_S64;
constexpr int PA_OFF = PW_G + 64 * PW_S128;
constexpr int PA_STRIDE = 784;
static_assert(PA_OFF + 128 * PA_STRIDE <= LDS_CTL, "prep LDS map");
__device__ __forceinline__ float tanh_fast(float x) { return 1.0f - 2.0f / (1.0f + __expf(2.0f * x)); }
__device__ __forceinline__ void unpack8(const u32x4 p, float (&o)[8]) {
#pragma unroll
    for (int j = 0; j < 4; ++j) { o[2 * j] = bf2f(p[j] & 0xffffu); o[2 * j + 1] = bf2f(p[j] >> 16); }
}
__device__ __forceinline__ u32x4 pack8(const float (&f)[8]) { u32x4 r; r.x = pk2(f[0], f[1]); r.y = pk2(f[2], f[3]); r.z = pk2(f[4], f[5]); r.w = pk2(f[6], f[7]); return r; }
__device__ __forceinline__ void shifted16(const bf16_t* Z, int row, bool hasp, bool hasn, int col, const float* mu, float (&o)[16]) {
    const bf16_t* p = Z + (size_t)row * ZLD + ZC_RW + col;
    const u32x4 z0 = *(const u32x4*)p, z1 = *(const u32x4*)(p + 8);
    const u32x4 zero = (u32x4){0u, 0u, 0u, 0u};
    const u32x4 m0 = hasp ? *(const u32x4*)(p - ZLD) : zero, m1 = hasp ? *(const u32x4*)(p - ZLD + 8) : zero;
    const u32x4 n0 = hasn ? *(const u32x4*)(p + ZLD) : zero, n1 = hasn ? *(const u32x4*)(p + ZLD + 8) : zero;
    float z[16], zm[16], zn[16];
    { float t[8]; unpack8(z0, t);
#pragma unroll
      for (int j = 0; j < 8; ++j) z[j] = t[j];
      unpack8(z1, t);
#pragma unroll
      for (int j = 0; j < 8; ++j) z[8 + j] = t[j];
      unpack8(m0, t);
#pragma unroll
      for (int j = 0; j < 8; ++j) zm[j] = t[j];
      unpack8(m1, t);
#pragma unroll
      for (int j = 0; j < 8; ++j) zm[8 + j] = t[j];
      unpack8(n0, t);
#pragma unroll
      for (int j = 0; j < 8; ++j) zn[j] = t[j];
      unpack8(n1, t);
#pragma unroll
      for (int j = 0; j < 8; ++j) zn[8 + j] = t[j]; }
#pragma unroll
    for (int q = 0; q < 4; ++q) { const f32x4 m = *(const f32x4*)(mu + col + 4 * q);
#pragma unroll
        for (int e = 0; e < 4; ++e) { const int j = 4 * q + e; o[j] = z[j] + m[e] * (0.5f * (zm[j] + zn[j]) - z[j]); } }
}
__device__ __forceinline__ void store16(bf16_t* dst, const float (&f)[16]) {
    u32x4 a, b; a.x = pk2(f[0], f[1]); a.y = pk2(f[2], f[3]); a.z = pk2(f[4], f[5]); a.w = pk2(f[6], f[7]); b.x = pk2(f[8], f[9]); b.y = pk2(f[10], f[11]); b.z = pk2(f[12], f[13]); b.w = pk2(f[14], f[15]);
    *(u32x4*)dst = a; *(u32x4*)(dst + 8) = b;
}
__device__ __forceinline__ void phase_prep(int l) {
    asm volatile("" : "+s"(l)); Frame F = make_frame();
    const int tid = F.tid, lane = F.lane, w = F.wave, tok = lane & 15, cq = lane >> 4;
    const bf16_t* Z = (const bf16_t*)(F.ws + WS_Z);
    const float* mu = F.inp(IN_SHMU) + l * RWC;
    float* BON = (float*)(F.ws + WS_BONUS);
    for (int unit = F.bid; unit < 256; unit += F.G) {
        const int h = unit & 7, rng = unit >> 3;
        __syncthreads();
#pragma unroll 1
        for (int o = 0; o < 5; ++o) {
            const float* src = o < 2 ? F.inp(IN_WUP) + (size_t)(l * 2 + o) * 64 * DH : (o < 4 ? F.inp(IN_AUP) + (size_t)(l * 2 + (o - 2)) * 64 * DH : F.inp(IN_GUP) + (size_t)l * 128 * DH);
            const int K = o < 4 ? 64 : 128, stride = o < 4 ? PW_S64 : PW_S128, off = o < 4 ? o * 64 * PW_S64 : PW_G;
            for (int idx = tid; idx < K * 64; idx += 512) { const int c = idx & 63, k = idx >> 6; const int rr = 16 * ((c >> 2) & 3) + 4 * (c >> 4) + (c & 3);
                *(LAS unsigned short*)(F.lds + off + rr * stride + 2 * k) = (unsigned short)f2bf(src[(size_t)k * DH + 64 * h + c]); }
        }
#pragma unroll 1
        for (int ti = 0; ti < 9; ++ti) {
            const int row0 = rng * 1152 + ti * 128;
            const bool isctx = row0 < NCTX; const int T = isctx ? CTXL : SEQ; const int t0 = isctx ? (row0 & (CTXL - 1)) : ((row0 - NCTX) & (SEQ - 1));
            __syncthreads();
#pragma unroll 2
            for (int gi = tid; gi < 128 * 48; gi += 512) {
                const int t = gi / 48, g = gi - t * 48, ts = t0 + t;
                const bf16_t* zp = Z + (size_t)(row0 + t) * ZLD + ZC_RW + 1536 + 8 * g;
                const u32x4 zero = (u32x4){0u, 0u, 0u, 0u};
                const u32x4 zc = *(const u32x4*)zp, zm = ts > 0 ? *(const u32x4*)(zp - ZLD) : zero, zn = ts < T - 1 ? *(const u32x4*)(zp + ZLD) : zero;
                const f32x4 mA = *(const f32x4*)(mu + 1536 + 8 * g), mB = *(const f32x4*)(mu + 1536 + 8 * g + 4);
                float c8[8], m8[8], n8[8], o8[8]; unpack8(zc, c8); unpack8(zm, m8); unpack8(zn, n8);
#pragma unroll
                for (int j = 0; j < 8; ++j) { const float mm = j < 4 ? mA[j] : mB[j - 4]; const float zs = c8[j] + mm * (0.5f * (m8[j] + n8[j]) - c8[j]);
                    o8[j] = g < 16 ? tanh_fast(zs) : (g < 32 ? zs : sigmoidf_(zs)); }
                *(LAS u32x4*)(F.lds + PA_OFF + t * PA_STRIDE + 16 * g) = pack8(o8);
            }
            __syncthreads();
            const int t = 16 * w + tok, row = row0 + t, ts = t0 + t; const bool hasp = ts > 0, hasn = ts < T - 1;
            const int cb = 64 * h + 16 * cq;
            float rv[16], kv[16], vv[16];
            shifted16(Z, row, hasp, hasn, cb, mu, rv); shifted16(Z, row, hasp, hasn, 512 + cb, mu, kv); shifted16(Z, row, hasp, hasn, 1024 + cb, mu, vv);
            f32x4 acc[5][4];
#pragma unroll
            for (int o = 0; o < 5; ++o)
#pragma unroll
                for (int nt = 0; nt < 4; ++nt) acc[o][nt] = (f32x4){0.f, 0.f, 0.f, 0.f};
            const LAS unsigned char* actp = F.lds + PA_OFF + (16 * w + tok) * PA_STRIDE + 16 * cq;
#pragma unroll
            for (int o = 0; o < 4; ++o)
#pragma unroll
                for (int ks = 0; ks < 2; ++ks) {
                    const bf16x8 bfrag = *(const LAS bf16x8*)(actp + (64 * o + 32 * ks) * 2);
#pragma unroll
                    for (int nt = 0; nt < 4; ++nt) { const bf16x8 afrag = *(const LAS bf16x8*)(F.lds + o * 64 * PW_S64 + (16 * nt + tok) * PW_S64 + (32 * ks + 8 * cq) * 2);
                        acc[o][nt] = __builtin_amdgcn_mfma_f32_16x16x32_bf16(afrag, bfrag, acc[o][nt], 0, 0, 0); }
                }
#pragma unroll
            for (int ks = 0; ks < 4; ++ks) {
                const bf16x8 bfrag = *(const LAS bf16x8*)(actp + (256 + 32 * ks) * 2);
#pragma unroll
                for (int nt = 0; nt < 4; ++nt) { const bf16x8 afrag = *(const LAS bf16x8*)(F.lds + PW_G + (16 * nt + tok) * PW_S128 + (32 * ks + 8 * cq) * 2);
                    acc[4][nt] = __builtin_amdgcn_mfma_f32_16x16x32_bf16(afrag, bfrag, acc[4][nt], 0, 0, 0); }
            }
            const size_t so = ((size_t)h * NT + row) * 64 + 16 * cq;
            float kkv[16]; float ss = 0.f;
#pragma unroll
            for (int q = 0; q < 4; ++q) { const f32x4 kw = *(const f32x4*)(F.inp(IN_KK) + l * DH + cb + 4 * q);
#pragma unroll
                for (int e = 0; e < 4; ++e) { const float ku = kv[4 * q + e] * kw[e]; kkv[4 * q + e] = ku; ss += ku * ku; } }
            ss += __shfl_xor(ss, 16); ss += __shfl_xor(ss, 32);
            const float rs = rsqrtf(ss + 1e-12f);
#pragma unroll
            for (int j = 0; j < 16; ++j) kkv[j] *= rs;
            store16((bf16_t*)(F.ws + WS_R) + so, rv); store16((bf16_t*)(F.ws + WS_V) + so, vv); store16((bf16_t*)(F.ws + WS_KK) + so, kkv);
            { float gv[16];
#pragma unroll
              for (int j = 0; j < 16; ++j) gv[j] = acc[4][j >> 2][j & 3];
              store16((bf16_t*)((unsigned char*)F.out + DO_G) + so, gv); }
            float bon = 0.f;
#pragma unroll
            for (int d = 0; d < 2; ++d) {
                float lwv[16], kdv[16], bv[16];
#pragma unroll
                for (int q = 0; q < 4; ++q) {
                    const f32x4 w0 = *(const f32x4*)(F.inp(IN_W0) + (l * 2 + d) * DH + cb + 4 * q), a0 = *(const f32x4*)(F.inp(IN_A0) + (l * 2 + d) * DH + cb + 4 * q);
                    const f32x4 ka = *(const f32x4*)(F.inp(IN_KA) + l * DH + cb + 4 * q), rk = *(const f32x4*)(F.inp(IN_RK) + l * DH + cb + 4 * q);
#pragma unroll
                    for (int e = 0; e < 4; ++e) { const int j = 4 * q + e;
                        const float x = -(w0[e] + acc[d][q][e]);
                        const float wl = -(fmaxf(x, 0.f) + __logf(1.0f + __expf(-fabsf(x)))) - 0.5f;
                        const float a = sigmoidf_(a0[e] + acc[2 + d][q][e]);
                        const float kd = kv[j] * (1.0f + (a - 1.0f) * ka[e]);
                        lwv[j] = -__expf(wl); kdv[j] = kd; bv[j] = kkv[j] * a; bon += rv[j] * kd * rk[e]; }
                }
                store16((bf16_t*)(F.ws + (d ? WS_LW1 : WS_LW0)) + so, lwv); store16((bf16_t*)(F.ws + (d ? WS_KD1 : WS_KD0)) + so, kdv); store16((bf16_t*)(F.ws + (d ? WS_B1 : WS_B0)) + so, bv);
            }
            bon += __shfl_xor(bon, 16); bon += __shfl_xor(bon, 32);
            if (cq == 0) BON[(size_t)row * 8 + h] = bon;
        }
    }
    __syncthreads();
}

__device__ __forceinline__ int scan_row(int b, int dir, int i) {
    if (i < CTXL) return b * CTXL + (dir ? CTXL - 1 - i : i);
    const int j = i - CTXL; return NCTX + b * SEQ + (dir ? SEQ - 1 - j : j);
}
template <int CTRL> __device__ __forceinline__ float dpp_add(float x) {
    return x + __int_as_float(__builtin_amdgcn_update_dpp(0, __float_as_int(x), CTRL, 0xf, 0xf, true));
}
__device__ __forceinline__ float reduce16(float x) {
    x = dpp_add<0xB1>(x);
    x = dpp_add<0x4E>(x);
    x = dpp_add<0x141>(x);
    x = dpp_add<0x140>(x);
    return x;
}
constexpr int SC_T = 32, SC_REC = 384, SC_PBUF = SC_T * SC_REC;
constexpr int SC_YOFF = 2 * SC_PBUF * 4;
__device__ __forceinline__ void phase_scan(int l) {
    asm volatile("" : "+s"(l)); Frame F = make_frame();
    const int tid = F.tid, q = tid & 15, rp = tid >> 4;
    LAS float* P = (LAS float*)F.lds; LAS float* YB = (LAS float*)(F.lds + SC_YOFF);
    const bf16_t* R = (const bf16_t*)(F.ws + WS_R); const bf16_t* V = (const bf16_t*)(F.ws + WS_V); const bf16_t* KK = (const bf16_t*)(F.ws + WS_KK);
    constexpr int NCH = (CTXL + SEQ) / SC_T;
    for (int task = F.bid; task < NBATCH * 8 * 2; task += F.G) {
        const int dir = task & 1, h = (task >> 1) & 7, b = task >> 4;
        const bf16_t* LW = (const bf16_t*)(F.ws + (dir ? WS_LW1 : WS_LW0)); const bf16_t* KD = (const bf16_t*)(F.ws + (dir ? WS_KD1 : WS_KD0)); const bf16_t* Bm = (const bf16_t*)(F.ws + (dir ? WS_B1 : WS_B0));
        bf16_t* Y = (bf16_t*)(F.ws + (dir ? WS_Y1 : WS_Y0));
        u32x4 stg[3];
#define SC_LOAD(c) do { _Pragma("unroll") for (int j = 0; j < 3; ++j) { const int u = tid + 512 * j, a = u >> 8, s_ = (u >> 3) & 31, o = u & 7; \
            const bf16_t* src = a == 0 ? KK : a == 1 ? LW : a == 2 ? Bm : a == 3 ? KD : a == 4 ? R : V; \
            stg[j] = *(const u32x4*)(src + ((size_t)h * NT + scan_row(b, dir, (c) * SC_T + s_)) * 64 + 8 * o); } } while (0)
#define SC_STORE(c) do { _Pragma("unroll") for (int j = 0; j < 3; ++j) { const int u = tid + 512 * j, a = u >> 8, s_ = (u >> 3) & 31, o = u & 7; \
            float f[8]; _Pragma("unroll") for (int e = 0; e < 4; ++e) { f[2 * e] = bf2f(stg[j][e] & 0xffffu); f[2 * e + 1] = bf2f(stg[j][e] >> 16); } \
            if (a == 1) { _Pragma("unroll") for (int e = 0; e < 8; ++e) f[e] = __expf(f[e]); } \
            LAS float* dst = P + ((c) & 1) * SC_PBUF + s_ * SC_REC + a * 64 + 8 * o; \
            *(LAS f32x4*)dst = (f32x4){f[0], f[1], f[2], f[3]}; *(LAS f32x4*)(dst + 4) = (f32x4){f[4], f[5], f[6], f[7]}; } } while (0)
        float S0[4] = {0.f, 0.f, 0.f, 0.f}, S1[4] = {0.f, 0.f, 0.f, 0.f};
        __syncthreads();
        SC_LOAD(0); SC_STORE(0);
        __syncthreads();
        for (int c = 0; c < NCH; ++c) {
            if (c + 1 < NCH) SC_LOAD(c + 1);
            if (c > 0) {
                const int s_ = tid >> 4, r4 = (tid & 15) * 4;
                const f32x4 yv = *(const LAS f32x4*)(YB + ((c - 1) & 1) * (SC_T * 64) + s_ * 64 + r4);
                u32x2 w; w.x = pk2(yv[0], yv[1]); w.y = pk2(yv[2], yv[3]);
                *(u32x2*)(Y + (size_t)scan_row(b, dir, (c - 1) * SC_T + s_) * DH + 64 * h + r4) = w;
            }
            const LAS float* pb = P + (c & 1) * SC_PBUF + 4 * q;
            LAS float* yb = YB + (c & 1) * (SC_T * 64) + 2 * rp;
            f32x4 kk = *(const LAS f32x4*)(pb), w = *(const LAS f32x4*)(pb + 64), bb = *(const LAS f32x4*)(pb + 128), kd = *(const LAS f32x4*)(pb + 192), rr = *(const LAS f32x4*)(pb + 256);
            float v0 = pb[320 - 4 * q + 2 * rp], v1 = pb[320 - 4 * q + 2 * rp + 1];
            float y0 = 0.f, y1 = 0.f;
#pragma unroll 8
            for (int s_ = 0; s_ < SC_T; ++s_) {
                const LAS float* pn = pb + (s_ + 1 < SC_T ? s_ + 1 : s_) * SC_REC;
                const f32x4 kkn = *(const LAS f32x4*)(pn), wn = *(const LAS f32x4*)(pn + 64), bbn = *(const LAS f32x4*)(pn + 128), kdn = *(const LAS f32x4*)(pn + 192), rrn = *(const LAS f32x4*)(pn + 256);
                const float v0n = pn[320 - 4 * q + 2 * rp], v1n = pn[320 - 4 * q + 2 * rp + 1];
                float sa0 = S0[0] * kk[0], sa1 = S1[0] * kk[0];
#pragma unroll
                for (int e = 1; e < 4; ++e) { sa0 = fmaf(S0[e], kk[e], sa0); sa1 = fmaf(S1[e], kk[e], sa1); }
                sa0 = dpp_add<0xB1>(sa0); sa1 = dpp_add<0xB1>(sa1); y0 = dpp_add<0xB1>(y0); y1 = dpp_add<0xB1>(y1);
                sa0 = dpp_add<0x4E>(sa0); sa1 = dpp_add<0x4E>(sa1); y0 = dpp_add<0x4E>(y0); y1 = dpp_add<0x4E>(y1);
                sa0 = dpp_add<0x141>(sa0); sa1 = dpp_add<0x141>(sa1); y0 = dpp_add<0x141>(y0); y1 = dpp_add<0x141>(y1);
                sa0 = dpp_add<0x140>(sa0); sa1 = dpp_add<0x140>(sa1); y0 = dpp_add<0x140>(y0); y1 = dpp_add<0x140>(y1);
                if (s_ > 0 && q == 0) { yb[(s_ - 1) * 64] = y0; yb[(s_ - 1) * 64 + 1] = y1; }
                y0 = 0.f; y1 = 0.f;
#pragma unroll
                for (int e = 0; e < 4; ++e) {
                    S0[e] = fmaf(S0[e], w[e], fmaf(-sa0, bb[e], v0 * kd[e]));
                    S1[e] = fmaf(S1[e], w[e], fmaf(-sa1, bb[e], v1 * kd[e]));
                    y0 = fmaf(S0[e], rr[e], y0); y1 = fmaf(S1[e], rr[e], y1);
                }
                kk = kkn; w = wn; bb = bbn; kd = kdn; rr = rrn; v0 = v0n; v1 = v1n;
            }
            y0 = reduce16(y0); y1 = reduce16(y1);
            if (q == 0) { yb[(SC_T - 1) * 64] = y0; yb[(SC_T - 1) * 64 + 1] = y1; }
            if (c + 1 < NCH) SC_STORE(c + 1);
            __syncthreads();
        }
        {
            const int s_ = tid >> 4, r4 = (tid & 15) * 4;
            const f32x4 yv = *(const LAS f32x4*)(YB + ((NCH - 1) & 1) * (SC_T * 64) + s_ * 64 + r4);
            u32x2 w; w.x = pk2(yv[0], yv[1]); w.y = pk2(yv[2], yv[3]);
            *(u32x2*)(Y + (size_t)scan_row(b, dir, (NCH - 1) * SC_T + s_) * DH + 64 * h + r4) = w;
        }
#undef SC_LOAD
#undef SC_STORE
    }
    __syncthreads();
}

__device__ __forceinline__ void phase_mix(int l) {
    asm volatile("" : "+s"(l)); Frame F = make_frame();
    const int n = F.tid;
    const bf16_t* Z = (const bf16_t*)(F.ws + WS_Z);
    const float* cw = F.inp(IN_CONVW) + (size_t)l * 3 * DH;
    const float cw0 = cw[n], cw1 = cw[DH + n], cw2 = cw[2 * DH + n];
    const float lg = F.inp(IN_LNG)[l * DH + n], lb = F.inp(IN_LNB)[l * DH + n];
    const bf16_t* Y0 = (const bf16_t*)(F.ws + WS_Y0); const bf16_t* Y1 = (const bf16_t*)(F.ws + WS_Y1); const bf16_t* V = (const bf16_t*)(F.ws + WS_V);
    const bf16_t* Gi = (const bf16_t*)((unsigned char*)F.out + DO_G); const float* BON = (const float*)(F.ws + WS_BONUS);
    bf16_t* UA = (bf16_t*)(F.ws + WS_UA); bf16_t* UB = (bf16_t*)(F.ws + WS_UB);
    for (int row = F.bid; row < NT; row += F.G) {
        int delta; bool hasp, hasn;
        if (row < NCTX) { const int t = row & (CTXL - 1); delta = 1; hasp = t > 0; hasn = t < CTXL - 1; }
        else { const int s = (row - NCTX) & (SEQ - 1);
            if (n < 256) { const int gc = s & 63; delta = 1; hasp = gc > 0; hasn = gc < 63; }
            else { const int gr = s >> 6; delta = 64; hasp = gr > 0; hasn = gr < 31; } }
        const bf16_t* zr = Z + (size_t)row * ZLD;
        const float u0 = bf2f(zr[ZC_CG + n]) * bf2f(zr[ZC_HA + n]);
        const float um = hasp ? bf2f(zr[ZC_CG + n - (ptrdiff_t)delta * ZLD]) * bf2f(zr[ZC_HA + n - (ptrdiff_t)delta * ZLD]) : 0.f;
        const float up = hasn ? bf2f(zr[ZC_CG + n + (ptrdiff_t)delta * ZLD]) * bf2f(zr[ZC_HA + n + (ptrdiff_t)delta * ZLD]) : 0.f;
        const float cv = um * cw0 + u0 * cw1 + up * cw2;
        const size_t o = (size_t)row * DH + n;
        UA[o] = (bf16_t)f2bf(bf2f(zr[ZC_BG + n]) * cv);
        const float y = bf2f(Y0[o]) + bf2f(Y1[o]);
        const float mu = wave_sum(y) * (1.0f / 64.0f); const float dv = y - mu; const float var = wave_sum(dv * dv) * (1.0f / 64.0f);
        const float yn = dv * rsqrtf(var + GN_EPS) * lg + lb;
        const float bon = BON[(size_t)row * 8 + (n >> 6)];
        const size_t oh = ((size_t)(n >> 6) * NT + row) * 64 + (n & 63);
        UB[o] = (bf16_t)f2bf((yn + bon * bf2f(V[oh])) * bf2f(Gi[oh]));
    }
}

constexpr int N2_STRIDE = 1028;
constexpr int N2_PART = 16 * N2_STRIDE * 4;
constexpr int N2_HIST = N2_PART + 8 * 16 * 48 * 4;
__device__ __forceinline__ void phase_norm2(int l) {
    asm volatile("" : "+s"(l)); Frame F = make_frame();
    const int lane = F.lane, w = F.wave;
    LAS float* HT = (LAS float*)F.lds; LAS float* PART = (LAS float*)(F.lds + N2_PART); LAS int* hist = (LAS int*)(F.lds + N2_HIST);
    const float* X = (const float*)(F.ws + WS_X); bf16_t* H = (bf16_t*)((unsigned char*)F.out + DO_H);
    const float* g2n = F.inp(IN_N2G) + l * D;
    const float* WC = (const float*)(F.ws + WS_WC) + (size_t)l * 1024 * 48; const float* RB = (const float*)(F.ws + WS_RB) + l * 48;
    int* RE = (int*)(F.ws + WS_RE); float* RG = (float*)(F.ws + WS_RG); int* RP = (int*)(F.ws + WS_RP);
    if (F.tid < 32) hist[F.tid] = 0;
    float Bv[32][3];
    { const int kg = lane >> 4, cc = lane & 15;
#pragma unroll
      for (int s_ = 0; s_ < 32; ++s_)
#pragma unroll
          for (int t = 0; t < 3; ++t) Bv[s_][t] = WC[(size_t)(256 * kg + 32 * w + s_) * 48 + 16 * t + cc]; }
    __syncthreads();
    for (int tile = F.bid; tile < NT / 16; tile += F.G) {
        const int row0 = tile * 16;
#pragma unroll
        for (int rr = 0; rr < 2; ++rr) {
            const int lr = 2 * w + rr, row = row0 + lr;
            const int mj = row < NCTX ? 16 : ((row - NCTX) >> 11);
            const float* mod = (const float*)(F.ws + WS_MOD) + ((size_t)l * 17 + mj) * NMOD;
            f32x4 v[4]; float ss = 0.f;
#pragma unroll
            for (int j = 0; j < 4; ++j) { v[j] = *(const f32x4*)(X + (size_t)row * D + 4 * lane + 256 * j); ss += v[j][0] * v[j][0] + v[j][1] * v[j][1] + v[j][2] * v[j][2] + v[j][3] * v[j][3]; }
            const float rs = rsqrtf(wave_sum(ss) * (1.0f / D) + NORM_EPS);
#pragma unroll
            for (int j = 0; j < 4; ++j) {
                const int c = 4 * lane + 256 * j;
                const f32x4 gg = *(const f32x4*)(g2n + c), sh = *(const f32x4*)(mod + 3072 + c), sc = *(const f32x4*)(mod + 4096 + c);
                f32x4 o;
#pragma unroll
                for (int q = 0; q < 4; ++q) o[q] = v[j][q] * rs * gg[q] * (1.0f + sc[q]) + sh[q];
                u32x2 wv; wv.x = pk2(o[0], o[1]); wv.y = pk2(o[2], o[3]);
                *(u32x2*)(H + (size_t)row * D + c) = wv;
                *(LAS f32x4*)(HT + lr * N2_STRIDE + c) = o;
            }
        }
        __syncthreads();
        {
            f32x4 acc[3];
#pragma unroll
            for (int t = 0; t < 3; ++t) acc[t] = (f32x4){0.f, 0.f, 0.f, 0.f};
            const LAS float* ap = HT + (lane & 15) * N2_STRIDE + 256 * (lane >> 4) + 32 * w;
#pragma unroll
            for (int i = 0; i < 8; ++i) {
                const f32x4 a4 = *(const LAS f32x4*)(ap + 4 * i);
#pragma unroll
                for (int e = 0; e < 4; ++e)
#pragma unroll
                    for (int t = 0; t < 3; ++t) acc[t] = __builtin_amdgcn_mfma_f32_16x16x4f32(a4[e], Bv[4 * i + e][t], acc[t], 0, 0, 0);
            }
#pragma unroll
            for (int t = 0; t < 3; ++t)
#pragma unroll
                for (int rg = 0; rg < 4; ++rg) PART[(w * 16 + (lane >> 4) * 4 + rg) * 48 + 16 * t + (lane & 15)] = acc[t][rg];
        }
        __syncthreads();
        if (F.tid < 16) {
            const int r = F.tid, row = row0 + r;
            float lgv[4];
#pragma unroll
            for (int g = 0; g < 4; ++g) { float a = RB[32 + g];
#pragma unroll
                for (int ww = 0; ww < 8; ++ww) a += PART[(ww * 16 + r) * 48 + 32 + g];
                lgv[g] = a; }
            int gs = 0; float lmax = lgv[0];
#pragma unroll
            for (int g = 1; g < 4; ++g) if (lgv[g] > lmax) { lmax = lgv[g]; gs = g; }
            float den = 0.f;
#pragma unroll
            for (int g = 0; g < 4; ++g) den += __expf(lgv[g] - lmax);
            const float pgmax = 1.0f / den;
            float le[8];
#pragma unroll
            for (int e = 0; e < 8; ++e) { float a = RB[gs * 8 + e];
#pragma unroll
                for (int ww = 0; ww < 8; ++ww) a += PART[(ww * 16 + r) * 48 + gs * 8 + e];
                le[e] = a; }
            int i1 = 0; float m1 = le[0];
#pragma unroll
            for (int e = 1; e < 8; ++e) if (le[e] > m1) { m1 = le[e]; i1 = e; }
            int i2 = -1; float m2 = -3.0e38f;
#pragma unroll
            for (int e = 0; e < 8; ++e) if (e != i1 && le[e] > m2) { m2 = le[e]; i2 = e; }
            const float dd = __expf(m2 - m1);
            const float gate1 = pgmax / (1.0f + dd), gate2 = pgmax * dd / (1.0f + dd);
            const int e1 = gs * 8 + i1, e2 = gs * 8 + i2;
            const int p1 = __hip_atomic_fetch_add(hist + e1, 1, __ATOMIC_RELAXED, __HIP_MEMORY_SCOPE_WORKGROUP), p2 = __hip_atomic_fetch_add(hist + e2, 1, __ATOMIC_RELAXED, __HIP_MEMORY_SCOPE_WORKGROUP);
            RE[2 * row] = e1; RE[2 * row + 1] = e2; RG[2 * row] = gate1; RG[2 * row + 1] = gate2; RP[2 * row] = p1; RP[2 * row + 1] = p2;
        }
    }
    __syncthreads();
    if (F.tid < 32) ((int*)(F.ws + WS_BH))[F.bid * 32 + F.tid] = hist[F.tid];
    __syncthreads();
}

__device__ __forceinline__ void moe_tables(Frame& F, int l) {
    LAS int* seg = (LAS int*)(F.lds + LC_SEG); LAS int* cnts = (LAS int*)(F.lds + LC_CNTS); LAS int* tile_e = (LAS int*)(F.lds + LC_TILEE);
    LAS int* red = (LAS int*)(F.lds + LC_RED);
    LAS int* bbase = (LAS int*)(F.lds + LC_BBASE);
    const int* BH = (const int*)(F.ws + WS_BH);
    __syncthreads();
    { const int e = F.tid & 31, part = F.tid >> 5; int tot = 0, pre = 0;
      for (int bq = part; bq < F.G; bq += 16) { const int v = BH[bq * 32 + e]; tot += v; if (bq < F.bid) pre += v; }
      red[part * 32 + e] = tot; red[512 + part * 32 + e] = pre; }
    __syncthreads();
    if (F.tid < 32) { int tot = 0, pre = 0;
#pragma unroll 1
        for (int p = 0; p < 16; ++p) { tot += red[p * 32 + F.tid]; pre += red[512 + p * 32 + F.tid]; }
        cnts[F.tid] = tot; bbase[F.tid] = pre; }
    __syncthreads();
    if (F.tid == 0) {
        int s = 0;
#pragma unroll 1
        for (int e = 0; e < NE; ++e) { const int c = cnts[e]; seg[e] = s; const int nt = (c + 255) >> 8;
#pragma unroll 1
            for (int t = 0; t < nt; ++t) tile_e[(s >> 8) + t] = e;
            s += nt << 8; }
        seg[32] = s; seg[33] = s >> 8;
    }
    __syncthreads();
}
__device__ __forceinline__ void phase_dispatch(int l) {
    asm volatile("" : "+s"(l)); Frame F = make_frame();
    moe_tables(F, l);
    const LAS int* seg = (const LAS int*)(F.lds + LC_SEG); const LAS int* cnts = (const LAS int*)(F.lds + LC_CNTS); const LAS int* bbase = (const LAS int*)(F.lds + LC_BBASE);
    const int gw = F.bid * 8 + F.wave, NGW = F.G * 8;
    const int* RE = (const int*)(F.ws + WS_RE); const int* RP = (const int*)(F.ws + WS_RP); int* RS = (int*)(F.ws + WS_RS);
    const bf16_t* H = (const bf16_t*)((unsigned char*)F.out + DO_H); bf16_t* XS = (bf16_t*)(F.ws + WS_XS);
    for (int tile = F.bid; tile < NT / 16; tile += F.G) {
#pragma unroll
        for (int q = 0; q < 4; ++q) {
            const int item = (tile * 16 + 2 * F.wave) * 2 + q;
            const int row = item >> 1; const int e = RE[item], pos = RP[item]; const int slot = seg[e] + bbase[e] + pos;
            if (F.lane == 0) RS[item] = slot;
            const u32x4* src = (const u32x4*)(H + (size_t)row * D); u32x4* dst = (u32x4*)(XS + (size_t)slot * D);
            dst[F.lane] = src[F.lane]; dst[64 + F.lane] = src[64 + F.lane];
        }
    }
#pragma unroll 1
    for (int e = 0; e < NE; ++e) {
        const int c = cnts[e], padded = (c + 255) & ~255;
        for (int p = c + gw; p < padded; p += NGW) { u32x4* dst = (u32x4*)(XS + (size_t)(seg[e] + p) * D); dst[F.lane] = (u32x4){0u, 0u, 0u, 0u}; dst[64 + F.lane] = (u32x4){0u, 0u, 0u, 0u}; }
    }
}

__device__ __forceinline__ void phase_combine(int l, int rep_ = 0) {
    asm volatile("" : "+s"(l)); Frame F = make_frame();
    const int gw = F.bid * 8 + F.wave, NGW = F.G * 8;
    float* X = rep_ ? (float*)(F.ws + WS_Z) : (float*)(F.ws + WS_X); const bf16_t* YS = (const bf16_t*)(F.ws + WS_YS);
    const int* RS = (const int*)(F.ws + WS_RS); const float* RG = (const float*)(F.ws + WS_RG);
    for (int row = gw; row < NT; row += NGW) {
        const int mj = row < NCTX ? 16 : ((row - NCTX) >> 11);
        const float* g2 = (const float*)(F.ws + WS_MOD) + ((size_t)l * 17 + mj) * NMOD + 5120;
        const int s0 = RS[2 * row], s1 = RS[2 * row + 1]; const float ga = RG[2 * row], gb = RG[2 * row + 1];
#pragma unroll
        for (int j = 0; j < 4; ++j) {
            const int c = 4 * F.lane + 256 * j;
            const u32x2 y0 = *(const u32x2*)(YS + (size_t)s0 * D + c), y1 = *(const u32x2*)(YS + (size_t)s1 * D + c);
            const f32x4 gg = *(const f32x4*)(g2 + c);
            f32x4* p = (f32x4*)(X + (size_t)row * D + c); f32x4 x = *p;
            x[0] += gg[0] * (ga * bf2f(y0.x & 0xffffu) + gb * bf2f(y1.x & 0xffffu));
            x[1] += gg[1] * (ga * bf2f(y0.x >> 16) + gb * bf2f(y1.x >> 16));
            x[2] += gg[2] * (ga * bf2f(y0.y & 0xffffu) + gb * bf2f(y1.y & 0xffffu));
            x[3] += gg[3] * (ga * bf2f(y0.y >> 16) + gb * bf2f(y1.y >> 16));
            *p = x;
        }
    }
}

__device__ __forceinline__ void phase_final() {
    Frame F = make_frame();
    const int gw = F.bid * 8 + F.wave, NGW = F.G * 8;
    const float* X = (const float*)(F.ws + WS_X); const float* fg = F.inp(IN_FG);
    for (int r = gw; r < NLAT; r += NGW) {
        const float* xr = X + (size_t)(NCTX + r) * D;
        f32x4 v[4]; float ss = 0.f;
#pragma unroll
        for (int j = 0; j < 4; ++j) { v[j] = *(const f32x4*)(xr + 4 * F.lane + 256 * j); ss += v[j][0] * v[j][0] + v[j][1] * v[j][1] + v[j][2] * v[j][2] + v[j][3] * v[j][3]; }
        const float rs = rsqrtf(wave_sum(ss) * (1.0f / D) + NORM_EPS);
#pragma unroll
        for (int j = 0; j < 4; ++j) { const int c = 4 * F.lane + 256 * j; const f32x4 gg = *(const f32x4*)(fg + c);
            f32x4 o; o[0] = v[j][0] * rs * gg[0]; o[1] = v[j][1] * rs * gg[1]; o[2] = v[j][2] * rs * gg[2]; o[3] = v[j][3] * rs * gg[3];
            *(f32x4*)(F.out + (size_t)r * D + c) = o; }
    }
}

constexpr int NPL = 13;
constexpr int NPH = 1 + DEPTH * NPL + 1;
__device__ __forceinline__ void seam() {
    Frame F = make_frame();
    XcdBarrier bar; bar.bar = (unsigned*)(F.ws + WS_CTL) + CW_BAR; bar.x = xb_xcc_id(); bar.st = (volatile LAS unsigned*)(F.lds + LC_BARW);
    xcd_barrier(bar);
}
__global__ void __launch_bounds__(512, 2) mk_fwd(Args args_unused) {
    {
        Frame F = make_frame();
        for (int u = F.tid; u < (LDS_BYTES - LDS_CTL) / 4; u += 512) ((LAS unsigned*)(F.lds + LDS_CTL))[u] = 0u;
        __syncthreads();
        if (F.ka->ph_hi - F.ka->ph_lo > 1) (void)xcd_barrier_post((unsigned*)(F.ws + WS_CTL) + CW_BAR, (volatile LAS unsigned*)(F.lds + LC_BARW));
    }
#define IN(k) (kargs()->ph_lo <= (k) && (k) < kargs()->ph_hi)
#define SEAM(k) do { if (IN(k) && IN((k) + 1)) seam(); } while (0)
    int ph = 0;
    for (int rep_ = 0; rep_ < DUP_N(13); ++rep_) { if (rep_) seam(); if (PH_EN(13) && IN(ph)) phase_prologue(); }
    SEAM(ph); ++ph;
    for (int l = 0; l < DEPTH; ++l) {
        for (int rep_ = 0; rep_ < DUP_N(0); ++rep_) { if (rep_) seam(); if (PH_EN(0) && IN(ph)) phase_norm1(l); }
        SEAM(ph); ++ph;
        for (int rep_ = 0; rep_ < DUP_N(1); ++rep_) { if (rep_) seam(); if (PH_EN(1) && IN(ph)) { Frame F = make_frame(); Gemm g{(const bf16_t*)((unsigned char*)F.out + DO_H), (const bf16_t*)(F.ws + WS_WIN), NT, ZLD, D, 0}; StaticOrder S; S.init(NT, ZLD, F.G, F.bid); EpiStoreBf16 E{(bf16_t*)(F.ws + WS_Z), ZLD}; gemm_phase(F.lds, g, S, E); } }
        SEAM(ph); ++ph;
        for (int rep_ = 0; rep_ < DUP_N(2); ++rep_) { if (rep_) seam(); if (PH_EN(2) && IN(ph)) phase_prep(l); }
        SEAM(ph); ++ph;
        for (int rep_ = 0; rep_ < DUP_N(3); ++rep_) { if (rep_) seam(); if (PH_EN(3) && IN(ph)) phase_scan(l); }
        SEAM(ph); ++ph;
        for (int rep_ = 0; rep_ < DUP_N(4); ++rep_) { if (rep_) seam(); if (PH_EN(4) && IN(ph)) phase_mix(l); }
        SEAM(ph); ++ph;
        for (int rep_ = 0; rep_ < DUP_N(5); ++rep_) { if (rep_) seam(); if (PH_EN(5) && IN(ph)) { Frame F = make_frame(); Gemm g{(const bf16_t*)(F.ws + WS_UA), (const bf16_t*)(F.ws + WS_WA), NT, D, DH, 0}; StaticOrder S; S.init(NT, D, F.G, F.bid); EpiGate<false> E{(bf16_t*)((unsigned char*)F.out + DO_H), (const bf16_t*)(F.ws + WS_Z), ZC_GA}; gemm_phase(F.lds, g, S, E); } }
        SEAM(ph); ++ph;
        for (int rep_ = 0; rep_ < DUP_N(6); ++rep_) { if (rep_) seam(); if (PH_EN(6) && IN(ph)) { Frame F = make_frame(); Gemm g{(const bf16_t*)(F.ws + WS_UB), (const bf16_t*)(F.ws + WS_WB), NT, D, DH, 0}; StaticOrder S; S.init(NT, D, F.G, F.bid); EpiGate<true> E{rep_ ? (bf16_t*)(F.ws + WS_KD0) : (bf16_t*)((unsigned char*)F.out + DO_H), (const bf16_t*)(F.ws + WS_Z), ZC_GB}; gemm_phase(F.lds, g, S, E); } }
        SEAM(ph); ++ph;
        for (int rep_ = 0; rep_ < DUP_N(7); ++rep_) { if (rep_) seam(); if (PH_EN(7) && IN(ph)) { int ll = l; asm volatile("" : "+s"(ll)); Frame F = make_frame(); Gemm g{(const bf16_t*)((unsigned char*)F.out + DO_H), (const bf16_t*)(F.ws + WS_WO), NT, D, D, 0}; StaticOrder S; S.init(NT, D, F.G, F.bid);
            EpiResid E{rep_ ? (float*)(F.ws + WS_Z) : (float*)(F.ws + WS_X), (const float*)(F.ws + WS_MOD) + (size_t)ll * 17 * NMOD + 2048}; gemm_phase(F.lds, g, S, E); } }
        SEAM(ph); ++ph;
        for (int rep_ = 0; rep_ < DUP_N(8); ++rep_) { if (rep_) seam(); if (PH_EN(8) && IN(ph)) phase_norm2(l); }
        SEAM(ph); ++ph;
        for (int rep_ = 0; rep_ < DUP_N(9); ++rep_) { if (rep_) seam(); if (PH_EN(9) && IN(ph)) phase_dispatch(l); }
        SEAM(ph); ++ph;
        for (int rep_ = 0; rep_ < DUP_N(10); ++rep_) { if (rep_) seam(); if (PH_EN(10) && IN(ph)) { int ll = l; asm volatile("" : "+s"(ll)); Frame F = make_frame(); moe_tables(F, ll); MoeOrder S{__builtin_amdgcn_readfirstlane(((const LAS int*)(F.lds + LC_SEG))[33]), F.G, F.bid, (const LAS int*)(F.lds + LC_TILEE)};
            Gemm g{(const bf16_t*)(F.ws + WS_XS), (const bf16_t*)(F.ws + WS_W13), MAXTILES * 256, D, D, (size_t)1024 * 1024}; EpiSwiGLU E{(bf16_t*)(F.ws + WS_HID)}; gemm_phase(F.lds, g, S, E); } }
        SEAM(ph); ++ph;
        for (int rep_ = 0; rep_ < DUP_N(11); ++rep_) { if (rep_) seam(); if (PH_EN(11) && IN(ph)) { int ll = l; asm volatile("" : "+s"(ll)); Frame F = make_frame(); moe_tables(F, ll); MoeOrder S{__builtin_amdgcn_readfirstlane(((const LAS int*)(F.lds + LC_SEG))[33]), F.G, F.bid, (const LAS int*)(F.lds + LC_TILEE)};
            Gemm g{(const bf16_t*)(F.ws + WS_HID), (const bf16_t*)(F.ws + WS_W2), MAXTILES * 256, D, DFF, (size_t)1024 * 512}; EpiStoreBf16 E{(bf16_t*)(F.ws + WS_YS), D}; gemm_phase(F.lds, g, S, E); } }
        SEAM(ph); ++ph;
        for (int rep_ = 0; rep_ < DUP_N(12); ++rep_) { if (rep_) seam(); if (PH_EN(12) && IN(ph)) phase_combine(l, rep_); }
        SEAM(ph); ++ph;
    }
    if (PH_EN(14) && IN(ph)) phase_final();
#undef IN
#undef SEAM
}

extern "C" void kernel_launch(void* const* d_in, const int* in_sizes, int n_in, void* d_out, int out_size, void* d_ws, size_t ws_size, hipStream_t stream) {
    static int grid = 0;
    if (grid == 0) {
        if (n_in != 32 || out_size != NLAT * D || ws_size < WS_END) { fprintf(stderr, "kernel_launch: unexpected shapes (n_in %d, out %d, ws %zu < %zu)\n", n_in, out_size, ws_size, (size_t)WS_END); grid = -1; return; }
        int dev = 0, cus = 0, per_cu = 0;
        if (hipGetDevice(&dev) != hipSuccess || hipDeviceGetAttribute(&cus, hipDeviceAttributeMultiprocessorCount, dev) != hipSuccess) { grid = -1; return; }
        if (hipFuncSetAttribute((const void*)mk_fwd, hipFuncAttributeMaxDynamicSharedMemorySize, LDS_BYTES) != hipSuccess) { fprintf(stderr, "kernel_launch: hipFuncSetAttribute failed\n"); grid = -1; return; }
        if (hipOccupancyMaxActiveBlocksPerMultiprocessor(&per_cu, (const void*)mk_fwd, 512, LDS_BYTES) != hipSuccess || per_cu < 1) { fprintf(stderr, "kernel_launch: occupancy query says %d\n", per_cu); }
        (void)hipGetLastError();
        grid = cus;
    }
    if (grid < 0) return;
    if (hipMemsetAsync((char*)d_ws + WS_CTL, 0, CTL_ZERO_BYTES, stream) != hipSuccess) return;
    Args a{};
    for (int i = 0; i < 32; ++i) a.in[i] = (const float*)d_in[i];
    a.out = (float*)d_out; a.ws = (unsigned char*)d_ws;
#if MK_ONE_LAUNCH
    a.ph_lo = 0; a.ph_hi = NPH;
    hipLaunchKernelGGL(mk_fwd, dim3(grid), dim3(512), LDS_BYTES, stream, a);
#else
    for (int p = 0; p < NPH; ++p) { a.ph_lo = p; a.ph_hi = p + 1; hipLaunchKernelGGL(mk_fwd, dim3(grid), dim3(512), LDS_BYTES, stream, a); }
#endif
}
```

```cpp
#include <hip/hip_runtime.h>
#include <cstdio>
#include <cstdint>

#ifndef MK_ONE_LAUNCH
#define MK_ONE_LAUNCH 1
#endif
#ifndef GEMM_IMPL
#define GEMM_IMPL 1
#endif

#ifndef PHASE_MASK
#define PHASE_MASK 0xffff
#endif
#define PH_EN(p) (((PHASE_MASK) >> (p)) & 1)
#ifndef DUP_MASK
#define DUP_MASK 0
#endif
#ifndef SCAN_VAR
#define SCAN_VAR 0
#endif
#define DUP_N(p) (1 + (((DUP_MASK) >> (p)) & 1))
#define LAS __attribute__((address_space(3)))
typedef unsigned short bf16_t;
typedef short bf16x8 __attribute__((ext_vector_type(8)));
typedef float f32x4 __attribute__((ext_vector_type(4)));
typedef unsigned u32x4 __attribute__((ext_vector_type(4)));
typedef unsigned u32x2 __attribute__((ext_vector_type(2)));

constexpr int D = 1024, NBATCH = 16, SEQ = 2048, DEPTH = 4, CTXL = 256;
constexpr int NCTX = NBATCH * CTXL;
constexpr int NLAT = NBATCH * SEQ;
constexpr int NT = NCTX + NLAT;
constexpr int DH = 512;
constexpr int NIN = 5504, ZLD = 5632;
constexpr int ZC_BG = 0, ZC_CG = 512, ZC_HA = 1024, ZC_RW = 1536, ZC_GA = 3456, ZC_GB = 4480;
constexpr int RWC = 1920;
constexpr int NE = 32, DFF = 512;
constexpr int MAXTILES = 320;
constexpr int NMOD = 6 * D;
constexpr float NORM_EPS = 1e-6f, GN_EPS = 64e-5f;

constexpr size_t MiB = 1u << 20;
constexpr size_t WS_CTL = 0, CTL_ZERO_BYTES = 1 * MiB;
constexpr size_t WS_MOD = 1 * MiB;
constexpr size_t WS_RE = 3 * MiB;
constexpr size_t WS_RG = WS_RE + (size_t)NT * 8;
constexpr size_t WS_RP = WS_RG + (size_t)NT * 8;
constexpr size_t WS_RS = WS_RP + (size_t)NT * 8;
constexpr size_t WS_BH = 4 * MiB + 256 * 1024;
constexpr size_t WS_RB = 4 * MiB + 384 * 1024;
constexpr size_t WS_WC = 6 * MiB + 256 * 1024;
constexpr size_t WS_BONUS = 5 * MiB;
constexpr size_t WS_X = 8 * MiB;
constexpr size_t WS_WIN = 152 * MiB;
constexpr size_t WS_WA = 163 * MiB;
constexpr size_t WS_WB = 164 * MiB;
constexpr size_t WS_WO = 165 * MiB;
constexpr size_t WS_W13 = 167 * MiB;
constexpr size_t WS_W2 = 231 * MiB;
constexpr size_t WS_Z = 264 * MiB;
constexpr size_t WS_XS = WS_Z;
constexpr size_t WS_HID = WS_Z + 160 * MiB;
constexpr size_t WS_SI = 660 * MiB;
constexpr size_t SI_SZ = 36 * MiB;
constexpr size_t WS_V = WS_SI, WS_KT0 = WS_SI + SI_SZ, WS_KT1 = WS_SI + 2 * SI_SZ, WS_BT0 = WS_SI + 3 * SI_SZ, WS_BT1 = WS_SI + 4 * SI_SZ,
                 WS_KDT0 = WS_SI + 5 * SI_SZ, WS_KDT1 = WS_SI + 6 * SI_SZ, WS_RT0 = WS_SI + 7 * SI_SZ, WS_RT1 = WS_SI + 8 * SI_SZ;
constexpr size_t WS_B1 = WS_RT1, WS_KD0 = WS_KDT0;
constexpr size_t WS_UA = WS_KT0, WS_UB = WS_KT1;
constexpr size_t WS_GE0 = 1092 * MiB, WS_GE1 = 1097 * MiB;
constexpr size_t WS_YS = WS_SI;
constexpr size_t WS_Y0 = 984 * MiB, WS_Y1 = 1020 * MiB;
constexpr size_t WS_END = 1102 * MiB;
constexpr size_t DO_H = 0, DO_G = 72 * MiB;
static_assert(WS_Z + (size_t)NT * ZLD * 2 <= WS_SI && WS_HID + (size_t)MAXTILES * 256 * DFF * 2 <= WS_SI && WS_B1 + SI_SZ <= WS_Y0 && WS_YS + (size_t)MAXTILES * 256 * D * 2 <= WS_Y0, "ws map");
static_assert((size_t)NT * DH * 2 == SI_SZ && WS_X + (size_t)NT * D * 4 <= WS_WIN && WS_W2 + 32 * MiB <= WS_Z, "ws map 2");
constexpr int CW_CNT = 1024;
constexpr int CW_BAR = 4096;

constexpr int LDS_BYTES = 163840;
constexpr int LDS_CTL = 155648;
constexpr int LC_BARW = LDS_CTL;
constexpr int LC_SEG = LDS_CTL + 64;
constexpr int LC_CNTS = LDS_CTL + 256;
constexpr int LC_TILEE = LDS_CTL + 512;
constexpr int LC_BBASE = LDS_CTL + 2048;
constexpr int LC_RED = LDS_CTL + 4096;

__device__ __forceinline__ float bf2f(unsigned b) { return __uint_as_float(b << 16); }
__device__ __forceinline__ unsigned f2bf(float f) { unsigned u = __float_as_uint(f); return (u + 0x7fffu + ((u >> 16) & 1u)) >> 16; }
__device__ __forceinline__ unsigned pk2(float lo, float hi) { return f2bf(lo) | (f2bf(hi) << 16); }
__device__ __forceinline__ float wave_sum(float v) {
#pragma unroll
    for (int o = 1; o < 64; o <<= 1) v += __shfl_xor(v, o);
    return v;
}
__device__ __forceinline__ float sigmoidf_(float x) { return __builtin_amdgcn_rcpf(1.0f + __expf(-x)); }
__device__ __forceinline__ float siluf_(float x) { return x * __builtin_amdgcn_rcpf(1.0f + __expf(-x)); }

#define XB_TMO      128
#define XB_XCNT(j)  (256  + 64 * (j))
#define XB_XSUB(j)  (1280 + 64 * (j))
#define XB_XGEN(j)  (2304 + 64 * (j))
#define XB_TOP      3328
#define XB_TOPGEN   3392
#define XCD_BAR_WORDS 3456
#define XB_SPIN_CAP (1u << 22)

__device__ __forceinline__ unsigned xb_ld(unsigned* p)              { return __hip_atomic_load(p, __ATOMIC_RELAXED, __HIP_MEMORY_SCOPE_AGENT); }
__device__ __forceinline__ unsigned xb_add(unsigned* p, unsigned v) { return __hip_atomic_fetch_add(p, v, __ATOMIC_RELAXED, __HIP_MEMORY_SCOPE_AGENT); }
__device__ __forceinline__ unsigned xb_xcc_id() { return (unsigned)__builtin_amdgcn_s_getreg((3 << 11) | 20) & 0xFu; }
#define XB_SPIN(cond, bar) do { unsigned _sp = 0; while (cond) { __builtin_amdgcn_s_sleep(1); \
    if ((++_sp & 255u) == 0u) { if (xb_ld(&(bar)[XB_TMO])) break; if (_sp > XB_SPIN_CAP) { atomicAdd(&(bar)[XB_TMO], 1u); break; } } } } while (0)

struct XcdBarrier { unsigned* bar; unsigned x; volatile LAS unsigned* st; };

__device__ __forceinline__ XcdBarrier xcd_barrier_post(unsigned* bar, volatile LAS unsigned* st) {
    XcdBarrier b; b.bar = bar; b.x = xb_xcc_id(); b.st = st;
    if (threadIdx.x == 0) (void)xb_add(&bar[XB_XCNT(b.x)], 1u);
    return b;
}
__device__ __forceinline__ void xcd_barrier_complete(unsigned* bar, unsigned x, unsigned& nloc, unsigned& nx) {
    const unsigned G = gridDim.x * gridDim.y * gridDim.z;
    unsigned sum, cnt, mine, sp = 0u;
    for (;;) {
        sum = 0u; cnt = 0u; mine = 0u;
#pragma unroll
        for (unsigned j = 0; j < 16; ++j) { const unsigned c = xb_ld(&bar[XB_XCNT(j)]); sum += c; cnt += (c > 0u) ? 1u : 0u; mine = (j == x) ? c : mine; }
        if (sum == G) break;
        __builtin_amdgcn_s_sleep(1);
        if ((++sp & 255u) == 0u) { if (xb_ld(&bar[XB_TMO])) break; if (sp > XB_SPIN_CAP) { atomicAdd(&bar[XB_TMO], 1u); break; } }
    }
    nloc = mine > 0u ? mine : 1u; nx = cnt > 0u ? cnt : 1u;
}
__device__ __forceinline__ void xcd_barrier(const XcdBarrier& b) {
    asm volatile("s_waitcnt vmcnt(0)" ::: "memory");
    __syncthreads();
    if (threadIdx.x == 0) {
        unsigned* bar = b.bar;
        __builtin_amdgcn_s_waitcnt(0);
        unsigned nloc = b.st[0], nx = b.st[1];
        if (nloc == 0u) { xcd_barrier_complete(bar, b.x, nloc, nx); b.st[0] = nloc; b.st[1] = nx; }
        const unsigned old = xb_add(&bar[XB_XSUB(b.x)], 1u);
        const unsigned gen = old / nloc;
        if (old + 1u == (gen + 1u) * nloc) {
            __builtin_amdgcn_fence(__ATOMIC_RELEASE, "agent");
            asm volatile("s_waitcnt vmcnt(0)" ::: "memory");
            const unsigned og = xb_add(&bar[XB_TOP], 1u);
            const unsigned tg = og / nx;
            if (og + 1u == (tg + 1u) * nx) xb_add(&bar[XB_TOPGEN], 1u);
            else XB_SPIN(xb_ld(&bar[XB_TOPGEN]) == tg, bar);
            __builtin_amdgcn_fence(__ATOMIC_ACQUIRE, "agent");
            xb_add(&bar[XB_XGEN(b.x)], 1u);
            asm volatile("s_waitcnt vmcnt(0)" ::: "memory");
        } else {
            XB_SPIN(xb_ld(&bar[XB_XGEN(b.x)]) == gen, bar);
            __builtin_amdgcn_fence(__ATOMIC_ACQUIRE, "agent");
            asm volatile("s_waitcnt vmcnt(0)" ::: "memory");
        }
    }
    __syncthreads();
}

struct Unit { int pm, pn, bs, as; };
struct Gemm { const bf16_t* A; const bf16_t* Bt; int M, N, K; size_t bstride; size_t astride; };
constexpr int NXCD = 8, WGM = 8;
struct StaticOrder {
    int nM, nN, nwg, G, c;
    __device__ __forceinline__ void init(int M, int N, int G_, int c_) { nM = M / 256; nN = N / 256; nwg = nM * nN; G = G_; c = c_; }
    __device__ __forceinline__ bool next(int i, Unit& u) const {
        const long L = (long)i * G + c; if (L >= nwg) return false;
        int wgid = (int)L; { const int q = nwg / NXCD, r = nwg % NXCD, xcd = wgid % NXCD, off = wgid / NXCD; wgid = (xcd < r ? xcd * (q + 1) : r * (q + 1) + (xcd - r) * q) + off; }
        const int nig = WGM * nN, gid = wgid / nig, fm = gid * WGM, gsz = (nM - fm) < WGM ? (nM - fm) : WGM;
        u.pm = fm + ((wgid % nig) % gsz); u.pn = (wgid % nig) / gsz; u.bs = 0; u.as = 0; return true;
    }
};
struct PairOrder {
    StaticOrder so;
    __device__ __forceinline__ bool next(int i, Unit& u) const { if (!so.next(i >> 1, u)) return false; u.bs = i & 1; u.as = i & 1; return true; }
};
struct MoeOrder {
    int ntiles, G, c; const LAS int* tile_e;
    __device__ __forceinline__ bool next(int i, Unit& u) const {
        const int L = i * G + c; if (L >= ntiles * 4) return false;
        u.pm = L >> 2; u.pn = L & 3; u.bs = __builtin_amdgcn_readfirstlane(tile_e[u.pm]); u.as = 0; return true;
    }
};

#if GEMM_IMPL == 0
template <class Epi, class Sched>
__device__ __forceinline__ void gemm_phase(LAS unsigned char* lds, const Gemm g, const Sched& S, const Epi& E) {
    LAS float* As = (LAS float*)lds;
    LAS float* Bs = As + 16 * 260;
    const int tid = threadIdx.x, ty = tid >> 4, tx = tid & 15, lr = tid >> 1, lh = tid & 1;
    Unit u;
    for (int it = 0; S.next(it, u); ++it) {
        float acc[8][16];
#pragma unroll
        for (int i = 0; i < 8; ++i)
#pragma unroll
            for (int j = 0; j < 16; ++j) acc[i][j] = 0.f;
        const bf16_t* Ap = g.A + ((size_t)u.pm * 256 + lr) * g.K + lh * 8;
        const bf16_t* Bp = g.Bt + (size_t)u.bs * g.bstride + ((size_t)u.pn * 256 + lr) * g.K + lh * 8;
        for (int k0 = 0; k0 < g.K; k0 += 16) {
            const u32x4 av = *(const u32x4*)(Ap + k0), bv = *(const u32x4*)(Bp + k0);
            __syncthreads();
#pragma unroll
            for (int j = 0; j < 4; ++j) {
                As[(lh * 8 + 2 * j) * 260 + lr] = bf2f(av[j] & 0xffffu); As[(lh * 8 + 2 * j + 1) * 260 + lr] = bf2f(av[j] >> 16);
                Bs[(lh * 8 + 2 * j) * 260 + lr] = bf2f(bv[j] & 0xffffu); Bs[(lh * 8 + 2 * j + 1) * 260 + lr] = bf2f(bv[j] >> 16);
            }
            __syncthreads();
#pragma unroll 4
            for (int kk = 0; kk < 16; ++kk) {
                float a[8], b[16];
                const f32x4 a0 = *(const LAS f32x4*)(As + kk * 260 + ty * 8), a1 = *(const LAS f32x4*)(As + kk * 260 + ty * 8 + 4);
                a[0] = a0[0]; a[1] = a0[1]; a[2] = a0[2]; a[3] = a0[3]; a[4] = a1[0]; a[5] = a1[1]; a[6] = a1[2]; a[7] = a1[3];
#pragma unroll
                for (int q = 0; q < 4; ++q) { const f32x4 bq = *(const LAS f32x4*)(Bs + kk * 260 + tx * 4 + 64 * q); b[4 * q] = bq[0]; b[4 * q + 1] = bq[1]; b[4 * q + 2] = bq[2]; b[4 * q + 3] = bq[3]; }
#pragma unroll
                for (int i = 0; i < 8; ++i)
#pragma unroll
                    for (int j = 0; j < 16; ++j) acc[i][j] = fmaf(a[i], b[j], acc[i][j]);
            }
        }
#pragma unroll
        for (int i = 0; i < 8; ++i)
#pragma unroll
            for (int q = 0; q < 4; ++q)
                E.elem4(u.pm * 256 + ty * 8 + i, u.pn * 256 + tx * 4 + 64 * q, (f32x4){acc[i][4 * q], acc[i][4 * q + 1], acc[i][4 * q + 2], acc[i][4 * q + 3]});
    }
    __syncthreads();
}
#else
namespace pg8 {
constexpr int BM = 256, BK = 64, HALF = 128, HTB = HALF * BK * 2, STAGE_BYTES = 8 * HTB;
__device__ __forceinline__ int lds_byte(int r, int c) { const int st = (r >> 4) * 2 + (c >> 5), rr = r & 15, cc = c & 31, ob = rr * 64 + cc * 2; return st * 1024 + (ob ^ (((ob >> 9) & 1) << 5)); }
__device__ __forceinline__ void stage_rc(int b, int& R, int& C) { const int st = b / 1024, sb = b % 1024, swz = sb ^ (((sb >> 9) & 1) << 5); R = (st >> 1) * 16 + swz / 64; C = (st & 1) * 32 + (swz % 64) / 2; }
}
template <class Epi, class Sched>
__device__ __forceinline__ void gemm_phase(LAS unsigned char* lds, const Gemm g, const Sched& S, const Epi& E) {
    using namespace pg8;
    int tid_ = threadIdx.x; asm volatile("" : "+v"(tid_));
    const int tid = tid_, wid = __builtin_amdgcn_readfirstlane(tid >> 6), lane = tid & 63, wr = wid >> 2, wc = wid & 3, fr = lane & 15, fq = lane >> 4;
    const int K = g.K, nt = K / BK;
    unsigned voffA[2];
#pragma unroll
    for (int i = 0; i < 2; ++i) { int R, C; stage_rc(tid * 16 + i * 8192, R, C); voffA[i] = (unsigned)(R * K + C) * 2u; }
    const size_t kstep = (size_t)(BK * 2);
    const size_t hstep = (size_t)HALF * K * 2;
    const size_t tstep = 2 * hstep;
    const unsigned ldsw = (unsigned)wid * 1024u;
    const int aoff = lds_byte(wr * 64 + fr, fq * 8), boff = lds_byte(wc * 32 + fr, fq * 8);
#define PG8_SA(b, h) (((b) * 2 + (h)) * HTB)
#define PG8_SB(b, h) ((4 + (b) * 2 + (h)) * HTB)
#define PG8_STAGE(bufoff, gbase, voff) do { _Pragma("unroll") for (int _i = 0; _i < 2; ++_i) \
        __builtin_amdgcn_global_load_lds((const unsigned*)((const char*)(gbase) + (voff)[_i]), (LAS unsigned*)(lds + (bufoff) + ldsw + _i * 8192), 16, 0, 0); } while (0)
#define PG8_LDA(dst, b, h) do { _Pragma("unroll") for (int m = 0; m < 4; ++m) _Pragma("unroll") for (int k = 0; k < 2; ++k) dst[m][k] = *(const LAS bf16x8*)(lds + PG8_SA(b, h) + aoff + m * 2048 + k * 1024); } while (0)
#define PG8_LDB(dst, b, h) do { _Pragma("unroll") for (int n = 0; n < 2; ++n) _Pragma("unroll") for (int k = 0; k < 2; ++k) dst[n][k] = *(const LAS bf16x8*)(lds + PG8_SB(b, h) + boff + n * 2048 + k * 1024); } while (0)
#define PG8_MMA(ai, bj, At, Bt) do { __builtin_amdgcn_s_setprio(1); _Pragma("unroll") for (int m = 0; m < 4; ++m) _Pragma("unroll") for (int n = 0; n < 2; ++n) _Pragma("unroll") for (int k = 0; k < 2; ++k) \
        acc[ai][bj][m][n] = __builtin_amdgcn_mfma_f32_16x16x32_bf16(Bt[n][k], At[m][k], acc[ai][bj][m][n], 0, 0, 0); __builtin_amdgcn_s_setprio(0); } while (0)
#define PG8_WAIT_V(n) asm volatile("s_waitcnt vmcnt(" #n ")" ::: "memory")
#define PG8_WAIT_L(n) asm volatile("s_waitcnt lgkmcnt(" #n ")" ::: "memory")
#define PG8_BAR __builtin_amdgcn_s_barrier()
#define PG8_SCHED __builtin_amdgcn_sched_barrier(0)
    Unit cur, nxt; int ui = 0;
    if (S.next(0, cur)) {
    f32x4 acc[2][2][4][2];
#pragma unroll
    for (int a = 0; a < 2; ++a)
#pragma unroll
        for (int b = 0; b < 2; ++b)
#pragma unroll
            for (int m = 0; m < 4; ++m)
#pragma unroll
                for (int n = 0; n < 2; ++n) acc[a][b][m][n] = (f32x4){0.f, 0.f, 0.f, 0.f};
    bf16x8 At[4][2], B0[2][2], B1[2][2];
    const char* cA = (const char*)(g.A + (size_t)cur.as * g.astride) + (size_t)cur.pm * tstep; const char* cB = (const char*)(g.Bt + (size_t)cur.bs * g.bstride) + (size_t)cur.pn * tstep;
    PG8_STAGE(PG8_SB(0, 0), cB, voffA); PG8_STAGE(PG8_SA(0, 0), cA, voffA); PG8_STAGE(PG8_SB(0, 1), cB + hstep, voffA); PG8_STAGE(PG8_SA(0, 1), cA + hstep, voffA);
    if (wr == 1) PG8_BAR;
    PG8_WAIT_V(4); PG8_BAR;
    PG8_STAGE(PG8_SB(1, 0), cB + kstep, voffA); PG8_STAGE(PG8_SA(1, 0), cA + kstep, voffA); PG8_STAGE(PG8_SB(1, 1), cB + hstep + kstep, voffA);
    PG8_WAIT_V(6); PG8_BAR;
    for (;;) {
        const bool has_next = S.next(ui + 1, nxt);
        const char* nA = has_next ? (const char*)(g.A + (size_t)nxt.as * g.astride) + (size_t)nxt.pm * tstep : cA; const char* nB = has_next ? (const char*)(g.Bt + (size_t)nxt.bs * g.bstride) + (size_t)nxt.pn * tstep : cB;
        for (int t = 0; t < nt; t += 2) {
            const bool last = (t == nt - 2);
            const char* a1 = cA + (size_t)(t + 1) * kstep;
            const char* a2 = last ? nA : cA + (size_t)(t + 2) * kstep; const char* b2 = last ? nB : cB + (size_t)(t + 2) * kstep;
            const char* a3 = a2 + kstep; const char* b3 = b2 + kstep;
            PG8_LDB(B0, 0, 0); PG8_SCHED; PG8_LDA(At, 0, 0); PG8_STAGE(PG8_SA(1, 1), a1 + hstep, voffA);
            PG8_WAIT_L(8); PG8_BAR; PG8_WAIT_L(0); PG8_MMA(0, 0, At, B0); PG8_BAR; PG8_SCHED;
            PG8_LDB(B1, 0, 1); PG8_STAGE(PG8_SB(0, 0), b2, voffA);
            PG8_BAR; PG8_WAIT_L(0); PG8_MMA(0, 1, At, B1); PG8_BAR;
            PG8_LDA(At, 0, 1); PG8_STAGE(PG8_SA(0, 0), a2, voffA);
            PG8_BAR; PG8_WAIT_L(0); PG8_MMA(1, 0, At, B0); PG8_BAR; PG8_SCHED;
            PG8_STAGE(PG8_SB(0, 1), b2 + hstep, voffA);
            PG8_WAIT_V(6); PG8_BAR; PG8_MMA(1, 1, At, B1); PG8_BAR;
            PG8_LDB(B0, 1, 0); PG8_SCHED; PG8_LDA(At, 1, 0); PG8_STAGE(PG8_SA(0, 1), a2 + hstep, voffA);
            PG8_WAIT_L(8); PG8_BAR; PG8_WAIT_L(0); PG8_MMA(0, 0, At, B0); PG8_BAR; PG8_SCHED;
            PG8_LDB(B1, 1, 1); PG8_STAGE(PG8_SB(1, 0), b3, voffA);
            PG8_BAR; PG8_WAIT_L(0); PG8_MMA(0, 1, At, B1); PG8_BAR;
            PG8_LDA(At, 1, 1); PG8_STAGE(PG8_SA(1, 0), a3, voffA);
            PG8_BAR; PG8_WAIT_L(0); PG8_MMA(1, 0, At, B0); PG8_BAR; PG8_SCHED;
            PG8_STAGE(PG8_SB(1, 1), b3 + hstep, voffA);
            PG8_WAIT_V(6); PG8_BAR; PG8_MMA(1, 1, At, B1); PG8_BAR;
        }
        bool keep = false;
        {
            const int row0 = cur.pm * 256 + wr * 64 + fr, col0 = cur.pn * 256 + wc * 32 + 4 * fq;
            if constexpr (Epi::TWO_PART) keep = (cur.as == 0);
#pragma unroll
            for (int ai = 0; ai < 2; ++ai)
#pragma unroll
                for (int m = 0; m < 4; ++m)
#pragma unroll
                    for (int bj = 0; bj < 2; ++bj)
#pragma unroll
                        for (int n = 0; n < 2; ++n) {
                            if constexpr (Epi::TWO_PART) { if (keep) E.mid4(row0 + ai * 128 + m * 16, col0 + bj * 128 + n * 16, acc[ai][bj][m][n]); else E.elem4(row0 + ai * 128 + m * 16, col0 + bj * 128 + n * 16, acc[ai][bj][m][n]); }
                            else E.elem4(row0 + ai * 128 + m * 16, col0 + bj * 128 + n * 16, acc[ai][bj][m][n]);
                        }
        }
        if (!has_next) break;
        if (!keep) {
#pragma unroll
        for (int a = 0; a < 2; ++a)
#pragma unroll
            for (int b = 0; b < 2; ++b)
#pragma unroll
                for (int m = 0; m < 4; ++m)
#pragma unroll
                    for (int n = 0; n < 2; ++n) acc[a][b][m][n] = (f32x4){0.f, 0.f, 0.f, 0.f};
        }
        cur = nxt; cA = nA; cB = nB; ++ui;
    }
    PG8_WAIT_V(0);
    if (wr == 0) PG8_BAR;
    PG8_BAR;
    }
#undef PG8_SA
#undef PG8_SB
#undef PG8_STAGE
#undef PG8_LDA
#undef PG8_LDB
#undef PG8_MMA
#undef PG8_WAIT_V
#undef PG8_WAIT_L
#undef PG8_BAR
#undef PG8_SCHED
    __syncthreads();
}
#endif

struct EpiStoreBf16 {
    static constexpr bool TWO_PART = false;
    bf16_t* O; int ldc;
    __device__ __forceinline__ void elem4(int row, int col, f32x4 v) const {
        u32x2 w; w.x = pk2(v[0], v[1]); w.y = pk2(v[2], v[3]);
        *(u32x2*)(O + (size_t)row * ldc + col) = w;
    }
};
struct EpiMerge {
    static constexpr bool TWO_PART = true;
    bf16_t* MG; const bf16_t* Z;
    __device__ __forceinline__ void mid4(int row, int col, f32x4& v) const {
        const u32x2 ga = *(const u32x2*)(Z + (size_t)row * ZLD + ZC_GA + col), gb = *(const u32x2*)(Z + (size_t)row * ZLD + ZC_GB + col);
        v[0] *= (1.0f + __expf(-bf2f(gb.x & 0xffffu))) * __builtin_amdgcn_rcpf(1.0f + __expf(-bf2f(ga.x & 0xffffu)));
        v[1] *= (1.0f + __expf(-bf2f(gb.x >> 16))) * __builtin_amdgcn_rcpf(1.0f + __expf(-bf2f(ga.x >> 16)));
        v[2] *= (1.0f + __expf(-bf2f(gb.y & 0xffffu))) * __builtin_amdgcn_rcpf(1.0f + __expf(-bf2f(ga.y & 0xffffu)));
        v[3] *= (1.0f + __expf(-bf2f(gb.y >> 16))) * __builtin_amdgcn_rcpf(1.0f + __expf(-bf2f(ga.y >> 16)));
    }
    __device__ __forceinline__ void elem4(int row, int col, f32x4 v) const {
        const u32x2 gb = *(const u32x2*)(Z + (size_t)row * ZLD + ZC_GB + col);
        u32x2 w; w.x = pk2(sigmoidf_(bf2f(gb.x & 0xffffu)) * v[0], sigmoidf_(bf2f(gb.x >> 16)) * v[1]); w.y = pk2(sigmoidf_(bf2f(gb.y & 0xffffu)) * v[2], sigmoidf_(bf2f(gb.y >> 16)) * v[3]);
        *(u32x2*)(MG + (size_t)row * D + col) = w;
    }
};
struct EpiResid {
    static constexpr bool TWO_PART = false;
    float* X; const float* modg;
    __device__ __forceinline__ void elem4(int row, int col, f32x4 v) const {
        const int mj = row < NCTX ? 16 : ((row - NCTX) >> 11);
        const f32x4 gv = *(const f32x4*)(modg + (size_t)mj * NMOD + col);
        f32x4* p = (f32x4*)(X + (size_t)row * D + col);
        f32x4 x = *p; x[0] += gv[0] * v[0]; x[1] += gv[1] * v[1]; x[2] += gv[2] * v[2]; x[3] += gv[3] * v[3]; *p = x;
    }
};
struct EpiSwiGLU {
    static constexpr bool TWO_PART = false;
    bf16_t* HID;
    __device__ __forceinline__ void elem4(int row, int col, f32x4 v) const {
        *(unsigned*)(HID + (size_t)row * DFF + (col >> 1)) = pk2(siluf_(v[0]) * v[2], siluf_(v[1]) * v[3]);
    }
};

struct Args { const float* in[32]; float* out; unsigned char* ws; int ph_lo, ph_hi; };
typedef const __attribute__((address_space(4))) Args* KArgs;
__device__ __forceinline__ KArgs kargs() { KArgs p = (KArgs)__builtin_amdgcn_kernarg_segment_ptr(); asm volatile("" : "+s"(p)); return p; }
struct Frame {
    LAS unsigned char* lds;
    int tid, lane, wave, G, bid;
    KArgs ka; float* out; unsigned char* ws;
    __device__ __forceinline__ const float* inp(int i) const { return ka->in[i]; }
};
__device__ __forceinline__ Frame make_frame() {
    extern __shared__ __attribute__((aligned(16))) unsigned char lds_raw[];
    Frame F; F.lds = (LAS unsigned char*)lds_raw; { int t = threadIdx.x; asm volatile("" : "+v"(t)); F.tid = t; } F.lane = F.tid & 63; F.wave = __builtin_amdgcn_readfirstlane(F.tid >> 6);
    { int g_ = gridDim.x, b_ = blockIdx.x; asm volatile("" : "+s"(g_), "+s"(b_)); F.G = g_; F.bid = b_; } F.ka = kargs(); F.out = F.ka->out; F.ws = F.ka->ws; return F;
}
#define IN_X 0
#define IN_C 1
#define IN_CTX 2
#define IN_CCTX 3
#define IN_WMOD 4
#define IN_BMOD 5
#define IN_N1G 6
#define IN_N2G 7
#define IN_WIN 8
#define IN_SHMU 9
#define IN_CONVW 10
#define IN_WUP 11
#define IN_W0 12
#define IN_AUP 13
#define IN_A0 14
#define IN_GUP 15
#define IN_KK 16
#define IN_KA 17
#define IN_RK 18
#define IN_LNG 19
#define IN_LNB 20
#define IN_WAO 21
#define IN_WBO 22
#define IN_WO 23
#define IN_RG 24
#define IN_RGB 25
#define IN_RE 26
#define IN_REB 27
#define IN_W1 28
#define IN_W3 29
#define IN_W2 30
#define IN_FG 31

__device__ __forceinline__ void phase_prologue() {
    Frame F = make_frame();
    {
        const f32x4* sc = (const f32x4*)F.inp(IN_CTX); const f32x4* sx = (const f32x4*)F.inp(IN_X); f32x4* X = (f32x4*)(F.ws + WS_X);
        const size_t n4c = (size_t)NCTX * D / 4, n4 = (size_t)NT * D / 4;
        for (size_t i = (size_t)F.bid * 512 + F.tid; i < n4; i += (size_t)F.G * 512) X[i] = i < n4c ? sc[i] : sx[i - n4c];
    }
    {
        float* WC = (float*)(F.ws + WS_WC); float* RB = (float*)(F.ws + WS_RB);
        for (int i = F.bid * 512 + F.tid; i < DEPTH * 1024 * 48; i += F.G * 512) { const int c = i % 48, lk = i / 48;
            WC[i] = c < 32 ? F.inp(IN_RE)[(size_t)lk * 32 + c] : (c < 36 ? F.inp(IN_RG)[(size_t)lk * 4 + (c - 32)] : 0.f); }
        if (F.bid == 0 && F.tid < DEPTH * 48) { const int c = F.tid % 48, l = F.tid / 48; RB[F.tid] = c < 32 ? F.inp(IN_REB)[l * 32 + c] : (c < 36 ? F.inp(IN_RGB)[l * 4 + (c - 32)] : 0.f); }
    }
    if (F.bid * 512 < DEPTH * NMOD) {
        LAS float* st = (LAS float*)F.lds;
        for (int i = F.tid; i < 17 * 1024; i += 512) { const int j = i >> 10, k = i & 1023; const float cv = j < 16 ? F.inp(IN_C)[j * 1024 + k] : F.inp(IN_CCTX)[k]; st[k * 20 + j] = siluf_(cv); }
        __syncthreads();
        for (int cidx = F.bid * 512 + F.tid; cidx < DEPTH * NMOD; cidx += F.G * 512) {
            const int l = cidx / NMOD, n = cidx % NMOD;
            const float* w = F.inp(IN_WMOD) + (size_t)l * D * NMOD + n;
            float acc[17]; const float b = F.inp(IN_BMOD)[l * NMOD + n];
#pragma unroll
            for (int j = 0; j < 17; ++j) acc[j] = b;
#pragma unroll 4
            for (int k = 0; k < 1024; ++k) {
                const float wv = w[(size_t)k * NMOD];
#pragma unroll
                for (int j = 0; j < 17; ++j) acc[j] = fmaf(st[k * 20 + j], wv, acc[j]);
            }
            float* mod = (float*)(F.ws + WS_MOD) + (size_t)l * 17 * NMOD + n;
#pragma unroll
            for (int j = 0; j < 17; ++j) mod[(size_t)j * NMOD] = acc[j];
        }
        __syncthreads();
    }
}

__device__ __forceinline__ void conv_item(const float* src0, const float* src1, int ldsrc, int nvalid, int mode, bf16_t* dst, int K, int item, LAS float* scr, int lane) {
    const int nkb = K / 64, kb = item % nkb, jb = item / nkb, k0 = 64 * kb, j0 = 32 * jb;
    const int jj = j0 + (lane & 31);
    const float* colp;
    if (mode == 0) colp = jj < nvalid ? src0 + jj : nullptr;
    else colp = ((jj & 2) ? src1 : src0) + 2 * (jj >> 2) + (jj & 1);
#pragma unroll 8
    for (int i = 0; i < 32; ++i) { const int kk = 2 * i + (lane >> 5); scr[kk * 33 + (lane & 31)] = colp ? colp[(size_t)(k0 + kk) * ldsrc] : 0.f; }
    asm volatile("s_waitcnt lgkmcnt(0)" ::: "memory");
    const int c = lane & 7;
#pragma unroll
    for (int j = 0; j < 4; ++j) { const int n = (lane >> 3) + 8 * j; const LAS float* s = scr + (8 * c) * 33 + n;
        u32x4 o; o.x = pk2(s[0 * 33], s[1 * 33]); o.y = pk2(s[2 * 33], s[3 * 33]); o.z = pk2(s[4 * 33], s[5 * 33]); o.w = pk2(s[6 * 33], s[7 * 33]);
        *(u32x4*)(dst + (size_t)(j0 + n) * K + k0 + 8 * c) = o; }
    asm volatile("s_waitcnt lgkmcnt(0)" ::: "memory");
}
__device__ __forceinline__ void convert_layer_weights(Frame& F, int l) {
    LAS float* scr = (LAS float*)(F.lds + F.wave * 8704);
    const int gw = F.bid * 8 + F.wave, NGW = F.G * 8;
    constexpr int I_IN = (1024 / 64) * (ZLD / 32), I_A = (512 / 64) * (1024 / 32), I_O = (1024 / 64) * (1024 / 32), I_13 = (1024 / 64) * (1024 / 32), I_2 = (512 / 64) * (1024 / 32);
    constexpr int NITEMS = I_IN + 2 * I_A + I_O + NE * I_13 + NE * I_2;
    for (int it = gw; it < NITEMS; it += NGW) {
        int r = it;
        if (r < I_IN) { conv_item(F.inp(IN_WIN) + (size_t)l * D * NIN, nullptr, NIN, NIN, 0, (bf16_t*)(F.ws + WS_WIN), 1024, r, scr, F.lane); continue; } r -= I_IN;
        if (r < I_A) { conv_item(F.inp(IN_WAO) + (size_t)l * DH * D, nullptr, D, D, 0, (bf16_t*)(F.ws + WS_WA), 512, r, scr, F.lane); continue; } r -= I_A;
        if (r < I_A) { conv_item(F.inp(IN_WBO) + (size_t)l * DH * D, nullptr, D, D, 0, (bf16_t*)(F.ws + WS_WB), 512, r, scr, F.lane); continue; } r -= I_A;
        if (r < I_O) { conv_item(F.inp(IN_WO) + (size_t)l * D * D, nullptr, D, D, 0, (bf16_t*)(F.ws + WS_WO), 1024, r, scr, F.lane); continue; } r -= I_O;
        if (r < NE * I_13) { const int e = r / I_13, ri = r % I_13; const size_t so = ((size_t)l * NE + e) * D * DFF;
            conv_item(F.inp(IN_W1) + so, F.inp(IN_W3) + so, DFF, 0, 1, (bf16_t*)(F.ws + WS_W13) + (size_t)e * 1024 * 1024, 1024, ri, scr, F.lane); continue; } r -= NE * I_13;
        { const int e = r / I_2, ri = r % I_2; const size_t so = ((size_t)l * NE + e) * DFF * D;
            conv_item(F.inp(IN_W2) + so, nullptr, D, D, 0, (bf16_t*)(F.ws + WS_W2) + (size_t)e * 1024 * 512, 512, ri, scr, F.lane); }
    }
}

__device__ __forceinline__ void combine_row(Frame& F, int lprev, int row, f32x4 (&v)[4]) {
    const bf16_t* YS = (const bf16_t*)(F.ws + WS_YS); const int* RS = (const int*)(F.ws + WS_RS); const float* RG = (const float*)(F.ws + WS_RG);
    const int mj = row < NCTX ? 16 : ((row - NCTX) >> 11);
    const float* g2 = (const float*)(F.ws + WS_MOD) + ((size_t)lprev * 17 + mj) * NMOD + 5120;
    const int s0 = RS[2 * row], s1 = RS[2 * row + 1]; const float ga = RG[2 * row], gb = RG[2 * row + 1];
#pragma unroll
    for (int j = 0; j < 4; ++j) {
        const int c = 4 * F.lane + 256 * j;
        const u32x2 y0 = *(const u32x2*)(YS + (size_t)s0 * D + c), y1 = *(const u32x2*)(YS + (size_t)s1 * D + c);
        const f32x4 gg = *(const f32x4*)(g2 + c);
        v[j][0] += gg[0] * (ga * bf2f(y0.x & 0xffffu) + gb * bf2f(y1.x & 0xffffu));
        v[j][1] += gg[1] * (ga * bf2f(y0.x >> 16) + gb * bf2f(y1.x >> 16));
        v[j][2] += gg[2] * (ga * bf2f(y0.y & 0xffffu) + gb * bf2f(y1.y & 0xffffu));
        v[j][3] += gg[3] * (ga * bf2f(y0.y >> 16) + gb * bf2f(y1.y >> 16));
    }
}
__device__ __forceinline__ void phase_norm1(int l) {
    asm volatile("" : "+s"(l)); Frame F = make_frame();
    convert_layer_weights(F, l);
    const int gw = F.bid * 8 + F.wave, NGW = F.G * 8;
    float* X = (float*)(F.ws + WS_X); bf16_t* H = (bf16_t*)((unsigned char*)F.out + DO_H);
    const float* g1n = F.inp(IN_N1G) + l * D;
    for (int row = gw; row < NT; row += NGW) {
        const int mj = row < NCTX ? 16 : ((row - NCTX) >> 11);
        const float* mod = (const float*)(F.ws + WS_MOD) + ((size_t)l * 17 + mj) * NMOD;
        f32x4 v[4];
#pragma unroll
        for (int j = 0; j < 4; ++j) v[j] = *(const f32x4*)(X + (size_t)row * D + 4 * F.lane + 256 * j);
        if (l > 0) {
            combine_row(F, l - 1, row, v);
#pragma unroll
            for (int j = 0; j < 4; ++j) *(f32x4*)(X + (size_t)row * D + 4 * F.lane + 256 * j) = v[j];
        }
        float ss = 0.f;
#pragma unroll
        for (int j = 0; j < 4; ++j) ss += v[j][0] * v[j][0] + v[j][1] * v[j][1] + v[j][2] * v[j][2] + v[j][3] * v[j][3];
        const float rs = rsqrtf(wave_sum(ss) * (1.0f / D) + NORM_EPS);
#pragma unroll
        for (int j = 0; j < 4; ++j) {
            const int c = 4 * F.lane + 256 * j;
            const f32x4 gg = *(const f32x4*)(g1n + c), sh = *(const f32x4*)(mod + c), sc = *(const f32x4*)(mod + 1024 + c);
            float o[4];
#pragma unroll
            for (int q = 0; q < 4; ++q) o[q] = v[j][q] * rs * gg[q] * (1.0f + sc[q]) + sh[q];
            u32x2 w; w.x = pk2(o[0], o[1]); w.y = pk2(o[2], o[3]);
            *(u32x2*)(H + (size_t)row * D + c) = w;
        }
    }
}

constexpr int PW_S64 = 144, PW_S128 = 272;
constexpr int PW_G = 4 * 64 * PW_S64;
constexpr int PA_OFF = PW_G + 64 * PW_S128;
constexpr int PA_STRIDE = 784;
static_assert(PA_OFF + 128 * PA_STRIDE <= LDS_CTL, "prep LDS map");
__device__ __forceinline__ float tanh_fast(float x) { return 1.0f - 2.0f * __builtin_amdgcn_rcpf(1.0f + __expf(2.0f * x)); }
__device__ __forceinline__ void unpack8(const u32x4 p, float (&o)[8]) {
#pragma unroll
    for (int j = 0; j < 4; ++j) { o[2 * j] = bf2f(p[j] & 0xffffu); o[2 * j + 1] = bf2f(p[j] >> 16); }
}
__device__ __forceinline__ u32x4 pack8(const float (&f)[8]) { u32x4 r; r.x = pk2(f[0], f[1]); r.y = pk2(f[2], f[3]); r.z = pk2(f[4], f[5]); r.w = pk2(f[6], f[7]); return r; }
__device__ __forceinline__ void shifted16(const bf16_t* Z, int row, bool hasp, bool hasn, int col, const float* mu, float (&o)[16]) {
    const bf16_t* p = Z + (size_t)row * ZLD + ZC_RW + col;
    const u32x4 z0 = *(const u32x4*)p, z1 = *(const u32x4*)(p + 8);
    const u32x4 zero = (u32x4){0u, 0u, 0u, 0u};
    const u32x4 m0 = hasp ? *(const u32x4*)(p - ZLD) : zero, m1 = hasp ? *(const u32x4*)(p - ZLD + 8) : zero;
    const u32x4 n0 = hasn ? *(const u32x4*)(p + ZLD) : zero, n1 = hasn ? *(const u32x4*)(p + ZLD + 8) : zero;
    float z[16], zm[16], zn[16];
    { float t[8]; unpack8(z0, t);
#pragma unroll
      for (int j = 0; j < 8; ++j) z[j] = t[j];
      unpack8(z1, t);
#pragma unroll
      for (int j = 0; j < 8; ++j) z[8 + j] = t[j];
      unpack8(m0, t);
#pragma unroll
      for (int j = 0; j < 8; ++j) zm[j] = t[j];
      unpack8(m1, t);
#pragma unroll
      for (int j = 0; j < 8; ++j) zm[8 + j] = t[j];
      unpack8(n0, t);
#pragma unroll
      for (int j = 0; j < 8; ++j) zn[j] = t[j];
      unpack8(n1, t);
#pragma unroll
      for (int j = 0; j < 8; ++j) zn[8 + j] = t[j]; }
#pragma unroll
    for (int q = 0; q < 4; ++q) { const f32x4 m = *(const f32x4*)(mu + col + 4 * q);
#pragma unroll
        for (int e = 0; e < 4; ++e) { const int j = 4 * q + e; o[j] = z[j] + m[e] * (0.5f * (zm[j] + zn[j]) - z[j]); } }
}
__device__ __forceinline__ void store16(bf16_t* dst, const float (&f)[16]) {
    u32x4 a, b; a.x = pk2(f[0], f[1]); a.y = pk2(f[2], f[3]); a.z = pk2(f[4], f[5]); a.w = pk2(f[6], f[7]); b.x = pk2(f[8], f[9]); b.y = pk2(f[10], f[11]); b.z = pk2(f[12], f[13]); b.w = pk2(f[14], f[15]);
    *(u32x4*)dst = a; *(u32x4*)(dst + 8) = b;
}
__device__ __forceinline__ void phase_prep(int l) {
    asm volatile("" : "+s"(l)); Frame F = make_frame();
    const int tid = F.tid, lane = F.lane, w = F.wave, tok = lane & 15, cq = lane >> 4;
    const bf16_t* Z = (const bf16_t*)(F.ws + WS_Z);
    const float* mu = F.inp(IN_SHMU) + l * RWC;
    float* BON = (float*)(F.ws + WS_BONUS);
    for (int unit = F.bid; unit < 256; unit += F.G) {
        const int h = unit & 7, rng = unit >> 3;
        __syncthreads();
#pragma unroll 1
        for (int o = 0; o < 5; ++o) {
            const float* src = o < 2 ? F.inp(IN_WUP) + (size_t)(l * 2 + o) * 64 * DH : (o < 4 ? F.inp(IN_AUP) + (size_t)(l * 2 + (o - 2)) * 64 * DH : F.inp(IN_GUP) + (size_t)l * 128 * DH);
            const int K = o < 4 ? 64 : 128, stride = o < 4 ? PW_S64 : PW_S128, off = o < 4 ? o * 64 * PW_S64 : PW_G;
            for (int idx = tid; idx < K * 64; idx += 512) { const int c = idx & 63, k = idx >> 6; const int rr = 16 * ((c >> 2) & 3) + 4 * (c >> 4) + (c & 3);
                *(LAS unsigned short*)(F.lds + off + rr * stride + 2 * k) = (unsigned short)f2bf(src[(size_t)k * DH + 64 * h + c]); }
        }
#pragma unroll 1
        for (int ti = 0; ti < 9; ++ti) {
            const int row0 = rng * 1152 + ti * 128;
            const bool isctx = row0 < NCTX; const int T = isctx ? CTXL : SEQ; const int t0 = isctx ? (row0 & (CTXL - 1)) : ((row0 - NCTX) & (SEQ - 1));
            __syncthreads();
#pragma unroll 2
            for (int gi = tid; gi < 128 * 48; gi += 512) {
                const int t = gi / 48, g = gi - t * 48, ts = t0 + t;
                const bf16_t* zp = Z + (size_t)(row0 + t) * ZLD + ZC_RW + 1536 + 8 * g;
                const u32x4 zero = (u32x4){0u, 0u, 0u, 0u};
                const u32x4 zc = *(const u32x4*)zp, zm = ts > 0 ? *(const u32x4*)(zp - ZLD) : zero, zn = ts < T - 1 ? *(const u32x4*)(zp + ZLD) : zero;
                const f32x4 mA = *(const f32x4*)(mu + 1536 + 8 * g), mB = *(const f32x4*)(mu + 1536 + 8 * g + 4);
                float c8[8], m8[8], n8[8], o8[8]; unpack8(zc, c8); unpack8(zm, m8); unpack8(zn, n8);
#pragma unroll
                for (int j = 0; j < 8; ++j) { const float mm = j < 4 ? mA[j] : mB[j - 4]; const float zs = c8[j] + mm * (0.5f * (m8[j] + n8[j]) - c8[j]);
                    o8[j] = g < 16 ? tanh_fast(zs) : (g < 32 ? zs : sigmoidf_(zs)); }
                *(LAS u32x4*)(F.lds + PA_OFF + t * PA_STRIDE + 16 * g) = pack8(o8);
            }
            __syncthreads();
            const int t = 16 * w + tok, row = row0 + t, ts = t0 + t; const bool hasp = ts > 0, hasn = ts < T - 1;
            const int cb = 64 * h + 16 * cq;
            f32x4 acc[5][4];
#pragma unroll
            for (int o = 0; o < 5; ++o)
#pragma unroll
                for (int nt = 0; nt < 4; ++nt) acc[o][nt] = (f32x4){0.f, 0.f, 0.f, 0.f};
            const LAS unsigned char* actp = F.lds + PA_OFF + (16 * w + tok) * PA_STRIDE + 16 * cq;
#pragma unroll
            for (int o = 0; o < 4; ++o)
#pragma unroll
                for (int ks = 0; ks < 2; ++ks) {
                    const bf16x8 bfrag = *(const LAS bf16x8*)(actp + (64 * o + 32 * ks) * 2);
#pragma unroll
                    for (int nt = 0; nt < 4; ++nt) { const bf16x8 afrag = *(const LAS bf16x8*)(F.lds + o * 64 * PW_S64 + (16 * nt + tok) * PW_S64 + (32 * ks + 8 * cq) * 2);
                        acc[o][nt] = __builtin_amdgcn_mfma_f32_16x16x32_bf16(afrag, bfrag, acc[o][nt], 0, 0, 0); }
                }
#pragma unroll
            for (int ks = 0; ks < 4; ++ks) {
                const bf16x8 bfrag = *(const LAS bf16x8*)(actp + (256 + 32 * ks) * 2);
#pragma unroll
                for (int nt = 0; nt < 4; ++nt) { const bf16x8 afrag = *(const LAS bf16x8*)(F.lds + PW_G + (16 * nt + tok) * PW_S128 + (32 * ks + 8 * cq) * 2);
                    acc[4][nt] = __builtin_amdgcn_mfma_f32_16x16x32_bf16(afrag, bfrag, acc[4][nt], 0, 0, 0); }
            }
            float rv[16], kv[16], vv[16];
            shifted16(Z, row, hasp, hasn, 1024 + cb, mu, vv);
            const size_t so = ((size_t)h * NT + row) * 64 + 16 * cq;
            shifted16(Z, row, hasp, hasn, 512 + cb, mu, kv);
            float kkv[16]; float ss = 0.f;
#pragma unroll
            for (int q = 0; q < 4; ++q) { const f32x4 kw = *(const f32x4*)(F.inp(IN_KK) + l * DH + cb + 4 * q);
#pragma unroll
                for (int e = 0; e < 4; ++e) { const float ku = kv[4 * q + e] * kw[e]; kkv[4 * q + e] = ku; ss += ku * ku; } }
            ss += __shfl_xor(ss, 16); ss += __shfl_xor(ss, 32);
            const float rs = rsqrtf(ss + 1e-12f);
#pragma unroll
            for (int j = 0; j < 16; ++j) kkv[j] *= rs;
            store16((bf16_t*)(F.ws + WS_V) + so, vv);
            shifted16(Z, row, hasp, hasn, cb, mu, rv);
            { float gv[16];
#pragma unroll
              for (int j = 0; j < 16; ++j) gv[j] = acc[4][j >> 2][j & 3];
              store16((bf16_t*)((unsigned char*)F.out + DO_G) + so, gv); }
            float bon = 0.f;
#pragma unroll
            for (int d = 0; d < 2; ++d) {
                float* gep = (float*)(F.ws + (d ? WS_GE1 : WS_GE0)) + ((size_t)h * (NT / 16) + (row >> 4)) * 64 + 16 * cq;
#pragma unroll
                for (int qq = 0; qq < 2; ++qq) {
                    float ktv[8], btv[8], kdtv[8], rtv[8], gev[8];
#pragma unroll
                    for (int q2 = 0; q2 < 2; ++q2) {
                        const int q = 2 * qq + q2;
                        const f32x4 w0 = *(const f32x4*)(F.inp(IN_W0) + (l * 2 + d) * DH + cb + 4 * q), a0 = *(const f32x4*)(F.inp(IN_A0) + (l * 2 + d) * DH + cb + 4 * q);
                        const f32x4 ka = *(const f32x4*)(F.inp(IN_KA) + l * DH + cb + 4 * q), rk = *(const f32x4*)(F.inp(IN_RK) + l * DH + cb + 4 * q);
#pragma unroll
                        for (int e = 0; e < 4; ++e) { const int j = 4 * q + e, j8 = 4 * q2 + e;
                            const float x = -(w0[e] + acc[d][q][e]);
                            const float wl = -(fmaxf(x, 0.f) + __logf(1.0f + __expf(-fabsf(x)))) - 0.5f;
                            const float a = sigmoidf_(a0[e] + acc[2 + d][q][e]);
                            const float kd = kv[j] * (1.0f + (a - 1.0f) * ka[e]);
                            bon += rv[j] * kd * rk[e];
                            const float lw = -__expf(wl);
                            float ci = lw;
                            if (d == 0) { ci += __int_as_float(__builtin_amdgcn_update_dpp(0, __float_as_int(ci), 0x111, 0xf, 0xf, true)); ci += __int_as_float(__builtin_amdgcn_update_dpp(0, __float_as_int(ci), 0x112, 0xf, 0xf, true));
                                          ci += __int_as_float(__builtin_amdgcn_update_dpp(0, __float_as_int(ci), 0x114, 0xf, 0xf, true)); ci += __int_as_float(__builtin_amdgcn_update_dpp(0, __float_as_int(ci), 0x118, 0xf, 0xf, true)); }
                            else        { ci += __int_as_float(__builtin_amdgcn_update_dpp(0, __float_as_int(ci), 0x101, 0xf, 0xf, true)); ci += __int_as_float(__builtin_amdgcn_update_dpp(0, __float_as_int(ci), 0x102, 0xf, 0xf, true));
                                          ci += __int_as_float(__builtin_amdgcn_update_dpp(0, __float_as_int(ci), 0x104, 0xf, 0xf, true)); ci += __int_as_float(__builtin_amdgcn_update_dpp(0, __float_as_int(ci), 0x108, 0xf, 0xf, true)); }
                            const float gam = __expf(ci), gprev = __expf(ci - lw), ig = __expf(-ci);
                            ktv[j8] = gprev * kkv[j]; btv[j8] = kkv[j] * a * ig; kdtv[j8] = kd * ig; rtv[j8] = gam * rv[j]; gev[j8] = gam; }
                    }
                    *(u32x4*)((bf16_t*)(F.ws + (d ? WS_KT1 : WS_KT0)) + so + 8 * qq) = pack8(ktv); *(u32x4*)((bf16_t*)(F.ws + (d ? WS_BT1 : WS_BT0)) + so + 8 * qq) = pack8(btv);
                    *(u32x4*)((bf16_t*)(F.ws + (d ? WS_KDT1 : WS_KDT0)) + so + 8 * qq) = pack8(kdtv); *(u32x4*)((bf16_t*)(F.ws + (d ? WS_RT1 : WS_RT0)) + so + 8 * qq) = pack8(rtv);
                    if (tok == (d ? 0 : 15)) {
                        *(f32x4*)(gep + 8 * qq) = (f32x4){gev[0], gev[1], gev[2], gev[3]}; *(f32x4*)(gep + 8 * qq + 4) = (f32x4){gev[4], gev[5], gev[6], gev[7]};
                    }
                }
            }
            bon += __shfl_xor(bon, 16); bon += __shfl_xor(bon, 32);
            if (cq == 0) BON[(size_t)row * 8 + h] = bon;
        }
    }
    __syncthreads();
}

__device__ __forceinline__ int scan_row(int b, int dir, int i) {
    if (i < CTXL) return b * CTXL + (dir ? CTXL - 1 - i : i);
    const int j = i - CTXL; return NCTX + b * SEQ + (dir ? SEQ - 1 - j : j);
}
template <int CTRL> __device__ __forceinline__ float dpp_add(float x) {
    return x + __int_as_float(__builtin_amdgcn_update_dpp(0, __float_as_int(x), CTRL, 0xf, 0xf, true));
}
__device__ __forceinline__ float reduce16(float x) {
    x = dpp_add<0xB1>(x);
    x = dpp_add<0x4E>(x);
    x = dpp_add<0x141>(x);
    x = dpp_add<0x140>(x);
    return x;
}
constexpr int SC_T = 32, SC_REC = 320, SC_PBUF = SC_T * SC_REC + 128;
constexpr int SC_YOFF = 2 * SC_PBUF * 4;
typedef float f32x2v __attribute__((ext_vector_type(2)));
#define SC_PKMUL_LO(d, a, b)     asm("v_pk_mul_f32 %0, %1, %2 op_sel_hi:[1,0]" : "=v"(d) : "v"(a), "v"(b))
#define SC_PKMUL_HI(d, a, b)     asm("v_pk_mul_f32 %0, %1, %2 op_sel:[0,1] op_sel_hi:[1,1]" : "=v"(d) : "v"(a), "v"(b))
#define SC_PKFMA_LO(d, a, b, c)  asm("v_pk_fma_f32 %0, %1, %2, %3 op_sel_hi:[1,0,1]" : "=v"(d) : "v"(a), "v"(b), "v"(c))
#define SC_PKFMA_HI(d, a, b, c)  asm("v_pk_fma_f32 %0, %1, %2, %3 op_sel:[0,1,0] op_sel_hi:[1,1,1]" : "=v"(d) : "v"(a), "v"(b), "v"(c))
#define SC_PKFMAN_LO(d, a, b, c) asm("v_pk_fma_f32 %0, %1, %2, %3 op_sel_hi:[1,0,1] neg_lo:[1,0,0] neg_hi:[1,0,0]" : "=v"(d) : "v"(a), "v"(b), "v"(c))
#define SC_PKFMAN_HI(d, a, b, c) asm("v_pk_fma_f32 %0, %1, %2, %3 op_sel:[0,1,0] op_sel_hi:[1,1,1] neg_lo:[1,0,0] neg_hi:[1,0,0]" : "=v"(d) : "v"(a), "v"(b), "v"(c))
#define SC_DPP4(a, b, c, d, CTRL) asm("s_nop 1\n\tv_add_f32_dpp %0, %0, %0 " CTRL " row_mask:0xf bank_mask:0xf\n\tv_add_f32_dpp %1, %1, %1 " CTRL " row_mask:0xf bank_mask:0xf\n\t" \
        "v_add_f32_dpp %2, %2, %2 " CTRL " row_mask:0xf bank_mask:0xf\n\tv_add_f32_dpp %3, %3, %3 " CTRL " row_mask:0xf bank_mask:0xf" : "+v"(a), "+v"(b), "+v"(c), "+v"(d))
#define SC_DPP2(a, b, CTRL) asm("s_nop 1\n\tv_add_f32_dpp %0, %0, %0 " CTRL " row_mask:0xf bank_mask:0xf\n\tv_add_f32_dpp %1, %1, %1 " CTRL " row_mask:0xf bank_mask:0xf\n\ts_nop 0" : "+v"(a), "+v"(b))
template <int VAR> __device__ __forceinline__ void phase_scan(int l) {
    asm volatile("" : "+s"(l)); Frame F = make_frame();
    const int tid = F.tid, q = tid & 15, rp = tid >> 4;
    LAS float* P = (LAS float*)F.lds; LAS float* YB = (LAS float*)(F.lds + SC_YOFF);
    const bf16_t* V = (const bf16_t*)(F.ws + WS_V);
    constexpr int NCH = (CTXL + SEQ) / SC_T;
    for (int task = F.bid; task < NBATCH * 8 * 2; task += F.G) {
        const int dir = task & 1, h = (task >> 1) & 7, b = task >> 4;
        const bf16_t* KT = (const bf16_t*)(F.ws + (dir ? WS_KT1 : WS_KT0)); const bf16_t* BT = (const bf16_t*)(F.ws + (dir ? WS_BT1 : WS_BT0));
        const bf16_t* KDT = (const bf16_t*)(F.ws + (dir ? WS_KDT1 : WS_KDT0)); const bf16_t* RT = (const bf16_t*)(F.ws + (dir ? WS_RT1 : WS_RT0));
        const float* GE = (const float*)(F.ws + (dir ? WS_GE1 : WS_GE0)) + (size_t)h * (NT / 16) * 64;
        bf16_t* Y = (bf16_t*)(F.ws + (dir ? WS_Y1 : WS_Y0));
        u32x4 stg[3]; f32x4 gstg;
#define SC_LOAD(c) do { _Pragma("unroll") for (int j = 0; j < 3; ++j) { const int u = tid + 512 * j, a = u >> 8, s_ = (u >> 3) & 31, o = u & 7; \
            const bf16_t* src = a == 0 ? KT : a == 1 ? BT : a == 2 ? KDT : a == 3 ? RT : V; \
            if (u < 1280) stg[j] = *(const u32x4*)(src + ((size_t)h * NT + scan_row(b, dir, (c) * SC_T + s_)) * 64 + 8 * o); } \
            if (tid < 32) gstg = *(const f32x4*)(GE + (size_t)(scan_row(b, dir, (c) * SC_T + 16 * (tid >> 4)) >> 4) * 64 + 4 * (tid & 15)); } while (0)
#define SC_STORE(c) do { _Pragma("unroll") for (int j = 0; j < 3; ++j) { const int u = tid + 512 * j, a = u >> 8, s_ = (u >> 3) & 31, o = u & 7; \
            if (u < 1280) { float f[8]; _Pragma("unroll") for (int e = 0; e < 4; ++e) { f[2 * e] = bf2f(stg[j][e] & 0xffffu); f[2 * e + 1] = bf2f(stg[j][e] >> 16); } \
            LAS float* dst = P + ((c) & 1) * SC_PBUF + s_ * SC_REC + a * 64 + 8 * o; \
            *(LAS f32x4*)dst = (f32x4){f[0], f[1], f[2], f[3]}; *(LAS f32x4*)(dst + 4) = (f32x4){f[4], f[5], f[6], f[7]}; } } \
            if (tid < 32) *(LAS f32x4*)(P + ((c) & 1) * SC_PBUF + SC_T * SC_REC + 4 * tid) = gstg; } while (0)
        f32x2v S[4];
#pragma unroll
        for (int e = 0; e < 4; ++e) S[e] = (f32x2v){0.f, 0.f};
        __syncthreads();
        SC_LOAD(0); SC_STORE(0);
        __syncthreads();
        for (int c = 0; c < NCH; ++c) {
            if (c + 1 < NCH) SC_LOAD(c + 1);
            if (c > 0) {
                const int s_ = tid >> 4, r4 = (tid & 15) * 4;
                const f32x4 yv = *(const LAS f32x4*)(YB + ((c - 1) & 1) * (SC_T * 64) + s_ * 64 + r4);
                u32x2 wv; wv.x = pk2(yv[0], yv[1]); wv.y = pk2(yv[2], yv[3]);
                if (VAR == 0) *(u32x2*)(Y + (size_t)scan_row(b, dir, (c - 1) * SC_T + s_) * DH + 64 * h + r4) = wv;
            }
            const LAS float* pb = P + (c & 1) * SC_PBUF + 4 * q;
            LAS float* yb = YB + (c & 1) * (SC_T * 64) + 2 * rp;
#pragma unroll
            for (int hb = 0; hb < 2; ++hb) {
                const LAS float* ph = pb + hb * 16 * SC_REC;
                f32x4 kt = *(const LAS f32x4*)(ph), bt = *(const LAS f32x4*)(ph + 64), kdt = *(const LAS f32x4*)(ph + 128), rt = *(const LAS f32x4*)(ph + 192);
                f32x2v vv = *(const LAS f32x2v*)(ph + 256 - 4 * q + 2 * rp);
                float y0 = 0.f, y1 = 0.f;
#pragma unroll
                for (int s_ = 0; s_ < 16; ++s_) {
                    const LAS float* pn = ph + (s_ + 1 < 16 ? s_ + 1 : s_) * SC_REC;
                    const f32x4 ktn = *(const LAS f32x4*)(pn), btn = *(const LAS f32x4*)(pn + 64), kdtn = *(const LAS f32x4*)(pn + 128), rtn = *(const LAS f32x4*)(pn + 192);
                    const f32x2v vvn = *(const LAS f32x2v*)(pn + 256 - 4 * q + 2 * rp);
                    const f32x2v kt01 = (f32x2v){kt[0], kt[1]}, kt23 = (f32x2v){kt[2], kt[3]}, bt01 = (f32x2v){bt[0], bt[1]}, bt23 = (f32x2v){bt[2], bt[3]};
                    const f32x2v kd01 = (f32x2v){kdt[0], kdt[1]}, kd23 = (f32x2v){kdt[2], kdt[3]}, rt01 = (f32x2v){rt[0], rt[1]}, rt23 = (f32x2v){rt[2], rt[3]};
                    f32x2v sa;
                    SC_PKMUL_LO(sa, S[0], kt01); SC_PKFMA_HI(sa, S[1], kt01, sa); SC_PKFMA_LO(sa, S[2], kt23, sa); SC_PKFMA_HI(sa, S[3], kt23, sa);
                    float sa0 = sa.x, sa1 = sa.y;
                    if (VAR != 2) {
                    SC_DPP4(sa0, sa1, y0, y1, "quad_perm:[1,0,3,2]");
                    SC_DPP4(sa0, sa1, y0, y1, "quad_perm:[2,3,0,1]");
                    SC_DPP4(sa0, sa1, y0, y1, "row_half_mirror");
                    SC_DPP4(sa0, sa1, y0, y1, "row_mirror"); }
                    if (s_ > 0 && q == 0) { yb[(hb * 16 + s_ - 1) * 64] = y0; yb[(hb * 16 + s_ - 1) * 64 + 1] = y1; }
                    sa = (f32x2v){sa0, sa1};
                    f32x2v yy;
                    if (VAR != 3) {
                    SC_PKFMA_LO(S[0], vv, kd01, S[0]); SC_PKFMA_HI(S[1], vv, kd01, S[1]); SC_PKFMA_LO(S[2], vv, kd23, S[2]); SC_PKFMA_HI(S[3], vv, kd23, S[3]);
                    SC_PKFMAN_LO(S[0], sa, bt01, S[0]); SC_PKFMAN_HI(S[1], sa, bt01, S[1]); SC_PKFMAN_LO(S[2], sa, bt23, S[2]); SC_PKFMAN_HI(S[3], sa, bt23, S[3]);
                    SC_PKMUL_LO(yy, S[0], rt01); SC_PKFMA_HI(yy, S[1], rt01, yy); SC_PKFMA_LO(yy, S[2], rt23, yy); SC_PKFMA_HI(yy, S[3], rt23, yy);
                    } else { SC_PKFMAN_LO(S[0], sa, bt01, S[0]); SC_PKMUL_LO(yy, S[0], rt01); }
                    y0 = yy.x; y1 = yy.y;
                    kt = ktn; bt = btn; kdt = kdtn; rt = rtn; vv = vvn;
                }
                SC_DPP2(y0, y1, "quad_perm:[1,0,3,2]"); SC_DPP2(y0, y1, "quad_perm:[2,3,0,1]"); SC_DPP2(y0, y1, "row_half_mirror"); SC_DPP2(y0, y1, "row_mirror");
                if (q == 0) { yb[(hb * 16 + 15) * 64] = y0; yb[(hb * 16 + 15) * 64 + 1] = y1; }
                const f32x4 ge = *(const LAS f32x4*)(pb + SC_T * SC_REC + hb * 64);
#pragma unroll
                for (int e = 0; e < 4; ++e) S[e] *= ge[e];
            }
            if (c + 1 < NCH) SC_STORE(c + 1);
            __syncthreads();
        }
        {
            const int s_ = tid >> 4, r4 = (tid & 15) * 4;
            const f32x4 yv = *(const LAS f32x4*)(YB + ((NCH - 1) & 1) * (SC_T * 64) + s_ * 64 + r4);
            u32x2 wv; wv.x = pk2(yv[0], yv[1]); wv.y = pk2(yv[2], yv[3]);
            if (VAR == 0) *(u32x2*)(Y + (size_t)scan_row(b, dir, (NCH - 1) * SC_T + s_) * DH + 64 * h + r4) = wv;
        }
#undef SC_LOAD
#undef SC_STORE
    }
    __syncthreads();
}

__device__ __forceinline__ void phase_mix(int l) {
    asm volatile("" : "+s"(l)); Frame F = make_frame();
    const int lane = F.lane, c0 = 8 * lane, hh = lane >> 3;
    const int gw = F.bid * 8 + F.wave, NGW = F.G * 8;
    const bf16_t* Z = (const bf16_t*)(F.ws + WS_Z);
    const float* cw = F.inp(IN_CONVW) + (size_t)l * 3 * DH;
    float cw0[8], cw1[8], cw2[8], lgv[8], lbv[8];
#pragma unroll
    for (int j = 0; j < 8; ++j) { cw0[j] = cw[c0 + j]; cw1[j] = cw[DH + c0 + j]; cw2[j] = cw[2 * DH + c0 + j]; lgv[j] = F.inp(IN_LNG)[l * DH + c0 + j]; lbv[j] = F.inp(IN_LNB)[l * DH + c0 + j]; }
    const bf16_t* Y0 = (const bf16_t*)(F.ws + WS_Y0); const bf16_t* Y1 = (const bf16_t*)(F.ws + WS_Y1); const bf16_t* V = (const bf16_t*)(F.ws + WS_V);
    const bf16_t* Gi = (const bf16_t*)((unsigned char*)F.out + DO_G); const float* BON = (const float*)(F.ws + WS_BONUS);
    bf16_t* UA = (bf16_t*)(F.ws + WS_UA); bf16_t* UB = (bf16_t*)(F.ws + WS_UB);
    for (int row = gw; row < NT; row += NGW) {
        int delta; bool hasp, hasn;
        if (row < NCTX) { const int t = row & (CTXL - 1); delta = 1; hasp = t > 0; hasn = t < CTXL - 1; }
        else { const int sq = (row - NCTX) & (SEQ - 1);
            if (c0 < 256) { const int gc = sq & 63; delta = 1; hasp = gc > 0; hasn = gc < 63; }
            else { const int gr = sq >> 6; delta = 64; hasp = gr > 0; hasn = gr < 31; } }
        const bf16_t* zr = Z + (size_t)row * ZLD;
        const u32x4 zero = (u32x4){0u, 0u, 0u, 0u};
        const u32x4 bg = *(const u32x4*)(zr + ZC_BG + c0), cg = *(const u32x4*)(zr + ZC_CG + c0), ha = *(const u32x4*)(zr + ZC_HA + c0);
        const u32x4 cgm = hasp ? *(const u32x4*)(zr + ZC_CG + c0 - (ptrdiff_t)delta * ZLD) : zero, ham = hasp ? *(const u32x4*)(zr + ZC_HA + c0 - (ptrdiff_t)delta * ZLD) : zero;
        const u32x4 cgp = hasn ? *(const u32x4*)(zr + ZC_CG + c0 + (ptrdiff_t)delta * ZLD) : zero, hap = hasn ? *(const u32x4*)(zr + ZC_HA + c0 + (ptrdiff_t)delta * ZLD) : zero;
        const size_t o = (size_t)row * DH + c0, oh = ((size_t)hh * NT + row) * 64 + (c0 & 63);
        const u32x4 y0p = *(const u32x4*)(Y0 + o), y1p = *(const u32x4*)(Y1 + o), vp = *(const u32x4*)(V + oh), gp = *(const u32x4*)(Gi + oh);
        const float bon = BON[(size_t)row * 8 + hh];
        float fb[8], fc[8], fh[8], fcm[8], fhm[8], fcp[8], fhp[8], ua[8];
        unpack8(bg, fb); unpack8(cg, fc); unpack8(ha, fh); unpack8(cgm, fcm); unpack8(ham, fhm); unpack8(cgp, fcp); unpack8(hap, fhp);
#pragma unroll
        for (int j = 0; j < 8; ++j) ua[j] = fb[j] * (fcm[j] * fhm[j] * cw0[j] + fc[j] * fh[j] * cw1[j] + fcp[j] * fhp[j] * cw2[j]);
        *(u32x4*)(UA + o) = pack8(ua);
        float ya[8], yb[8], fv[8], fg[8], ub[8]; unpack8(y0p, ya); unpack8(y1p, yb); unpack8(vp, fv); unpack8(gp, fg);
        float sm = 0.f;
#pragma unroll
        for (int j = 0; j < 8; ++j) { ya[j] += yb[j]; sm += ya[j]; }
        sm = dpp_add<0xB1>(sm); sm = dpp_add<0x4E>(sm); sm = dpp_add<0x141>(sm);
        const float mu = sm * (1.0f / 64.0f); float sq2 = 0.f;
#pragma unroll
        for (int j = 0; j < 8; ++j) { ya[j] -= mu; sq2 += ya[j] * ya[j]; }
        sq2 = dpp_add<0xB1>(sq2); sq2 = dpp_add<0x4E>(sq2); sq2 = dpp_add<0x141>(sq2);
        const float rstd = rsqrtf(sq2 * (1.0f / 64.0f) + GN_EPS);
#pragma unroll
        for (int j = 0; j < 8; ++j) ub[j] = (ya[j] * rstd * lgv[j] + lbv[j] + bon * fv[j]) * fg[j];
        *(u32x4*)(UB + o) = pack8(ub);
    }
}

constexpr int N2_STRIDE = 1028;
constexpr int N2_PART = 16 * N2_STRIDE * 4;
constexpr int N2_HIST = N2_PART + 8 * 16 * 48 * 4;
__device__ __forceinline__ void phase_norm2(int l) {
    asm volatile("" : "+s"(l)); Frame F = make_frame();
    const int lane = F.lane, w = F.wave;
    LAS float* HT = (LAS float*)F.lds; LAS float* PART = (LAS float*)(F.lds + N2_PART); LAS int* hist = (LAS int*)(F.lds + N2_HIST);
    const float* X = (const float*)(F.ws + WS_X); bf16_t* H = (bf16_t*)((unsigned char*)F.out + DO_H);
    const float* g2n = F.inp(IN_N2G) + l * D;
    const float* WC = (const float*)(F.ws + WS_WC) + (size_t)l * 1024 * 48; const float* RB = (const float*)(F.ws + WS_RB) + l * 48;
    int* RE = (int*)(F.ws + WS_RE); float* RG = (float*)(F.ws + WS_RG); int* RP = (int*)(F.ws + WS_RP);
    if (F.tid < 32) hist[F.tid] = 0;
    float Bv[32][3];
    { const int kg = lane >> 4, cc = lane & 15;
#pragma unroll
      for (int s_ = 0; s_ < 32; ++s_)
#pragma unroll
          for (int t = 0; t < 3; ++t) Bv[s_][t] = WC[(size_t)(256 * kg + 32 * w + s_) * 48 + 16 * t + cc]; }
    __syncthreads();
    for (int tile = F.bid; tile < NT / 16; tile += F.G) {
        const int row0 = tile * 16;
#pragma unroll
        for (int rr = 0; rr < 2; ++rr) {
            const int lr = 2 * w + rr, row = row0 + lr;
            const int mj = row < NCTX ? 16 : ((row - NCTX) >> 11);
            const float* mod = (const float*)(F.ws + WS_MOD) + ((size_t)l * 17 + mj) * NMOD;
            f32x4 v[4]; float ss = 0.f;
#pragma unroll
            for (int j = 0; j < 4; ++j) { v[j] = *(const f32x4*)(X + (size_t)row * D + 4 * lane + 256 * j); ss += v[j][0] * v[j][0] + v[j][1] * v[j][1] + v[j][2] * v[j][2] + v[j][3] * v[j][3]; }
            const float rs = rsqrtf(wave_sum(ss) * (1.0f / D) + NORM_EPS);
#pragma unroll
            for (int j = 0; j < 4; ++j) {
                const int c = 4 * lane + 256 * j;
                const f32x4 gg = *(const f32x4*)(g2n + c), sh = *(const f32x4*)(mod + 3072 + c), sc = *(const f32x4*)(mod + 4096 + c);
                f32x4 o;
#pragma unroll
                for (int q = 0; q < 4; ++q) o[q] = v[j][q] * rs * gg[q] * (1.0f + sc[q]) + sh[q];
                u32x2 wv; wv.x = pk2(o[0], o[1]); wv.y = pk2(o[2], o[3]);
                *(u32x2*)(H + (size_t)row * D + c) = wv;
                *(LAS f32x4*)(HT + lr * N2_STRIDE + c) = o;
            }
        }
        __syncthreads();
        {
            f32x4 acc[3];
#pragma unroll
            for (int t = 0; t < 3; ++t) acc[t] = (f32x4){0.f, 0.f, 0.f, 0.f};
            const LAS float* ap = HT + (lane & 15) * N2_STRIDE + 256 * (lane >> 4) + 32 * w;
#pragma unroll
            for (int i = 0; i < 8; ++i) {
                const f32x4 a4 = *(const LAS f32x4*)(ap + 4 * i);
#pragma unroll
                for (int e = 0; e < 4; ++e)
#pragma unroll
                    for (int t = 0; t < 3; ++t) acc[t] = __builtin_amdgcn_mfma_f32_16x16x4f32(a4[e], Bv[4 * i + e][t], acc[t], 0, 0, 0);
            }
#pragma unroll
            for (int t = 0; t < 3; ++t)
#pragma unroll
                for (int rg = 0; rg < 4; ++rg) PART[(w * 16 + (lane >> 4) * 4 + rg) * 48 + 16 * t + (lane & 15)] = acc[t][rg];
        }
        __syncthreads();
        if (F.tid < 16) {
            const int r = F.tid, row = row0 + r;
            float lgv[4];
#pragma unroll
            for (int g = 0; g < 4; ++g) { float a = RB[32 + g];
#pragma unroll
                for (int ww = 0; ww < 8; ++ww) a += PART[(ww * 16 + r) * 48 + 32 + g];
                lgv[g] = a; }
            int gs = 0; float lmax = lgv[0];
#pragma unroll
            for (int g = 1; g < 4; ++g) if (lgv[g] > lmax) { lmax = lgv[g]; gs = g; }
            float den = 0.f;
#pragma unroll
            for (int g = 0; g < 4; ++g) den += __expf(lgv[g] - lmax);
            const float pgmax = 1.0f / den;
            float le[8];
#pragma unroll
            for (int e = 0; e < 8; ++e) { float a = RB[gs * 8 + e];
#pragma unroll
                for (int ww = 0; ww < 8; ++ww) a += PART[(ww * 16 + r) * 48 + gs * 8 + e];
                le[e] = a; }
            int i1 = 0; float m1 = le[0];
#pragma unroll
            for (int e = 1; e < 8; ++e) if (le[e] > m1) { m1 = le[e]; i1 = e; }
            int i2 = -1; float m2 = -3.0e38f;
#pragma unroll
            for (int e = 0; e < 8; ++e) if (e != i1 && le[e] > m2) { m2 = le[e]; i2 = e; }
            const float dd = __expf(m2 - m1);
            const float gate1 = pgmax / (1.0f + dd), gate2 = pgmax * dd / (1.0f + dd);
            const int e1 = gs * 8 + i1, e2 = gs * 8 + i2;
            const int p1 = __hip_atomic_fetch_add(hist + e1, 1, __ATOMIC_RELAXED, __HIP_MEMORY_SCOPE_WORKGROUP), p2 = __hip_atomic_fetch_add(hist + e2, 1, __ATOMIC_RELAXED, __HIP_MEMORY_SCOPE_WORKGROUP);
            RE[2 * row] = e1; RE[2 * row + 1] = e2; RG[2 * row] = gate1; RG[2 * row + 1] = gate2; RP[2 * row] = p1; RP[2 * row + 1] = p2;
        }
    }
    __syncthreads();
    if (F.tid < 32) ((int*)(F.ws + WS_BH))[F.bid * 32 + F.tid] = hist[F.tid];
    __syncthreads();
}

__device__ __forceinline__ void moe_tables(Frame& F, int l) {
    LAS int* seg = (LAS int*)(F.lds + LC_SEG); LAS int* cnts = (LAS int*)(F.lds + LC_CNTS); LAS int* tile_e = (LAS int*)(F.lds + LC_TILEE);
    LAS int* red = (LAS int*)(F.lds + LC_RED);
    LAS int* bbase = (LAS int*)(F.lds + LC_BBASE);
    const int* BH = (const int*)(F.ws + WS_BH);
    __syncthreads();
    { const int e = F.tid & 31, part = F.tid >> 5; int tot = 0, pre = 0;
      for (int bq = part; bq < F.G; bq += 16) { const int v = BH[bq * 32 + e]; tot += v; if (bq < F.bid) pre += v; }
      red[part * 32 + e] = tot; red[512 + part * 32 + e] = pre; }
    __syncthreads();
    if (F.tid < 32) { int tot = 0, pre = 0;
#pragma unroll 1
        for (int p = 0; p < 16; ++p) { tot += red[p * 32 + F.tid]; pre += red[512 + p * 32 + F.tid]; }
        cnts[F.tid] = tot; bbase[F.tid] = pre; }
    __syncthreads();
    if (F.tid == 0) {
        int s = 0;
#pragma unroll 1
        for (int e = 0; e < NE; ++e) { const int c = cnts[e]; seg[e] = s; const int nt = (c + 255) >> 8;
#pragma unroll 1
            for (int t = 0; t < nt; ++t) tile_e[(s >> 8) + t] = e;
            s += nt << 8; }
        seg[32] = s; seg[33] = s >> 8;
    }
    __syncthreads();
}
__device__ __forceinline__ void phase_dispatch(int l) {
    asm volatile("" : "+s"(l)); Frame F = make_frame();
    moe_tables(F, l);
    const LAS int* seg = (const LAS int*)(F.lds + LC_SEG); const LAS int* cnts = (const LAS int*)(F.lds + LC_CNTS); const LAS int* bbase = (const LAS int*)(F.lds + LC_BBASE);
    const int gw = F.bid * 8 + F.wave, NGW = F.G * 8;
    const int* RE = (const int*)(F.ws + WS_RE); const int* RP = (const int*)(F.ws + WS_RP); int* RS = (int*)(F.ws + WS_RS);
    const bf16_t* H = (const bf16_t*)((unsigned char*)F.out + DO_H); bf16_t* XS = (bf16_t*)(F.ws + WS_XS);
    for (int tile = F.bid; tile < NT / 16; tile += F.G) {
        const int item0 = (tile * 16 + 2 * F.wave) * 2;
        int slot[4]; u32x4 d0[2], d1[2];
#pragma unroll
        for (int q = 0; q < 4; ++q) { const int e = RE[item0 + q], pos = RP[item0 + q]; slot[q] = seg[e] + bbase[e] + pos; }
#pragma unroll
        for (int r = 0; r < 2; ++r) { const u32x4* src = (const u32x4*)(H + (size_t)((item0 >> 1) + r) * D); d0[r] = src[F.lane]; d1[r] = src[64 + F.lane]; }
        if (F.lane < 4) { int sl = slot[0]; sl = F.lane == 1 ? slot[1] : sl; sl = F.lane == 2 ? slot[2] : sl; sl = F.lane == 3 ? slot[3] : sl; RS[item0 + F.lane] = sl; }
#pragma unroll
        for (int q = 0; q < 4; ++q) { u32x4* dst = (u32x4*)(XS + (size_t)slot[q] * D); dst[F.lane] = d0[q >> 1]; dst[64 + F.lane] = d1[q >> 1]; }
    }
#pragma unroll 1
    for (int e = 0; e < NE; ++e) {
        const int c = cnts[e], padded = (c + 255) & ~255;
        for (int p = c + gw; p < padded; p += NGW) { u32x4* dst = (u32x4*)(XS + (size_t)(seg[e] + p) * D); dst[F.lane] = (u32x4){0u, 0u, 0u, 0u}; dst[64 + F.lane] = (u32x4){0u, 0u, 0u, 0u}; }
    }
}

__device__ __forceinline__ void phase_final() {
    Frame F = make_frame();
    const int gw = F.bid * 8 + F.wave, NGW = F.G * 8;
    const float* X = (const float*)(F.ws + WS_X); const float* fg = F.inp(IN_FG);
    for (int r = gw; r < NLAT; r += NGW) {
        const float* xr = X + (size_t)(NCTX + r) * D;
        f32x4 v[4]; float ss = 0.f;
#pragma unroll
        for (int j = 0; j < 4; ++j) v[j] = *(const f32x4*)(xr + 4 * F.lane + 256 * j);
        combine_row(F, DEPTH - 1, NCTX + r, v);
#pragma unroll
        for (int j = 0; j < 4; ++j) ss += v[j][0] * v[j][0] + v[j][1] * v[j][1] + v[j][2] * v[j][2] + v[j][3] * v[j][3];
        const float rs = rsqrtf(wave_sum(ss) * (1.0f / D) + NORM_EPS);
#pragma unroll
        for (int j = 0; j < 4; ++j) { const int c = 4 * F.lane + 256 * j; const f32x4 gg = *(const f32x4*)(fg + c);
            f32x4 o; o[0] = v[j][0] * rs * gg[0]; o[1] = v[j][1] * rs * gg[1]; o[2] = v[j][2] * rs * gg[2]; o[3] = v[j][3] * rs * gg[3];
            *(f32x4*)(F.out + (size_t)r * D + c) = o; }
    }
}

constexpr int NPL = 11;
constexpr int NPH = 1 + DEPTH * NPL + 1;
__device__ __forceinline__ void seam() {
    Frame F = make_frame();
    XcdBarrier bar; bar.bar = (unsigned*)(F.ws + WS_CTL) + CW_BAR; bar.x = xb_xcc_id(); bar.st = (volatile LAS unsigned*)(F.lds + LC_BARW);
    xcd_barrier(bar);
}
__global__ void __launch_bounds__(512, 2) mk_fwd(Args args_unused) {
    {
        Frame F = make_frame();
        for (int u = F.tid; u < (LDS_BYTES - LDS_CTL) / 4; u += 512) ((LAS unsigned*)(F.lds + LDS_CTL))[u] = 0u;
        __syncthreads();
        if (F.ka->ph_hi - F.ka->ph_lo > 1) (void)xcd_barrier_post((unsigned*)(F.ws + WS_CTL) + CW_BAR, (volatile LAS unsigned*)(F.lds + LC_BARW));
    }
#define IN(k) (kargs()->ph_lo <= (k) && (k) < kargs()->ph_hi)
#define SEAM(k) do { if (IN(k) && IN((k) + 1)) seam(); } while (0)
    int ph = 0;
    for (int rep_ = 0; rep_ < DUP_N(13); ++rep_) { if (rep_) seam(); if (PH_EN(13) && IN(ph)) phase_prologue(); }
    SEAM(ph); ++ph;
    for (int l = 0; l < DEPTH; ++l) {
        for (int rep_ = 0; rep_ < DUP_N(0); ++rep_) { if (rep_) seam(); if (PH_EN(0) && IN(ph)) phase_norm1(l); }
        SEAM(ph); ++ph;
        for (int rep_ = 0; rep_ < DUP_N(1); ++rep_) { if (rep_) seam(); if (PH_EN(1) && IN(ph)) { Frame F = make_frame(); Gemm g{(const bf16_t*)((unsigned char*)F.out + DO_H), (const bf16_t*)(F.ws + WS_WIN), NT, ZLD, D, 0, 0}; StaticOrder S; S.init(NT, ZLD, F.G, F.bid); EpiStoreBf16 E{(bf16_t*)(F.ws + WS_Z), ZLD}; gemm_phase(F.lds, g, S, E); } }
        SEAM(ph); ++ph;
        for (int rep_ = 0; rep_ < DUP_N(2); ++rep_) { if (rep_) seam(); if (PH_EN(2) && IN(ph)) phase_prep(l); }
        SEAM(ph); ++ph;
        for (int rep_ = 0; rep_ < DUP_N(3); ++rep_) { if (rep_) seam(); if (PH_EN(3) && IN(ph)) { if (rep_ == 0) phase_scan<0>(l); else phase_scan<SCAN_VAR>(l); } }
        SEAM(ph); ++ph;
        for (int rep_ = 0; rep_ < DUP_N(4); ++rep_) { if (rep_) seam(); if (PH_EN(4) && IN(ph)) phase_mix(l); }
        SEAM(ph); ++ph;
        for (int rep_ = 0; rep_ < DUP_N(5); ++rep_) { if (rep_) seam(); if (PH_EN(5) && IN(ph)) { Frame F = make_frame(); Gemm g{(const bf16_t*)(F.ws + WS_UA), (const bf16_t*)(F.ws + WS_WA), NT, D, DH, (size_t)(WS_WB - WS_WA) / 2, (size_t)(WS_UB - WS_UA) / 2}; PairOrder S; S.so.init(NT, D, F.G, F.bid); EpiMerge E{(bf16_t*)((unsigned char*)F.out + DO_H), (const bf16_t*)(F.ws + WS_Z)}; gemm_phase(F.lds, g, S, E); } }
        SEAM(ph); ++ph;
        for (int rep_ = 0; rep_ < DUP_N(7); ++rep_) { if (rep_) seam(); if (PH_EN(7) && IN(ph)) { int ll = l; asm volatile("" : "+s"(ll)); Frame F = make_frame(); Gemm g{(const bf16_t*)((unsigned char*)F.out + DO_H), (const bf16_t*)(F.ws + WS_WO), NT, D, D, 0, 0}; StaticOrder S; S.init(NT, D, F.G, F.bid);
            EpiResid E{rep_ ? (float*)(F.ws + WS_Z) : (float*)(F.ws + WS_X), (const float*)(F.ws + WS_MOD) + (size_t)ll * 17 * NMOD + 2048}; gemm_phase(F.lds, g, S, E); } }
        SEAM(ph); ++ph;
        for (int rep_ = 0; rep_ < DUP_N(8); ++rep_) { if (rep_) seam(); if (PH_EN(8) && IN(ph)) phase_norm2(l); }
        SEAM(ph); ++ph;
        for (int rep_ = 0; rep_ < DUP_N(9); ++rep_) { if (rep_) seam(); if (PH_EN(9) && IN(ph)) phase_dispatch(l); }
        SEAM(ph); ++ph;
        for (int rep_ = 0; rep_ < DUP_N(10); ++rep_) { if (rep_) seam(); if (PH_EN(10) && IN(ph)) { int ll = l; asm volatile("" : "+s"(ll)); Frame F = make_frame(); moe_tables(F, ll); MoeOrder S{__builtin_amdgcn_readfirstlane(((const LAS int*)(F.lds + LC_SEG))[33]), F.G, F.bid, (const LAS int*)(F.lds + LC_TILEE)};
            Gemm g{(const bf16_t*)(F.ws + WS_XS), (const bf16_t*)(F.ws + WS_W13), MAXTILES * 256, D, D, (size_t)1024 * 1024, 0}; EpiSwiGLU E{(bf16_t*)(F.ws + WS_HID)}; gemm_phase(F.lds, g, S, E); } }
        SEAM(ph); ++ph;
        for (int rep_ = 0; rep_ < DUP_N(11); ++rep_) { if (rep_) seam(); if (PH_EN(11) && IN(ph)) { int ll = l; asm volatile("" : "+s"(ll)); Frame F = make_frame(); moe_tables(F, ll); MoeOrder S{__builtin_amdgcn_readfirstlane(((const LAS int*)(F.lds + LC_SEG))[33]), F.G, F.bid, (const LAS int*)(F.lds + LC_TILEE)};
            Gemm g{(const bf16_t*)(F.ws + WS_HID), (const bf16_t*)(F.ws + WS_W2), MAXTILES * 256, D, DFF, (size_t)1024 * 512, 0}; EpiStoreBf16 E{(bf16_t*)(F.ws + WS_YS), D}; gemm_phase(F.lds, g, S, E); } }
        SEAM(ph); ++ph;
    }
    if (PH_EN(14) && IN(ph)) phase_final();
#undef IN
#undef SEAM
}

extern "C" void kernel_launch(void* const* d_in, const int* in_sizes, int n_in, void* d_out, int out_size, void* d_ws, size_t ws_size, hipStream_t stream) {
    static int grid = 0;
    if (grid == 0) {
        if (n_in != 32 || out_size != NLAT * D || ws_size < WS_END) { fprintf(stderr, "kernel_launch: unexpected shapes (n_in %d, out %d, ws %zu < %zu)\n", n_in, out_size, ws_size, (size_t)WS_END); grid = -1; return; }
        int dev = 0, cus = 0, per_cu = 0;
        if (hipGetDevice(&dev) != hipSuccess || hipDeviceGetAttribute(&cus, hipDeviceAttributeMultiprocessorCount, dev) != hipSuccess) { grid = -1; return; }
        if (hipFuncSetAttribute((const void*)mk_fwd, hipFuncAttributeMaxDynamicSharedMemorySize, LDS_BYTES) != hipSuccess) { fprintf(stderr, "kernel_launch: hipFuncSetAttribute failed\n"); grid = -1; return; }
        if (hipOccupancyMaxActiveBlocksPerMultiprocessor(&per_cu, (const void*)mk_fwd, 512, LDS_BYTES) != hipSuccess || per_cu < 1) { fprintf(stderr, "kernel_launch: occupancy query says %d\n", per_cu); }
        (void)hipGetLastError();
        grid = cus;
    }
    if (grid < 0) return;
    if (hipMemsetAsync((char*)d_ws + WS_CTL, 0, CTL_ZERO_BYTES, stream) != hipSuccess) return;
    Args a{};
    for (int i = 0; i < 32; ++i) a.in[i] = (const float*)d_in[i];
    a.out = (float*)d_out; a.ws = (unsigned char*)d_ws;
#if MK_ONE_LAUNCH
    a.ph_lo = 0; a.ph_hi = NPH;
    hipLaunchKernelGGL(mk_fwd, dim3(grid), dim3(512), LDS_BYTES, stream, a);
#else
    for (int p = 0; p < NPH; ++p) { a.ph_lo = p; a.ph_hi = p + 1; hipLaunchKernelGGL(mk_fwd, dim3(grid), dim3(512), LDS_BYTES, stream, a); }
#endif
}
```

```cpp
#include <hip/hip_runtime.h>
#include <cstdio>
#include <cstdint>

#ifndef MK_ONE_LAUNCH
#define MK_ONE_LAUNCH 1
#endif
#ifndef GEMM_IMPL
#define GEMM_IMPL 1
#endif

#ifndef PHASE_MASK
#define PHASE_MASK 0xffff
#endif
#define PH_EN(p) (((PHASE_MASK) >> (p)) & 1)
#ifndef DUP_MASK
#define DUP_MASK 0
#endif
#ifndef EXTRA_SEAMS
#define EXTRA_SEAMS 0
#endif
#ifndef SCAN_VAR
#define SCAN_VAR 0
#endif
#ifndef SCAN_DBG
#define SCAN_DBG 0
#endif
#ifndef SCAN_IMPL
#define SCAN_IMPL 1
#endif
#define DUP_N(p) (1 + (((DUP_MASK) >> (p)) & 1))
#define LAS __attribute__((address_space(3)))
typedef unsigned short bf16_t;
typedef short bf16x8 __attribute__((ext_vector_type(8)));
typedef float f32x4 __attribute__((ext_vector_type(4)));
typedef unsigned u32x4 __attribute__((ext_vector_type(4)));
typedef unsigned u32x2 __attribute__((ext_vector_type(2)));

constexpr int D = 1024, NBATCH = 16, SEQ = 2048, DEPTH = 4, CTXL = 256;
constexpr int NCTX = NBATCH * CTXL;
constexpr int NLAT = NBATCH * SEQ;
constexpr int NT = NCTX + NLAT;
constexpr int DH = 512;
constexpr int NIN = 5504, ZLD = 5632;
constexpr int ZC_BG = 0, ZC_CG = 512, ZC_HA = 1024, ZC_RW = 1536, ZC_GA = 3456, ZC_GB = 4480;
constexpr int RWC = 1920;
constexpr int NE = 32, DFF = 512;
constexpr int MAXTILES = 320;
constexpr int NMOD = 6 * D;
constexpr float NORM_EPS = 1e-6f, GN_EPS = 64e-5f;

constexpr size_t MiB = 1u << 20;
constexpr size_t WS_CTL = 0, CTL_ZERO_BYTES = 1 * MiB;
constexpr size_t WS_MOD = 1 * MiB;
constexpr size_t WS_RE = 3 * MiB;
constexpr size_t WS_RG = WS_RE + (size_t)NT * 8;
constexpr size_t WS_RP = WS_RG + (size_t)NT * 8;
constexpr size_t WS_RS = WS_RP + (size_t)NT * 8;
constexpr size_t WS_BH = 4 * MiB + 256 * 1024;
constexpr size_t WS_RB = 4 * MiB + 384 * 1024;
constexpr size_t WS_WC = 6 * MiB + 256 * 1024;
constexpr size_t WS_BONUS = 5 * MiB;
constexpr size_t WS_X = 8 * MiB;
constexpr size_t WS_WIN = 152 * MiB;
constexpr size_t WS_WA = 163 * MiB;
constexpr size_t WS_WB = 164 * MiB;
constexpr size_t WS_WO = 165 * MiB;
constexpr size_t WS_W13 = 167 * MiB;
constexpr size_t WS_W2 = 231 * MiB;
constexpr size_t WS_Z = 264 * MiB;
constexpr size_t WS_XS = WS_Z;
constexpr size_t WS_HID = WS_Z + 160 * MiB;
constexpr size_t WS_SI = 660 * MiB;
constexpr size_t SI_SZ = 36 * MiB;
constexpr size_t WS_V = WS_SI, WS_KT0 = WS_SI + SI_SZ, WS_KT1 = WS_SI + 2 * SI_SZ, WS_BT0 = WS_SI + 3 * SI_SZ, WS_BT1 = WS_SI + 4 * SI_SZ,
                 WS_KDT0 = WS_SI + 5 * SI_SZ, WS_KDT1 = WS_SI + 6 * SI_SZ, WS_RT0 = WS_SI + 7 * SI_SZ, WS_RT1 = WS_SI + 8 * SI_SZ;
constexpr size_t WS_B1 = WS_RT1, WS_KD0 = WS_KDT0;
constexpr size_t WS_UA = WS_KT0, WS_UB = WS_KT1;
constexpr size_t WS_GE0 = 1092 * MiB, WS_GE1 = 1097 * MiB;
constexpr size_t WS_YS = WS_SI;
constexpr size_t WS_Y0 = 984 * MiB, WS_Y1 = 1020 * MiB;
constexpr size_t WS_END = 1102 * MiB;
constexpr size_t DO_H = 0, DO_G = 72 * MiB;
static_assert(WS_Z + (size_t)NT * ZLD * 2 <= WS_SI && WS_HID + (size_t)MAXTILES * 256 * DFF * 2 <= WS_SI && WS_B1 + SI_SZ <= WS_Y0 && WS_YS + (size_t)MAXTILES * 256 * D * 2 <= WS_Y0, "ws map");
static_assert((size_t)NT * DH * 2 == SI_SZ && WS_X + (size_t)NT * D * 4 <= WS_WIN && WS_W2 + 32 * MiB <= WS_Z, "ws map 2");
constexpr int CW_CNT = 1024;
constexpr int CW_BAR = 4096;

constexpr int LDS_BYTES = 163840;
constexpr int LDS_CTL = 155648;
constexpr int LC_BARW = LDS_CTL;
constexpr int LC_SEG = LDS_CTL + 64;
constexpr int LC_CNTS = LDS_CTL + 256;
constexpr int LC_TILEE = LDS_CTL + 512;
constexpr int LC_BBASE = LDS_CTL + 2048;
constexpr int LC_RED = LDS_CTL + 4096;

__device__ __forceinline__ float bf2f(unsigned b) { return __uint_as_float(b << 16); }
typedef float f32x2c __attribute__((ext_vector_type(2)));
typedef __bf16 bf16v2c __attribute__((ext_vector_type(2)));
__device__ __forceinline__ unsigned pk2(float lo, float hi) { const f32x2c v = {lo, hi}; return __builtin_bit_cast(unsigned, __builtin_convertvector(v, bf16v2c)); }
__device__ __forceinline__ unsigned f2bf(float f) { return pk2(f, 0.f) & 0xffffu; }
__device__ __forceinline__ float wave_sum(float v) {
#pragma unroll
    for (int o = 1; o < 64; o <<= 1) v += __shfl_xor(v, o);
    return v;
}
__device__ __forceinline__ float sigmoidf_(float x) { return __builtin_amdgcn_rcpf(1.0f + __expf(-x)); }
__device__ __forceinline__ float siluf_(float x) { return x * __builtin_amdgcn_rcpf(1.0f + __expf(-x)); }

#define XB_TMO      128
#define XB_XCNT(j)  (256  + 64 * (j))
#define XB_XSUB(j)  (1280 + 64 * (j))
#define XB_XGEN(j)  (2304 + 64 * (j))
#define XB_TOP      3328
#define XB_TOPGEN   3392
#define XCD_BAR_WORDS 3456
#define XB_SPIN_CAP (1u << 22)

__device__ __forceinline__ unsigned xb_ld(unsigned* p)              { return __hip_atomic_load(p, __ATOMIC_RELAXED, __HIP_MEMORY_SCOPE_AGENT); }
__device__ __forceinline__ unsigned xb_add(unsigned* p, unsigned v) { return __hip_atomic_fetch_add(p, v, __ATOMIC_RELAXED, __HIP_MEMORY_SCOPE_AGENT); }
__device__ __forceinline__ unsigned xb_xcc_id() { return (unsigned)__builtin_amdgcn_s_getreg((3 << 11) | 20) & 0xFu; }
#define XB_SPIN(cond, bar) do { unsigned _sp = 0; while (cond) { __builtin_amdgcn_s_sleep(1); \
    if ((++_sp & 255u) == 0u) { if (xb_ld(&(bar)[XB_TMO])) break; if (_sp > XB_SPIN_CAP) { atomicAdd(&(bar)[XB_TMO], 1u); break; } } } } while (0)

struct XcdBarrier { unsigned* bar; unsigned x; volatile LAS unsigned* st; };

__device__ __forceinline__ XcdBarrier xcd_barrier_post(unsigned* bar, volatile LAS unsigned* st) {
    XcdBarrier b; b.bar = bar; b.x = xb_xcc_id(); b.st = st;
    if (threadIdx.x == 0) (void)xb_add(&bar[XB_XCNT(b.x)], 1u);
    return b;
}
__device__ __forceinline__ void xcd_barrier_complete(unsigned* bar, unsigned x, unsigned& nloc, unsigned& nx) {
    const unsigned G = gridDim.x * gridDim.y * gridDim.z;
    unsigned sum, cnt, mine, sp = 0u;
    for (;;) {
        sum = 0u; cnt = 0u; mine = 0u;
#pragma unroll
        for (unsigned j = 0; j < 16; ++j) { const unsigned c = xb_ld(&bar[XB_XCNT(j)]); sum += c; cnt += (c > 0u) ? 1u : 0u; mine = (j == x) ? c : mine; }
        if (sum == G) break;
        __builtin_amdgcn_s_sleep(1);
        if ((++sp & 255u) == 0u) { if (xb_ld(&bar[XB_TMO])) break; if (sp > XB_SPIN_CAP) { atomicAdd(&bar[XB_TMO], 1u); break; } }
    }
    nloc = mine > 0u ? mine : 1u; nx = cnt > 0u ? cnt : 1u;
}
__device__ __forceinline__ void xcd_barrier(const XcdBarrier& b) {
    asm volatile("s_waitcnt vmcnt(0)" ::: "memory");
    __syncthreads();
    if (threadIdx.x == 0) {
        unsigned* bar = b.bar;
        __builtin_amdgcn_s_waitcnt(0);
        unsigned nloc = b.st[0], nx = b.st[1];
        if (nloc == 0u) { xcd_barrier_complete(bar, b.x, nloc, nx); b.st[0] = nloc; b.st[1] = nx; }
        const unsigned old = xb_add(&bar[XB_XSUB(b.x)], 1u);
        const unsigned gen = old / nloc;
        if (old + 1u == (gen + 1u) * nloc) {
            __builtin_amdgcn_fence(__ATOMIC_RELEASE, "agent");
            asm volatile("s_waitcnt vmcnt(0)" ::: "memory");
            const unsigned og = xb_add(&bar[XB_TOP], 1u);
            const unsigned tg = og / nx;
            if (og + 1u == (tg + 1u) * nx) xb_add(&bar[XB_TOPGEN], 1u);
            else XB_SPIN(xb_ld(&bar[XB_TOPGEN]) == tg, bar);
            __builtin_amdgcn_fence(__ATOMIC_ACQUIRE, "agent");
            xb_add(&bar[XB_XGEN(b.x)], 1u);
            asm volatile("s_waitcnt vmcnt(0)" ::: "memory");
        } else {
            XB_SPIN(xb_ld(&bar[XB_XGEN(b.x)]) == gen, bar);
            __builtin_amdgcn_fence(__ATOMIC_ACQUIRE, "agent");
            asm volatile("s_waitcnt vmcnt(0)" ::: "memory");
        }
    }
    __syncthreads();
}

struct Unit { int pm, pn, bs, as; };
struct Gemm { const bf16_t* A; const bf16_t* Bt; int M, N, K; size_t bstride; size_t astride; };
constexpr int NXCD = 8, WGM = 8;
struct StaticOrder {
    int nM, nN, nwg, G, c;
    __device__ __forceinline__ void init(int M, int N, int G_, int c_) { nM = M / 256; nN = N / 256; nwg = nM * nN; G = G_; c = c_; }
    __device__ __forceinline__ bool next(int i, Unit& u) const {
        const long L = (long)i * G + c; if (L >= nwg) return false;
        int wgid = (int)L; { const int q = nwg / NXCD, r = nwg % NXCD, xcd = wgid % NXCD, off = wgid / NXCD; wgid = (xcd < r ? xcd * (q + 1) : r * (q + 1) + (xcd - r) * q) + off; }
        const int nig = WGM * nN, gid = wgid / nig, fm = gid * WGM, gsz = (nM - fm) < WGM ? (nM - fm) : WGM;
        u.pm = fm + ((wgid % nig) % gsz); u.pn = (wgid % nig) / gsz; u.bs = 0; u.as = 0; return true;
    }
};
struct PairOrder {
    StaticOrder so;
    __device__ __forceinline__ bool next(int i, Unit& u) const { if (!so.next(i >> 1, u)) return false; u.bs = i & 1; u.as = i & 1; return true; }
};
struct MoeOrder {
    int ntiles, G, c; const LAS int* tile_e;
    __device__ __forceinline__ bool next(int i, Unit& u) const {
        const int L = i * G + c; if (L >= ntiles * 4) return false;
        u.pm = L >> 2; u.pn = L & 3; u.bs = __builtin_amdgcn_readfirstlane(tile_e[u.pm]); u.as = 0; return true;
    }
};

#if GEMM_IMPL == 0
template <class Epi, class Sched>
__device__ __forceinline__ void gemm_phase(LAS unsigned char* lds, const Gemm g, const Sched& S, const Epi& E) {
    LAS float* As = (LAS float*)lds;
    LAS float* Bs = As + 16 * 260;
    const int tid = threadIdx.x, ty = tid >> 4, tx = tid & 15, lr = tid >> 1, lh = tid & 1;
    Unit u;
    for (int it = 0; S.next(it, u); ++it) {
        float acc[8][16];
#pragma unroll
        for (int i = 0; i < 8; ++i)
#pragma unroll
            for (int j = 0; j < 16; ++j) acc[i][j] = 0.f;
        const bf16_t* Ap = g.A + ((size_t)u.pm * 256 + lr) * g.K + lh * 8;
        const bf16_t* Bp = g.Bt + (size_t)u.bs * g.bstride + ((size_t)u.pn * 256 + lr) * g.K + lh * 8;
        for (int k0 = 0; k0 < g.K; k0 += 16) {
            const u32x4 av = *(const u32x4*)(Ap + k0), bv = *(const u32x4*)(Bp + k0);
            __syncthreads();
#pragma unroll
            for (int j = 0; j < 4; ++j) {
                As[(lh * 8 + 2 * j) * 260 + lr] = bf2f(av[j] & 0xffffu); As[(lh * 8 + 2 * j + 1) * 260 + lr] = bf2f(av[j] >> 16);
                Bs[(lh * 8 + 2 * j) * 260 + lr] = bf2f(bv[j] & 0xffffu); Bs[(lh * 8 + 2 * j + 1) * 260 + lr] = bf2f(bv[j] >> 16);
            }
            __syncthreads();
#pragma unroll 4
            for (int kk = 0; kk < 16; ++kk) {
                float a[8], b[16];
                const f32x4 a0 = *(const LAS f32x4*)(As + kk * 260 + ty * 8), a1 = *(const LAS f32x4*)(As + kk * 260 + ty * 8 + 4);
                a[0] = a0[0]; a[1] = a0[1]; a[2] = a0[2]; a[3] = a0[3]; a[4] = a1[0]; a[5] = a1[1]; a[6] = a1[2]; a[7] = a1[3];
#pragma unroll
                for (int q = 0; q < 4; ++q) { const f32x4 bq = *(const LAS f32x4*)(Bs + kk * 260 + tx * 4 + 64 * q); b[4 * q] = bq[0]; b[4 * q + 1] = bq[1]; b[4 * q + 2] = bq[2]; b[4 * q + 3] = bq[3]; }
#pragma unroll
                for (int i = 0; i < 8; ++i)
#pragma unroll
                    for (int j = 0; j < 16; ++j) acc[i][j] = fmaf(a[i], b[j], acc[i][j]);
            }
        }
#pragma unroll
        for (int i = 0; i < 8; ++i)
#pragma unroll
            for (int q = 0; q < 4; ++q)
                E.elem4(u.pm * 256 + ty * 8 + i, u.pn * 256 + tx * 4 + 64 * q, (f32x4){acc[i][4 * q], acc[i][4 * q + 1], acc[i][4 * q + 2], acc[i][4 * q + 3]});
    }
    __syncthreads();
}
#else
namespace pg8 {
constexpr int BM = 256, BK = 64, HALF = 128, HTB = HALF * BK * 2, STAGE_BYTES = 8 * HTB;
__device__ __forceinline__ int lds_byte(int r, int c) { const int st = (r >> 4) * 2 + (c >> 5), rr = r & 15, cc = c & 31, ob = rr * 64 + cc * 2; return st * 1024 + (ob ^ (((ob >> 9) & 1) << 5)); }
__device__ __forceinline__ void stage_rc(int b, int& R, int& C) { const int st = b / 1024, sb = b % 1024, swz = sb ^ (((sb >> 9) & 1) << 5); R = (st >> 1) * 16 + swz / 64; C = (st & 1) * 32 + (swz % 64) / 2; }
}
template <class Epi, class Sched>
__device__ __forceinline__ void gemm_phase(LAS unsigned char* lds, const Gemm g, const Sched& S, const Epi& E) {
    using namespace pg8;
    int tid_ = threadIdx.x; asm volatile("" : "+v"(tid_));
    const int tid = tid_, wid = __builtin_amdgcn_readfirstlane(tid >> 6), lane = tid & 63, wr = wid >> 2, wc = wid & 3, fr = lane & 15, fq = lane >> 4;
    const int K = g.K, nt = K / BK;
    unsigned voffA[2];
#pragma unroll
    for (int i = 0; i < 2; ++i) { int R, C; stage_rc(tid * 16 + i * 8192, R, C); voffA[i] = (unsigned)(R * K + C) * 2u; }
    const size_t kstep = (size_t)(BK * 2);
    const size_t hstep = (size_t)HALF * K * 2;
    const size_t tstep = 2 * hstep;
    const unsigned ldsw = (unsigned)wid * 1024u;
    const int aoff = lds_byte(wr * 64 + fr, fq * 8), boff = lds_byte(wc * 32 + fr, fq * 8);
#define PG8_SA(b, h) (((b) * 2 + (h)) * HTB)
#define PG8_SB(b, h) ((4 + (b) * 2 + (h)) * HTB)
#define PG8_STAGE(bufoff, gbase, voff) do { _Pragma("unroll") for (int _i = 0; _i < 2; ++_i) \
        __builtin_amdgcn_global_load_lds((const unsigned*)((const char*)(gbase) + (voff)[_i]), (LAS unsigned*)(lds + (bufoff) + ldsw + _i * 8192), 16, 0, 0); } while (0)
#define PG8_LDA(dst, b, h) do { _Pragma("unroll") for (int m = 0; m < 4; ++m) _Pragma("unroll") for (int k = 0; k < 2; ++k) dst[m][k] = *(const LAS bf16x8*)(lds + PG8_SA(b, h) + aoff + m * 2048 + k * 1024); } while (0)
#define PG8_LDB(dst, b, h) do { _Pragma("unroll") for (int n = 0; n < 2; ++n) _Pragma("unroll") for (int k = 0; k < 2; ++k) dst[n][k] = *(const LAS bf16x8*)(lds + PG8_SB(b, h) + boff + n * 2048 + k * 1024); } while (0)
#define PG8_MMA(ai, bj, At, Bt) do { __builtin_amdgcn_s_setprio(1); _Pragma("unroll") for (int m = 0; m < 4; ++m) _Pragma("unroll") for (int n = 0; n < 2; ++n) _Pragma("unroll") for (int k = 0; k < 2; ++k) \
        acc[ai][bj][m][n] = __builtin_amdgcn_mfma_f32_16x16x32_bf16(Bt[n][k], At[m][k], acc[ai][bj][m][n], 0, 0, 0); __builtin_amdgcn_s_setprio(0); } while (0)
#define PG8_WAIT_V(n) asm volatile("s_waitcnt vmcnt(" #n ")" ::: "memory")
#define PG8_WAIT_L(n) asm volatile("s_waitcnt lgkmcnt(" #n ")" ::: "memory")
#define PG8_BAR __builtin_amdgcn_s_barrier()
#define PG8_SCHED __builtin_amdgcn_sched_barrier(0)
    Unit cur, nxt; int ui = 0;
    if (S.next(0, cur)) {
    f32x4 acc[2][2][4][2];
#pragma unroll
    for (int a = 0; a < 2; ++a)
#pragma unroll
        for (int b = 0; b < 2; ++b)
#pragma unroll
            for (int m = 0; m < 4; ++m)
#pragma unroll
                for (int n = 0; n < 2; ++n) acc[a][b][m][n] = (f32x4){0.f, 0.f, 0.f, 0.f};
    bf16x8 At[4][2], B0[2][2], B1[2][2];
    const char* cA = (const char*)(g.A + (size_t)cur.as * g.astride) + (size_t)cur.pm * tstep; const char* cB = (const char*)(g.Bt + (size_t)cur.bs * g.bstride) + (size_t)cur.pn * tstep;
    PG8_STAGE(PG8_SB(0, 0), cB, voffA); PG8_STAGE(PG8_SA(0, 0), cA, voffA); PG8_STAGE(PG8_SB(0, 1), cB + hstep, voffA); PG8_STAGE(PG8_SA(0, 1), cA + hstep, voffA);
    if (wr == 1) PG8_BAR;
    PG8_WAIT_V(4); PG8_BAR;
    PG8_STAGE(PG8_SB(1, 0), cB + kstep, voffA); PG8_STAGE(PG8_SA(1, 0), cA + kstep, voffA); PG8_STAGE(PG8_SB(1, 1), cB + hstep + kstep, voffA);
    PG8_WAIT_V(6); PG8_BAR;
    for (;;) {
        const bool has_next = S.next(ui + 1, nxt);
        const char* nA = has_next ? (const char*)(g.A + (size_t)nxt.as * g.astride) + (size_t)nxt.pm * tstep : cA; const char* nB = has_next ? (const char*)(g.Bt + (size_t)nxt.bs * g.bstride) + (size_t)nxt.pn * tstep : cB;
        for (int t = 0; t < nt; t += 2) {
            const bool last = (t == nt - 2);
            const char* a1 = cA + (size_t)(t + 1) * kstep;
            const char* a2 = last ? nA : cA + (size_t)(t + 2) * kstep; const char* b2 = last ? nB : cB + (size_t)(t + 2) * kstep;
            const char* a3 = a2 + kstep; const char* b3 = b2 + kstep;
            PG8_LDB(B0, 0, 0); PG8_SCHED; PG8_LDA(At, 0, 0); PG8_STAGE(PG8_SA(1, 1), a1 + hstep, voffA);
            PG8_WAIT_L(8); PG8_BAR; PG8_WAIT_L(0); PG8_MMA(0, 0, At, B0); PG8_BAR; PG8_SCHED;
            PG8_LDB(B1, 0, 1); PG8_STAGE(PG8_SB(0, 0), b2, voffA);
            PG8_BAR; PG8_WAIT_L(0); PG8_MMA(0, 1, At, B1); PG8_BAR;
            PG8_LDA(At, 0, 1); PG8_STAGE(PG8_SA(0, 0), a2, voffA);
            PG8_BAR; PG8_WAIT_L(0); PG8_MMA(1, 0, At, B0); PG8_BAR; PG8_SCHED;
            PG8_STAGE(PG8_SB(0, 1), b2 + hstep, voffA);
            PG8_WAIT_V(6); PG8_BAR; PG8_MMA(1, 1, At, B1); PG8_BAR;
            PG8_LDB(B0, 1, 0); PG8_SCHED; PG8_LDA(At, 1, 0); PG8_STAGE(PG8_SA(0, 1), a2 + hstep, voffA);
            PG8_WAIT_L(8); PG8_BAR; PG8_WAIT_L(0); PG8_MMA(0, 0, At, B0); PG8_BAR; PG8_SCHED;
            PG8_LDB(B1, 1, 1); PG8_STAGE(PG8_SB(1, 0), b3, voffA);
            PG8_BAR; PG8_WAIT_L(0); PG8_MMA(0, 1, At, B1); PG8_BAR;
            PG8_LDA(At, 1, 1); PG8_STAGE(PG8_SA(1, 0), a3, voffA);
            PG8_BAR; PG8_WAIT_L(0); PG8_MMA(1, 0, At, B0); PG8_BAR; PG8_SCHED;
            PG8_STAGE(PG8_SB(1, 1), b3 + hstep, voffA);
            PG8_WAIT_V(6); PG8_BAR; PG8_MMA(1, 1, At, B1); PG8_BAR;
        }
        bool keep = false;
        {
            const int row0 = cur.pm * 256 + wr * 64 + fr, col0 = cur.pn * 256 + wc * 32 + 4 * fq;
            if constexpr (Epi::TWO_PART) keep = (cur.as == 0);
#pragma unroll
            for (int ai = 0; ai < 2; ++ai)
#pragma unroll
                for (int m = 0; m < 4; ++m)
#pragma unroll
                    for (int bj = 0; bj < 2; ++bj)
#pragma unroll
                        for (int n = 0; n < 2; ++n) {
                            if constexpr (Epi::TWO_PART) { if (keep) E.mid4(row0 + ai * 128 + m * 16, col0 + bj * 128 + n * 16, acc[ai][bj][m][n]); else E.elem4(row0 + ai * 128 + m * 16, col0 + bj * 128 + n * 16, acc[ai][bj][m][n]); }
                            else E.elem4(row0 + ai * 128 + m * 16, col0 + bj * 128 + n * 16, acc[ai][bj][m][n]);
                        }
        }
        if (!has_next) break;
        if (!keep) {
#pragma unroll
        for (int a = 0; a < 2; ++a)
#pragma unroll
            for (int b = 0; b < 2; ++b)
#pragma unroll
                for (int m = 0; m < 4; ++m)
#pragma unroll
                    for (int n = 0; n < 2; ++n) acc[a][b][m][n] = (f32x4){0.f, 0.f, 0.f, 0.f};
        }
        cur = nxt; cA = nA; cB = nB; ++ui;
    }
    PG8_WAIT_V(0);
    if (wr == 0) PG8_BAR;
    PG8_BAR;
    }
#undef PG8_SA
#undef PG8_SB
#undef PG8_STAGE
#undef PG8_LDA
#undef PG8_LDB
#undef PG8_MMA
#undef PG8_WAIT_V
#undef PG8_WAIT_L
#undef PG8_BAR
#undef PG8_SCHED
    __syncthreads();
}
#endif

struct EpiStoreBf16 {
    static constexpr bool TWO_PART = false;
    bf16_t* O; int ldc;
    __device__ __forceinline__ void elem4(int row, int col, f32x4 v) const {
        u32x2 w; w.x = pk2(v[0], v[1]); w.y = pk2(v[2], v[3]);
        *(u32x2*)(O + (size_t)row * ldc + col) = w;
    }
};
struct EpiMerge {
    static constexpr bool TWO_PART = true;
    bf16_t* MG; const bf16_t* Z;
    __device__ __forceinline__ void mid4(int row, int col, f32x4& v) const {
        const u32x2 ga = *(const u32x2*)(Z + (size_t)row * ZLD + ZC_GA + col), gb = *(const u32x2*)(Z + (size_t)row * ZLD + ZC_GB + col);
        v[0] *= (1.0f + __expf(-bf2f(gb.x & 0xffffu))) * __builtin_amdgcn_rcpf(1.0f + __expf(-bf2f(ga.x & 0xffffu)));
        v[1] *= (1.0f + __expf(-bf2f(gb.x >> 16))) * __builtin_amdgcn_rcpf(1.0f + __expf(-bf2f(ga.x >> 16)));
        v[2] *= (1.0f + __expf(-bf2f(gb.y & 0xffffu))) * __builtin_amdgcn_rcpf(1.0f + __expf(-bf2f(ga.y & 0xffffu)));
        v[3] *= (1.0f + __expf(-bf2f(gb.y >> 16))) * __builtin_amdgcn_rcpf(1.0f + __expf(-bf2f(ga.y >> 16)));
    }
    __device__ __forceinline__ void elem4(int row, int col, f32x4 v) const {
        const u32x2 gb = *(const u32x2*)(Z + (size_t)row * ZLD + ZC_GB + col);
        u32x2 w; w.x = pk2(sigmoidf_(bf2f(gb.x & 0xffffu)) * v[0], sigmoidf_(bf2f(gb.x >> 16)) * v[1]); w.y = pk2(sigmoidf_(bf2f(gb.y & 0xffffu)) * v[2], sigmoidf_(bf2f(gb.y >> 16)) * v[3]);
        *(u32x2*)(MG + (size_t)row * D + col) = w;
    }
};
struct EpiResid {
    static constexpr bool TWO_PART = false;
    float* X; const float* modg;
    __device__ __forceinline__ void elem4(int row, int col, f32x4 v) const {
        const int mj = row < NCTX ? 16 : ((row - NCTX) >> 11);
        const f32x4 gv = *(const f32x4*)(modg + (size_t)mj * NMOD + col);
        f32x4* p = (f32x4*)(X + (size_t)row * D + col);
        f32x4 x = *p; x[0] += gv[0] * v[0]; x[1] += gv[1] * v[1]; x[2] += gv[2] * v[2]; x[3] += gv[3] * v[3]; *p = x;
    }
};
struct EpiSwiGLU {
    static constexpr bool TWO_PART = false;
    bf16_t* HID;
    __device__ __forceinline__ void elem4(int row, int col, f32x4 v) const {
        *(unsigned*)(HID + (size_t)row * DFF + (col >> 1)) = pk2(siluf_(v[0]) * v[2], siluf_(v[1]) * v[3]);
    }
};

struct Args { const float* in[32]; float* out; unsigned char* ws; int ph_lo, ph_hi; };
typedef const __attribute__((address_space(4))) Args* KArgs;
__device__ __forceinline__ KArgs kargs() { KArgs p = (KArgs)__builtin_amdgcn_kernarg_segment_ptr(); asm volatile("" : "+s"(p)); return p; }
struct Frame {
    LAS unsigned char* lds;
    int tid, lane, wave, G, bid;
    KArgs ka; float* out; unsigned char* ws;
    __device__ __forceinline__ const float* inp(int i) const { return ka->in[i]; }
};
__device__ __forceinline__ Frame make_frame() {
    extern __shared__ __attribute__((aligned(16))) unsigned char lds_raw[];
    Frame F; F.lds = (LAS unsigned char*)lds_raw; { int t = threadIdx.x; asm volatile("" : "+v"(t)); F.tid = t; } F.lane = F.tid & 63; F.wave = __builtin_amdgcn_readfirstlane(F.tid >> 6);
    { int g_ = gridDim.x, b_ = blockIdx.x; asm volatile("" : "+s"(g_), "+s"(b_)); F.G = g_; F.bid = b_; } F.ka = kargs(); F.out = F.ka->out; F.ws = F.ka->ws; return F;
}
#define IN_X 0
#define IN_C 1
#define IN_CTX 2
#define IN_CCTX 3
#define IN_WMOD 4
#define IN_BMOD 5
#define IN_N1G 6
#define IN_N2G 7
#define IN_WIN 8
#define IN_SHMU 9
#define IN_CONVW 10
#define IN_WUP 11
#define IN_W0 12
#define IN_AUP 13
#define IN_A0 14
#define IN_GUP 15
#define IN_KK 16
#define IN_KA 17
#define IN_RK 18
#define IN_LNG 19
#define IN_LNB 20
#define IN_WAO 21
#define IN_WBO 22
#define IN_WO 23
#define IN_RG 24
#define IN_RGB 25
#define IN_RE 26
#define IN_REB 27
#define IN_W1 28
#define IN_W3 29
#define IN_W2 30
#define IN_FG 31

__device__ __forceinline__ void phase_prologue() {
    Frame F = make_frame();
    {
        const f32x4* sc = (const f32x4*)F.inp(IN_CTX); const f32x4* sx = (const f32x4*)F.inp(IN_X); f32x4* X = (f32x4*)(F.ws + WS_X);
        const size_t n4c = (size_t)NCTX * D / 4, n4 = (size_t)NT * D / 4;
        for (size_t i = (size_t)F.bid * 512 + F.tid; i < n4; i += (size_t)F.G * 512) X[i] = i < n4c ? sc[i] : sx[i - n4c];
    }
    {
        float* WC = (float*)(F.ws + WS_WC); float* RB = (float*)(F.ws + WS_RB);
        for (int i = F.bid * 512 + F.tid; i < DEPTH * 1024 * 48; i += F.G * 512) { const int c = i % 48, lk = i / 48;
            WC[i] = c < 32 ? F.inp(IN_RE)[(size_t)lk * 32 + c] : (c < 36 ? F.inp(IN_RG)[(size_t)lk * 4 + (c - 32)] : 0.f); }
        if (F.bid == 0 && F.tid < DEPTH * 48) { const int c = F.tid % 48, l = F.tid / 48; RB[F.tid] = c < 32 ? F.inp(IN_REB)[l * 32 + c] : (c < 36 ? F.inp(IN_RGB)[l * 4 + (c - 32)] : 0.f); }
    }
    if (F.bid * 512 < DEPTH * NMOD) {
        LAS float* st = (LAS float*)F.lds;
        for (int i = F.tid; i < 17 * 1024; i += 512) { const int j = i >> 10, k = i & 1023; const float cv = j < 16 ? F.inp(IN_C)[j * 1024 + k] : F.inp(IN_CCTX)[k]; st[k * 20 + j] = siluf_(cv); }
        __syncthreads();
        for (int cidx = F.bid * 512 + F.tid; cidx < DEPTH * NMOD; cidx += F.G * 512) {
            const int l = cidx / NMOD, n = cidx % NMOD;
            const float* w = F.inp(IN_WMOD) + (size_t)l * D * NMOD + n;
            float acc[17]; const float b = F.inp(IN_BMOD)[l * NMOD + n];
#pragma unroll
            for (int j = 0; j < 17; ++j) acc[j] = b;
#pragma unroll 4
            for (int k = 0; k < 1024; ++k) {
                const float wv = w[(size_t)k * NMOD];
#pragma unroll
                for (int j = 0; j < 17; ++j) acc[j] = fmaf(st[k * 20 + j], wv, acc[j]);
            }
            float* mod = (float*)(F.ws + WS_MOD) + (size_t)l * 17 * NMOD + n;
#pragma unroll
            for (int j = 0; j < 17; ++j) mod[(size_t)j * NMOD] = acc[j];
        }
        __syncthreads();
    }
}

__device__ __forceinline__ void conv_item(const float* src0, const float* src1, int ldsrc, int nvalid, int mode, bf16_t* dst, int K, int item, LAS float* scr, int lane) {
    const int nkb = K / 64, kb = item % nkb, jb = item / nkb, k0 = 64 * kb, j0 = 32 * jb;
    const int jj = j0 + (lane & 31);
    const float* colp;
    if (mode == 0) colp = jj < nvalid ? src0 + jj : nullptr;
    else colp = ((jj & 2) ? src1 : src0) + 2 * (jj >> 2) + (jj & 1);
#pragma unroll 8
    for (int i = 0; i < 32; ++i) { const int kk = 2 * i + (lane >> 5); scr[kk * 33 + (lane & 31)] = colp ? colp[(size_t)(k0 + kk) * ldsrc] : 0.f; }
    asm volatile("s_waitcnt lgkmcnt(0)" ::: "memory");
    const int c = lane & 7;
#pragma unroll
    for (int j = 0; j < 4; ++j) { const int n = (lane >> 3) + 8 * j; const LAS float* s = scr + (8 * c) * 33 + n;
        u32x4 o; o.x = pk2(s[0 * 33], s[1 * 33]); o.y = pk2(s[2 * 33], s[3 * 33]); o.z = pk2(s[4 * 33], s[5 * 33]); o.w = pk2(s[6 * 33], s[7 * 33]);
        *(u32x4*)(dst + (size_t)(j0 + n) * K + k0 + 8 * c) = o; }
    asm volatile("s_waitcnt lgkmcnt(0)" ::: "memory");
}
__device__ __forceinline__ void convert_layer_weights(Frame& F, int l) {
    LAS float* scr = (LAS float*)(F.lds + F.wave * 8704);
    const int gw = F.bid * 8 + F.wave, NGW = F.G * 8;
    constexpr int I_IN = (1024 / 64) * (ZLD / 32), I_A = (512 / 64) * (1024 / 32), I_O = (1024 / 64) * (1024 / 32), I_13 = (1024 / 64) * (1024 / 32), I_2 = (512 / 64) * (1024 / 32);
    constexpr int NITEMS = I_IN + 2 * I_A + I_O + NE * I_13 + NE * I_2;
    for (int it = gw; it < NITEMS; it += NGW) {
        int r = it;
        if (r < I_IN) { conv_item(F.inp(IN_WIN) + (size_t)l * D * NIN, nullptr, NIN, NIN, 0, (bf16_t*)(F.ws + WS_WIN), 1024, r, scr, F.lane); continue; } r -= I_IN;
        if (r < I_A) { conv_item(F.inp(IN_WAO) + (size_t)l * DH * D, nullptr, D, D, 0, (bf16_t*)(F.ws + WS_WA), 512, r, scr, F.lane); continue; } r -= I_A;
        if (r < I_A) { conv_item(F.inp(IN_WBO) + (size_t)l * DH * D, nullptr, D, D, 0, (bf16_t*)(F.ws + WS_WB), 512, r, scr, F.lane); continue; } r -= I_A;
        if (r < I_O) { conv_item(F.inp(IN_WO) + (size_t)l * D * D, nullptr, D, D, 0, (bf16_t*)(F.ws + WS_WO), 1024, r, scr, F.lane); continue; } r -= I_O;
        if (r < NE * I_13) { const int e = r / I_13, ri = r % I_13; const size_t so = ((size_t)l * NE + e) * D * DFF;
            conv_item(F.inp(IN_W1) + so, F.inp(IN_W3) + so, DFF, 0, 1, (bf16_t*)(F.ws + WS_W13) + (size_t)e * 1024 * 1024, 1024, ri, scr, F.lane); continue; } r -= NE * I_13;
        { const int e = r / I_2, ri = r % I_2; const size_t so = ((size_t)l * NE + e) * DFF * D;
            conv_item(F.inp(IN_W2) + so, nullptr, D, D, 0, (bf16_t*)(F.ws + WS_W2) + (size_t)e * 1024 * 512, 512, ri, scr, F.lane); }
    }
}

__device__ __forceinline__ void combine_row(Frame& F, int lprev, int row, f32x4 (&v)[4]) {
    const bf16_t* YS = (const bf16_t*)(F.ws + WS_YS); const int* RS = (const int*)(F.ws + WS_RS); const float* RG = (const float*)(F.ws + WS_RG);
    const int mj = row < NCTX ? 16 : ((row - NCTX) >> 11);
    const float* g2 = (const float*)(F.ws + WS_MOD) + ((size_t)lprev * 17 + mj) * NMOD + 5120;
    const int s0 = RS[2 * row], s1 = RS[2 * row + 1]; const float ga = RG[2 * row], gb = RG[2 * row + 1];
#pragma unroll
    for (int j = 0; j < 4; ++j) {
        const int c = 4 * F.lane + 256 * j;
        const u32x2 y0 = *(const u32x2*)(YS + (size_t)s0 * D + c), y1 = *(const u32x2*)(YS + (size_t)s1 * D + c);
        const f32x4 gg = *(const f32x4*)(g2 + c);
        v[j][0] += gg[0] * (ga * bf2f(y0.x & 0xffffu) + gb * bf2f(y1.x & 0xffffu));
        v[j][1] += gg[1] * (ga * bf2f(y0.x >> 16) + gb * bf2f(y1.x >> 16));
        v[j][2] += gg[2] * (ga * bf2f(y0.y & 0xffffu) + gb * bf2f(y1.y & 0xffffu));
        v[j][3] += gg[3] * (ga * bf2f(y0.y >> 16) + gb * bf2f(y1.y >> 16));
    }
}
__device__ __forceinline__ void phase_norm1(int l) {
    asm volatile("" : "+s"(l)); Frame F = make_frame();
    convert_layer_weights(F, l);
    const int gw = F.bid * 8 + F.wave, NGW = F.G * 8;
    float* X = (float*)(F.ws + WS_X); bf16_t* H = (bf16_t*)((unsigned char*)F.out + DO_H);
    const float* g1n = F.inp(IN_N1G) + l * D;
    for (int row = gw; row < NT; row += NGW) {
        const int mj = row < NCTX ? 16 : ((row - NCTX) >> 11);
        const float* mod = (const float*)(F.ws + WS_MOD) + ((size_t)l * 17 + mj) * NMOD;
        f32x4 v[4];
#pragma unroll
        for (int j = 0; j < 4; ++j) v[j] = *(const f32x4*)(X + (size_t)row * D + 4 * F.lane + 256 * j);
        if (l > 0) {
            combine_row(F, l - 1, row, v);
#pragma unroll
            for (int j = 0; j < 4; ++j) *(f32x4*)(X + (size_t)row * D + 4 * F.lane + 256 * j) = v[j];
        }
        float ss = 0.f;
#pragma unroll
        for (int j = 0; j < 4; ++j) ss += v[j][0] * v[j][0] + v[j][1] * v[j][1] + v[j][2] * v[j][2] + v[j][3] * v[j][3];
        const float rs = rsqrtf(wave_sum(ss) * (1.0f / D) + NORM_EPS);
#pragma unroll
        for (int j = 0; j < 4; ++j) {
            const int c = 4 * F.lane + 256 * j;
            const f32x4 gg = *(const f32x4*)(g1n + c), sh = *(const f32x4*)(mod + c), sc = *(const f32x4*)(mod + 1024 + c);
            float o[4];
#pragma unroll
            for (int q = 0; q < 4; ++q) o[q] = v[j][q] * rs * gg[q] * (1.0f + sc[q]) + sh[q];
            u32x2 w; w.x = pk2(o[0], o[1]); w.y = pk2(o[2], o[3]);
            *(u32x2*)(H + (size_t)row * D + c) = w;
        }
    }
}

constexpr int PW_S64 = 144, PW_S128 = 272;
constexpr int PW_G = 4 * 64 * PW_S64;
constexpr int PA_OFF = PW_G + 64 * PW_S128;
constexpr int PA_STRIDE = 784;
static_assert(PA_OFF + 128 * PA_STRIDE <= LDS_CTL, "prep LDS map");
__device__ __forceinline__ float tanh_fast(float x) { return 1.0f - 2.0f * __builtin_amdgcn_rcpf(1.0f + __expf(2.0f * x)); }
__device__ __forceinline__ void unpack8(const u32x4 p, float (&o)[8]) {
#pragma unroll
    for (int j = 0; j < 4; ++j) { o[2 * j] = bf2f(p[j] & 0xffffu); o[2 * j + 1] = bf2f(p[j] >> 16); }
}
__device__ __forceinline__ u32x4 pack8(const float (&f)[8]) { u32x4 r; r.x = pk2(f[0], f[1]); r.y = pk2(f[2], f[3]); r.z = pk2(f[4], f[5]); r.w = pk2(f[6], f[7]); return r; }
__device__ __forceinline__ void shifted16(const bf16_t* Z, int row, bool hasp, bool hasn, int col, const float* mu, float (&o)[16]) {
    const bf16_t* p = Z + (size_t)row * ZLD + ZC_RW + col;
    const u32x4 z0 = *(const u32x4*)p, z1 = *(const u32x4*)(p + 8);
    const u32x4 zero = (u32x4){0u, 0u, 0u, 0u};
    const u32x4 m0 = hasp ? *(const u32x4*)(p - ZLD) : zero, m1 = hasp ? *(const u32x4*)(p - ZLD + 8) : zero;
    const u32x4 n0 = hasn ? *(const u32x4*)(p + ZLD) : zero, n1 = hasn ? *(const u32x4*)(p + ZLD + 8) : zero;
    float z[16], zm[16], zn[16];
    { float t[8]; unpack8(z0, t);
#pragma unroll
      for (int j = 0; j < 8; ++j) z[j] = t[j];
      unpack8(z1, t);
#pragma unroll
      for (int j = 0; j < 8; ++j) z[8 + j] = t[j];
      unpack8(m0, t);
#pragma unroll
      for (int j = 0; j < 8; ++j) zm[j] = t[j];
      unpack8(m1, t);
#pragma unroll
      for (int j = 0; j < 8; ++j) zm[8 + j] = t[j];
      unpack8(n0, t);
#pragma unroll
      for (int j = 0; j < 8; ++j) zn[j] = t[j];
      unpack8(n1, t);
#pragma unroll
      for (int j = 0; j < 8; ++j) zn[8 + j] = t[j]; }
#pragma unroll
    for (int q = 0; q < 4; ++q) { const f32x4 m = *(const f32x4*)(mu + col + 4 * q);
#pragma unroll
        for (int e = 0; e < 4; ++e) { const int j = 4 * q + e; o[j] = z[j] + m[e] * (0.5f * (zm[j] + zn[j]) - z[j]); } }
}
__device__ __forceinline__ void store16(bf16_t* dst, const float (&f)[16]) {
    u32x4 a, b; a.x = pk2(f[0], f[1]); a.y = pk2(f[2], f[3]); a.z = pk2(f[4], f[5]); a.w = pk2(f[6], f[7]); b.x = pk2(f[8], f[9]); b.y = pk2(f[10], f[11]); b.z = pk2(f[12], f[13]); b.w = pk2(f[14], f[15]);
    *(u32x4*)dst = a; *(u32x4*)(dst + 8) = b;
}
__device__ __forceinline__ void phase_prep(int l) {
    asm volatile("" : "+s"(l)); Frame F = make_frame();
    const int tid = F.tid, lane = F.lane, w = F.wave, tok = lane & 15, cq = lane >> 4;
    const bf16_t* Z = (const bf16_t*)(F.ws + WS_Z);
    const float* mu = F.inp(IN_SHMU) + l * RWC;
    float* BON = (float*)(F.ws + WS_BONUS);
    for (int unit = F.bid; unit < 256; unit += F.G) {
        const int h = unit & 7, rng = unit >> 3;
        __syncthreads();
#pragma unroll 1
        for (int o = 0; o < 5; ++o) {
            const float* src = o < 2 ? F.inp(IN_WUP) + (size_t)(l * 2 + o) * 64 * DH : (o < 4 ? F.inp(IN_AUP) + (size_t)(l * 2 + (o - 2)) * 64 * DH : F.inp(IN_GUP) + (size_t)l * 128 * DH);
            const int K = o < 4 ? 64 : 128, stride = o < 4 ? PW_S64 : PW_S128, off = o < 4 ? o * 64 * PW_S64 : PW_G;
            for (int idx = tid; idx < K * 64; idx += 512) { const int c = idx & 63, k = idx >> 6; const int rr = 16 * ((c >> 2) & 3) + 4 * (c >> 4) + (c & 3);
                *(LAS unsigned short*)(F.lds + off + rr * stride + 2 * k) = (unsigned short)f2bf(src[(size_t)k * DH + 64 * h + c]); }
        }
#pragma unroll 1
        for (int ti = 0; ti < 9; ++ti) {
            const int row0 = rng * 1152 + ti * 128;
            const bool isctx = row0 < NCTX; const int T = isctx ? CTXL : SEQ; const int t0 = isctx ? (row0 & (CTXL - 1)) : ((row0 - NCTX) & (SEQ - 1));
            __syncthreads();
#pragma unroll 2
            for (int gi = tid; gi < 128 * 48; gi += 512) {
                const int t = gi / 48, g = gi - t * 48, ts = t0 + t;
                const bf16_t* zp = Z + (size_t)(row0 + t) * ZLD + ZC_RW + 1536 + 8 * g;
                const u32x4 zero = (u32x4){0u, 0u, 0u, 0u};
                const u32x4 zc = *(const u32x4*)zp, zm = ts > 0 ? *(const u32x4*)(zp - ZLD) : zero, zn = ts < T - 1 ? *(const u32x4*)(zp + ZLD) : zero;
                const f32x4 mA = *(const f32x4*)(mu + 1536 + 8 * g), mB = *(const f32x4*)(mu + 1536 + 8 * g + 4);
                float c8[8], m8[8], n8[8], o8[8]; unpack8(zc, c8); unpack8(zm, m8); unpack8(zn, n8);
#pragma unroll
                for (int j = 0; j < 8; ++j) { const float mm = j < 4 ? mA[j] : mB[j - 4]; const float zs = c8[j] + mm * (0.5f * (m8[j] + n8[j]) - c8[j]);
                    o8[j] = g < 16 ? tanh_fast(zs) : (g < 32 ? zs : sigmoidf_(zs)); }
                *(LAS u32x4*)(F.lds + PA_OFF + t * PA_STRIDE + 16 * g) = pack8(o8);
            }
            __syncthreads();
            const int t = 16 * w + tok, row = row0 + t, ts = t0 + t; const bool hasp = ts > 0, hasn = ts < T - 1;
            const int cb = 64 * h + 16 * cq;
            f32x4 acc[5][4];
#pragma unroll
            for (int o = 0; o < 5; ++o)
#pragma unroll
                for (int nt = 0; nt < 4; ++nt) acc[o][nt] = (f32x4){0.f, 0.f, 0.f, 0.f};
            const LAS unsigned char* actp = F.lds + PA_OFF + (16 * w + tok) * PA_STRIDE + 16 * cq;
#pragma unroll
            for (int o = 0; o < 4; ++o)
#pragma unroll
                for (int ks = 0; ks < 2; ++ks) {
                    const bf16x8 bfrag = *(const LAS bf16x8*)(actp + (64 * o + 32 * ks) * 2);
#pragma unroll
                    for (int nt = 0; nt < 4; ++nt) { const bf16x8 afrag = *(const LAS bf16x8*)(F.lds + o * 64 * PW_S64 + (16 * nt + tok) * PW_S64 + (32 * ks + 8 * cq) * 2);
                        acc[o][nt] = __builtin_amdgcn_mfma_f32_16x16x32_bf16(afrag, bfrag, acc[o][nt], 0, 0, 0); }
                }
#pragma unroll
            for (int ks = 0; ks < 4; ++ks) {
                const bf16x8 bfrag = *(const LAS bf16x8*)(actp + (256 + 32 * ks) * 2);
#pragma unroll
                for (int nt = 0; nt < 4; ++nt) { const bf16x8 afrag = *(const LAS bf16x8*)(F.lds + PW_G + (16 * nt + tok) * PW_S128 + (32 * ks + 8 * cq) * 2);
                    acc[4][nt] = __builtin_amdgcn_mfma_f32_16x16x32_bf16(afrag, bfrag, acc[4][nt], 0, 0, 0); }
            }
            float rv[16], kv[16], vv[16];
            shifted16(Z, row, hasp, hasn, 1024 + cb, mu, vv);
            const size_t so = ((size_t)h * NT + row) * 64 + 16 * cq;
            shifted16(Z, row, hasp, hasn, 512 + cb, mu, kv);
            float kkv[16]; float ss = 0.f;
#pragma unroll
            for (int q = 0; q < 4; ++q) { const f32x4 kw = *(const f32x4*)(F.inp(IN_KK) + l * DH + cb + 4 * q);
#pragma unroll
                for (int e = 0; e < 4; ++e) { const float ku = kv[4 * q + e] * kw[e]; kkv[4 * q + e] = ku; ss += ku * ku; } }
            ss += __shfl_xor(ss, 16); ss += __shfl_xor(ss, 32);
            const float rs = rsqrtf(ss + 1e-12f);
#pragma unroll
            for (int j = 0; j < 16; ++j) kkv[j] *= rs;
            store16((bf16_t*)(F.ws + WS_V) + so, vv);
            shifted16(Z, row, hasp, hasn, cb, mu, rv);
            { float gv[16];
#pragma unroll
              for (int j = 0; j < 16; ++j) gv[j] = acc[4][j >> 2][j & 3];
              store16((bf16_t*)((unsigned char*)F.out + DO_G) + so, gv); }
            float bon = 0.f;
#pragma unroll
            for (int d = 0; d < 2; ++d) {
                float* gep = (float*)(F.ws + (d ? WS_GE1 : WS_GE0)) + ((size_t)h * (NT / 16) + (row >> 4)) * 64 + 16 * cq;
#pragma unroll
                for (int qq = 0; qq < 2; ++qq) {
                    float ktv[8], btv[8], kdtv[8], rtv[8], gev[8];
#pragma unroll
                    for (int q2 = 0; q2 < 2; ++q2) {
                        const int q = 2 * qq + q2;
                        const f32x4 w0 = *(const f32x4*)(F.inp(IN_W0) + (l * 2 + d) * DH + cb + 4 * q), a0 = *(const f32x4*)(F.inp(IN_A0) + (l * 2 + d) * DH + cb + 4 * q);
                        const f32x4 ka = *(const f32x4*)(F.inp(IN_KA) + l * DH + cb + 4 * q), rk = *(const f32x4*)(F.inp(IN_RK) + l * DH + cb + 4 * q);
#pragma unroll
                        for (int e = 0; e < 4; ++e) { const int j = 4 * q + e, j8 = 4 * q2 + e;
                            const float x = -(w0[e] + acc[d][q][e]);
                            const float wl = -(fmaxf(x, 0.f) + __logf(1.0f + __expf(-fabsf(x)))) - 0.5f;
                            const float a = sigmoidf_(a0[e] + acc[2 + d][q][e]);
                            const float kd = kv[j] * (1.0f + (a - 1.0f) * ka[e]);
                            bon += rv[j] * kd * rk[e];
                            const float lw = -__expf(wl);
                            float ci = lw;
                            if (d == 0) { ci += __int_as_float(__builtin_amdgcn_update_dpp(0, __float_as_int(ci), 0x111, 0xf, 0xf, true)); ci += __int_as_float(__builtin_amdgcn_update_dpp(0, __float_as_int(ci), 0x112, 0xf, 0xf, true));
                                          ci += __int_as_float(__builtin_amdgcn_update_dpp(0, __float_as_int(ci), 0x114, 0xf, 0xf, true)); ci += __int_as_float(__builtin_amdgcn_update_dpp(0, __float_as_int(ci), 0x118, 0xf, 0xf, true)); }
                            else        { ci += __int_as_float(__builtin_amdgcn_update_dpp(0, __float_as_int(ci), 0x101, 0xf, 0xf, true)); ci += __int_as_float(__builtin_amdgcn_update_dpp(0, __float_as_int(ci), 0x102, 0xf, 0xf, true));
                                          ci += __int_as_float(__builtin_amdgcn_update_dpp(0, __float_as_int(ci), 0x104, 0xf, 0xf, true)); ci += __int_as_float(__builtin_amdgcn_update_dpp(0, __float_as_int(ci), 0x108, 0xf, 0xf, true)); }
                            const float gam = __expf(ci), gprev = __expf(ci - lw), ig = __expf(-ci);
                            ktv[j8] = gprev * kkv[j]; btv[j8] = kkv[j] * a * ig; kdtv[j8] = kd * ig; rtv[j8] = gam * rv[j]; gev[j8] = gam; }
                    }
                    *(u32x4*)((bf16_t*)(F.ws + (d ? WS_KT1 : WS_KT0)) + so + 8 * qq) = pack8(ktv); *(u32x4*)((bf16_t*)(F.ws + (d ? WS_BT1 : WS_BT0)) + so + 8 * qq) = pack8(btv);
                    *(u32x4*)((bf16_t*)(F.ws + (d ? WS_KDT1 : WS_KDT0)) + so + 8 * qq) = pack8(kdtv); *(u32x4*)((bf16_t*)(F.ws + (d ? WS_RT1 : WS_RT0)) + so + 8 * qq) = pack8(rtv);
                    if (tok == (d ? 0 : 15)) {
                        *(f32x4*)(gep + 8 * qq) = (f32x4){gev[0], gev[1], gev[2], gev[3]}; *(f32x4*)(gep + 8 * qq + 4) = (f32x4){gev[4], gev[5], gev[6], gev[7]};
                    }
                }
            }
            bon += __shfl_xor(bon, 16); bon += __shfl_xor(bon, 32);
            if (cq == 0) BON[(size_t)row * 8 + h] = bon;
        }
    }
    __syncthreads();
}

__device__ __forceinline__ int scan_row(int b, int dir, int i) {
    if (i < CTXL) return b * CTXL + (dir ? CTXL - 1 - i : i);
    const int j = i - CTXL; return NCTX + b * SEQ + (dir ? SEQ - 1 - j : j);
}
template <int CTRL> __device__ __forceinline__ float dpp_add(float x) {
    return x + __int_as_float(__builtin_amdgcn_update_dpp(0, __float_as_int(x), CTRL, 0xf, 0xf, true));
}
__device__ __forceinline__ float reduce16(float x) {
    x = dpp_add<0xB1>(x);
    x = dpp_add<0x4E>(x);
    x = dpp_add<0x141>(x);
    x = dpp_add<0x140>(x);
    return x;
}
constexpr int SC_T = 32, SC_REC = 320, SC_PBUF = SC_T * SC_REC + 128;
constexpr int SC_YOFF = 2 * SC_PBUF * 4;
typedef float f32x2v __attribute__((ext_vector_type(2)));
#define SC_PKMUL_LO(d, a, b)     asm("v_pk_mul_f32 %0, %1, %2 op_sel_hi:[1,0]" : "=v"(d) : "v"(a), "v"(b))
#define SC_PKMUL_HI(d, a, b)     asm("v_pk_mul_f32 %0, %1, %2 op_sel:[0,1] op_sel_hi:[1,1]" : "=v"(d) : "v"(a), "v"(b))
#define SC_PKFMA_LO(d, a, b, c)  asm("v_pk_fma_f32 %0, %1, %2, %3 op_sel_hi:[1,0,1]" : "=v"(d) : "v"(a), "v"(b), "v"(c))
#define SC_PKFMA_HI(d, a, b, c)  asm("v_pk_fma_f32 %0, %1, %2, %3 op_sel:[0,1,0] op_sel_hi:[1,1,1]" : "=v"(d) : "v"(a), "v"(b), "v"(c))
#define SC_PKFMAN_LO(d, a, b, c) asm("v_pk_fma_f32 %0, %1, %2, %3 op_sel_hi:[1,0,1] neg_lo:[1,0,0] neg_hi:[1,0,0]" : "=v"(d) : "v"(a), "v"(b), "v"(c))
#define SC_PKFMAN_HI(d, a, b, c) asm("v_pk_fma_f32 %0, %1, %2, %3 op_sel:[0,1,0] op_sel_hi:[1,1,1] neg_lo:[1,0,0] neg_hi:[1,0,0]" : "=v"(d) : "v"(a), "v"(b), "v"(c))
#define SC_DPP4(a, b, c, d, CTRL) asm("s_nop 1\n\tv_add_f32_dpp %0, %0, %0 " CTRL " row_mask:0xf bank_mask:0xf\n\tv_add_f32_dpp %1, %1, %1 " CTRL " row_mask:0xf bank_mask:0xf\n\t" \
        "v_add_f32_dpp %2, %2, %2 " CTRL " row_mask:0xf bank_mask:0xf\n\tv_add_f32_dpp %3, %3, %3 " CTRL " row_mask:0xf bank_mask:0xf" : "+v"(a), "+v"(b), "+v"(c), "+v"(d))
#define SC_DPP2(a, b, CTRL) asm("s_nop 1\n\tv_add_f32_dpp %0, %0, %0 " CTRL " row_mask:0xf bank_mask:0xf\n\tv_add_f32_dpp %1, %1, %1 " CTRL " row_mask:0xf bank_mask:0xf\n\ts_nop 0" : "+v"(a), "+v"(b))
template <int VAR> __device__ __forceinline__ void phase_scan(int l) {
    asm volatile("" : "+s"(l)); Frame F = make_frame();
    const int tid = F.tid, q = tid & 15, rp = tid >> 4;
    LAS float* P = (LAS float*)F.lds; LAS float* YB = (LAS float*)(F.lds + SC_YOFF);
    const bf16_t* V = (const bf16_t*)(F.ws + WS_V);
    constexpr int NCH = (CTXL + SEQ) / SC_T;
    for (int task = F.bid; task < NBATCH * 8 * 2; task += F.G) {
        const int dir = task & 1, h = (task >> 1) & 7, b = task >> 4;
        const bf16_t* KT = (const bf16_t*)(F.ws + (dir ? WS_KT1 : WS_KT0)); const bf16_t* BT = (const bf16_t*)(F.ws + (dir ? WS_BT1 : WS_BT0));
        const bf16_t* KDT = (const bf16_t*)(F.ws + (dir ? WS_KDT1 : WS_KDT0)); const bf16_t* RT = (const bf16_t*)(F.ws + (dir ? WS_RT1 : WS_RT0));
        const float* GE = (const float*)(F.ws + (dir ? WS_GE1 : WS_GE0)) + (size_t)h * (NT / 16) * 64;
        bf16_t* Y = (bf16_t*)(F.ws + (dir ? WS_Y1 : WS_Y0));
        u32x4 stg[3]; f32x4 gstg;
#define SC_LOAD(c) do { _Pragma("unroll") for (int j = 0; j < 3; ++j) { const int u = tid + 512 * j, a = u >> 8, s_ = (u >> 3) & 31, o = u & 7; \
            const bf16_t* src = a == 0 ? KT : a == 1 ? BT : a == 2 ? KDT : a == 3 ? RT : V; \
            if (u < 1280) stg[j] = *(const u32x4*)(src + ((size_t)h * NT + scan_row(b, dir, (c) * SC_T + s_)) * 64 + 8 * o); } \
            if (tid < 32) gstg = *(const f32x4*)(GE + (size_t)(scan_row(b, dir, (c) * SC_T + 16 * (tid >> 4)) >> 4) * 64 + 4 * (tid & 15)); } while (0)
#define SC_STORE(c) do { _Pragma("unroll") for (int j = 0; j < 3; ++j) { const int u = tid + 512 * j, a = u >> 8, s_ = (u >> 3) & 31, o = u & 7; \
            if (u < 1280) { float f[8]; _Pragma("unroll") for (int e = 0; e < 4; ++e) { f[2 * e] = bf2f(stg[j][e] & 0xffffu); f[2 * e + 1] = bf2f(stg[j][e] >> 16); } \
            LAS float* dst = P + ((c) & 1) * SC_PBUF + s_ * SC_REC + a * 64 + 8 * o; \
            *(LAS f32x4*)dst = (f32x4){f[0], f[1], f[2], f[3]}; *(LAS f32x4*)(dst + 4) = (f32x4){f[4], f[5], f[6], f[7]}; } } \
            if (tid < 32) *(LAS f32x4*)(P + ((c) & 1) * SC_PBUF + SC_T * SC_REC + 4 * tid) = gstg; } while (0)
        f32x2v S[4];
#pragma unroll
        for (int e = 0; e < 4; ++e) S[e] = (f32x2v){0.f, 0.f};
        __syncthreads();
        SC_LOAD(0); SC_STORE(0);
        __syncthreads();
        for (int c = 0; c < NCH; ++c) {
            if (c + 1 < NCH) SC_LOAD(c + 1);
            if (c > 0) {
                const int s_ = tid >> 4, r4 = (tid & 15) * 4;
                const f32x4 yv = *(const LAS f32x4*)(YB + ((c - 1) & 1) * (SC_T * 64) + s_ * 64 + r4);
                u32x2 wv; wv.x = pk2(yv[0], yv[1]); wv.y = pk2(yv[2], yv[3]);
                if (VAR == 0) *(u32x2*)(Y + (size_t)scan_row(b, dir, (c - 1) * SC_T + s_) * DH + 64 * h + r4) = wv;
            }
            const LAS float* pb = P + (c & 1) * SC_PBUF + 4 * q;
            LAS float* yb = YB + (c & 1) * (SC_T * 64) + 2 * rp;
#pragma unroll
            for (int hb = 0; hb < 2; ++hb) {
                const LAS float* ph = pb + hb * 16 * SC_REC;
                f32x4 kt = *(const LAS f32x4*)(ph), bt = *(const LAS f32x4*)(ph + 64), kdt = *(const LAS f32x4*)(ph + 128), rt = *(const LAS f32x4*)(ph + 192);
                f32x2v vv = *(const LAS f32x2v*)(ph + 256 - 4 * q + 2 * rp);
                float y0 = 0.f, y1 = 0.f;
#pragma unroll
                for (int s_ = 0; s_ < 16; ++s_) {
                    const LAS float* pn = ph + (s_ + 1 < 16 ? s_ + 1 : s_) * SC_REC;
                    const f32x4 ktn = *(const LAS f32x4*)(pn), btn = *(const LAS f32x4*)(pn + 64), kdtn = *(const LAS f32x4*)(pn + 128), rtn = *(const LAS f32x4*)(pn + 192);
                    const f32x2v vvn = *(const LAS f32x2v*)(pn + 256 - 4 * q + 2 * rp);
                    const f32x2v kt01 = (f32x2v){kt[0], kt[1]}, kt23 = (f32x2v){kt[2], kt[3]}, bt01 = (f32x2v){bt[0], bt[1]}, bt23 = (f32x2v){bt[2], bt[3]};
                    const f32x2v kd01 = (f32x2v){kdt[0], kdt[1]}, kd23 = (f32x2v){kdt[2], kdt[3]}, rt01 = (f32x2v){rt[0], rt[1]}, rt23 = (f32x2v){rt[2], rt[3]};
                    f32x2v sa;
                    SC_PKMUL_LO(sa, S[0], kt01); SC_PKFMA_HI(sa, S[1], kt01, sa); SC_PKFMA_LO(sa, S[2], kt23, sa); SC_PKFMA_HI(sa, S[3], kt23, sa);
                    float sa0 = sa.x, sa1 = sa.y;
                    if (VAR != 2) {
                    SC_DPP4(sa0, sa1, y0, y1, "quad_perm:[1,0,3,2]");
                    SC_DPP4(sa0, sa1, y0, y1, "quad_perm:[2,3,0,1]");
                    SC_DPP4(sa0, sa1, y0, y1, "row_half_mirror");
                    SC_DPP4(sa0, sa1, y0, y1, "row_mirror"); }
                    if (s_ > 0 && q == 0) { yb[(hb * 16 + s_ - 1) * 64] = y0; yb[(hb * 16 + s_ - 1) * 64 + 1] = y1; }
                    sa = (f32x2v){sa0, sa1};
                    f32x2v yy;
                    if (VAR != 3) {
                    SC_PKFMA_LO(S[0], vv, kd01, S[0]); SC_PKFMA_HI(S[1], vv, kd01, S[1]); SC_PKFMA_LO(S[2], vv, kd23, S[2]); SC_PKFMA_HI(S[3], vv, kd23, S[3]);
                    SC_PKFMAN_LO(S[0], sa, bt01, S[0]); SC_PKFMAN_HI(S[1], sa, bt01, S[1]); SC_PKFMAN_LO(S[2], sa, bt23, S[2]); SC_PKFMAN_HI(S[3], sa, bt23, S[3]);
                    SC_PKMUL_LO(yy, S[0], rt01); SC_PKFMA_HI(yy, S[1], rt01, yy); SC_PKFMA_LO(yy, S[2], rt23, yy); SC_PKFMA_HI(yy, S[3], rt23, yy);
                    } else { SC_PKFMAN_LO(S[0], sa, bt01, S[0]); SC_PKMUL_LO(yy, S[0], rt01); }
                    y0 = yy.x; y1 = yy.y;
                    kt = ktn; bt = btn; kdt = kdtn; rt = rtn; vv = vvn;
                }
                SC_DPP2(y0, y1, "quad_perm:[1,0,3,2]"); SC_DPP2(y0, y1, "quad_perm:[2,3,0,1]"); SC_DPP2(y0, y1, "row_half_mirror"); SC_DPP2(y0, y1, "row_mirror");
                if (q == 0) { yb[(hb * 16 + 15) * 64] = y0; yb[(hb * 16 + 15) * 64 + 1] = y1; }
                const f32x4 ge = *(const LAS f32x4*)(pb + SC_T * SC_REC + hb * 64);
#pragma unroll
                for (int e = 0; e < 4; ++e) S[e] *= ge[e];
            }
            if (c + 1 < NCH) SC_STORE(c + 1);
            __syncthreads();
        }
        {
            const int s_ = tid >> 4, r4 = (tid & 15) * 4;
            const f32x4 yv = *(const LAS f32x4*)(YB + ((NCH - 1) & 1) * (SC_T * 64) + s_ * 64 + r4);
            u32x2 wv; wv.x = pk2(yv[0], yv[1]); wv.y = pk2(yv[2], yv[3]);
            if (VAR == 0) *(u32x2*)(Y + (size_t)scan_row(b, dir, (NCH - 1) * SC_T + s_) * DH + 64 * h + r4) = wv;
        }
#undef SC_LOAD
#undef SC_STORE
    }
    __syncthreads();
}

typedef short bf16x4 __attribute__((ext_vector_type(4)));
__device__ __forceinline__ bf16x4 cvt4(const f32x4 v) { u32x2 r; r.x = pk2(v[0], v[1]); r.y = pk2(v[2], v[3]); return __builtin_bit_cast(bf16x4, r); }
__device__ __forceinline__ f32x4 unpk4(const bf16x4 p) { const u32x2 r = __builtin_bit_cast(u32x2, p); return (f32x4){bf2f(r.x & 0xffffu), bf2f(r.x >> 16), bf2f(r.y & 0xffffu), bf2f(r.y >> 16)}; }
#define MFMA16(a, b, c) __builtin_amdgcn_mfma_f32_16x16x16bf16_1k(a, b, c, 0, 0, 0)
constexpr int CS_RS = 144, CS_ARR = 32 * CS_RS;
constexpr int CS_TS = 40, CS_TBLK = 64 * CS_TS;
constexpr int CS_KDTT = 4 * CS_ARR, CS_BTT = CS_KDTT + 2 * CS_TBLK, CS_VT = CS_BTT + 2 * CS_TBLK, CS_GE = CS_VT + 2 * CS_TBLK, CS_PB = CS_GE + 512;
constexpr int CS_GB0 = 3 * CS_PB;
constexpr int CS_GS = 40, CS_GMAT = 16 * CS_GS, CS_ABT = 4 * CS_GMAT, CS_GBLK = 3840, CS_GB = 2 * CS_GBLK;
constexpr int CS_YB = CS_GB0 + 2 * CS_GB;
static_assert(CS_YB + 2 * 8192 <= LDS_CTL, "chunked scan LDS map");
template <int SDBG> __device__ __forceinline__ void phase_scan_mfma(int l) {
    asm volatile("" : "+s"(l)); Frame F = make_frame();
    const int tid = F.tid, lane = F.lane, wave = F.wave, c16 = lane & 15, g4 = lane >> 4, htid = tid - 256;
    const bool is_state = wave < 4;
    LAS unsigned char* lds = F.lds; LAS float* YB = (LAS float*)(F.lds + CS_YB);
    constexpr int NCH = (CTXL + SEQ) / 32;
    for (int task = F.bid; task < NBATCH * 8 * 2; task += F.G) {
        const int dir = task & 1, h = (task >> 1) & 7, b = task >> 4;
        const unsigned char* wsb = F.ws;
        const unsigned oKT = (unsigned)(dir ? WS_KT1 : WS_KT0), oBT = (unsigned)(dir ? WS_BT1 : WS_BT0), oKDT = (unsigned)(dir ? WS_KDT1 : WS_KDT0), oRT = (unsigned)(dir ? WS_RT1 : WS_RT0);
        const unsigned oGE = (unsigned)(dir ? WS_GE1 : WS_GE0) + (unsigned)h * (NT / 16) * 256u, oY = (unsigned)(dir ? WS_Y1 : WS_Y0);
        u32x4 stg[3][5]; f32x4 gstg[3];
#define CS_LOAD(cc, rs) do { _Pragma("unroll") for (int jj = 0; jj < 5; ++jj) { const int a = jj, s_ = (htid >> 3) & 31, o = htid & 7; \
            const unsigned ao = a == 0 ? oKT : a == 1 ? oRT : a == 2 ? oKDT : a == 3 ? oBT : (unsigned)WS_V; \
            stg[rs][jj] = *(const u32x4*)(wsb + (ao + ((unsigned)(h * NT + scan_row(b, dir, (cc) * 32 + s_)) * 128u + 16u * o))); } \
            gstg[rs] = *(const f32x4*)(wsb + (oGE + (unsigned)(scan_row(b, dir, (cc) * 32 + 16 * ((htid >> 4) & 1)) >> 4) * 256u + 16u * (htid & 15))); } while (0)
#define CS_STORE(pbi, rs) do { LAS unsigned char* pbs = lds + (pbi) * CS_PB; _Pragma("unroll") for (int jj = 0; jj < 5; ++jj) { const int a = jj, s_ = (htid >> 3) & 31, o = htid & 7; \
            if (a < 4) *(LAS u32x4*)(pbs + a * CS_ARR + s_ * CS_RS + 16 * o) = stg[rs][jj]; \
            if (a >= 2) { LAS unsigned char* tb = pbs + (a == 2 ? CS_KDTT : (a == 3 ? CS_BTT : CS_VT)) + (s_ >> 4) * CS_TBLK + (8 * o) * CS_TS + 2 * (s_ & 15); \
                _Pragma("unroll") for (int e = 0; e < 4; ++e) { *(LAS unsigned short*)(tb + (2 * e) * CS_TS) = (unsigned short)(stg[rs][jj][e] & 0xffffu); *(LAS unsigned short*)(tb + (2 * e + 1) * CS_TS) = (unsigned short)(stg[rs][jj][e] >> 16); } } } \
            *(LAS f32x4*)(pbs + CS_GE + ((htid >> 4) & 1) * 256 + 16 * (htid & 15)) = gstg[rs]; } while (0)
#define CS_GRAM(pbi, gbi, bq) do { const LAS unsigned char* pbg = lds + (pbi) * CS_PB; LAS unsigned char* gb = lds + CS_GB0 + (gbi) * CS_GB + (bq) * CS_GBLK; \
            const int rowoff = (16 * (bq) + c16) * CS_RS + 16 * g4; \
            _Pragma("unroll") for (int mat = 0; mat < 4; ++mat) { f32x4 acc = (f32x4){0.f, 0.f, 0.f, 0.f}; \
                _Pragma("unroll") for (int ks = 0; ks < 2; ++ks) { const bf16x8 av = *(const LAS bf16x8*)(pbg + (mat < 2 ? 0 : 1) * CS_ARR + rowoff + 64 * ks); \
                    const bf16x8 bv = *(const LAS bf16x8*)(pbg + ((mat & 1) ? 3 : 2) * CS_ARR + rowoff + 64 * ks); acc = __builtin_amdgcn_mfma_f32_16x16x32_bf16(av, bv, acc, 0, 0, 0); } \
                _Pragma("unroll") for (int rg = 0; rg < 4; ++rg) { const int t = 4 * g4 + rg; const bool keep = mat < 2 ? (c16 < t) : (c16 <= t); const float val = keep ? acc[rg] : 0.f; \
                    if (mat == 1) *(LAS float*)(gb + CS_ABT + (t * 17 + c16) * 4) = val; \
                    else *(LAS unsigned short*)(gb + (mat == 0 ? 0 : (mat == 2 ? 1 : 2)) * CS_GMAT + t * CS_GS + 2 * c16) = (unsigned short)f2bf(val); } } \
            { float colv[16]; const LAS float* abt = (const LAS float*)(gb + CS_ABT); \
              _Pragma("unroll") for (int t = 0; t < 16; ++t) { float a_ = (t == c16) ? 1.f : 0.f; _Pragma("unroll") for (int s2 = 0; s2 < t; ++s2) a_ = fmaf(-abt[t * 17 + s2], colv[s2], a_); colv[t] = a_; } \
              if (lane < 16) { _Pragma("unroll") for (int t = 0; t < 16; ++t) *(LAS unsigned short*)(gb + 3 * CS_GMAT + t * CS_GS + 2 * c16) = (unsigned short)f2bf(colv[t]); } } } while (0)
#define CS_FLUSH(cc) do { const int s_ = htid >> 3, r8 = 8 * (htid & 7); const LAS float* yp = YB + ((cc) & 1) * 2048 + s_ * 64 + r8; \
            f32x4 ya = *(const LAS f32x4*)yp, yb2 = *(const LAS f32x4*)(yp + 4); if (SDBG & 8) { _Pragma("unroll") for (int e = 0; e < 4; ++e) { if (!(fabsf(ya[e]) < 1e30f)) ya[e] = 0.f; if (!(fabsf(yb2[e]) < 1e30f)) yb2[e] = 0.f; } } u32x4 wv; wv.x = pk2(ya[0], ya[1]); wv.y = pk2(ya[2], ya[3]); wv.z = pk2(yb2[0], yb2[1]); wv.w = pk2(yb2[2], yb2[3]); \
            *(u32x4*)(const_cast<unsigned char*>(wsb) + (oY + (unsigned)scan_row(b, dir, (cc) * 32 + s_) * 1024u + 128u * h + 2u * r8)) = wv; } while (0)
#define CS_STATE(c, P0) do { \
                const int m = wave; \
_Pragma("unroll") \
                for (int blk = 0; blk < 2; ++blk) { \
                    const LAS unsigned char* pb = lds + (P0) * CS_PB; const LAS unsigned char* gb = lds + CS_GB0 + ((c) & 1) * CS_GB + blk * CS_GBLK; \
                    const LAS unsigned char* rowb = pb + (16 * blk + c16) * CS_RS + 8 * g4; \
                    bf16x4 hi[4], lo[4]; \
_Pragma("unroll") \
                    for (int j = 0; j < 4; ++j) { hi[j] = cvt4(H[j]); lo[j] = cvt4(H[j] - unpk4(hi[j])); } \
                    f32x4 wt = (f32x4){0.f, 0.f, 0.f, 0.f}, yt = (f32x4){0.f, 0.f, 0.f, 0.f}; \
_Pragma("unroll") \
                    for (int j = 0; j < 4; ++j) { const bf16x4 ak = *(const LAS bf16x4*)(rowb + 32 * j), ar = *(const LAS bf16x4*)(rowb + CS_ARR + 32 * j); \
                        wt = MFMA16(ak, hi[j], wt); wt = MFMA16(ak, lo[j], wt); yt = MFMA16(ar, hi[j], yt); yt = MFMA16(ar, lo[j], yt); } \
                    const bf16x4 vt = *(const LAS bf16x4*)(pb + CS_VT + blk * CS_TBLK + (16 * m + c16) * CS_TS + 8 * g4); \
                    wt = MFMA16(*(const LAS bf16x4*)(gb + c16 * CS_GS + 8 * g4), vt, wt); \
                    const f32x4 ut = MFMA16(*(const LAS bf16x4*)(gb + 3 * CS_GMAT + c16 * CS_GS + 8 * g4), cvt4(wt), ((f32x4){0.f, 0.f, 0.f, 0.f})); \
                    const bf16x4 utn = cvt4(-ut); \
                    yt = MFMA16(*(const LAS bf16x4*)(gb + CS_GMAT + c16 * CS_GS + 8 * g4), vt, yt); \
                    yt = MFMA16(*(const LAS bf16x4*)(gb + 2 * CS_GMAT + c16 * CS_GS + 8 * g4), utn, yt); \
_Pragma("unroll") \
                    for (int rg = 0; rg < 4; ++rg) YB[((c) & 1) * 2048 + (16 * blk + 4 * g4 + rg) * 64 + 16 * m + c16] = yt[rg]; \
_Pragma("unroll") \
                    for (int j = 0; j < 4; ++j) { \
                        const bf16x4 a1 = *(const LAS bf16x4*)(pb + CS_KDTT + blk * CS_TBLK + (16 * j + c16) * CS_TS + 8 * g4), a2 = *(const LAS bf16x4*)(pb + CS_BTT + blk * CS_TBLK + (16 * j + c16) * CS_TS + 8 * g4); \
                        H[j] = MFMA16(a1, vt, H[j]); H[j] = MFMA16(a2, utn, H[j]); \
                        const f32x4 ge = *(const LAS f32x4*)(pb + CS_GE + blk * 256 + (16 * j + 4 * g4) * 4); \
                        H[j] = H[j] * ge; \
                    } \
                } \
            } while (0)
        f32x4 H[4];
#pragma unroll
        for (int j = 0; j < 4; ++j) H[j] = (f32x4){0.f, 0.f, 0.f, 0.f};
        __syncthreads();
        if (!is_state) { CS_LOAD(0, 0); CS_LOAD(1, 1); CS_STORE(0, 0); CS_STORE(1, 1); CS_LOAD(2, 2); CS_LOAD(3, 0); CS_LOAD(4, 1); }
        __syncthreads();
        if (!is_state) { if (!(SDBG & 2)) { if (wave < 6) CS_GRAM(0, 0, wave - 4); } }
        __syncthreads();
#define CS_ITER(c, P0, P1, P2) do { \
            if (is_state) { if (!(SDBG & 1)) { CS_STATE(c, P0); } } \
            else { CS_STORE(P2, P2); CS_LOAD(((c) + 5 < NCH ? (c) + 5 : NCH - 1), P2); \
                   if (!(SDBG & 2)) { if ((c) + 1 < NCH && wave < 6) CS_GRAM(P1, ((c) + 1) & 1, wave - 4); } \
                   if (!(SDBG & 4)) { CS_FLUSH(((c) > 0 ? (c) - 1 : 0)); } } \
            asm volatile("s_waitcnt lgkmcnt(0)" ::: "memory"); __builtin_amdgcn_s_barrier(); asm volatile("" ::: "memory"); } while (0)
        for (int c3 = 0; c3 < NCH; c3 += 3) { CS_ITER(c3, 0, 1, 2); CS_ITER(c3 + 1, 1, 2, 0); CS_ITER(c3 + 2, 2, 0, 1); }
#undef CS_ITER
        if (!(SDBG & 4)) { if (!is_state) CS_FLUSH(NCH - 1); }
#undef CS_LOAD
#undef CS_STATE
#undef CS_STORE
#undef CS_GRAM
#undef CS_FLUSH
    }
    __syncthreads();
}

__device__ __forceinline__ void phase_mix(int l) {
    asm volatile("" : "+s"(l)); Frame F = make_frame();
    const int lane = F.lane, c0 = 8 * lane, hh = lane >> 3;
    const int gw = F.bid * 8 + F.wave, NGW = F.G * 8;
    const bf16_t* Z = (const bf16_t*)(F.ws + WS_Z);
    const float* cw = F.inp(IN_CONVW) + (size_t)l * 3 * DH;
    float cw0[8], cw1[8], cw2[8], lgv[8], lbv[8];
#pragma unroll
    for (int j = 0; j < 8; ++j) { cw0[j] = cw[c0 + j]; cw1[j] = cw[DH + c0 + j]; cw2[j] = cw[2 * DH + c0 + j]; lgv[j] = F.inp(IN_LNG)[l * DH + c0 + j]; lbv[j] = F.inp(IN_LNB)[l * DH + c0 + j]; }
    const bf16_t* Y0 = (const bf16_t*)(F.ws + WS_Y0); const bf16_t* Y1 = (const bf16_t*)(F.ws + WS_Y1); const bf16_t* V = (const bf16_t*)(F.ws + WS_V);
    const bf16_t* Gi = (const bf16_t*)((unsigned char*)F.out + DO_G); const float* BON = (const float*)(F.ws + WS_BONUS);
    bf16_t* UA = (bf16_t*)(F.ws + WS_UA); bf16_t* UB = (bf16_t*)(F.ws + WS_UB);
    for (int row = gw; row < NT; row += NGW) {
        int delta; bool hasp, hasn;
        if (row < NCTX) { const int t = row & (CTXL - 1); delta = 1; hasp = t > 0; hasn = t < CTXL - 1; }
        else { const int sq = (row - NCTX) & (SEQ - 1);
            if (c0 < 256) { const int gc = sq & 63; delta = 1; hasp = gc > 0; hasn = gc < 63; }
            else { const int gr = sq >> 6; delta = 64; hasp = gr > 0; hasn = gr < 31; } }
        const bf16_t* zr = Z + (size_t)row * ZLD;
        const u32x4 zero = (u32x4){0u, 0u, 0u, 0u};
        const u32x4 bg = *(const u32x4*)(zr + ZC_BG + c0), cg = *(const u32x4*)(zr + ZC_CG + c0), ha = *(const u32x4*)(zr + ZC_HA + c0);
        const u32x4 cgm = hasp ? *(const u32x4*)(zr + ZC_CG + c0 - (ptrdiff_t)delta * ZLD) : zero, ham = hasp ? *(const u32x4*)(zr + ZC_HA + c0 - (ptrdiff_t)delta * ZLD) : zero;
        const u32x4 cgp = hasn ? *(const u32x4*)(zr + ZC_CG + c0 + (ptrdiff_t)delta * ZLD) : zero, hap = hasn ? *(const u32x4*)(zr + ZC_HA + c0 + (ptrdiff_t)delta * ZLD) : zero;
        const size_t o = (size_t)row * DH + c0, oh = ((size_t)hh * NT + row) * 64 + (c0 & 63);
        const u32x4 y0p = *(const u32x4*)(Y0 + o), y1p = *(const u32x4*)(Y1 + o), vp = *(const u32x4*)(V + oh), gp = *(const u32x4*)(Gi + oh);
        const float bon = BON[(size_t)row * 8 + hh];
        float fb[8], fc[8], fh[8], fcm[8], fhm[8], fcp[8], fhp[8], ua[8];
        unpack8(bg, fb); unpack8(cg, fc); unpack8(ha, fh); unpack8(cgm, fcm); unpack8(ham, fhm); unpack8(cgp, fcp); unpack8(hap, fhp);
#pragma unroll
        for (int j = 0; j < 8; ++j) ua[j] = fb[j] * (fcm[j] * fhm[j] * cw0[j] + fc[j] * fh[j] * cw1[j] + fcp[j] * fhp[j] * cw2[j]);
        *(u32x4*)(UA + o) = pack8(ua);
        float ya[8], yb[8], fv[8], fg[8], ub[8]; unpack8(y0p, ya); unpack8(y1p, yb); unpack8(vp, fv); unpack8(gp, fg);
        float sm = 0.f;
#pragma unroll
        for (int j = 0; j < 8; ++j) { ya[j] += yb[j]; sm += ya[j]; }
        sm = dpp_add<0xB1>(sm); sm = dpp_add<0x4E>(sm); sm = dpp_add<0x141>(sm);
        const float mu = sm * (1.0f / 64.0f); float sq2 = 0.f;
#pragma unroll
        for (int j = 0; j < 8; ++j) { ya[j] -= mu; sq2 += ya[j] * ya[j]; }
        sq2 = dpp_add<0xB1>(sq2); sq2 = dpp_add<0x4E>(sq2); sq2 = dpp_add<0x141>(sq2);
        const float rstd = rsqrtf(sq2 * (1.0f / 64.0f) + GN_EPS);
#pragma unroll
        for (int j = 0; j < 8; ++j) ub[j] = (ya[j] * rstd * lgv[j] + lbv[j] + bon * fv[j]) * fg[j];
        *(u32x4*)(UB + o) = pack8(ub);
    }
}

constexpr int N2_STRIDE = 1028;
constexpr int N2_PART = 16 * N2_STRIDE * 4;
constexpr int N2_HIST = N2_PART + 8 * 16 * 48 * 4;
__device__ __forceinline__ void phase_norm2(int l) {
    asm volatile("" : "+s"(l)); Frame F = make_frame();
    const int lane = F.lane, w = F.wave;
    LAS float* HT = (LAS float*)F.lds; LAS float* PART = (LAS float*)(F.lds + N2_PART); LAS int* hist = (LAS int*)(F.lds + N2_HIST);
    const float* X = (const float*)(F.ws + WS_X); bf16_t* H = (bf16_t*)((unsigned char*)F.out + DO_H);
    const float* g2n = F.inp(IN_N2G) + l * D;
    const float* WC = (const float*)(F.ws + WS_WC) + (size_t)l * 1024 * 48; const float* RB = (const float*)(F.ws + WS_RB) + l * 48;
    int* RE = (int*)(F.ws + WS_RE); float* RG = (float*)(F.ws + WS_RG); int* RP = (int*)(F.ws + WS_RP);
    if (F.tid < 32) hist[F.tid] = 0;
    float Bv[32][3];
    { const int kg = lane >> 4, cc = lane & 15;
#pragma unroll
      for (int s_ = 0; s_ < 32; ++s_)
#pragma unroll
          for (int t = 0; t < 3; ++t) Bv[s_][t] = WC[(size_t)(256 * kg + 32 * w + s_) * 48 + 16 * t + cc]; }
    __syncthreads();
    for (int tile = F.bid; tile < NT / 16; tile += F.G) {
        const int row0 = tile * 16;
#pragma unroll
        for (int rr = 0; rr < 2; ++rr) {
            const int lr = 2 * w + rr, row = row0 + lr;
            const int mj = row < NCTX ? 16 : ((row - NCTX) >> 11);
            const float* mod = (const float*)(F.ws + WS_MOD) + ((size_t)l * 17 + mj) * NMOD;
            f32x4 v[4]; float ss = 0.f;
#pragma unroll
            for (int j = 0; j < 4; ++j) { v[j] = *(const f32x4*)(X + (size_t)row * D + 4 * lane + 256 * j); ss += v[j][0] * v[j][0] + v[j][1] * v[j][1] + v[j][2] * v[j][2] + v[j][3] * v[j][3]; }
            const float rs = rsqrtf(wave_sum(ss) * (1.0f / D) + NORM_EPS);
#pragma unroll
            for (int j = 0; j < 4; ++j) {
                const int c = 4 * lane + 256 * j;
                const f32x4 gg = *(const f32x4*)(g2n + c), sh = *(const f32x4*)(mod + 3072 + c), sc = *(const f32x4*)(mod + 4096 + c);
                f32x4 o;
#pragma unroll
                for (int q = 0; q < 4; ++q) o[q] = v[j][q] * rs * gg[q] * (1.0f + sc[q]) + sh[q];
                u32x2 wv; wv.x = pk2(o[0], o[1]); wv.y = pk2(o[2], o[3]);
                *(u32x2*)(H + (size_t)row * D + c) = wv;
                *(LAS f32x4*)(HT + lr * N2_STRIDE + c) = o;
            }
        }
        __syncthreads();
        {
            f32x4 acc[3];
#pragma unroll
            for (int t = 0; t < 3; ++t) acc[t] = (f32x4){0.f, 0.f, 0.f, 0.f};
            const LAS float* ap = HT + (lane & 15) * N2_STRIDE + 256 * (lane >> 4) + 32 * w;
#pragma unroll
            for (int i = 0; i < 8; ++i) {
                const f32x4 a4 = *(const LAS f32x4*)(ap + 4 * i);
#pragma unroll
                for (int e = 0; e < 4; ++e)
#pragma unroll
                    for (int t = 0; t < 3; ++t) acc[t] = __builtin_amdgcn_mfma_f32_16x16x4f32(a4[e], Bv[4 * i + e][t], acc[t], 0, 0, 0);
            }
#pragma unroll
            for (int t = 0; t < 3; ++t)
#pragma unroll
                for (int rg = 0; rg < 4; ++rg) PART[(w * 16 + (lane >> 4) * 4 + rg) * 48 + 16 * t + (lane & 15)] = acc[t][rg];
        }
        __syncthreads();
        if (F.tid < 16) {
            const int r = F.tid, row = row0 + r;
            float lgv[4];
#pragma unroll
            for (int g = 0; g < 4; ++g) { float a = RB[32 + g];
#pragma unroll
                for (int ww = 0; ww < 8; ++ww) a += PART[(ww * 16 + r) * 48 + 32 + g];
                lgv[g] = a; }
            int gs = 0; float lmax = lgv[0];
#pragma unroll
            for (int g = 1; g < 4; ++g) if (lgv[g] > lmax) { lmax = lgv[g]; gs = g; }
            float den = 0.f;
#pragma unroll
            for (int g = 0; g < 4; ++g) den += __expf(lgv[g] - lmax);
            const float pgmax = 1.0f / den;
            float le[8];
#pragma unroll
            for (int e = 0; e < 8; ++e) { float a = RB[gs * 8 + e];
#pragma unroll
                for (int ww = 0; ww < 8; ++ww) a += PART[(ww * 16 + r) * 48 + gs * 8 + e];
                le[e] = a; }
            int i1 = 0; float m1 = le[0];
#pragma unroll
            for (int e = 1; e < 8; ++e) if (le[e] > m1) { m1 = le[e]; i1 = e; }
            int i2 = i1 == 0 ? 1 : 0; float m2 = le[i1 == 0 ? 1 : 0];
#pragma unroll
            for (int e = 0; e < 8; ++e) if (e != i1 && le[e] > m2) { m2 = le[e]; i2 = e; }
            const float dd = __expf(m2 - m1);
            const float gate1 = pgmax / (1.0f + dd), gate2 = pgmax * dd / (1.0f + dd);
            const int e1 = gs * 8 + i1, e2 = gs * 8 + i2;
            const int p1 = __hip_atomic_fetch_add(hist + e1, 1, __ATOMIC_RELAXED, __HIP_MEMORY_SCOPE_WORKGROUP), p2 = __hip_atomic_fetch_add(hist + e2, 1, __ATOMIC_RELAXED, __HIP_MEMORY_SCOPE_WORKGROUP);
            RE[2 * row] = e1; RE[2 * row + 1] = e2; RG[2 * row] = gate1; RG[2 * row + 1] = gate2; RP[2 * row] = p1; RP[2 * row + 1] = p2;
        }
    }
    __syncthreads();
    if (F.tid < 32) ((int*)(F.ws + WS_BH))[F.bid * 32 + F.tid] = hist[F.tid];
    __syncthreads();
}

__device__ __forceinline__ void moe_tables(Frame& F, int l) {
    LAS int* seg = (LAS int*)(F.lds + LC_SEG); LAS int* cnts = (LAS int*)(F.lds + LC_CNTS); LAS int* tile_e = (LAS int*)(F.lds + LC_TILEE);
    LAS int* red = (LAS int*)(F.lds + LC_RED);
    LAS int* bbase = (LAS int*)(F.lds + LC_BBASE);
    const int* BH = (const int*)(F.ws + WS_BH);
    __syncthreads();
    { const int e = F.tid & 31, part = F.tid >> 5; int tot = 0, pre = 0;
      for (int bq = part; bq < F.G; bq += 16) { const int v = BH[bq * 32 + e]; tot += v; if (bq < F.bid) pre += v; }
      red[part * 32 + e] = tot; red[512 + part * 32 + e] = pre; }
    __syncthreads();
    if (F.tid < 32) { int tot = 0, pre = 0;
#pragma unroll 1
        for (int p = 0; p < 16; ++p) { tot += red[p * 32 + F.tid]; pre += red[512 + p * 32 + F.tid]; }
        cnts[F.tid] = tot; bbase[F.tid] = pre; }
    __syncthreads();
    if (F.tid == 0) {
        int s = 0;
#pragma unroll 1
        for (int e = 0; e < NE; ++e) { const int c = cnts[e]; seg[e] = s; const int nt = (c + 255) >> 8;
#pragma unroll 1
            for (int t = 0; t < nt; ++t) tile_e[(s >> 8) + t] = e;
            s += nt << 8; }
        seg[32] = s; seg[33] = s >> 8;
    }
    __syncthreads();
}
__device__ __forceinline__ void phase_dispatch(int l) {
    asm volatile("" : "+s"(l)); Frame F = make_frame();
    moe_tables(F, l);
    const LAS int* seg = (const LAS int*)(F.lds + LC_SEG); const LAS int* cnts = (const LAS int*)(F.lds + LC_CNTS); const LAS int* bbase = (const LAS int*)(F.lds + LC_BBASE);
    const int gw = F.bid * 8 + F.wave, NGW = F.G * 8;
    const int* RE = (const int*)(F.ws + WS_RE); const int* RP = (const int*)(F.ws + WS_RP); int* RS = (int*)(F.ws + WS_RS);
    const bf16_t* H = (const bf16_t*)((unsigned char*)F.out + DO_H); bf16_t* XS = (bf16_t*)(F.ws + WS_XS);
    for (int tile = F.bid; tile < NT / 16; tile += F.G) {
        const int item0 = (tile * 16 + 2 * F.wave) * 2;
        int slot[4]; u32x4 d0[2], d1[2];
#pragma unroll
        for (int q = 0; q < 4; ++q) { const int e = RE[item0 + q], pos = RP[item0 + q]; slot[q] = seg[e] + bbase[e] + pos; }
#pragma unroll
        for (int r = 0; r < 2; ++r) { const u32x4* src = (const u32x4*)(H + (size_t)((item0 >> 1) + r) * D); d0[r] = src[F.lane]; d1[r] = src[64 + F.lane]; }
        if (F.lane < 4) { int sl = slot[0]; sl = F.lane == 1 ? slot[1] : sl; sl = F.lane == 2 ? slot[2] : sl; sl = F.lane == 3 ? slot[3] : sl; RS[item0 + F.lane] = sl; }
#pragma unroll
        for (int q = 0; q < 4; ++q) { u32x4* dst = (u32x4*)(XS + (size_t)slot[q] * D); dst[F.lane] = d0[q >> 1]; dst[64 + F.lane] = d1[q >> 1]; }
    }
#pragma unroll 1
    for (int e = 0; e < NE; ++e) {
        const int c = cnts[e], padded = (c + 255) & ~255;
        for (int p = c + gw; p < padded; p += NGW) { u32x4* dst = (u32x4*)(XS + (size_t)(seg[e] + p) * D); dst[F.lane] = (u32x4){0u, 0u, 0u, 0u}; dst[64 + F.lane] = (u32x4){0u, 0u, 0u, 0u}; }
    }
}

__device__ __forceinline__ void phase_final() {
    Frame F = make_frame();
    const int gw = F.bid * 8 + F.wave, NGW = F.G * 8;
    const float* X = (const float*)(F.ws + WS_X); const float* fg = F.inp(IN_FG);
    for (int r = gw; r < NLAT; r += NGW) {
        const float* xr = X + (size_t)(NCTX + r) * D;
        f32x4 v[4]; float ss = 0.f;
#pragma unroll
        for (int j = 0; j < 4; ++j) v[j] = *(const f32x4*)(xr + 4 * F.lane + 256 * j);
        combine_row(F, DEPTH - 1, NCTX + r, v);
#pragma unroll
        for (int j = 0; j < 4; ++j) ss += v[j][0] * v[j][0] + v[j][1] * v[j][1] + v[j][2] * v[j][2] + v[j][3] * v[j][3];
        const float rs = rsqrtf(wave_sum(ss) * (1.0f / D) + NORM_EPS);
#pragma unroll
        for (int j = 0; j < 4; ++j) { const int c = 4 * F.lane + 256 * j; const f32x4 gg = *(const f32x4*)(fg + c);
            f32x4 o; o[0] = v[j][0] * rs * gg[0]; o[1] = v[j][1] * rs * gg[1]; o[2] = v[j][2] * rs * gg[2]; o[3] = v[j][3] * rs * gg[3];
            *(f32x4*)(F.out + (size_t)r * D + c) = o; }
    }
}

constexpr int NPL = 11;
constexpr int NPH = 1 + DEPTH * NPL + 1;
__device__ __forceinline__ void seam() {
    Frame F = make_frame();
    XcdBarrier bar; bar.bar = (unsigned*)(F.ws + WS_CTL) + CW_BAR; bar.x = xb_xcc_id(); bar.st = (volatile LAS unsigned*)(F.lds + LC_BARW);
    xcd_barrier(bar);
}
__global__ void __launch_bounds__(512, 2) mk_fwd(Args args_unused) {
    {
        Frame F = make_frame();
        for (int u = F.tid; u < (LDS_BYTES - LDS_CTL) / 4; u += 512) ((LAS unsigned*)(F.lds + LDS_CTL))[u] = 0u;
        __syncthreads();
        if (F.ka->ph_hi - F.ka->ph_lo > 1) (void)xcd_barrier_post((unsigned*)(F.ws + WS_CTL) + CW_BAR, (volatile LAS unsigned*)(F.lds + LC_BARW));
    }
#define IN(k) (kargs()->ph_lo <= (k) && (k) < kargs()->ph_hi)
#define SEAM(k) do { if (IN(k) && IN((k) + 1)) seam(); } while (0)
    int ph = 0;
    for (int rep_ = 0; rep_ < DUP_N(13); ++rep_) { if (rep_) seam(); if (PH_EN(13) && IN(ph)) phase_prologue(); }
    SEAM(ph); ++ph;
    for (int l = 0; l < DEPTH; ++l) {
        if (IN(ph) && IN(ph + 1)) { for (int i_ = 0; i_ < EXTRA_SEAMS; ++i_) seam(); }
        for (int rep_ = 0; rep_ < DUP_N(0); ++rep_) { if (rep_) seam(); if (PH_EN(0) && IN(ph)) phase_norm1(l); }
        SEAM(ph); ++ph;
        for (int rep_ = 0; rep_ < DUP_N(1); ++rep_) { if (rep_) seam(); if (PH_EN(1) && IN(ph)) { Frame F = make_frame(); Gemm g{(const bf16_t*)((unsigned char*)F.out + DO_H), (const bf16_t*)(F.ws + WS_WIN), NT, ZLD, D, 0, 0}; StaticOrder S; S.init(NT, ZLD, F.G, F.bid); EpiStoreBf16 E{(bf16_t*)(F.ws + WS_Z), ZLD}; gemm_phase(F.lds, g, S, E); } }
        SEAM(ph); ++ph;
        for (int rep_ = 0; rep_ < DUP_N(2); ++rep_) { if (rep_) seam(); if (PH_EN(2) && IN(ph)) phase_prep(l); }
        SEAM(ph); ++ph;
        for (int rep_ = 0; rep_ < DUP_N(3); ++rep_) { if (rep_) seam(); if (PH_EN(3) && IN(ph)) { if (SCAN_IMPL == 1) { if (rep_ == 0) phase_scan_mfma<0>(l); else phase_scan_mfma<SCAN_DBG>(l); } else if (rep_ == 0) phase_scan<0>(l); else phase_scan<SCAN_VAR>(l); } }
        SEAM(ph); ++ph;
        for (int rep_ = 0; rep_ < DUP_N(4); ++rep_) { if (rep_) seam(); if (PH_EN(4) && IN(ph)) phase_mix(l); }
        SEAM(ph); ++ph;
        for (int rep_ = 0; rep_ < DUP_N(5); ++rep_) { if (rep_) seam(); if (PH_EN(5) && IN(ph)) { Frame F = make_frame(); Gemm g{(const bf16_t*)(F.ws + WS_UA), (const bf16_t*)(F.ws + WS_WA), NT, D, DH, (size_t)(WS_WB - WS_WA) / 2, (size_t)(WS_UB - WS_UA) / 2}; PairOrder S; S.so.init(NT, D, F.G, F.bid); EpiMerge E{(bf16_t*)((unsigned char*)F.out + DO_H), (const bf16_t*)(F.ws + WS_Z)}; gemm_phase(F.lds, g, S, E); } }
        SEAM(ph); ++ph;
        for (int rep_ = 0; rep_ < DUP_N(7); ++rep_) { if (rep_) seam(); if (PH_EN(7) && IN(ph)) { int ll = l; asm volatile("" : "+s"(ll)); Frame F = make_frame(); Gemm g{(const bf16_t*)((unsigned char*)F.out + DO_H), (const bf16_t*)(F.ws + WS_WO), NT, D, D, 0, 0}; StaticOrder S; S.init(NT, D, F.G, F.bid);
            EpiResid E{rep_ ? (float*)(F.ws + WS_Z) : (float*)(F.ws + WS_X), (const float*)(F.ws + WS_MOD) + (size_t)ll * 17 * NMOD + 2048}; gemm_phase(F.lds, g, S, E); } }
        SEAM(ph); ++ph;
        for (int rep_ = 0; rep_ < DUP_N(8); ++rep_) { if (rep_) seam(); if (PH_EN(8) && IN(ph)) phase_norm2(l); }
        SEAM(ph); ++ph;
        for (int rep_ = 0; rep_ < DUP_N(9); ++rep_) { if (rep_) seam(); if (PH_EN(9) && IN(ph)) phase_dispatch(l); }
        SEAM(ph); ++ph;
        for (int rep_ = 0; rep_ < DUP_N(10); ++rep_) { if (rep_) seam(); if (PH_EN(10) && IN(ph)) { int ll = l; asm volatile("" : "+s"(ll)); Frame F = make_frame(); moe_tables(F, ll); MoeOrder S{__builtin_amdgcn_readfirstlane(((const LAS int*)(F.lds + LC_SEG))[33]), F.G, F.bid, (const LAS int*)(F.lds + LC_TILEE)};
            Gemm g{(const bf16_t*)(F.ws + WS_XS), (const bf16_t*)(F.ws + WS_W13), MAXTILES * 256, D, D, (size_t)1024 * 1024, 0}; EpiSwiGLU E{(bf16_t*)(F.ws + WS_HID)}; gemm_phase(F.lds, g, S, E); } }
        SEAM(ph); ++ph;
        for (int rep_ = 0; rep_ < DUP_N(11); ++rep_) { if (rep_) seam(); if (PH_EN(11) && IN(ph)) { int ll = l; asm volatile("" : "+s"(ll)); Frame F = make_frame(); moe_tables(F, ll); MoeOrder S{__builtin_amdgcn_readfirstlane(((const LAS int*)(F.lds + LC_SEG))[33]), F.G, F.bid, (const LAS int*)(F.lds + LC_TILEE)};
            Gemm g{(const bf16_t*)(F.ws + WS_HID), (const bf16_t*)(F.ws + WS_W2), MAXTILES * 256, D, DFF, (size_t)1024 * 512, 0}; EpiStoreBf16 E{(bf16_t*)(F.ws + WS_YS), D}; gemm_phase(F.lds, g, S, E); } }
        SEAM(ph); ++ph;
    }
    if (PH_EN(14) && IN(ph)) phase_final();
#undef IN
#undef SEAM
}

extern "C" void kernel_launch(void* const* d_in, const int* in_sizes, int n_in, void* d_out, int out_size, void* d_ws, size_t ws_size, hipStream_t stream) {
    static int grid = 0;
    if (grid == 0) {
        if (n_in != 32 || out_size != NLAT * D || ws_size < WS_END) { fprintf(stderr, "kernel_launch: unexpected shapes (n_in %d, out %d, ws %zu < %zu)\n", n_in, out_size, ws_size, (size_t)WS_END); grid = -1; return; }
        int dev = 0, cus = 0, per_cu = 0;
        if (hipGetDevice(&dev) != hipSuccess || hipDeviceGetAttribute(&cus, hipDeviceAttributeMultiprocessorCount, dev) != hipSuccess) { grid = -1; return; }
        if (hipFuncSetAttribute((const void*)mk_fwd, hipFuncAttributeMaxDynamicSharedMemorySize, LDS_BYTES) != hipSuccess) { fprintf(stderr, "kernel_launch: hipFuncSetAttribute failed\n"); grid = -1; return; }
        if (hipOccupancyMaxActiveBlocksPerMultiprocessor(&per_cu, (const void*)mk_fwd, 512, LDS_BYTES) != hipSuccess || per_cu < 1) { fprintf(stderr, "kernel_launch: occupancy query says %d\n", per_cu); }
        (void)hipGetLastError();
        grid = cus;
    }
    if (grid < 0) return;
    if (hipMemsetAsync((char*)d_ws + WS_CTL, 0, CTL_ZERO_BYTES, stream) != hipSuccess) return;
    Args a{};
    for (int i = 0; i < 32; ++i) a.in[i] = (const float*)d_in[i];
    a.out = (float*)d_out; a.ws = (unsigned char*)d_ws;
#if MK_ONE_LAUNCH
    a.ph_lo = 0; a.ph_hi = NPH;
    hipLaunchKernelGGL(mk_fwd, dim3(grid), dim3(512), LDS_BYTES, stream, a);
#else
    for (int p = 0; p < NPH; ++p) { a.ph_lo = p; a.ph_hi = p + 1; hipLaunchKernelGGL(mk_fwd, dim3(grid), dim3(512), LDS_BYTES, stream, a); }
#endif
}
```

```cpp
#include <hip/hip_runtime.h>
#include <cstdio>
#include <cstdint>

#ifndef MK_ONE_LAUNCH
#define MK_ONE_LAUNCH 1
#endif
#ifndef GEMM_IMPL
#define GEMM_IMPL 1
#endif

#ifndef PHASE_MASK
#define PHASE_MASK 0xffff
#endif
#define PH_EN(p) (((PHASE_MASK) >> (p)) & 1)
#ifndef DUP_MASK
#define DUP_MASK 0
#endif
#ifndef EXTRA_SEAMS
#define EXTRA_SEAMS 0
#endif
#ifndef SCAN_VAR
#define SCAN_VAR 0
#endif
#ifndef SCAN_DBG
#define SCAN_DBG 0
#endif
#ifndef SCAN_HILO
#define SCAN_HILO 0
#endif
#ifndef SCAN_IMPL
#define SCAN_IMPL 1
#endif
#define DUP_N(p) (1 + (((DUP_MASK) >> (p)) & 1))
#define LAS __attribute__((address_space(3)))
typedef unsigned short bf16_t;
typedef short bf16x8 __attribute__((ext_vector_type(8)));
typedef float f32x4 __attribute__((ext_vector_type(4)));
typedef unsigned u32x4 __attribute__((ext_vector_type(4)));
typedef unsigned u32x2 __attribute__((ext_vector_type(2)));

constexpr int D = 1024, NBATCH = 16, SEQ = 2048, DEPTH = 4, CTXL = 256;
constexpr int NCTX = NBATCH * CTXL;
constexpr int NLAT = NBATCH * SEQ;
constexpr int NT = NCTX + NLAT;
constexpr int DH = 512;
constexpr int NIN = 5504, ZLD = 5632;
constexpr int ZC_BG = 0, ZC_CG = 512, ZC_HA = 1024, ZC_RW = 1536, ZC_GA = 3456, ZC_GB = 4480;
constexpr int RWC = 1920;
constexpr int NE = 32, DFF = 512;
constexpr int MAXTILES = 320;
constexpr int NMOD = 6 * D;
constexpr float NORM_EPS = 1e-6f, GN_EPS = 64e-5f;

constexpr size_t MiB = 1u << 20;
constexpr size_t WS_CTL = 0, CTL_ZERO_BYTES = 1 * MiB;
constexpr size_t WS_MOD = 1 * MiB;
constexpr size_t WS_RE = 3 * MiB;
constexpr size_t WS_RG = WS_RE + (size_t)NT * 8;
constexpr size_t WS_RP = WS_RG + (size_t)NT * 8;
constexpr size_t WS_RS = WS_RP + (size_t)NT * 8;
constexpr size_t WS_BH = 4 * MiB + 256 * 1024;
constexpr size_t WS_RB = 4 * MiB + 384 * 1024;
constexpr size_t WS_WC = 6 * MiB + 256 * 1024;
constexpr size_t WS_BONUS = 5 * MiB;
constexpr size_t WS_X = 8 * MiB;
constexpr size_t WS_WIN = 152 * MiB;
constexpr size_t WS_WA = 163 * MiB;
constexpr size_t WS_WB = 164 * MiB;
constexpr size_t WS_WO = 165 * MiB;
constexpr size_t WS_W13 = 167 * MiB;
constexpr size_t WS_W2 = 231 * MiB;
constexpr size_t WS_Z = 264 * MiB;
constexpr size_t WS_XS = WS_Z;
constexpr size_t WS_HID = WS_Z + 160 * MiB;
constexpr size_t WS_SI = 660 * MiB;
constexpr size_t SI_SZ = 36 * MiB;
constexpr size_t WS_V = WS_SI, WS_KT0 = WS_SI + SI_SZ, WS_KT1 = WS_SI + 2 * SI_SZ, WS_BT0 = WS_SI + 3 * SI_SZ, WS_BT1 = WS_SI + 4 * SI_SZ,
                 WS_KDT0 = WS_SI + 5 * SI_SZ, WS_KDT1 = WS_SI + 6 * SI_SZ, WS_RT0 = WS_SI + 7 * SI_SZ, WS_RT1 = WS_SI + 8 * SI_SZ;
constexpr size_t WS_B1 = WS_RT1, WS_KD0 = WS_KDT0;
constexpr size_t WS_UA = WS_KT0, WS_UB = WS_KT1;
constexpr size_t WS_GE0 = 1092 * MiB, WS_GE1 = 1097 * MiB;
constexpr size_t WS_YS = WS_SI;
constexpr size_t WS_Y0 = 984 * MiB, WS_Y1 = 1020 * MiB;
constexpr size_t WS_END = 1102 * MiB;
constexpr size_t DO_H = 0, DO_G = 72 * MiB;
static_assert(WS_Z + (size_t)NT * ZLD * 2 <= WS_SI && WS_HID + (size_t)MAXTILES * 256 * DFF * 2 <= WS_SI && WS_B1 + SI_SZ <= WS_Y0 && WS_YS + (size_t)MAXTILES * 256 * D * 2 <= WS_Y0, "ws map");
static_assert((size_t)NT * DH * 2 == SI_SZ && WS_X + (size_t)NT * D * 4 <= WS_WIN && WS_W2 + 32 * MiB <= WS_Z, "ws map 2");
constexpr int CW_CNT = 1024;
constexpr int CW_BAR = 4096;

constexpr int LDS_BYTES = 163840;
constexpr int LDS_CTL = 155648;
constexpr int LC_BARW = LDS_CTL;
constexpr int LC_SEG = LDS_CTL + 64;
constexpr int LC_CNTS = LDS_CTL + 256;
constexpr int LC_TILEE = LDS_CTL + 512;
constexpr int LC_BBASE = LDS_CTL + 2048;
constexpr int LC_RED = LDS_CTL + 4096;

__device__ __forceinline__ float bf2f(unsigned b) { return __uint_as_float(b << 16); }
typedef float f32x2c __attribute__((ext_vector_type(2)));
typedef __bf16 bf16v2c __attribute__((ext_vector_type(2)));
__device__ __forceinline__ unsigned pk2(float lo, float hi) { const f32x2c v = {lo, hi}; return __builtin_bit_cast(unsigned, __builtin_convertvector(v, bf16v2c)); }
__device__ __forceinline__ unsigned f2bf(float f) { return pk2(f, 0.f) & 0xffffu; }
__device__ __forceinline__ float wave_sum(float v) {
#pragma unroll
    for (int o = 1; o < 64; o <<= 1) v += __shfl_xor(v, o);
    return v;
}
__device__ __forceinline__ float fexp(float x) { return __builtin_amdgcn_exp2f(x * 1.4426950408889634f); }
__device__ __forceinline__ float sigmoidf_(float x) { return __builtin_amdgcn_rcpf(1.0f + fexp(-x)); }
__device__ __forceinline__ float siluf_(float x) { return x * __builtin_amdgcn_rcpf(1.0f + fexp(-x)); }

#define XB_TMO      128
#define XB_XCNT(j)  (256  + 64 * (j))
#define XB_XSUB(j)  (1280 + 64 * (j))
#define XB_XGEN(j)  (2304 + 64 * (j))
#define XB_TOP      3328
#define XB_TOPGEN   3392
#define XCD_BAR_WORDS 3456
#define XB_SPIN_CAP (1u << 22)

__device__ __forceinline__ unsigned xb_ld(unsigned* p)              { return __hip_atomic_load(p, __ATOMIC_RELAXED, __HIP_MEMORY_SCOPE_AGENT); }
__device__ __forceinline__ unsigned xb_add(unsigned* p, unsigned v) { return __hip_atomic_fetch_add(p, v, __ATOMIC_RELAXED, __HIP_MEMORY_SCOPE_AGENT); }
__device__ __forceinline__ unsigned xb_xcc_id() { return (unsigned)__builtin_amdgcn_s_getreg((3 << 11) | 20) & 0xFu; }
#define XB_SPIN(cond, bar) do { unsigned _sp = 0; while (cond) { __builtin_amdgcn_s_sleep(1); \
    if ((++_sp & 255u) == 0u) { if (xb_ld(&(bar)[XB_TMO])) break; if (_sp > XB_SPIN_CAP) { atomicAdd(&(bar)[XB_TMO], 1u); break; } } } } while (0)

struct XcdBarrier { unsigned* bar; unsigned x; volatile LAS unsigned* st; };

__device__ __forceinline__ XcdBarrier xcd_barrier_post(unsigned* bar, volatile LAS unsigned* st) {
    XcdBarrier b; b.bar = bar; b.x = xb_xcc_id(); b.st = st;
    if (threadIdx.x == 0) (void)xb_add(&bar[XB_XCNT(b.x)], 1u);
    return b;
}
__device__ __forceinline__ void xcd_barrier_complete(unsigned* bar, unsigned x, unsigned& nloc, unsigned& nx) {
    const unsigned G = gridDim.x * gridDim.y * gridDim.z;
    unsigned sum, cnt, mine, sp = 0u;
    for (;;) {
        sum = 0u; cnt = 0u; mine = 0u;
#pragma unroll
        for (unsigned j = 0; j < 16; ++j) { const unsigned c = xb_ld(&bar[XB_XCNT(j)]); sum += c; cnt += (c > 0u) ? 1u : 0u; mine = (j == x) ? c : mine; }
        if (sum == G) break;
        __builtin_amdgcn_s_sleep(1);
        if ((++sp & 255u) == 0u) { if (xb_ld(&bar[XB_TMO])) break; if (sp > XB_SPIN_CAP) { atomicAdd(&bar[XB_TMO], 1u); break; } }
    }
    nloc = mine > 0u ? mine : 1u; nx = cnt > 0u ? cnt : 1u;
}
__device__ __forceinline__ void xcd_barrier(const XcdBarrier& b) {
    asm volatile("s_waitcnt vmcnt(0)" ::: "memory");
    __syncthreads();
    if (threadIdx.x == 0) {
        unsigned* bar = b.bar;
        __builtin_amdgcn_s_waitcnt(0);
        unsigned nloc = b.st[0], nx = b.st[1];
        if (nloc == 0u) { xcd_barrier_complete(bar, b.x, nloc, nx); b.st[0] = nloc; b.st[1] = nx; }
        const unsigned old = xb_add(&bar[XB_XSUB(b.x)], 1u);
        const unsigned gen = old / nloc;
        if (old + 1u == (gen + 1u) * nloc) {
            __builtin_amdgcn_fence(__ATOMIC_RELEASE, "agent");
            asm volatile("s_waitcnt vmcnt(0)" ::: "memory");
            const unsigned og = xb_add(&bar[XB_TOP], 1u);
            const unsigned tg = og / nx;
            if (og + 1u == (tg + 1u) * nx) xb_add(&bar[XB_TOPGEN], 1u);
            else XB_SPIN(xb_ld(&bar[XB_TOPGEN]) == tg, bar);
            __builtin_amdgcn_fence(__ATOMIC_ACQUIRE, "agent");
            xb_add(&bar[XB_XGEN(b.x)], 1u);
            asm volatile("s_waitcnt vmcnt(0)" ::: "memory");
        } else {
            XB_SPIN(xb_ld(&bar[XB_XGEN(b.x)]) == gen, bar);
            __builtin_amdgcn_fence(__ATOMIC_ACQUIRE, "agent");
            asm volatile("s_waitcnt vmcnt(0)" ::: "memory");
        }
    }
    __syncthreads();
}

struct Unit { int pm, pn, bs, as; };
struct Gemm { const bf16_t* A; const bf16_t* Bt; int M, N, K; size_t bstride; size_t astride; };
constexpr int NXCD = 8, WGM = 8;
struct StaticOrder {
    int nM, nN, nwg, G, c;
    __device__ __forceinline__ void init(int M, int N, int G_, int c_) { nM = M / 256; nN = N / 256; nwg = nM * nN; G = G_; c = c_; }
    __device__ __forceinline__ bool next(int i, Unit& u) const {
        const long L = (long)i * G + c; if (L >= nwg) return false;
        int wgid = (int)L; { const int q = nwg / NXCD, r = nwg % NXCD, xcd = wgid % NXCD, off = wgid / NXCD; wgid = (xcd < r ? xcd * (q + 1) : r * (q + 1) + (xcd - r) * q) + off; }
        const int nig = WGM * nN, gid = wgid / nig, fm = gid * WGM, gsz = (nM - fm) < WGM ? (nM - fm) : WGM;
        u.pm = fm + ((wgid % nig) % gsz); u.pn = (wgid % nig) / gsz; u.bs = 0; u.as = 0; return true;
    }
};
struct PairOrder {
    StaticOrder so;
    __device__ __forceinline__ bool next(int i, Unit& u) const { if (!so.next(i >> 1, u)) return false; u.bs = i & 1; u.as = i & 1; return true; }
};
struct MoeOrder {
    int ntiles, G, c; const LAS int* tile_e;
    __device__ __forceinline__ bool next(int i, Unit& u) const {
        const int L = i * G + c; if (L >= ntiles * 4) return false;
        u.pm = L >> 2; u.pn = L & 3; u.bs = __builtin_amdgcn_readfirstlane(tile_e[u.pm]); u.as = 0; return true;
    }
};

#if GEMM_IMPL == 0
template <class Epi, class Sched>
__device__ __forceinline__ void gemm_phase(LAS unsigned char* lds, const Gemm g, const Sched& S, const Epi& E) {
    LAS float* As = (LAS float*)lds;
    LAS float* Bs = As + 16 * 260;
    const int tid = threadIdx.x, ty = tid >> 4, tx = tid & 15, lr = tid >> 1, lh = tid & 1;
    Unit u;
    for (int it = 0; S.next(it, u); ++it) {
        float acc[8][16];
#pragma unroll
        for (int i = 0; i < 8; ++i)
#pragma unroll
            for (int j = 0; j < 16; ++j) acc[i][j] = 0.f;
        const bf16_t* Ap = g.A + ((size_t)u.pm * 256 + lr) * g.K + lh * 8;
        const bf16_t* Bp = g.Bt + (size_t)u.bs * g.bstride + ((size_t)u.pn * 256 + lr) * g.K + lh * 8;
        for (int k0 = 0; k0 < g.K; k0 += 16) {
            const u32x4 av = *(const u32x4*)(Ap + k0), bv = *(const u32x4*)(Bp + k0);
            __syncthreads();
#pragma unroll
            for (int j = 0; j < 4; ++j) {
                As[(lh * 8 + 2 * j) * 260 + lr] = bf2f(av[j] & 0xffffu); As[(lh * 8 + 2 * j + 1) * 260 + lr] = bf2f(av[j] >> 16);
                Bs[(lh * 8 + 2 * j) * 260 + lr] = bf2f(bv[j] & 0xffffu); Bs[(lh * 8 + 2 * j + 1) * 260 + lr] = bf2f(bv[j] >> 16);
            }
            __syncthreads();
#pragma unroll 4
            for (int kk = 0; kk < 16; ++kk) {
                float a[8], b[16];
                const f32x4 a0 = *(const LAS f32x4*)(As + kk * 260 + ty * 8), a1 = *(const LAS f32x4*)(As + kk * 260 + ty * 8 + 4);
                a[0] = a0[0]; a[1] = a0[1]; a[2] = a0[2]; a[3] = a0[3]; a[4] = a1[0]; a[5] = a1[1]; a[6] = a1[2]; a[7] = a1[3];
#pragma unroll
                for (int q = 0; q < 4; ++q) { const f32x4 bq = *(const LAS f32x4*)(Bs + kk * 260 + tx * 4 + 64 * q); b[4 * q] = bq[0]; b[4 * q + 1] = bq[1]; b[4 * q + 2] = bq[2]; b[4 * q + 3] = bq[3]; }
#pragma unroll
                for (int i = 0; i < 8; ++i)
#pragma unroll
                    for (int j = 0; j < 16; ++j) acc[i][j] = fmaf(a[i], b[j], acc[i][j]);
            }
        }
#pragma unroll
        for (int i = 0; i < 8; ++i)
#pragma unroll
            for (int q = 0; q < 4; ++q)
                E.elem4(u.pm * 256 + ty * 8 + i, u.pn * 256 + tx * 4 + 64 * q, (f32x4){acc[i][4 * q], acc[i][4 * q + 1], acc[i][4 * q + 2], acc[i][4 * q + 3]});
    }
    __syncthreads();
}
#else
namespace pg8 {
constexpr int BM = 256, BK = 64, HALF = 128, HTB = HALF * BK * 2, STAGE_BYTES = 8 * HTB;
__device__ __forceinline__ int lds_byte(int r, int c) { const int st = (r >> 4) * 2 + (c >> 5), rr = r & 15, cc = c & 31, ob = rr * 64 + cc * 2; return st * 1024 + (ob ^ (((ob >> 9) & 1) << 5)); }
__device__ __forceinline__ int perm32(int rho) { const int n = rho >> 4, i = rho & 15; return 8 * (i >> 2) + 4 * n + (i & 3); }
__device__ __forceinline__ void stage_rc(int b, int& R, int& C) { const int st = b / 1024, sb = b % 1024, swz = sb ^ (((sb >> 9) & 1) << 5); R = (st >> 1) * 16 + swz / 64; C = (st & 1) * 32 + (swz % 64) / 2; }
}
template <class Epi, class Sched>
__device__ __forceinline__ void gemm_phase(LAS unsigned char* lds, const Gemm g, const Sched& S, const Epi& E) {
    using namespace pg8;
    int tid_ = threadIdx.x; asm volatile("" : "+v"(tid_));
    const int tid = tid_, wid = __builtin_amdgcn_readfirstlane(tid >> 6), lane = tid & 63, wr = wid >> 2, wc = wid & 3, fr = lane & 15, fq = lane >> 4;
    const int K = g.K, nt = K / BK;
    unsigned voffA[2], voffB[2];
#pragma unroll
    for (int i = 0; i < 2; ++i) { int R, C; stage_rc(tid * 16 + i * 8192, R, C); const int Rb = Epi::PERM ? ((R & ~31) + perm32(R & 31)) : R;
        voffA[i] = (unsigned)(R * K + C) * 2u; voffB[i] = (unsigned)(Rb * K + C) * 2u; }
    const size_t kstep = (size_t)(BK * 2);
    const size_t hstep = (size_t)HALF * K * 2;
    const size_t tstep = 2 * hstep;
    const unsigned ldsw = (unsigned)wid * 1024u;
    const int aoff = lds_byte(wr * 64 + fr, fq * 8), boff = lds_byte(wc * 32 + fr, fq * 8);
#define PG8_SA(b, h) (((b) * 2 + (h)) * HTB)
#define PG8_SB(b, h) ((4 + (b) * 2 + (h)) * HTB)
#define PG8_STAGE(bufoff, gbase, voff) do { _Pragma("unroll") for (int _i = 0; _i < 2; ++_i) \
        __builtin_amdgcn_global_load_lds((const unsigned*)((const char*)(gbase) + (voff)[_i]), (LAS unsigned*)(lds + (bufoff) + ldsw + _i * 8192), 16, 0, 0); } while (0)
#define PG8_LDA(dst, b, h) do { _Pragma("unroll") for (int m = 0; m < 4; ++m) _Pragma("unroll") for (int k = 0; k < 2; ++k) dst[m][k] = *(const LAS bf16x8*)(lds + PG8_SA(b, h) + aoff + m * 2048 + k * 1024); } while (0)
#define PG8_LDB(dst, b, h) do { _Pragma("unroll") for (int n = 0; n < 2; ++n) _Pragma("unroll") for (int k = 0; k < 2; ++k) dst[n][k] = *(const LAS bf16x8*)(lds + PG8_SB(b, h) + boff + n * 2048 + k * 1024); } while (0)
#define PG8_MMA(ai, bj, At, Bt) do { __builtin_amdgcn_s_setprio(1); _Pragma("unroll") for (int m = 0; m < 4; ++m) _Pragma("unroll") for (int n = 0; n < 2; ++n) _Pragma("unroll") for (int k = 0; k < 2; ++k) \
        acc[ai][bj][m][n] = __builtin_amdgcn_mfma_f32_16x16x32_bf16(Bt[n][k], At[m][k], acc[ai][bj][m][n], 0, 0, 0); __builtin_amdgcn_s_setprio(0); } while (0)
#define PG8_WAIT_V(n) asm volatile("s_waitcnt vmcnt(" #n ")" ::: "memory")
#define PG8_WAIT_L(n) asm volatile("s_waitcnt lgkmcnt(" #n ")" ::: "memory")
#define PG8_BAR __builtin_amdgcn_s_barrier()
#define PG8_SCHED __builtin_amdgcn_sched_barrier(0)
    Unit cur, nxt; int ui = 0;
    if (S.next(0, cur)) {
    f32x4 acc[2][2][4][2];
#pragma unroll
    for (int a = 0; a < 2; ++a)
#pragma unroll
        for (int b = 0; b < 2; ++b)
#pragma unroll
            for (int m = 0; m < 4; ++m)
#pragma unroll
                for (int n = 0; n < 2; ++n) acc[a][b][m][n] = (f32x4){0.f, 0.f, 0.f, 0.f};
    bf16x8 At[4][2], B0[2][2], B1[2][2];
    const char* cA = (const char*)(g.A + (size_t)cur.as * g.astride) + (size_t)cur.pm * tstep; const char* cB = (const char*)(g.Bt + (size_t)cur.bs * g.bstride) + (size_t)cur.pn * tstep;
    PG8_STAGE(PG8_SB(0, 0), cB, voffB); PG8_STAGE(PG8_SA(0, 0), cA, voffA); PG8_STAGE(PG8_SB(0, 1), cB + hstep, voffB); PG8_STAGE(PG8_SA(0, 1), cA + hstep, voffA);
    if (wr == 1) PG8_BAR;
    PG8_WAIT_V(4); PG8_BAR;
    PG8_STAGE(PG8_SB(1, 0), cB + kstep, voffB); PG8_STAGE(PG8_SA(1, 0), cA + kstep, voffA); PG8_STAGE(PG8_SB(1, 1), cB + hstep + kstep, voffB);
    PG8_WAIT_V(6); PG8_BAR;
    for (;;) {
        const bool has_next = S.next(ui + 1, nxt);
        const char* nA = has_next ? (const char*)(g.A + (size_t)nxt.as * g.astride) + (size_t)nxt.pm * tstep : cA; const char* nB = has_next ? (const char*)(g.Bt + (size_t)nxt.bs * g.bstride) + (size_t)nxt.pn * tstep : cB;
        for (int t = 0; t < nt; t += 2) {
            const bool last = (t == nt - 2);
            const char* a1 = cA + (size_t)(t + 1) * kstep;
            const char* a2 = last ? nA : cA + (size_t)(t + 2) * kstep; const char* b2 = last ? nB : cB + (size_t)(t + 2) * kstep;
            const char* a3 = a2 + kstep; const char* b3 = b2 + kstep;
            PG8_LDB(B0, 0, 0); PG8_SCHED; PG8_LDA(At, 0, 0); PG8_STAGE(PG8_SA(1, 1), a1 + hstep, voffA);
            PG8_WAIT_L(8); PG8_BAR; PG8_WAIT_L(0); PG8_MMA(0, 0, At, B0); PG8_BAR; PG8_SCHED;
            PG8_LDB(B1, 0, 1); PG8_STAGE(PG8_SB(0, 0), b2, voffB);
            PG8_BAR; PG8_WAIT_L(0); PG8_MMA(0, 1, At, B1); PG8_BAR;
            PG8_LDA(At, 0, 1); PG8_STAGE(PG8_SA(0, 0), a2, voffA);
            PG8_BAR; PG8_WAIT_L(0); PG8_MMA(1, 0, At, B0); PG8_BAR; PG8_SCHED;
            PG8_STAGE(PG8_SB(0, 1), b2 + hstep, voffB);
            PG8_WAIT_V(6); PG8_BAR; PG8_MMA(1, 1, At, B1); PG8_BAR;
            PG8_LDB(B0, 1, 0); PG8_SCHED; PG8_LDA(At, 1, 0); PG8_STAGE(PG8_SA(0, 1), a2 + hstep, voffA);
            PG8_WAIT_L(8); PG8_BAR; PG8_WAIT_L(0); PG8_MMA(0, 0, At, B0); PG8_BAR; PG8_SCHED;
            PG8_LDB(B1, 1, 1); PG8_STAGE(PG8_SB(1, 0), b3, voffB);
            PG8_BAR; PG8_WAIT_L(0); PG8_MMA(0, 1, At, B1); PG8_BAR;
            PG8_LDA(At, 1, 1); PG8_STAGE(PG8_SA(1, 0), a3, voffA);
            PG8_BAR; PG8_WAIT_L(0); PG8_MMA(1, 0, At, B0); PG8_BAR; PG8_SCHED;
            PG8_STAGE(PG8_SB(1, 1), b3 + hstep, voffB);
            PG8_WAIT_V(6); PG8_BAR; PG8_MMA(1, 1, At, B1); PG8_BAR;
        }
        bool keep = false;
        {
            const int row0 = cur.pm * 256 + wr * 64 + fr;
            if constexpr (Epi::TWO_PART) keep = (cur.as == 0);
            if constexpr (Epi::PERM) {
                const int col0 = cur.pn * 256 + wc * 32 + 8 * fq;
#pragma unroll
                for (int ai = 0; ai < 2; ++ai)
#pragma unroll
                    for (int m = 0; m < 4; ++m)
#pragma unroll
                        for (int bj = 0; bj < 2; ++bj) {
                            if constexpr (Epi::TWO_PART) { if (keep) E.mid8(row0 + ai * 128 + m * 16, col0 + bj * 128, acc[ai][bj][m][0], acc[ai][bj][m][1]); else E.elem8(row0 + ai * 128 + m * 16, col0 + bj * 128, acc[ai][bj][m][0], acc[ai][bj][m][1]); }
                            else E.elem8(row0 + ai * 128 + m * 16, col0 + bj * 128, acc[ai][bj][m][0], acc[ai][bj][m][1]);
                        }
            } else {
                const int col0 = cur.pn * 256 + wc * 32 + 4 * fq;
#pragma unroll
                for (int ai = 0; ai < 2; ++ai)
#pragma unroll
                    for (int m = 0; m < 4; ++m)
#pragma unroll
                        for (int bj = 0; bj < 2; ++bj)
#pragma unroll
                            for (int n = 0; n < 2; ++n) E.elem4(row0 + ai * 128 + m * 16, col0 + bj * 128 + n * 16, acc[ai][bj][m][n]);
            }
        }
        if (!has_next) break;
        if (!keep) {
#pragma unroll
        for (int a = 0; a < 2; ++a)
#pragma unroll
            for (int b = 0; b < 2; ++b)
#pragma unroll
                for (int m = 0; m < 4; ++m)
#pragma unroll
                    for (int n = 0; n < 2; ++n) acc[a][b][m][n] = (f32x4){0.f, 0.f, 0.f, 0.f};
        }
        cur = nxt; cA = nA; cB = nB; ++ui;
    }
    PG8_WAIT_V(0);
    if (wr == 0) PG8_BAR;
    PG8_BAR;
    }
#undef PG8_SA
#undef PG8_SB
#undef PG8_STAGE
#undef PG8_LDA
#undef PG8_LDB
#undef PG8_MMA
#undef PG8_WAIT_V
#undef PG8_WAIT_L
#undef PG8_BAR
#undef PG8_SCHED
    __syncthreads();
}
#endif

__device__ __forceinline__ u32x4 pack8v(const f32x4 a, const f32x4 b) { u32x4 r; r.x = pk2(a[0], a[1]); r.y = pk2(a[2], a[3]); r.z = pk2(b[0], b[1]); r.w = pk2(b[2], b[3]); return r; }
struct EpiStoreBf16 {
    static constexpr bool TWO_PART = false, PERM = true;
    bf16_t* O; int ldc;
    __device__ __forceinline__ void elem8(int row, int col, f32x4 v0, f32x4 v1) const { *(u32x4*)(O + (size_t)row * ldc + col) = pack8v(v0, v1); }
};
struct EpiMerge {
    static constexpr bool TWO_PART = true, PERM = true;
    bf16_t* MG; const bf16_t* Z;
    __device__ __forceinline__ void mid8(int row, int col, f32x4& v0, f32x4& v1) const {
        const u32x4 ga = *(const u32x4*)(Z + (size_t)row * ZLD + ZC_GA + col), gb = *(const u32x4*)(Z + (size_t)row * ZLD + ZC_GB + col);
#pragma unroll
        for (int e = 0; e < 4; ++e) { const float al = bf2f(ga[e] & 0xffffu), ah = bf2f(ga[e] >> 16), bl = bf2f(gb[e] & 0xffffu), bh = bf2f(gb[e] >> 16);
            const float rl = (1.0f + fexp(-bl)) * __builtin_amdgcn_rcpf(1.0f + fexp(-al)), rh = (1.0f + fexp(-bh)) * __builtin_amdgcn_rcpf(1.0f + fexp(-ah));
            if (e < 2) { v0[2 * e] *= rl; v0[2 * e + 1] *= rh; } else { v1[2 * e - 4] *= rl; v1[2 * e - 3] *= rh; } }
    }
    __device__ __forceinline__ void elem8(int row, int col, f32x4 v0, f32x4 v1) const {
        const u32x4 gb = *(const u32x4*)(Z + (size_t)row * ZLD + ZC_GB + col);
#pragma unroll
        for (int e = 0; e < 4; ++e) { const float sl = sigmoidf_(bf2f(gb[e] & 0xffffu)), sh = sigmoidf_(bf2f(gb[e] >> 16));
            if (e < 2) { v0[2 * e] *= sl; v0[2 * e + 1] *= sh; } else { v1[2 * e - 4] *= sl; v1[2 * e - 3] *= sh; } }
        *(u32x4*)(MG + (size_t)row * D + col) = pack8v(v0, v1);
    }
};
struct EpiResid {
    static constexpr bool TWO_PART = false, PERM = false;
    float* X; const float* modg;
    __device__ __forceinline__ void elem4(int row, int col, f32x4 v) const {
        const int mj = row < NCTX ? 16 : ((row - NCTX) >> 11);
        const f32x4 gv = *(const f32x4*)(modg + (size_t)mj * NMOD + col);
        f32x4* p = (f32x4*)(X + (size_t)row * D + col);
        f32x4 x = *p; x[0] += gv[0] * v[0]; x[1] += gv[1] * v[1]; x[2] += gv[2] * v[2]; x[3] += gv[3] * v[3]; *p = x;
    }
};
struct EpiSwiGLU {
    static constexpr bool TWO_PART = false, PERM = true;
    bf16_t* HID;
    __device__ __forceinline__ void elem8(int row, int col, f32x4 v0, f32x4 v1) const {
        u32x2 w; w.x = pk2(siluf_(v0[0]) * v1[0], siluf_(v0[1]) * v1[1]); w.y = pk2(siluf_(v0[2]) * v1[2], siluf_(v0[3]) * v1[3]);
        *(u32x2*)(HID + (size_t)row * DFF + (col >> 1)) = w;
    }
};

struct Args { const float* in[32]; float* out; unsigned char* ws; int ph_lo, ph_hi; };
typedef const __attribute__((address_space(4))) Args* KArgs;
__device__ __forceinline__ KArgs kargs() { KArgs p = (KArgs)__builtin_amdgcn_kernarg_segment_ptr(); asm volatile("" : "+s"(p)); return p; }
struct Frame {
    LAS unsigned char* lds;
    int tid, lane, wave, G, bid;
    KArgs ka; float* out; unsigned char* ws;
    __device__ __forceinline__ const float* inp(int i) const { return ka->in[i]; }
};
__device__ __forceinline__ Frame make_frame() {
    extern __shared__ __attribute__((aligned(16))) unsigned char lds_raw[];
    Frame F; F.lds = (LAS unsigned char*)lds_raw; { int t = threadIdx.x; asm volatile("" : "+v"(t)); F.tid = t; } F.lane = F.tid & 63; F.wave = __builtin_amdgcn_readfirstlane(F.tid >> 6);
    { int g_ = gridDim.x, b_ = blockIdx.x; asm volatile("" : "+s"(g_), "+s"(b_)); F.G = g_; F.bid = b_; } F.ka = kargs(); F.out = F.ka->out; F.ws = F.ka->ws; return F;
}
#define IN_X 0
#define IN_C 1
#define IN_CTX 2
#define IN_CCTX 3
#define IN_WMOD 4
#define IN_BMOD 5
#define IN_N1G 6
#define IN_N2G 7
#define IN_WIN 8
#define IN_SHMU 9
#define IN_CONVW 10
#define IN_WUP 11
#define IN_W0 12
#define IN_AUP 13
#define IN_A0 14
#define IN_GUP 15
#define IN_KK 16
#define IN_KA 17
#define IN_RK 18
#define IN_LNG 19
#define IN_LNB 20
#define IN_WAO 21
#define IN_WBO 22
#define IN_WO 23
#define IN_RG 24
#define IN_RGB 25
#define IN_RE 26
#define IN_REB 27
#define IN_W1 28
#define IN_W3 29
#define IN_W2 30
#define IN_FG 31

__device__ __forceinline__ void phase_prologue() {
    Frame F = make_frame();
    {
        const f32x4* sc = (const f32x4*)F.inp(IN_CTX); const f32x4* sx = (const f32x4*)F.inp(IN_X); f32x4* X = (f32x4*)(F.ws + WS_X);
        const size_t n4c = (size_t)NCTX * D / 4, n4 = (size_t)NT * D / 4;
        for (size_t i = (size_t)F.bid * 512 + F.tid; i < n4; i += (size_t)F.G * 512) X[i] = i < n4c ? sc[i] : sx[i - n4c];
    }
    {
        float* WC = (float*)(F.ws + WS_WC); float* RB = (float*)(F.ws + WS_RB);
        for (int i = F.bid * 512 + F.tid; i < DEPTH * 1024 * 48; i += F.G * 512) { const int c = i % 48, lk = i / 48;
            WC[i] = c < 32 ? F.inp(IN_RE)[(size_t)lk * 32 + c] : (c < 36 ? F.inp(IN_RG)[(size_t)lk * 4 + (c - 32)] : 0.f); }
        if (F.bid == 0 && F.tid < DEPTH * 48) { const int c = F.tid % 48, l = F.tid / 48; RB[F.tid] = c < 32 ? F.inp(IN_REB)[l * 32 + c] : (c < 36 ? F.inp(IN_RGB)[l * 4 + (c - 32)] : 0.f); }
    }
    if (F.bid * 512 < DEPTH * NMOD) {
        LAS float* st = (LAS float*)F.lds;
        for (int i = F.tid; i < 17 * 1024; i += 512) { const int j = i >> 10, k = i & 1023; const float cv = j < 16 ? F.inp(IN_C)[j * 1024 + k] : F.inp(IN_CCTX)[k]; st[k * 20 + j] = siluf_(cv); }
        __syncthreads();
        for (int cidx = F.bid * 512 + F.tid; cidx < DEPTH * NMOD; cidx += F.G * 512) {
            const int l = cidx / NMOD, n = cidx % NMOD;
            const float* w = F.inp(IN_WMOD) + (size_t)l * D * NMOD + n;
            float acc[17]; const float b = F.inp(IN_BMOD)[l * NMOD + n];
#pragma unroll
            for (int j = 0; j < 17; ++j) acc[j] = b;
#pragma unroll 4
            for (int k = 0; k < 1024; ++k) {
                const float wv = w[(size_t)k * NMOD];
#pragma unroll
                for (int j = 0; j < 17; ++j) acc[j] = fmaf(st[k * 20 + j], wv, acc[j]);
            }
            float* mod = (float*)(F.ws + WS_MOD) + (size_t)l * 17 * NMOD + n;
#pragma unroll
            for (int j = 0; j < 17; ++j) mod[(size_t)j * NMOD] = acc[j];
        }
        __syncthreads();
    }
}

__device__ __forceinline__ void conv_item(const float* src0, const float* src1, int ldsrc, int nvalid, int mode, bf16_t* dst, int K, int item, LAS float* scr, int lane) {
    const int nkb = K / 64, kb = item % nkb, jb = item / nkb, k0 = 64 * kb, j0 = 32 * jb;
    const int jj = j0 + (lane & 31);
    const float* colp;
    if (mode == 0) colp = jj < nvalid ? src0 + jj : nullptr;
    else colp = ((jj & 4) ? src1 : src0) + 4 * (jj >> 3) + (jj & 3);
    float cv[32];
#pragma unroll
    for (int i = 0; i < 32; ++i) { const int kk = 2 * i + (lane >> 5); cv[i] = colp ? colp[(size_t)(k0 + kk) * ldsrc] : 0.f; }
#pragma unroll
    for (int i = 0; i < 32; ++i) { const int kk = 2 * i + (lane >> 5); scr[kk * 33 + (lane & 31)] = cv[i]; }
    asm volatile("s_waitcnt lgkmcnt(0)" ::: "memory");
    const int c = lane & 7;
#pragma unroll
    for (int j = 0; j < 4; ++j) { const int n = (lane >> 3) + 8 * j; const LAS float* s = scr + (8 * c) * 33 + n;
        u32x4 o; o.x = pk2(s[0 * 33], s[1 * 33]); o.y = pk2(s[2 * 33], s[3 * 33]); o.z = pk2(s[4 * 33], s[5 * 33]); o.w = pk2(s[6 * 33], s[7 * 33]);
        *(u32x4*)(dst + (size_t)(j0 + n) * K + k0 + 8 * c) = o; }
    asm volatile("s_waitcnt lgkmcnt(0)" ::: "memory");
}
__device__ __forceinline__ void convert_layer_weights(Frame& F, int l) {
    LAS float* scr = (LAS float*)(F.lds + F.wave * 8704);
    const int gw = F.bid * 8 + F.wave, NGW = F.G * 8;
    constexpr int I_IN = (1024 / 64) * (ZLD / 32), I_A = (512 / 64) * (1024 / 32), I_O = (1024 / 64) * (1024 / 32), I_13 = (1024 / 64) * (1024 / 32), I_2 = (512 / 64) * (1024 / 32);
    constexpr int NITEMS = I_IN + 2 * I_A + I_O + NE * I_13 + NE * I_2;
    for (int it = gw; it < NITEMS; it += NGW) {
        int r = it;
        if (r < I_IN) { conv_item(F.inp(IN_WIN) + (size_t)l * D * NIN, nullptr, NIN, NIN, 0, (bf16_t*)(F.ws + WS_WIN), 1024, r, scr, F.lane); continue; } r -= I_IN;
        if (r < I_A) { conv_item(F.inp(IN_WAO) + (size_t)l * DH * D, nullptr, D, D, 0, (bf16_t*)(F.ws + WS_WA), 512, r, scr, F.lane); continue; } r -= I_A;
        if (r < I_A) { conv_item(F.inp(IN_WBO) + (size_t)l * DH * D, nullptr, D, D, 0, (bf16_t*)(F.ws + WS_WB), 512, r, scr, F.lane); continue; } r -= I_A;
        if (r < I_O) { conv_item(F.inp(IN_WO) + (size_t)l * D * D, nullptr, D, D, 0, (bf16_t*)(F.ws + WS_WO), 1024, r, scr, F.lane); continue; } r -= I_O;
        if (r < NE * I_13) { const int e = r / I_13, ri = r % I_13; const size_t so = ((size_t)l * NE + e) * D * DFF;
            conv_item(F.inp(IN_W1) + so, F.inp(IN_W3) + so, DFF, 0, 1, (bf16_t*)(F.ws + WS_W13) + (size_t)e * 1024 * 1024, 1024, ri, scr, F.lane); continue; } r -= NE * I_13;
        { const int e = r / I_2, ri = r % I_2; const size_t so = ((size_t)l * NE + e) * DFF * D;
            conv_item(F.inp(IN_W2) + so, nullptr, D, D, 0, (bf16_t*)(F.ws + WS_W2) + (size_t)e * 1024 * 512, 512, ri, scr, F.lane); }
    }
}

__device__ __forceinline__ void combine_row(Frame& F, int lprev, int row, f32x4 (&v)[4]) {
    const bf16_t* YS = (const bf16_t*)(F.ws + WS_YS); const int* RS = (const int*)(F.ws + WS_RS); const float* RG = (const float*)(F.ws + WS_RG);
    const int mj = row < NCTX ? 16 : ((row - NCTX) >> 11);
    const float* g2 = (const float*)(F.ws + WS_MOD) + ((size_t)lprev * 17 + mj) * NMOD + 5120;
    const int s0 = RS[2 * row], s1 = RS[2 * row + 1]; const float ga = RG[2 * row], gb = RG[2 * row + 1];
#pragma unroll
    for (int j = 0; j < 4; ++j) {
        const int c = 4 * F.lane + 256 * j;
        const u32x2 y0 = *(const u32x2*)(YS + (size_t)s0 * D + c), y1 = *(const u32x2*)(YS + (size_t)s1 * D + c);
        const f32x4 gg = *(const f32x4*)(g2 + c);
        v[j][0] += gg[0] * (ga * bf2f(y0.x & 0xffffu) + gb * bf2f(y1.x & 0xffffu));
        v[j][1] += gg[1] * (ga * bf2f(y0.x >> 16) + gb * bf2f(y1.x >> 16));
        v[j][2] += gg[2] * (ga * bf2f(y0.y & 0xffffu) + gb * bf2f(y1.y & 0xffffu));
        v[j][3] += gg[3] * (ga * bf2f(y0.y >> 16) + gb * bf2f(y1.y >> 16));
    }
}
__device__ __forceinline__ void phase_norm1(int l, int rep_ = 0) {
    asm volatile("" : "+s"(l)); Frame F = make_frame();
    convert_layer_weights(F, l);
    const int gw = F.bid * 8 + F.wave, NGW = F.G * 8;
    const float* X = (const float*)(F.ws + WS_X); float* XW = rep_ ? (float*)(F.ws + WS_Z) : (float*)(F.ws + WS_X);
    bf16_t* H = rep_ ? (bf16_t*)(F.ws + WS_Z + 160 * MiB) : (bf16_t*)((unsigned char*)F.out + DO_H);
    const float* g1n = F.inp(IN_N1G) + l * D;
    for (int row = gw; row < NT; row += NGW) {
        const int mj = row < NCTX ? 16 : ((row - NCTX) >> 11);
        const float* mod = (const float*)(F.ws + WS_MOD) + ((size_t)l * 17 + mj) * NMOD;
        f32x4 v[4];
#pragma unroll
        for (int j = 0; j < 4; ++j) v[j] = *(const f32x4*)(X + (size_t)row * D + 4 * F.lane + 256 * j);
        if (l > 0) {
            combine_row(F, l - 1, row, v);
#pragma unroll
            for (int j = 0; j < 4; ++j) *(f32x4*)(XW + (size_t)row * D + 4 * F.lane + 256 * j) = v[j];
        }
        float ss = 0.f;
#pragma unroll
        for (int j = 0; j < 4; ++j) ss += v[j][0] * v[j][0] + v[j][1] * v[j][1] + v[j][2] * v[j][2] + v[j][3] * v[j][3];
        const float rs = rsqrtf(wave_sum(ss) * (1.0f / D) + NORM_EPS);
#pragma unroll
        for (int j = 0; j < 4; ++j) {
            const int c = 4 * F.lane + 256 * j;
            const f32x4 gg = *(const f32x4*)(g1n + c), sh = *(const f32x4*)(mod + c), sc = *(const f32x4*)(mod + 1024 + c);
            float o[4];
#pragma unroll
            for (int q = 0; q < 4; ++q) o[q] = v[j][q] * rs * gg[q] * (1.0f + sc[q]) + sh[q];
            u32x2 w; w.x = pk2(o[0], o[1]); w.y = pk2(o[2], o[3]);
            *(u32x2*)(H + (size_t)row * D + c) = w;
        }
    }
}

constexpr int PW_S64 = 144, PW_S128 = 272;
constexpr int PW_G = 4 * 64 * PW_S64;
constexpr int PA_OFF = PW_G + 64 * PW_S128;
constexpr int PA_STRIDE = 784;
static_assert(PA_OFF + 128 * PA_STRIDE <= LDS_CTL, "prep LDS map");
__device__ __forceinline__ float tanh_fast(float x) { return 1.0f - 2.0f * __builtin_amdgcn_rcpf(1.0f + fexp(2.0f * x)); }
__device__ __forceinline__ void unpack8(const u32x4 p, float (&o)[8]) {
#pragma unroll
    for (int j = 0; j < 4; ++j) { o[2 * j] = bf2f(p[j] & 0xffffu); o[2 * j + 1] = bf2f(p[j] >> 16); }
}
__device__ __forceinline__ u32x4 pack8(const float (&f)[8]) { u32x4 r; r.x = pk2(f[0], f[1]); r.y = pk2(f[2], f[3]); r.z = pk2(f[4], f[5]); r.w = pk2(f[6], f[7]); return r; }
__device__ __forceinline__ void shifted16(const bf16_t* Z, int row, bool hasp, bool hasn, int col, const float* mu, float (&o)[16]) {
    const bf16_t* p = Z + (size_t)row * ZLD + ZC_RW + col;
    const u32x4 z0 = *(const u32x4*)p, z1 = *(const u32x4*)(p + 8);
    const u32x4 zero = (u32x4){0u, 0u, 0u, 0u};
    const u32x4 m0 = hasp ? *(const u32x4*)(p - ZLD) : zero, m1 = hasp ? *(const u32x4*)(p - ZLD + 8) : zero;
    const u32x4 n0 = hasn ? *(const u32x4*)(p + ZLD) : zero, n1 = hasn ? *(const u32x4*)(p + ZLD + 8) : zero;
    float z[16], zm[16], zn[16];
    { float t[8]; unpack8(z0, t);
#pragma unroll
      for (int j = 0; j < 8; ++j) z[j] = t[j];
      unpack8(z1, t);
#pragma unroll
      for (int j = 0; j < 8; ++j) z[8 + j] = t[j];
      unpack8(m0, t);
#pragma unroll
      for (int j = 0; j < 8; ++j) zm[j] = t[j];
      unpack8(m1, t);
#pragma unroll
      for (int j = 0; j < 8; ++j) zm[8 + j] = t[j];
      unpack8(n0, t);
#pragma unroll
      for (int j = 0; j < 8; ++j) zn[j] = t[j];
      unpack8(n1, t);
#pragma unroll
      for (int j = 0; j < 8; ++j) zn[8 + j] = t[j]; }
#pragma unroll
    for (int q = 0; q < 4; ++q) { const f32x4 m = *(const f32x4*)(mu + col + 4 * q);
#pragma unroll
        for (int e = 0; e < 4; ++e) { const int j = 4 * q + e; o[j] = z[j] + m[e] * (0.5f * (zm[j] + zn[j]) - z[j]); } }
}
__device__ __forceinline__ void store16(bf16_t* dst, const float (&f)[16]) {
    u32x4 a, b; a.x = pk2(f[0], f[1]); a.y = pk2(f[2], f[3]); a.z = pk2(f[4], f[5]); a.w = pk2(f[6], f[7]); b.x = pk2(f[8], f[9]); b.y = pk2(f[10], f[11]); b.z = pk2(f[12], f[13]); b.w = pk2(f[14], f[15]);
    *(u32x4*)dst = a; *(u32x4*)(dst + 8) = b;
}
__device__ __forceinline__ void phase_prep(int l) {
    asm volatile("" : "+s"(l)); Frame F = make_frame();
    const int tid = F.tid, lane = F.lane, w = F.wave, tok = lane & 15, cq = lane >> 4;
    const bf16_t* Z = (const bf16_t*)(F.ws + WS_Z);
    const float* mu = F.inp(IN_SHMU) + l * RWC;
    float* BON = (float*)(F.ws + WS_BONUS);
    for (int unit = F.bid; unit < 256; unit += F.G) {
        const int h = unit & 7, rng = unit >> 3;
        __syncthreads();
#pragma unroll 1
        for (int o = 0; o < 5; ++o) {
            const float* src = o < 2 ? F.inp(IN_WUP) + (size_t)(l * 2 + o) * 64 * DH : (o < 4 ? F.inp(IN_AUP) + (size_t)(l * 2 + (o - 2)) * 64 * DH : F.inp(IN_GUP) + (size_t)l * 128 * DH);
            const int K = o < 4 ? 64 : 128, stride = o < 4 ? PW_S64 : PW_S128, off = o < 4 ? o * 64 * PW_S64 : PW_G;
            for (int idx = tid; idx < K * 64; idx += 512) { const int c = idx & 63, k = idx >> 6; const int rr = 16 * ((c >> 2) & 3) + 4 * (c >> 4) + (c & 3);
                *(LAS unsigned short*)(F.lds + off + rr * stride + 2 * k) = (unsigned short)f2bf(src[(size_t)k * DH + 64 * h + c]); }
        }
        __syncthreads();
#pragma unroll 1
        for (int ti = 0; ti < 9; ++ti) {
            const int row0 = rng * 1152 + ti * 128;
            const bool isctx = row0 < NCTX; const int T = isctx ? CTXL : SEQ; const int t0 = isctx ? (row0 & (CTXL - 1)) : ((row0 - NCTX) & (SEQ - 1));
#pragma unroll 2
            for (int gi = lane; gi < 16 * 48; gi += 64) {
                const int tl = gi / 48, g = gi - tl * 48, t = 16 * w + tl, ts = t0 + t;
                const bf16_t* zp = Z + (size_t)(row0 + t) * ZLD + ZC_RW + 1536 + 8 * g;
                const u32x4 zero = (u32x4){0u, 0u, 0u, 0u};
                const u32x4 zc = *(const u32x4*)zp, zm = ts > 0 ? *(const u32x4*)(zp - ZLD) : zero, zn = ts < T - 1 ? *(const u32x4*)(zp + ZLD) : zero;
                const f32x4 mA = *(const f32x4*)(mu + 1536 + 8 * g), mB = *(const f32x4*)(mu + 1536 + 8 * g + 4);
                float c8[8], m8[8], n8[8], o8[8]; unpack8(zc, c8); unpack8(zm, m8); unpack8(zn, n8);
#pragma unroll
                for (int j = 0; j < 8; ++j) { const float mm = j < 4 ? mA[j] : mB[j - 4]; const float zs = c8[j] + mm * (0.5f * (m8[j] + n8[j]) - c8[j]);
                    o8[j] = g < 16 ? tanh_fast(zs) : (g < 32 ? zs : sigmoidf_(zs)); }
                *(LAS u32x4*)(F.lds + PA_OFF + t * PA_STRIDE + 16 * g) = pack8(o8);
            }
            const int t = 16 * w + tok, row = row0 + t, ts = t0 + t; const bool hasp = ts > 0, hasn = ts < T - 1;
            const int cb = 64 * h + 16 * cq;
            f32x4 acc[5][4];
#pragma unroll
            for (int o = 0; o < 5; ++o)
#pragma unroll
                for (int nt = 0; nt < 4; ++nt) acc[o][nt] = (f32x4){0.f, 0.f, 0.f, 0.f};
            const LAS unsigned char* actp = F.lds + PA_OFF + (16 * w + tok) * PA_STRIDE + 16 * cq;
#pragma unroll
            for (int o = 0; o < 4; ++o)
#pragma unroll
                for (int ks = 0; ks < 2; ++ks) {
                    const bf16x8 bfrag = *(const LAS bf16x8*)(actp + (64 * o + 32 * ks) * 2);
#pragma unroll
                    for (int nt = 0; nt < 4; ++nt) { const bf16x8 afrag = *(const LAS bf16x8*)(F.lds + o * 64 * PW_S64 + (16 * nt + tok) * PW_S64 + (32 * ks + 8 * cq) * 2);
                        acc[o][nt] = __builtin_amdgcn_mfma_f32_16x16x32_bf16(afrag, bfrag, acc[o][nt], 0, 0, 0); }
                }
#pragma unroll
            for (int ks = 0; ks < 4; ++ks) {
                const bf16x8 bfrag = *(const LAS bf16x8*)(actp + (256 + 32 * ks) * 2);
#pragma unroll
                for (int nt = 0; nt < 4; ++nt) { const bf16x8 afrag = *(const LAS bf16x8*)(F.lds + PW_G + (16 * nt + tok) * PW_S128 + (32 * ks + 8 * cq) * 2);
                    acc[4][nt] = __builtin_amdgcn_mfma_f32_16x16x32_bf16(afrag, bfrag, acc[4][nt], 0, 0, 0); }
            }
            float rv[16], kv[16], vv[16];
            shifted16(Z, row, hasp, hasn, 1024 + cb, mu, vv);
            const size_t so = ((size_t)h * NT + row) * 64 + 16 * cq;
            shifted16(Z, row, hasp, hasn, 512 + cb, mu, kv);
            float kkv[16]; float ss = 0.f;
#pragma unroll
            for (int q = 0; q < 4; ++q) { const f32x4 kw = *(const f32x4*)(F.inp(IN_KK) + l * DH + cb + 4 * q);
#pragma unroll
                for (int e = 0; e < 4; ++e) { const float ku = kv[4 * q + e] * kw[e]; kkv[4 * q + e] = ku; ss += ku * ku; } }
            ss += __shfl_xor(ss, 16); ss += __shfl_xor(ss, 32);
            const float rs = rsqrtf(ss + 1e-12f);
#pragma unroll
            for (int j = 0; j < 16; ++j) kkv[j] *= rs;
            store16((bf16_t*)(F.ws + WS_V) + so, vv);
            shifted16(Z, row, hasp, hasn, cb, mu, rv);
            { float gv[16];
#pragma unroll
              for (int j = 0; j < 16; ++j) gv[j] = acc[4][j >> 2][j & 3];
              store16((bf16_t*)((unsigned char*)F.out + DO_G) + so, gv); }
            float bon = 0.f;
#pragma unroll
            for (int d = 0; d < 2; ++d) {
                float* gep = (float*)(F.ws + (d ? WS_GE1 : WS_GE0)) + ((size_t)h * (NT / 16) + (row >> 4)) * 64 + 16 * cq;
#pragma unroll
                for (int qq = 0; qq < 2; ++qq) {
                    float ktv[8], btv[8], kdtv[8], rtv[8], gev[8];
#pragma unroll
                    for (int q2 = 0; q2 < 2; ++q2) {
                        const int q = 2 * qq + q2;
                        const f32x4 w0 = *(const f32x4*)(F.inp(IN_W0) + (l * 2 + d) * DH + cb + 4 * q), a0 = *(const f32x4*)(F.inp(IN_A0) + (l * 2 + d) * DH + cb + 4 * q);
                        const f32x4 ka = *(const f32x4*)(F.inp(IN_KA) + l * DH + cb + 4 * q), rk = *(const f32x4*)(F.inp(IN_RK) + l * DH + cb + 4 * q);
#pragma unroll
                        for (int e = 0; e < 4; ++e) { const int j = 4 * q + e, j8 = 4 * q2 + e;
                            const float lw = -0.6065306597126334f * sigmoidf_(w0[e] + acc[d][q][e]);
                            const float a = sigmoidf_(a0[e] + acc[2 + d][q][e]);
                            const float kd = kv[j] * (1.0f + (a - 1.0f) * ka[e]);
                            bon += rv[j] * kd * rk[e];
                            float ci = lw;
                            if (d == 0) { ci += __int_as_float(__builtin_amdgcn_update_dpp(0, __float_as_int(ci), 0x111, 0xf, 0xf, true)); ci += __int_as_float(__builtin_amdgcn_update_dpp(0, __float_as_int(ci), 0x112, 0xf, 0xf, true));
                                          ci += __int_as_float(__builtin_amdgcn_update_dpp(0, __float_as_int(ci), 0x114, 0xf, 0xf, true)); ci += __int_as_float(__builtin_amdgcn_update_dpp(0, __float_as_int(ci), 0x118, 0xf, 0xf, true)); }
                            else        { ci += __int_as_float(__builtin_amdgcn_update_dpp(0, __float_as_int(ci), 0x101, 0xf, 0xf, true)); ci += __int_as_float(__builtin_amdgcn_update_dpp(0, __float_as_int(ci), 0x102, 0xf, 0xf, true));
                                          ci += __int_as_float(__builtin_amdgcn_update_dpp(0, __float_as_int(ci), 0x104, 0xf, 0xf, true)); ci += __int_as_float(__builtin_amdgcn_update_dpp(0, __float_as_int(ci), 0x108, 0xf, 0xf, true)); }
                            const float gam = fexp(ci), ig = __builtin_amdgcn_rcpf(gam);
                            const float gprev = d == 0 ? __int_as_float(__builtin_amdgcn_update_dpp(0x3f800000, __float_as_int(gam), 0x111, 0xf, 0xf, false)) : __int_as_float(__builtin_amdgcn_update_dpp(0x3f800000, __float_as_int(gam), 0x101, 0xf, 0xf, false));
                            ktv[j8] = gprev * kkv[j]; btv[j8] = kkv[j] * a * ig; kdtv[j8] = kd * ig; rtv[j8] = gam * rv[j]; gev[j8] = gam; }
                    }
                    *(u32x4*)((bf16_t*)(F.ws + (d ? WS_KT1 : WS_KT0)) + so + 8 * qq) = pack8(ktv); *(u32x4*)((bf16_t*)(F.ws + (d ? WS_BT1 : WS_BT0)) + so + 8 * qq) = pack8(btv);
                    *(u32x4*)((bf16_t*)(F.ws + (d ? WS_KDT1 : WS_KDT0)) + so + 8 * qq) = pack8(kdtv); *(u32x4*)((bf16_t*)(F.ws + (d ? WS_RT1 : WS_RT0)) + so + 8 * qq) = pack8(rtv);
                    if (tok == (d ? 0 : 15)) {
                        *(f32x4*)(gep + 8 * qq) = (f32x4){gev[0], gev[1], gev[2], gev[3]}; *(f32x4*)(gep + 8 * qq + 4) = (f32x4){gev[4], gev[5], gev[6], gev[7]};
                    }
                }
            }
            bon += __shfl_xor(bon, 16); bon += __shfl_xor(bon, 32);
            if (cq == 0) BON[(size_t)row * 8 + h] = bon;
        }
    }
    __syncthreads();
}

__device__ __forceinline__ int scan_row(int b, int dir, int i) {
    if (i < CTXL) return b * CTXL + (dir ? CTXL - 1 - i : i);
    const int j = i - CTXL; return NCTX + b * SEQ + (dir ? SEQ - 1 - j : j);
}
template <int CTRL> __device__ __forceinline__ float dpp_add(float x) {
    return x + __int_as_float(__builtin_amdgcn_update_dpp(0, __float_as_int(x), CTRL, 0xf, 0xf, true));
}
__device__ __forceinline__ float reduce16(float x) {
    x = dpp_add<0xB1>(x);
    x = dpp_add<0x4E>(x);
    x = dpp_add<0x141>(x);
    x = dpp_add<0x140>(x);
    return x;
}
constexpr int SC_T = 32, SC_REC = 320, SC_PBUF = SC_T * SC_REC + 128;
constexpr int SC_YOFF = 2 * SC_PBUF * 4;
typedef float f32x2v __attribute__((ext_vector_type(2)));
#define SC_PKMUL_LO(d, a, b)     asm("v_pk_mul_f32 %0, %1, %2 op_sel_hi:[1,0]" : "=v"(d) : "v"(a), "v"(b))
#define SC_PKMUL_HI(d, a, b)     asm("v_pk_mul_f32 %0, %1, %2 op_sel:[0,1] op_sel_hi:[1,1]" : "=v"(d) : "v"(a), "v"(b))
#define SC_PKFMA_LO(d, a, b, c)  asm("v_pk_fma_f32 %0, %1, %2, %3 op_sel_hi:[1,0,1]" : "=v"(d) : "v"(a), "v"(b), "v"(c))
#define SC_PKFMA_HI(d, a, b, c)  asm("v_pk_fma_f32 %0, %1, %2, %3 op_sel:[0,1,0] op_sel_hi:[1,1,1]" : "=v"(d) : "v"(a), "v"(b), "v"(c))
#define SC_PKFMAN_LO(d, a, b, c) asm("v_pk_fma_f32 %0, %1, %2, %3 op_sel_hi:[1,0,1] neg_lo:[1,0,0] neg_hi:[1,0,0]" : "=v"(d) : "v"(a), "v"(b), "v"(c))
#define SC_PKFMAN_HI(d, a, b, c) asm("v_pk_fma_f32 %0, %1, %2, %3 op_sel:[0,1,0] op_sel_hi:[1,1,1] neg_lo:[1,0,0] neg_hi:[1,0,0]" : "=v"(d) : "v"(a), "v"(b), "v"(c))
#define SC_DPP4(a, b, c, d, CTRL) asm("s_nop 1\n\tv_add_f32_dpp %0, %0, %0 " CTRL " row_mask:0xf bank_mask:0xf\n\tv_add_f32_dpp %1, %1, %1 " CTRL " row_mask:0xf bank_mask:0xf\n\t" \
        "v_add_f32_dpp %2, %2, %2 " CTRL " row_mask:0xf bank_mask:0xf\n\tv_add_f32_dpp %3, %3, %3 " CTRL " row_mask:0xf bank_mask:0xf" : "+v"(a), "+v"(b), "+v"(c), "+v"(d))
#define SC_DPP2(a, b, CTRL) asm("s_nop 1\n\tv_add_f32_dpp %0, %0, %0 " CTRL " row_mask:0xf bank_mask:0xf\n\tv_add_f32_dpp %1, %1, %1 " CTRL " row_mask:0xf bank_mask:0xf\n\ts_nop 0" : "+v"(a), "+v"(b))
template <int VAR> __device__ __forceinline__ void phase_scan(int l) {
    asm volatile("" : "+s"(l)); Frame F = make_frame();
    const int tid = F.tid, q = tid & 15, rp = tid >> 4;
    LAS float* P = (LAS float*)F.lds; LAS float* YB = (LAS float*)(F.lds + SC_YOFF);
    const bf16_t* V = (const bf16_t*)(F.ws + WS_V);
    constexpr int NCH = (CTXL + SEQ) / SC_T;
    for (int task = F.bid; task < NBATCH * 8 * 2; task += F.G) {
        const int dir = task & 1, h = (task >> 1) & 7, b = task >> 4;
        const bf16_t* KT = (const bf16_t*)(F.ws + (dir ? WS_KT1 : WS_KT0)); const bf16_t* BT = (const bf16_t*)(F.ws + (dir ? WS_BT1 : WS_BT0));
        const bf16_t* KDT = (const bf16_t*)(F.ws + (dir ? WS_KDT1 : WS_KDT0)); const bf16_t* RT = (const bf16_t*)(F.ws + (dir ? WS_RT1 : WS_RT0));
        const float* GE = (const float*)(F.ws + (dir ? WS_GE1 : WS_GE0)) + (size_t)h * (NT / 16) * 64;
        bf16_t* Y = (bf16_t*)(F.ws + (dir ? WS_Y1 : WS_Y0));
        u32x4 stg[3]; f32x4 gstg;
#define SC_LOAD(c) do { _Pragma("unroll") for (int j = 0; j < 3; ++j) { const int u = tid + 512 * j, a = u >> 8, s_ = (u >> 3) & 31, o = u & 7; \
            const bf16_t* src = a == 0 ? KT : a == 1 ? BT : a == 2 ? KDT : a == 3 ? RT : V; \
            if (u < 1280) stg[j] = *(const u32x4*)(src + ((size_t)h * NT + scan_row(b, dir, (c) * SC_T + s_)) * 64 + 8 * o); } \
            if (tid < 32) gstg = *(const f32x4*)(GE + (size_t)(scan_row(b, dir, (c) * SC_T + 16 * (tid >> 4)) >> 4) * 64 + 4 * (tid & 15)); } while (0)
#define SC_STORE(c) do { _Pragma("unroll") for (int j = 0; j < 3; ++j) { const int u = tid + 512 * j, a = u >> 8, s_ = (u >> 3) & 31, o = u & 7; \
            if (u < 1280) { float f[8]; _Pragma("unroll") for (int e = 0; e < 4; ++e) { f[2 * e] = bf2f(stg[j][e] & 0xffffu); f[2 * e + 1] = bf2f(stg[j][e] >> 16); } \
            LAS float* dst = P + ((c) & 1) * SC_PBUF + s_ * SC_REC + a * 64 + 8 * o; \
            *(LAS f32x4*)dst = (f32x4){f[0], f[1], f[2], f[3]}; *(LAS f32x4*)(dst + 4) = (f32x4){f[4], f[5], f[6], f[7]}; } } \
            if (tid < 32) *(LAS f32x4*)(P + ((c) & 1) * SC_PBUF + SC_T * SC_REC + 4 * tid) = gstg; } while (0)
        f32x2v S[4];
#pragma unroll
        for (int e = 0; e < 4; ++e) S[e] = (f32x2v){0.f, 0.f};
        __syncthreads();
        SC_LOAD(0); SC_STORE(0);
        __syncthreads();
        for (int c = 0; c < NCH; ++c) {
            if (c + 1 < NCH) SC_LOAD(c + 1);
            if (c > 0) {
                const int s_ = tid >> 4, r4 = (tid & 15) * 4;
                const f32x4 yv = *(const LAS f32x4*)(YB + ((c - 1) & 1) * (SC_T * 64) + s_ * 64 + r4);
                u32x2 wv; wv.x = pk2(yv[0], yv[1]); wv.y = pk2(yv[2], yv[3]);
                if (VAR == 0) *(u32x2*)(Y + (size_t)scan_row(b, dir, (c - 1) * SC_T + s_) * DH + 64 * h + r4) = wv;
            }
            const LAS float* pb = P + (c & 1) * SC_PBUF + 4 * q;
            LAS float* yb = YB + (c & 1) * (SC_T * 64) + 2 * rp;
#pragma unroll
            for (int hb = 0; hb < 2; ++hb) {
                const LAS float* ph = pb + hb * 16 * SC_REC;
                f32x4 kt = *(const LAS f32x4*)(ph), bt = *(const LAS f32x4*)(ph + 64), kdt = *(const LAS f32x4*)(ph + 128), rt = *(const LAS f32x4*)(ph + 192);
                f32x2v vv = *(const LAS f32x2v*)(ph + 256 - 4 * q + 2 * rp);
                float y0 = 0.f, y1 = 0.f;
#pragma unroll
                for (int s_ = 0; s_ < 16; ++s_) {
                    const LAS float* pn = ph + (s_ + 1 < 16 ? s_ + 1 : s_) * SC_REC;
                    const f32x4 ktn = *(const LAS f32x4*)(pn), btn = *(const LAS f32x4*)(pn + 64), kdtn = *(const LAS f32x4*)(pn + 128), rtn = *(const LAS f32x4*)(pn + 192);
                    const f32x2v vvn = *(const LAS f32x2v*)(pn + 256 - 4 * q + 2 * rp);
                    const f32x2v kt01 = (f32x2v){kt[0], kt[1]}, kt23 = (f32x2v){kt[2], kt[3]}, bt01 = (f32x2v){bt[0], bt[1]}, bt23 = (f32x2v){bt[2], bt[3]};
                    const f32x2v kd01 = (f32x2v){kdt[0], kdt[1]}, kd23 = (f32x2v){kdt[2], kdt[3]}, rt01 = (f32x2v){rt[0], rt[1]}, rt23 = (f32x2v){rt[2], rt[3]};
                    f32x2v sa;
                    SC_PKMUL_LO(sa, S[0], kt01); SC_PKFMA_HI(sa, S[1], kt01, sa); SC_PKFMA_LO(sa, S[2], kt23, sa); SC_PKFMA_HI(sa, S[3], kt23, sa);
                    float sa0 = sa.x, sa1 = sa.y;
                    if (VAR != 2) {
                    SC_DPP4(sa0, sa1, y0, y1, "quad_perm:[1,0,3,2]");
                    SC_DPP4(sa0, sa1, y0, y1, "quad_perm:[2,3,0,1]");
                    SC_DPP4(sa0, sa1, y0, y1, "row_half_mirror");
                    SC_DPP4(sa0, sa1, y0, y1, "row_mirror"); }
                    if (s_ > 0 && q == 0) { yb[(hb * 16 + s_ - 1) * 64] = y0; yb[(hb * 16 + s_ - 1) * 64 + 1] = y1; }
                    sa = (f32x2v){sa0, sa1};
                    f32x2v yy;
                    if (VAR != 3) {
                    SC_PKFMA_LO(S[0], vv, kd01, S[0]); SC_PKFMA_HI(S[1], vv, kd01, S[1]); SC_PKFMA_LO(S[2], vv, kd23, S[2]); SC_PKFMA_HI(S[3], vv, kd23, S[3]);
                    SC_PKFMAN_LO(S[0], sa, bt01, S[0]); SC_PKFMAN_HI(S[1], sa, bt01, S[1]); SC_PKFMAN_LO(S[2], sa, bt23, S[2]); SC_PKFMAN_HI(S[3], sa, bt23, S[3]);
                    SC_PKMUL_LO(yy, S[0], rt01); SC_PKFMA_HI(yy, S[1], rt01, yy); SC_PKFMA_LO(yy, S[2], rt23, yy); SC_PKFMA_HI(yy, S[3], rt23, yy);
                    } else { SC_PKFMAN_LO(S[0], sa, bt01, S[0]); SC_PKMUL_LO(yy, S[0], rt01); }
                    y0 = yy.x; y1 = yy.y;
                    kt = ktn; bt = btn; kdt = kdtn; rt = rtn; vv = vvn;
                }
                SC_DPP2(y0, y1, "quad_perm:[1,0,3,2]"); SC_DPP2(y0, y1, "quad_perm:[2,3,0,1]"); SC_DPP2(y0, y1, "row_half_mirror"); SC_DPP2(y0, y1, "row_mirror");
                if (q == 0) { yb[(hb * 16 + 15) * 64] = y0; yb[(hb * 16 + 15) * 64 + 1] = y1; }
                const f32x4 ge = *(const LAS f32x4*)(pb + SC_T * SC_REC + hb * 64);
#pragma unroll
                for (int e = 0; e < 4; ++e) S[e] *= ge[e];
            }
            if (c + 1 < NCH) SC_STORE(c + 1);
            __syncthreads();
        }
        {
            const int s_ = tid >> 4, r4 = (tid & 15) * 4;
            const f32x4 yv = *(const LAS f32x4*)(YB + ((NCH - 1) & 1) * (SC_T * 64) + s_ * 64 + r4);
            u32x2 wv; wv.x = pk2(yv[0], yv[1]); wv.y = pk2(yv[2], yv[3]);
            if (VAR == 0) *(u32x2*)(Y + (size_t)scan_row(b, dir, (NCH - 1) * SC_T + s_) * DH + 64 * h + r4) = wv;
        }
#undef SC_LOAD
#undef SC_STORE
    }
    __syncthreads();
}

typedef short bf16x4 __attribute__((ext_vector_type(4)));
__device__ __forceinline__ bf16x4 cvt4(const f32x4 v) { u32x2 r; r.x = pk2(v[0], v[1]); r.y = pk2(v[2], v[3]); return __builtin_bit_cast(bf16x4, r); }
__device__ __forceinline__ f32x4 unpk4(const bf16x4 p) { const u32x2 r = __builtin_bit_cast(u32x2, p); return (f32x4){bf2f(r.x & 0xffffu), bf2f(r.x >> 16), bf2f(r.y & 0xffffu), bf2f(r.y >> 16)}; }
#define MFMA16(a, b, c) __builtin_amdgcn_mfma_f32_16x16x16bf16_1k(a, b, c, 0, 0, 0)
constexpr int CS_RS = 144, CS_ARR = 32 * CS_RS;
constexpr int CS_TS = 40, CS_TBLK = 64 * CS_TS;
constexpr int CS_KDTT = 4 * CS_ARR, CS_BTT = CS_KDTT + 2 * CS_TBLK, CS_VT = CS_BTT + 2 * CS_TBLK, CS_GE = CS_VT + 2 * CS_TBLK, CS_PB = CS_GE + 512;
constexpr int CS_GB0 = 3 * CS_PB;
constexpr int CS_GS = 40, CS_GMAT = 16 * CS_GS, CS_ABT = 4 * CS_GMAT, CS_GBLK = 3840, CS_GB = 2 * CS_GBLK;
constexpr int CS_YB = CS_GB0 + 2 * CS_GB;
static_assert(CS_YB + 2 * 8192 <= LDS_CTL, "chunked scan LDS map");
template <int SDBG> __device__ __forceinline__ void phase_scan_mfma(int l) {
    asm volatile("" : "+s"(l)); Frame F = make_frame();
    const int lane = F.lane, wave = F.wave, c16 = lane & 15, g4 = lane >> 4;
    const bool is_state = wave < 4;
    LAS unsigned char* lds = F.lds; LAS float* YB = (LAS float*)(F.lds + CS_YB);
    constexpr int NCH = (CTXL + SEQ) / 32;
    for (int task = F.bid; task < NBATCH * 8 * 2; task += F.G) {
        const int dir = task & 1, h = (task >> 1) & 7, b = task >> 4;
        const unsigned char* wsb = F.ws;
        const unsigned oKT = (unsigned)(dir ? WS_KT1 : WS_KT0), oBT = (unsigned)(dir ? WS_BT1 : WS_BT0), oKDT = (unsigned)(dir ? WS_KDT1 : WS_KDT0), oRT = (unsigned)(dir ? WS_RT1 : WS_RT0);
        const unsigned oGE = (unsigned)(dir ? WS_GE1 : WS_GE0) + (unsigned)h * (NT / 16) * 256u, oY = (unsigned)(dir ? WS_Y1 : WS_Y0);
        u32x4 stg[10]; f32x4 gstg;
#define CS_LOAD(cc) do { _Pragma("unroll") for (int jj = 0; jj < 10; ++jj) { const int a = jj >> 1, idx = hq * 64 + lane + 128 * (jj & 1), s_ = idx >> 3, o = idx & 7; \
            const unsigned ao = a == 0 ? oKT : a == 1 ? oRT : a == 2 ? oKDT : a == 3 ? oBT : (unsigned)WS_V; \
            stg[jj] = *(const u32x4*)(wsb + (ao + ((unsigned)(h * NT + scan_row(b, dir, (cc) * 32 + s_)) * 128u + 16u * o))); } \
            gstg = *(const f32x4*)(wsb + (oGE + (unsigned)(scan_row(b, dir, (cc) * 32 + 16 * ((lane >> 4) & 1)) >> 4) * 256u + 16u * (lane & 15))); } while (0)
#define CS_STORE(pbi) do { LAS unsigned char* pbs = lds + (pbi) * CS_PB; _Pragma("unroll") for (int jj = 0; jj < 10; ++jj) { const int a = jj >> 1, idx = hq * 64 + lane + 128 * (jj & 1), s_ = idx >> 3, o = idx & 7; \
            if (a < 4) *(LAS u32x4*)(pbs + a * CS_ARR + s_ * CS_RS + 16 * o) = stg[jj]; \
            if (a >= 2) { LAS unsigned char* tb = pbs + (a == 2 ? CS_KDTT : (a == 3 ? CS_BTT : CS_VT)) + (s_ >> 4) * CS_TBLK + (8 * o) * CS_TS + 2 * (s_ & 15); \
                _Pragma("unroll") for (int e = 0; e < 4; ++e) { *(LAS unsigned short*)(tb + (2 * e) * CS_TS) = (unsigned short)(stg[jj][e] & 0xffffu); *(LAS unsigned short*)(tb + (2 * e + 1) * CS_TS) = (unsigned short)(stg[jj][e] >> 16); } } } \
            if (hq == 0 && lane < 32) *(LAS f32x4*)(pbs + CS_GE + (lane >> 4) * 256 + 16 * (lane & 15)) = gstg; } while (0)
#define CS_GRAM(pbi, gbi, bq) do { const LAS unsigned char* pbg = lds + (pbi) * CS_PB; LAS unsigned char* gb = lds + CS_GB0 + (gbi) * CS_GB + (bq) * CS_GBLK; \
            const int rowoff = (16 * (bq) + c16) * CS_RS + 16 * g4; \
            _Pragma("unroll") for (int mat = 0; mat < 4; ++mat) { f32x4 acc = (f32x4){0.f, 0.f, 0.f, 0.f}; \
                _Pragma("unroll") for (int ks = 0; ks < 2; ++ks) { const bf16x8 av = *(const LAS bf16x8*)(pbg + (mat < 2 ? 0 : 1) * CS_ARR + rowoff + 64 * ks); \
                    const bf16x8 bv = *(const LAS bf16x8*)(pbg + ((mat & 1) ? 3 : 2) * CS_ARR + rowoff + 64 * ks); acc = __builtin_amdgcn_mfma_f32_16x16x32_bf16(av, bv, acc, 0, 0, 0); } \
                _Pragma("unroll") for (int rg = 0; rg < 4; ++rg) { const int t = 4 * g4 + rg; const bool keep = mat < 2 ? (c16 < t) : (c16 <= t); const float val = keep ? acc[rg] : 0.f; \
                    if (mat == 1) *(LAS float*)(gb + CS_ABT + (t * 17 + c16) * 4) = val; \
                    else *(LAS unsigned short*)(gb + (mat == 0 ? 0 : (mat == 2 ? 1 : 2)) * CS_GMAT + t * CS_GS + 2 * c16) = (unsigned short)f2bf(val); } } \
            { float colv[16]; const LAS float* abt = (const LAS float*)(gb + CS_ABT); \
              _Pragma("unroll") for (int t = 0; t < 16; ++t) { float a_ = (t == c16) ? 1.f : 0.f; _Pragma("unroll") for (int s2 = 0; s2 < t; ++s2) a_ = fmaf(-abt[t * 17 + s2], colv[s2], a_); colv[t] = a_; } \
              if (lane < 16) { _Pragma("unroll") for (int t = 0; t < 16; ++t) *(LAS unsigned short*)(gb + 3 * CS_GMAT + t * CS_GS + 2 * c16) = (unsigned short)f2bf(colv[t]); } } } while (0)
#define CS_FLUSH(cc) do { _Pragma("unroll") for (int p_ = 0; p_ < 2; ++p_) { const int s_ = (lane >> 3) + 8 * p_ + 16 * hq, r8 = 8 * (lane & 7); const LAS float* yp = YB + ((cc) & 1) * 2048 + s_ * 64 + r8; \
            const f32x4 ya = *(const LAS f32x4*)yp, yb2 = *(const LAS f32x4*)(yp + 4); u32x4 wv; wv.x = pk2(ya[0], ya[1]); wv.y = pk2(ya[2], ya[3]); wv.z = pk2(yb2[0], yb2[1]); wv.w = pk2(yb2[2], yb2[3]); \
            *(u32x4*)(const_cast<unsigned char*>(wsb) + (oY + (unsigned)scan_row(b, dir, (cc) * 32 + s_) * 1024u + 128u * h + 2u * r8)) = wv; } } while (0)
#define CS_STATE(c, P0) do { \
                const int m = wave; \
_Pragma("unroll") \
                for (int blk = 0; blk < 2; ++blk) { \
                    const LAS unsigned char* pb = lds + (P0) * CS_PB; const LAS unsigned char* gb = lds + CS_GB0 + ((c) & 1) * CS_GB + blk * CS_GBLK; \
                    const LAS unsigned char* rowb = pb + (16 * blk + c16) * CS_RS + 8 * g4; \
                    bf16x4 hi[4]; \
_Pragma("unroll") \
                    for (int j = 0; j < 4; ++j) hi[j] = cvt4(H[j]); \
                    bf16x4 ak[4], ar[4]; \
_Pragma("unroll") \
                    for (int j = 0; j < 4; ++j) { ak[j] = *(const LAS bf16x4*)(rowb + 32 * j); ar[j] = *(const LAS bf16x4*)(rowb + CS_ARR + 32 * j); } \
                    const bf16x4 vt = *(const LAS bf16x4*)(pb + CS_VT + blk * CS_TBLK + (16 * m + c16) * CS_TS + 8 * g4); \
                    const f32x4 z4 = (f32x4){0.f, 0.f, 0.f, 0.f}; \
                    f32x4 wa = MFMA16(ak[0], hi[0], z4), wb = MFMA16(ak[2], hi[2], z4), ya = MFMA16(ar[0], hi[0], z4), yb_ = MFMA16(ar[2], hi[2], z4); \
                    wa = MFMA16(ak[1], hi[1], wa); wb = MFMA16(ak[3], hi[3], wb); ya = MFMA16(ar[1], hi[1], ya); yb_ = MFMA16(ar[3], hi[3], yb_); \
                    if (SCAN_HILO) { bf16x4 lo[4]; _Pragma("unroll") for (int j = 0; j < 4; ++j) lo[j] = cvt4(H[j] - unpk4(hi[j])); \
                        wa = MFMA16(ak[0], lo[0], wa); wb = MFMA16(ak[2], lo[2], wb); ya = MFMA16(ar[0], lo[0], ya); yb_ = MFMA16(ar[2], lo[2], yb_); \
                        wa = MFMA16(ak[1], lo[1], wa); wb = MFMA16(ak[3], lo[3], wb); ya = MFMA16(ar[1], lo[1], ya); yb_ = MFMA16(ar[3], lo[3], yb_); } \
                    wb = MFMA16(*(const LAS bf16x4*)(gb + c16 * CS_GS + 8 * g4), vt, wb); \
                    ya = MFMA16(*(const LAS bf16x4*)(gb + CS_GMAT + c16 * CS_GS + 8 * g4), vt, ya); \
                    const f32x4 wt = wa + wb; \
                    const f32x4 ut = MFMA16(*(const LAS bf16x4*)(gb + 3 * CS_GMAT + c16 * CS_GS + 8 * g4), cvt4(wt), z4); \
                    const bf16x4 utn = cvt4(-ut); \
                    yb_ = MFMA16(*(const LAS bf16x4*)(gb + 2 * CS_GMAT + c16 * CS_GS + 8 * g4), utn, yb_); \
_Pragma("unroll") \
                    for (int j = 0; j < 4; ++j) { \
                        const bf16x4 a1 = *(const LAS bf16x4*)(pb + CS_KDTT + blk * CS_TBLK + (16 * j + c16) * CS_TS + 8 * g4), a2 = *(const LAS bf16x4*)(pb + CS_BTT + blk * CS_TBLK + (16 * j + c16) * CS_TS + 8 * g4); \
                        H[j] = MFMA16(a1, vt, H[j]); H[j] = MFMA16(a2, utn, H[j]); \
                        const f32x4 ge = *(const LAS f32x4*)(pb + CS_GE + blk * 256 + (16 * j + 4 * g4) * 4); \
                        H[j] = H[j] * ge; \
                    } \
                    const f32x4 yt = ya + yb_; \
_Pragma("unroll") \
                    for (int rg = 0; rg < 4; ++rg) YB[((c) & 1) * 2048 + (16 * blk + 4 * g4 + rg) * 64 + 16 * m + c16] = yt[rg]; \
                } \
            } while (0)
        f32x4 H[4];
#pragma unroll
        for (int j = 0; j < 4; ++j) H[j] = (f32x4){0.f, 0.f, 0.f, 0.f};
        __syncthreads();
        const int hw = wave - 4, hp = hw >> 1, hq = hw & 1;
        if (!is_state) { CS_LOAD(hp); CS_STORE(hp); CS_LOAD(hp + 2); }
        __syncthreads();
        if (!is_state) { if (!(SDBG & 2)) { if (hp == 1) CS_GRAM(0, 0, hq); } }
        __syncthreads();
#define CS_ITER(c, P0, P1, P2) do { \
            if (is_state) { if (!(SDBG & 1)) { CS_STATE(c, P0); } } \
            else if (hp == ((c) & 1)) { CS_STORE(P2); CS_LOAD(((c) + 4 < NCH ? (c) + 4 : NCH - 1)); if (!(SDBG & 4)) { if ((c) > 0) CS_FLUSH((c) - 1); } } \
            else { if (!(SDBG & 2)) { if ((c) + 1 < NCH) CS_GRAM(P1, ((c) + 1) & 1, hq); } } \
            asm volatile("s_waitcnt lgkmcnt(0)" ::: "memory"); __builtin_amdgcn_s_barrier(); asm volatile("" ::: "memory"); } while (0)
        for (int c3 = 0; c3 < NCH; c3 += 3) { CS_ITER(c3, 0, 1, 2); CS_ITER(c3 + 1, 1, 2, 0); CS_ITER(c3 + 2, 2, 0, 1); }
#undef CS_ITER
        if (!(SDBG & 4)) { if (!is_state && hp == 0) CS_FLUSH(NCH - 1); }
#undef CS_LOAD
#undef CS_STATE
#undef CS_STORE
#undef CS_GRAM
#undef CS_FLUSH
    }
    __syncthreads();
}

__device__ __forceinline__ void phase_mix(int l) {
    asm volatile("" : "+s"(l)); Frame F = make_frame();
    const int lane = F.lane, c0 = 8 * lane, hh = lane >> 3;
    const int gw = F.bid * 8 + F.wave, NGW = F.G * 8;
    const bf16_t* Z = (const bf16_t*)(F.ws + WS_Z);
    const float* cw = F.inp(IN_CONVW) + (size_t)l * 3 * DH;
    float cw0[8], cw1[8], cw2[8], lgv[8], lbv[8];
#pragma unroll
    for (int j = 0; j < 8; ++j) { cw0[j] = cw[c0 + j]; cw1[j] = cw[DH + c0 + j]; cw2[j] = cw[2 * DH + c0 + j]; lgv[j] = F.inp(IN_LNG)[l * DH + c0 + j]; lbv[j] = F.inp(IN_LNB)[l * DH + c0 + j]; }
    const bf16_t* Y0 = (const bf16_t*)(F.ws + WS_Y0); const bf16_t* Y1 = (const bf16_t*)(F.ws + WS_Y1); const bf16_t* V = (const bf16_t*)(F.ws + WS_V);
    const bf16_t* Gi = (const bf16_t*)((unsigned char*)F.out + DO_G); const float* BON = (const float*)(F.ws + WS_BONUS);
    bf16_t* UA = (bf16_t*)(F.ws + WS_UA); bf16_t* UB = (bf16_t*)(F.ws + WS_UB);
    for (int row = gw; row < NT; row += NGW) {
        int delta; bool hasp, hasn;
        if (row < NCTX) { const int t = row & (CTXL - 1); delta = 1; hasp = t > 0; hasn = t < CTXL - 1; }
        else { const int sq = (row - NCTX) & (SEQ - 1);
            if (c0 < 256) { const int gc = sq & 63; delta = 1; hasp = gc > 0; hasn = gc < 63; }
            else { const int gr = sq >> 6; delta = 64; hasp = gr > 0; hasn = gr < 31; } }
        const bf16_t* zr = Z + (size_t)row * ZLD;
        const u32x4 zero = (u32x4){0u, 0u, 0u, 0u};
        const u32x4 bg = *(const u32x4*)(zr + ZC_BG + c0), cg = *(const u32x4*)(zr + ZC_CG + c0), ha = *(const u32x4*)(zr + ZC_HA + c0);
        const u32x4 cgm = hasp ? *(const u32x4*)(zr + ZC_CG + c0 - (ptrdiff_t)delta * ZLD) : zero, ham = hasp ? *(const u32x4*)(zr + ZC_HA + c0 - (ptrdiff_t)delta * ZLD) : zero;
        const u32x4 cgp = hasn ? *(const u32x4*)(zr + ZC_CG + c0 + (ptrdiff_t)delta * ZLD) : zero, hap = hasn ? *(const u32x4*)(zr + ZC_HA + c0 + (ptrdiff_t)delta * ZLD) : zero;
        const size_t o = (size_t)row * DH + c0, oh = ((size_t)hh * NT + row) * 64 + (c0 & 63);
        const u32x4 y0p = *(const u32x4*)(Y0 + o), y1p = *(const u32x4*)(Y1 + o), vp = *(const u32x4*)(V + oh), gp = *(const u32x4*)(Gi + oh);
        const float bon = BON[(size_t)row * 8 + hh];
        float fb[8], fc[8], fh[8], fcm[8], fhm[8], fcp[8], fhp[8], ua[8];
        unpack8(bg, fb); unpack8(cg, fc); unpack8(ha, fh); unpack8(cgm, fcm); unpack8(ham, fhm); unpack8(cgp, fcp); unpack8(hap, fhp);
#pragma unroll
        for (int j = 0; j < 8; ++j) ua[j] = fb[j] * (fcm[j] * fhm[j] * cw0[j] + fc[j] * fh[j] * cw1[j] + fcp[j] * fhp[j] * cw2[j]);
        *(u32x4*)(UA + o) = pack8(ua);
        float ya[8], yb[8], fv[8], fg[8], ub[8]; unpack8(y0p, ya); unpack8(y1p, yb); unpack8(vp, fv); unpack8(gp, fg);
        float sm = 0.f;
#pragma unroll
        for (int j = 0; j < 8; ++j) { ya[j] += yb[j]; sm += ya[j]; }
        sm = dpp_add<0xB1>(sm); sm = dpp_add<0x4E>(sm); sm = dpp_add<0x141>(sm);
        const float mu = sm * (1.0f / 64.0f); float sq2 = 0.f;
#pragma unroll
        for (int j = 0; j < 8; ++j) { ya[j] -= mu; sq2 += ya[j] * ya[j]; }
        sq2 = dpp_add<0xB1>(sq2); sq2 = dpp_add<0x4E>(sq2); sq2 = dpp_add<0x141>(sq2);
        const float rstd = rsqrtf(sq2 * (1.0f / 64.0f) + GN_EPS);
#pragma unroll
        for (int j = 0; j < 8; ++j) ub[j] = (ya[j] * rstd * lgv[j] + lbv[j] + bon * fv[j]) * fg[j];
        *(u32x4*)(UB + o) = pack8(ub);
    }
}

constexpr int N2_STRIDE = 1028;
constexpr int N2_PART = 16 * N2_STRIDE * 4;
constexpr int N2_HIST = N2_PART + 8 * 16 * 48 * 4;
__device__ __forceinline__ void phase_norm2(int l) {
    asm volatile("" : "+s"(l)); Frame F = make_frame();
    const int lane = F.lane, w = F.wave;
    LAS float* HT = (LAS float*)F.lds; LAS float* PART = (LAS float*)(F.lds + N2_PART); LAS int* hist = (LAS int*)(F.lds + N2_HIST);
    const float* X = (const float*)(F.ws + WS_X); bf16_t* H = (bf16_t*)((unsigned char*)F.out + DO_H);
    const float* g2n = F.inp(IN_N2G) + l * D;
    const float* WC = (const float*)(F.ws + WS_WC) + (size_t)l * 1024 * 48; const float* RB = (const float*)(F.ws + WS_RB) + l * 48;
    int* RE = (int*)(F.ws + WS_RE); float* RG = (float*)(F.ws + WS_RG); int* RP = (int*)(F.ws + WS_RP);
    if (F.tid < 32) hist[F.tid] = 0;
    float Bv[32][3];
    { const int kg = lane >> 4, cc = lane & 15;
#pragma unroll
      for (int s_ = 0; s_ < 32; ++s_)
#pragma unroll
          for (int t = 0; t < 3; ++t) Bv[s_][t] = WC[(size_t)(256 * kg + 32 * w + s_) * 48 + 16 * t + cc]; }
    __syncthreads();
    for (int tile = F.bid; tile < NT / 16; tile += F.G) {
        const int row0 = tile * 16;
#pragma unroll
        for (int rr = 0; rr < 2; ++rr) {
            const int lr = 2 * w + rr, row = row0 + lr;
            const int mj = row < NCTX ? 16 : ((row - NCTX) >> 11);
            const float* mod = (const float*)(F.ws + WS_MOD) + ((size_t)l * 17 + mj) * NMOD;
            f32x4 v[4]; float ss = 0.f;
#pragma unroll
            for (int j = 0; j < 4; ++j) { v[j] = *(const f32x4*)(X + (size_t)row * D + 4 * lane + 256 * j); ss += v[j][0] * v[j][0] + v[j][1] * v[j][1] + v[j][2] * v[j][2] + v[j][3] * v[j][3]; }
            const float rs = rsqrtf(wave_sum(ss) * (1.0f / D) + NORM_EPS);
#pragma unroll
            for (int j = 0; j < 4; ++j) {
                const int c = 4 * lane + 256 * j;
                const f32x4 gg = *(const f32x4*)(g2n + c), sh = *(const f32x4*)(mod + 3072 + c), sc = *(const f32x4*)(mod + 4096 + c);
                f32x4 o;
#pragma unroll
                for (int q = 0; q < 4; ++q) o[q] = v[j][q] * rs * gg[q] * (1.0f + sc[q]) + sh[q];
                u32x2 wv; wv.x = pk2(o[0], o[1]); wv.y = pk2(o[2], o[3]);
                *(u32x2*)(H + (size_t)row * D + c) = wv;
                *(LAS f32x4*)(HT + lr * N2_STRIDE + c) = o;
            }
        }
        __syncthreads();
        {
            f32x4 acc[3];
#pragma unroll
            for (int t = 0; t < 3; ++t) acc[t] = (f32x4){0.f, 0.f, 0.f, 0.f};
            const LAS float* ap = HT + (lane & 15) * N2_STRIDE + 256 * (lane >> 4) + 32 * w;
#pragma unroll
            for (int i = 0; i < 8; ++i) {
                const f32x4 a4 = *(const LAS f32x4*)(ap + 4 * i);
#pragma unroll
                for (int e = 0; e < 4; ++e)
#pragma unroll
                    for (int t = 0; t < 3; ++t) acc[t] = __builtin_amdgcn_mfma_f32_16x16x4f32(a4[e], Bv[4 * i + e][t], acc[t], 0, 0, 0);
            }
#pragma unroll
            for (int t = 0; t < 3; ++t)
#pragma unroll
                for (int rg = 0; rg < 4; ++rg) PART[(w * 16 + (lane >> 4) * 4 + rg) * 48 + 16 * t + (lane & 15)] = acc[t][rg];
        }
        __syncthreads();
        if (F.tid < 16) {
            const int r = F.tid, row = row0 + r;
            float lgv[4];
#pragma unroll
            for (int g = 0; g < 4; ++g) { float a = RB[32 + g];
#pragma unroll
                for (int ww = 0; ww < 8; ++ww) a += PART[(ww * 16 + r) * 48 + 32 + g];
                lgv[g] = a; }
            int gs = 0; float lmax = lgv[0];
#pragma unroll
            for (int g = 1; g < 4; ++g) if (lgv[g] > lmax) { lmax = lgv[g]; gs = g; }
            float den = 0.f;
#pragma unroll
            for (int g = 0; g < 4; ++g) den += fexp(lgv[g] - lmax);
            const float pgmax = 1.0f / den;
            float le[8];
#pragma unroll
            for (int e = 0; e < 8; ++e) { float a = RB[gs * 8 + e];
#pragma unroll
                for (int ww = 0; ww < 8; ++ww) a += PART[(ww * 16 + r) * 48 + gs * 8 + e];
                le[e] = a; }
            int i1 = 0; float m1 = le[0];
#pragma unroll
            for (int e = 1; e < 8; ++e) if (le[e] > m1) { m1 = le[e]; i1 = e; }
            int i2 = i1 == 0 ? 1 : 0; float m2 = le[i1 == 0 ? 1 : 0];
#pragma unroll
            for (int e = 0; e < 8; ++e) if (e != i1 && le[e] > m2) { m2 = le[e]; i2 = e; }
            const float dd = fexp(m2 - m1);
            const float gate1 = pgmax / (1.0f + dd), gate2 = pgmax * dd / (1.0f + dd);
            const int e1 = gs * 8 + i1, e2 = gs * 8 + i2;
            const int p1 = __hip_atomic_fetch_add(hist + e1, 1, __ATOMIC_RELAXED, __HIP_MEMORY_SCOPE_WORKGROUP), p2 = __hip_atomic_fetch_add(hist + e2, 1, __ATOMIC_RELAXED, __HIP_MEMORY_SCOPE_WORKGROUP);
            RE[2 * row] = e1; RE[2 * row + 1] = e2; RG[2 * row] = gate1; RG[2 * row + 1] = gate2; RP[2 * row] = p1; RP[2 * row + 1] = p2;
        }
    }
    __syncthreads();
    if (F.tid < 32) ((int*)(F.ws + WS_BH))[F.bid * 32 + F.tid] = hist[F.tid];
    __syncthreads();
}

__device__ __forceinline__ void moe_tables(Frame& F, int l) {
    LAS int* seg = (LAS int*)(F.lds + LC_SEG); LAS int* cnts = (LAS int*)(F.lds + LC_CNTS); LAS int* tile_e = (LAS int*)(F.lds + LC_TILEE);
    LAS int* red = (LAS int*)(F.lds + LC_RED);
    LAS int* bbase = (LAS int*)(F.lds + LC_BBASE);
    const int* BH = (const int*)(F.ws + WS_BH);
    __syncthreads();
    { const int e = F.tid & 31, part = F.tid >> 5; int tot = 0, pre = 0;
      for (int bq = part; bq < F.G; bq += 16) { const int v = BH[bq * 32 + e]; tot += v; if (bq < F.bid) pre += v; }
      red[part * 32 + e] = tot; red[512 + part * 32 + e] = pre; }
    __syncthreads();
    if (F.tid < 32) { int tot = 0, pre = 0;
#pragma unroll 1
        for (int p = 0; p < 16; ++p) { tot += red[p * 32 + F.tid]; pre += red[512 + p * 32 + F.tid]; }
        cnts[F.tid] = tot; bbase[F.tid] = pre; }
    __syncthreads();
    if (F.tid == 0) {
        int s = 0;
#pragma unroll 1
        for (int e = 0; e < NE; ++e) { const int c = cnts[e]; seg[e] = s; const int nt = (c + 255) >> 8;
#pragma unroll 1
            for (int t = 0; t < nt; ++t) tile_e[(s >> 8) + t] = e;
            s += nt << 8; }
        seg[32] = s; seg[33] = s >> 8;
    }
    __syncthreads();
}
__device__ __forceinline__ void phase_dispatch(int l) {
    asm volatile("" : "+s"(l)); Frame F = make_frame();
    moe_tables(F, l);
    const LAS int* seg = (const LAS int*)(F.lds + LC_SEG); const LAS int* cnts = (const LAS int*)(F.lds + LC_CNTS); const LAS int* bbase = (const LAS int*)(F.lds + LC_BBASE);
    const int gw = F.bid * 8 + F.wave, NGW = F.G * 8;
    const int* RE = (const int*)(F.ws + WS_RE); const int* RP = (const int*)(F.ws + WS_RP); int* RS = (int*)(F.ws + WS_RS);
    const bf16_t* H = (const bf16_t*)((unsigned char*)F.out + DO_H); bf16_t* XS = (bf16_t*)(F.ws + WS_XS);
    for (int tile = F.bid; tile < NT / 16; tile += F.G) {
        const int item0 = (tile * 16 + 2 * F.wave) * 2;
        int slot[4]; u32x4 d0[2], d1[2];
#pragma unroll
        for (int q = 0; q < 4; ++q) { const int e = RE[item0 + q], pos = RP[item0 + q]; slot[q] = seg[e] + bbase[e] + pos; }
#pragma unroll
        for (int r = 0; r < 2; ++r) { const u32x4* src = (const u32x4*)(H + (size_t)((item0 >> 1) + r) * D); d0[r] = src[F.lane]; d1[r] = src[64 + F.lane]; }
        if (F.lane < 4) { int sl = slot[0]; sl = F.lane == 1 ? slot[1] : sl; sl = F.lane == 2 ? slot[2] : sl; sl = F.lane == 3 ? slot[3] : sl; RS[item0 + F.lane] = sl; }
#pragma unroll
        for (int q = 0; q < 4; ++q) { u32x4* dst = (u32x4*)(XS + (size_t)slot[q] * D); dst[F.lane] = d0[q >> 1]; dst[64 + F.lane] = d1[q >> 1]; }
    }
#pragma unroll 1
    for (int e = 0; e < NE; ++e) {
        const int c = cnts[e], padded = (c + 255) & ~255;
        for (int p = c + gw; p < padded; p += NGW) { u32x4* dst = (u32x4*)(XS + (size_t)(seg[e] + p) * D); dst[F.lane] = (u32x4){0u, 0u, 0u, 0u}; dst[64 + F.lane] = (u32x4){0u, 0u, 0u, 0u}; }
    }
}

__device__ __forceinline__ void phase_final() {
    Frame F = make_frame();
    const int gw = F.bid * 8 + F.wave, NGW = F.G * 8;
    const float* X = (const float*)(F.ws + WS_X); const float* fg = F.inp(IN_FG);
    for (int r = gw; r < NLAT; r += NGW) {
        const float* xr = X + (size_t)(NCTX + r) * D;
        f32x4 v[4]; float ss = 0.f;
#pragma unroll
        for (int j = 0; j < 4; ++j) v[j] = *(const f32x4*)(xr + 4 * F.lane + 256 * j);
        combine_row(F, DEPTH - 1, NCTX + r, v);
#pragma unroll
        for (int j = 0; j < 4; ++j) ss += v[j][0] * v[j][0] + v[j][1] * v[j][1] + v[j][2] * v[j][2] + v[j][3] * v[j][3];
        const float rs = rsqrtf(wave_sum(ss) * (1.0f / D) + NORM_EPS);
#pragma unroll
        for (int j = 0; j < 4; ++j) { const int c = 4 * F.lane + 256 * j; const f32x4 gg = *(const f32x4*)(fg + c);
            f32x4 o; o[0] = v[j][0] * rs * gg[0]; o[1] = v[j][1] * rs * gg[1]; o[2] = v[j][2] * rs * gg[2]; o[3] = v[j][3] * rs * gg[3];
            *(f32x4*)(F.out + (size_t)r * D + c) = o; }
    }
}

constexpr int NPL = 11;
constexpr int NPH = 1 + DEPTH * NPL + 1;
__device__ __forceinline__ void seam() {
    Frame F = make_frame();
    XcdBarrier bar; bar.bar = (unsigned*)(F.ws + WS_CTL) + CW_BAR; bar.x = xb_xcc_id(); bar.st = (volatile LAS unsigned*)(F.lds + LC_BARW);
    xcd_barrier(bar);
}
__global__ void __launch_bounds__(512, 2) mk_fwd(Args args_unused) {
    {
        Frame F = make_frame();
        for (int u = F.tid; u < (LDS_BYTES - LDS_CTL) / 4; u += 512) ((LAS unsigned*)(F.lds + LDS_CTL))[u] = 0u;
        __syncthreads();
        if (F.ka->ph_hi - F.ka->ph_lo > 1) (void)xcd_barrier_post((unsigned*)(F.ws + WS_CTL) + CW_BAR, (volatile LAS unsigned*)(F.lds + LC_BARW));
    }
#define IN(k) (kargs()->ph_lo <= (k) && (k) < kargs()->ph_hi)
#define SEAM(k) do { if (IN(k) && IN((k) + 1)) seam(); } while (0)
    int ph = 0;
    for (int rep_ = 0; rep_ < DUP_N(13); ++rep_) { if (rep_) seam(); if (PH_EN(13) && IN(ph)) phase_prologue(); }
    SEAM(ph); ++ph;
    for (int l = 0; l < DEPTH; ++l) {
        if (IN(ph) && IN(ph + 1)) { for (int i_ = 0; i_ < EXTRA_SEAMS; ++i_) seam(); }
        for (int rep_ = 0; rep_ < DUP_N(0); ++rep_) { if (rep_) seam(); if (PH_EN(0) && IN(ph)) phase_norm1(l, rep_); }
        SEAM(ph); ++ph;
        for (int rep_ = 0; rep_ < DUP_N(1); ++rep_) { if (rep_) seam(); if (PH_EN(1) && IN(ph)) { Frame F = make_frame(); Gemm g{(const bf16_t*)((unsigned char*)F.out + DO_H), (const bf16_t*)(F.ws + WS_WIN), NT, ZLD, D, 0, 0}; StaticOrder S; S.init(NT, ZLD, F.G, F.bid); EpiStoreBf16 E{(bf16_t*)(F.ws + WS_Z), ZLD}; gemm_phase(F.lds, g, S, E); } }
        SEAM(ph); ++ph;
        for (int rep_ = 0; rep_ < DUP_N(2); ++rep_) { if (rep_) seam(); if (PH_EN(2) && IN(ph)) phase_prep(l); }
        SEAM(ph); ++ph;
        for (int rep_ = 0; rep_ < DUP_N(3); ++rep_) { if (rep_) seam(); if (PH_EN(3) && IN(ph)) { if (SCAN_IMPL == 1) { if (rep_ == 0) phase_scan_mfma<0>(l); else phase_scan_mfma<SCAN_DBG>(l); } else if (rep_ == 0) phase_scan<0>(l); else phase_scan<SCAN_VAR>(l); } }
        SEAM(ph); ++ph;
        for (int rep_ = 0; rep_ < DUP_N(4); ++rep_) { if (rep_) seam(); if (PH_EN(4) && IN(ph)) phase_mix(l); }
        SEAM(ph); ++ph;
        for (int rep_ = 0; rep_ < DUP_N(5); ++rep_) { if (rep_) seam(); if (PH_EN(5) && IN(ph)) { Frame F = make_frame(); Gemm g{(const bf16_t*)(F.ws + WS_UA), (const bf16_t*)(F.ws + WS_WA), NT, D, DH, (size_t)(WS_WB - WS_WA) / 2, (size_t)(WS_UB - WS_UA) / 2}; PairOrder S; S.so.init(NT, D, F.G, F.bid); EpiMerge E{(bf16_t*)((unsigned char*)F.out + DO_H), (const bf16_t*)(F.ws + WS_Z)}; gemm_phase(F.lds, g, S, E); } }
        SEAM(ph); ++ph;
        for (int rep_ = 0; rep_ < DUP_N(7); ++rep_) { if (rep_) seam(); if (PH_EN(7) && IN(ph)) { int ll = l; asm volatile("" : "+s"(ll)); Frame F = make_frame(); Gemm g{(const bf16_t*)((unsigned char*)F.out + DO_H), (const bf16_t*)(F.ws + WS_WO), NT, D, D, 0, 0}; StaticOrder S; S.init(NT, D, F.G, F.bid);
            EpiResid E{rep_ ? (float*)(F.ws + WS_Z) : (float*)(F.ws + WS_X), (const float*)(F.ws + WS_MOD) + (size_t)ll * 17 * NMOD + 2048}; gemm_phase(F.lds, g, S, E); } }
        SEAM(ph); ++ph;
        for (int rep_ = 0; rep_ < DUP_N(8); ++rep_) { if (rep_) seam(); if (PH_EN(8) && IN(ph)) phase_norm2(l); }
        SEAM(ph); ++ph;
        for (int rep_ = 0; rep_ < DUP_N(9); ++rep_) { if (rep_) seam(); if (PH_EN(9) && IN(ph)) phase_dispatch(l); }
        SEAM(ph); ++ph;
        for (int rep_ = 0; rep_ < DUP_N(10); ++rep_) { if (rep_) seam(); if (PH_EN(10) && IN(ph)) { int ll = l; asm volatile("" : "+s"(ll)); Frame F = make_frame(); moe_tables(F, ll); MoeOrder S{__builtin_amdgcn_readfirstlane(((const LAS int*)(F.lds + LC_SEG))[33]), F.G, F.bid, (const LAS int*)(F.lds + LC_TILEE)};
            Gemm g{(const bf16_t*)(F.ws + WS_XS), (const bf16_t*)(F.ws + WS_W13), MAXTILES * 256, D, D, (size_t)1024 * 1024, 0}; EpiSwiGLU E{(bf16_t*)(F.ws + WS_HID)}; gemm_phase(F.lds, g, S, E); } }
        SEAM(ph); ++ph;
        for (int rep_ = 0; rep_ < DUP_N(11); ++rep_) { if (rep_) seam(); if (PH_EN(11) && IN(ph)) { int ll = l; asm volatile("" : "+s"(ll)); Frame F = make_frame(); moe_tables(F, ll); MoeOrder S{__builtin_amdgcn_readfirstlane(((const LAS int*)(F.lds + LC_SEG))[33]), F.G, F.bid, (const LAS int*)(F.lds + LC_TILEE)};
            Gemm g{(const bf16_t*)(F.ws + WS_HID), (const bf16_t*)(F.ws + WS_W2), MAXTILES * 256, D, DFF, (size_t)1024 * 512, 0}; EpiStoreBf16 E{(bf16_t*)(F.ws + WS_YS), D}; gemm_phase(F.lds, g, S, E); } }
        SEAM(ph); ++ph;
    }
    if (PH_EN(14) && IN(ph)) phase_final();
#undef IN
#undef SEAM
}

extern "C" void kernel_launch(void* const* d_in, const int* in_sizes, int n_in, void* d_out, int out_size, void* d_ws, size_t ws_size, hipStream_t stream) {
    static int grid = 0;
    if (grid == 0) {
        if (n_in != 32 || out_size != NLAT * D || ws_size < WS_END) { fprintf(stderr, "kernel_launch: unexpected shapes (n_in %d, out %d, ws %zu < %zu)\n", n_in, out_size, ws_size, (size_t)WS_END); grid = -1; return; }
        int dev = 0, cus = 0, per_cu = 0;
        if (hipGetDevice(&dev) != hipSuccess || hipDeviceGetAttribute(&cus, hipDeviceAttributeMultiprocessorCount, dev) != hipSuccess) { grid = -1; return; }
        if (hipFuncSetAttribute((const void*)mk_fwd, hipFuncAttributeMaxDynamicSharedMemorySize, LDS_BYTES) != hipSuccess) { fprintf(stderr, "kernel_launch: hipFuncSetAttribute failed\n"); grid = -1; return; }
        if (hipOccupancyMaxActiveBlocksPerMultiprocessor(&per_cu, (const void*)mk_fwd, 512, LDS_BYTES) != hipSuccess || per_cu < 1) { fprintf(stderr, "kernel_launch: occupancy query says %d\n", per_cu); }
        (void)hipGetLastError();
        grid = cus;
    }
    if (grid < 0) return;
    if (hipMemsetAsync((char*)d_ws + WS_CTL, 0, CTL_ZERO_BYTES, stream) != hipSuccess) return;
    Args a{};
    for (int i = 0; i < 32; ++i) a.in[i] = (const float*)d_in[i];
    a.out = (float*)d_out; a.ws = (unsigned char*)d_ws;
#if MK_ONE_LAUNCH
    a.ph_lo = 0; a.ph_hi = NPH;
    hipLaunchKernelGGL(mk_fwd, dim3(grid), dim3(512), LDS_BYTES, stream, a);
#else
    for (int p = 0; p < NPH; ++p) { a.ph_lo = p; a.ph_hi = p + 1; hipLaunchKernelGGL(mk_fwd, dim3(grid), dim3(512), LDS_BYTES, stream, a); }
#endif
}
```

```cpp
#include <hip/hip_runtime.h>
#include <cstdio>
#include <cstdint>

#ifndef MK_ONE_LAUNCH
#define MK_ONE_LAUNCH 1
#endif
#ifndef GEMM_IMPL
#define GEMM_IMPL 1
#endif

#ifndef PHASE_MASK
#define PHASE_MASK 0xffff
#endif
#define PH_EN(p) (((PHASE_MASK) >> (p)) & 1)
#ifndef DUP_MASK
#define DUP_MASK 0
#endif
#ifndef EXTRA_SEAMS
#define EXTRA_SEAMS 0
#endif
#ifndef SCAN_VAR
#define SCAN_VAR 0
#endif
#ifndef SCAN_DBG
#define SCAN_DBG 0
#endif
#ifndef SCAN_HILO
#define SCAN_HILO 0
#endif
#ifndef SCAN_IMPL
#define SCAN_IMPL 1
#endif
#define DUP_N(p) (1 + (((DUP_MASK) >> (p)) & 1))
#define LAS __attribute__((address_space(3)))
typedef unsigned short bf16_t;
typedef short bf16x8 __attribute__((ext_vector_type(8)));
typedef float f32x4 __attribute__((ext_vector_type(4)));
typedef unsigned u32x4 __attribute__((ext_vector_type(4)));
typedef unsigned u32x2 __attribute__((ext_vector_type(2)));

constexpr int D = 1024, NBATCH = 16, SEQ = 2048, DEPTH = 4, CTXL = 256;
constexpr int NCTX = NBATCH * CTXL;
constexpr int NLAT = NBATCH * SEQ;
constexpr int NT = NCTX + NLAT;
constexpr int DH = 512;
constexpr int NIN = 5504, ZLD = 5632;
constexpr int ZC_BG = 0, ZC_CG = 512, ZC_HA = 1024, ZC_RW = 1536, ZC_GA = 3456, ZC_GB = 4480;
constexpr int RWC = 1920;
constexpr int NE = 32, DFF = 512;
constexpr int MAXTILES = 320;
constexpr int NMOD = 6 * D;
constexpr float NORM_EPS = 1e-6f, GN_EPS = 64e-5f;

constexpr size_t MiB = 1u << 20;
constexpr size_t WS_CTL = 0, CTL_ZERO_BYTES = 1 * MiB;
constexpr size_t WS_MOD = 1 * MiB;
constexpr size_t WS_RE = 3 * MiB;
constexpr size_t WS_RG = WS_RE + (size_t)NT * 8;
constexpr size_t WS_RP = WS_RG + (size_t)NT * 8;
constexpr size_t WS_RS = WS_RP + (size_t)NT * 8;
constexpr size_t WS_BH = 4 * MiB + 256 * 1024;
constexpr size_t WS_RB = 4 * MiB + 384 * 1024;
constexpr size_t WS_WC = 6 * MiB + 256 * 1024;
constexpr size_t WS_BONUS = 5 * MiB;
constexpr size_t WS_X = 8 * MiB;
constexpr size_t WS_WIN = 152 * MiB;
constexpr size_t WS_WA = 163 * MiB;
constexpr size_t WS_WB = 164 * MiB;
constexpr size_t WS_WO = 165 * MiB;
constexpr size_t WS_W13 = 167 * MiB;
constexpr size_t WS_W2 = 231 * MiB;
constexpr size_t WS_Z = 264 * MiB;
constexpr size_t WS_XS = WS_Z;
constexpr size_t WS_HID = WS_Z + 160 * MiB;
constexpr size_t WS_SI = 660 * MiB;
constexpr size_t SI_SZ = 36 * MiB;
constexpr size_t WS_V = WS_SI, WS_KT0 = WS_SI + SI_SZ, WS_KT1 = WS_SI + 2 * SI_SZ, WS_BT0 = WS_SI + 3 * SI_SZ, WS_BT1 = WS_SI + 4 * SI_SZ,
                 WS_KDT0 = WS_SI + 5 * SI_SZ, WS_KDT1 = WS_SI + 6 * SI_SZ, WS_RT0 = WS_SI + 7 * SI_SZ, WS_RT1 = WS_SI + 8 * SI_SZ;
constexpr size_t WS_B1 = WS_RT1, WS_KD0 = WS_KDT0;
constexpr size_t WS_UA = WS_KT0, WS_UB = WS_KT1;
constexpr size_t WS_GE0 = 1092 * MiB, WS_GE1 = 1097 * MiB;
constexpr size_t WS_YS = WS_SI;
constexpr size_t WS_Y0 = 984 * MiB, WS_Y1 = 1020 * MiB;
constexpr size_t WS_END = 1102 * MiB;
constexpr size_t DO_H = 0, DO_G = 72 * MiB;
static_assert(WS_Z + (size_t)NT * ZLD * 2 <= WS_SI && WS_HID + (size_t)MAXTILES * 256 * DFF * 2 <= WS_SI && WS_B1 + SI_SZ <= WS_Y0 && WS_YS + (size_t)MAXTILES * 256 * D * 2 <= WS_Y0, "ws map");
static_assert((size_t)NT * DH * 2 == SI_SZ && WS_X + (size_t)NT * D * 4 <= WS_WIN && WS_W2 + 32 * MiB <= WS_Z, "ws map 2");
constexpr int CW_CNT = 1024;
constexpr int CW_BAR = 4096;

constexpr int LDS_BYTES = 163840;
constexpr int LDS_CTL = 155648;
constexpr int LC_BARW = LDS_CTL;
constexpr int LC_SEG = LDS_CTL + 64;
constexpr int LC_CNTS = LDS_CTL + 256;
constexpr int LC_TILEE = LDS_CTL + 512;
constexpr int LC_BBASE = LDS_CTL + 2048;
constexpr int LC_RED = LDS_CTL + 4096;

__device__ __forceinline__ float bf2f(unsigned b) { return __uint_as_float(b << 16); }
typedef float f32x2c __attribute__((ext_vector_type(2)));
typedef __bf16 bf16v2c __attribute__((ext_vector_type(2)));
__device__ __forceinline__ unsigned pk2(float lo, float hi) { const f32x2c v = {lo, hi}; return __builtin_bit_cast(unsigned, __builtin_convertvector(v, bf16v2c)); }
__device__ __forceinline__ unsigned f2bf(float f) { return pk2(f, 0.f) & 0xffffu; }
__device__ __forceinline__ float wave_sum(float v) {
#pragma unroll
    for (int o = 1; o < 64; o <<= 1) v += __shfl_xor(v, o);
    return v;
}
__device__ __forceinline__ float fexp(float x) { return __builtin_amdgcn_exp2f(x * 1.4426950408889634f); }
__device__ __forceinline__ float sigmoidf_(float x) { return __builtin_amdgcn_rcpf(1.0f + fexp(-x)); }
__device__ __forceinline__ float siluf_(float x) { return x * __builtin_amdgcn_rcpf(1.0f + fexp(-x)); }

#define XB_TMO      128
#define XB_XCNT(j)  (256  + 64 * (j))
#define XB_XSUB(j)  (1280 + 64 * (j))
#define XB_XGEN(j)  (2304 + 64 * (j))
#define XB_TOP      3328
#define XB_TOPGEN   3392
#define XCD_BAR_WORDS 3456
#define XB_SPIN_CAP (1u << 22)

__device__ __forceinline__ unsigned xb_ld(unsigned* p)              { return __hip_atomic_load(p, __ATOMIC_RELAXED, __HIP_MEMORY_SCOPE_AGENT); }
__device__ __forceinline__ unsigned xb_add(unsigned* p, unsigned v) { return __hip_atomic_fetch_add(p, v, __ATOMIC_RELAXED, __HIP_MEMORY_SCOPE_AGENT); }
__device__ __forceinline__ unsigned xb_xcc_id() { return (unsigned)__builtin_amdgcn_s_getreg((3 << 11) | 20) & 0xFu; }
#define XB_SPIN(cond, bar) do { unsigned _sp = 0; while (cond) { __builtin_amdgcn_s_sleep(1); \
    if ((++_sp & 255u) == 0u) { if (xb_ld(&(bar)[XB_TMO])) break; if (_sp > XB_SPIN_CAP) { atomicAdd(&(bar)[XB_TMO], 1u); break; } } } } while (0)

struct XcdBarrier { unsigned* bar; unsigned x; volatile LAS unsigned* st; };

__device__ __forceinline__ XcdBarrier xcd_barrier_post(unsigned* bar, volatile LAS unsigned* st) {
    XcdBarrier b; b.bar = bar; b.x = xb_xcc_id(); b.st = st;
    if (threadIdx.x == 0) (void)xb_add(&bar[XB_XCNT(b.x)], 1u);
    return b;
}
__device__ __forceinline__ void xcd_barrier_complete(unsigned* bar, unsigned x, unsigned& nloc, unsigned& nx) {
    const unsigned G = gridDim.x * gridDim.y * gridDim.z;
    unsigned sum, cnt, mine, sp = 0u;
    for (;;) {
        sum = 0u; cnt = 0u; mine = 0u;
#pragma unroll
        for (unsigned j = 0; j < 16; ++j) { const unsigned c = xb_ld(&bar[XB_XCNT(j)]); sum += c; cnt += (c > 0u) ? 1u : 0u; mine = (j == x) ? c : mine; }
        if (sum == G) break;
        __builtin_amdgcn_s_sleep(1);
        if ((++sp & 255u) == 0u) { if (xb_ld(&bar[XB_TMO])) break; if (sp > XB_SPIN_CAP) { atomicAdd(&bar[XB_TMO], 1u); break; } }
    }
    nloc = mine > 0u ? mine : 1u; nx = cnt > 0u ? cnt : 1u;
}
__device__ __forceinline__ void xcd_barrier(const XcdBarrier& b) {
    asm volatile("s_waitcnt vmcnt(0)" ::: "memory");
    __syncthreads();
    if (threadIdx.x == 0) {
        unsigned* bar = b.bar;
        __builtin_amdgcn_s_waitcnt(0);
        unsigned nloc = b.st[0], nx = b.st[1];
        if (nloc == 0u) { xcd_barrier_complete(bar, b.x, nloc, nx); b.st[0] = nloc; b.st[1] = nx; }
        const unsigned old = xb_add(&bar[XB_XSUB(b.x)], 1u);
        const unsigned gen = old / nloc;
        if (old + 1u == (gen + 1u) * nloc) {
            __builtin_amdgcn_fence(__ATOMIC_RELEASE, "agent");
            asm volatile("s_waitcnt vmcnt(0)" ::: "memory");
            const unsigned og = xb_add(&bar[XB_TOP], 1u);
            const unsigned tg = og / nx;
            if (og + 1u == (tg + 1u) * nx) xb_add(&bar[XB_TOPGEN], 1u);
            else XB_SPIN(xb_ld(&bar[XB_TOPGEN]) == tg, bar);
            __builtin_amdgcn_fence(__ATOMIC_ACQUIRE, "agent");
            xb_add(&bar[XB_XGEN(b.x)], 1u);
            asm volatile("s_waitcnt vmcnt(0)" ::: "memory");
        } else {
            XB_SPIN(xb_ld(&bar[XB_XGEN(b.x)]) == gen, bar);
            __builtin_amdgcn_fence(__ATOMIC_ACQUIRE, "agent");
            asm volatile("s_waitcnt vmcnt(0)" ::: "memory");
        }
    }
    __syncthreads();
}

struct Unit { int pm, pn, bs, as; };
struct Gemm { const bf16_t* A; const bf16_t* Bt; int M, N, K; size_t bstride; size_t astride; };
constexpr int NXCD = 8, WGM = 8;
struct StaticOrder {
    int nM, nN, nwg, G, c;
    __device__ __forceinline__ void init(int M, int N, int G_, int c_) { nM = M / 256; nN = N / 256; nwg = nM * nN; G = G_; c = c_; }
    __device__ __forceinline__ bool next(int i, Unit& u) const {
        const long L = (long)i * G + c; if (L >= nwg) return false;
        int wgid = (int)L; { const int q = nwg / NXCD, r = nwg % NXCD, xcd = wgid % NXCD, off = wgid / NXCD; wgid = (xcd < r ? xcd * (q + 1) : r * (q + 1) + (xcd - r) * q) + off; }
        const int nig = WGM * nN, gid = wgid / nig, fm = gid * WGM, gsz = (nM - fm) < WGM ? (nM - fm) : WGM;
        u.pm = fm + ((wgid % nig) % gsz); u.pn = (wgid % nig) / gsz; u.bs = 0; u.as = 0; return true;
    }
};
struct PairOrder {
    StaticOrder so;
    __device__ __forceinline__ bool next(int i, Unit& u) const { if (!so.next(i >> 1, u)) return false; u.bs = i & 1; u.as = i & 1; return true; }
};
struct MoeOrder {
    int ntiles, G, c; const LAS int* tile_e;
    __device__ __forceinline__ bool next(int i, Unit& u) const {
        const int L = i * G + c; if (L >= ntiles * 4) return false;
        u.pm = L >> 2; u.pn = L & 3; u.bs = __builtin_amdgcn_readfirstlane(tile_e[u.pm]); u.as = 0; return true;
    }
};

#if GEMM_IMPL == 0
template <class Epi, class Sched>
__device__ __forceinline__ void gemm_phase(LAS unsigned char* lds, const Gemm g, const Sched& S, const Epi& E) {
    LAS float* As = (LAS float*)lds;
    LAS float* Bs = As + 16 * 260;
    const int tid = threadIdx.x, ty = tid >> 4, tx = tid & 15, lr = tid >> 1, lh = tid & 1;
    Unit u;
    for (int it = 0; S.next(it, u); ++it) {
        float acc[8][16];
#pragma unroll
        for (int i = 0; i < 8; ++i)
#pragma unroll
            for (int j = 0; j < 16; ++j) acc[i][j] = 0.f;
        const bf16_t* Ap = g.A + ((size_t)u.pm * 256 + lr) * g.K + lh * 8;
        const bf16_t* Bp = g.Bt + (size_t)u.bs * g.bstride + ((size_t)u.pn * 256 + lr) * g.K + lh * 8;
        for (int k0 = 0; k0 < g.K; k0 += 16) {
            const u32x4 av = *(const u32x4*)(Ap + k0), bv = *(const u32x4*)(Bp + k0);
            __syncthreads();
#pragma unroll
            for (int j = 0; j < 4; ++j) {
                As[(lh * 8 + 2 * j) * 260 + lr] = bf2f(av[j] & 0xffffu); As[(lh * 8 + 2 * j + 1) * 260 + lr] = bf2f(av[j] >> 16);
                Bs[(lh * 8 + 2 * j) * 260 + lr] = bf2f(bv[j] & 0xffffu); Bs[(lh * 8 + 2 * j + 1) * 260 + lr] = bf2f(bv[j] >> 16);
            }
            __syncthreads();
#pragma unroll 4
            for (int kk = 0; kk < 16; ++kk) {
                float a[8], b[16];
                const f32x4 a0 = *(const LAS f32x4*)(As + kk * 260 + ty * 8), a1 = *(const LAS f32x4*)(As + kk * 260 + ty * 8 + 4);
                a[0] = a0[0]; a[1] = a0[1]; a[2] = a0[2]; a[3] = a0[3]; a[4] = a1[0]; a[5] = a1[1]; a[6] = a1[2]; a[7] = a1[3];
#pragma unroll
                for (int q = 0; q < 4; ++q) { const f32x4 bq = *(const LAS f32x4*)(Bs + kk * 260 + tx * 4 + 64 * q); b[4 * q] = bq[0]; b[4 * q + 1] = bq[1]; b[4 * q + 2] = bq[2]; b[4 * q + 3] = bq[3]; }
#pragma unroll
                for (int i = 0; i < 8; ++i)
#pragma unroll
                    for (int j = 0; j < 16; ++j) acc[i][j] = fmaf(a[i], b[j], acc[i][j]);
            }
        }
#pragma unroll
        for (int i = 0; i < 8; ++i)
#pragma unroll
            for (int q = 0; q < 4; ++q)
                E.elem4(u.pm * 256 + ty * 8 + i, u.pn * 256 + tx * 4 + 64 * q, (f32x4){acc[i][4 * q], acc[i][4 * q + 1], acc[i][4 * q + 2], acc[i][4 * q + 3]});
    }
    __syncthreads();
}
#else
namespace pg8 {
constexpr int BM = 256, BK = 64, HALF = 128, HTB = HALF * BK * 2, STAGE_BYTES = 8 * HTB;
__device__ __forceinline__ int lds_byte(int r, int c) { const int st = (r >> 4) * 2 + (c >> 5), rr = r & 15, cc = c & 31, ob = rr * 64 + cc * 2; return st * 1024 + (ob ^ (((ob >> 9) & 1) << 5)); }
__device__ __forceinline__ int perm32(int rho) { const int n = rho >> 4, i = rho & 15; return 8 * (i >> 2) + 4 * n + (i & 3); }
__device__ __forceinline__ void stage_rc(int b, int& R, int& C) { const int st = b / 1024, sb = b % 1024, swz = sb ^ (((sb >> 9) & 1) << 5); R = (st >> 1) * 16 + swz / 64; C = (st & 1) * 32 + (swz % 64) / 2; }
}
template <class Epi, class Sched>
__device__ __forceinline__ void gemm_phase(LAS unsigned char* lds, const Gemm g, const Sched& S, const Epi& E) {
    using namespace pg8;
    int tid_ = threadIdx.x; asm volatile("" : "+v"(tid_));
    const int tid = tid_, wid = __builtin_amdgcn_readfirstlane(tid >> 6), lane = tid & 63, wr = wid >> 2, wc = wid & 3, fr = lane & 15, fq = lane >> 4;
    const int K = g.K, nt = K / BK;
    unsigned voffA[2], voffB[2];
#pragma unroll
    for (int i = 0; i < 2; ++i) { int R, C; stage_rc(tid * 16 + i * 8192, R, C); const int Rb = Epi::PERM ? ((R & ~31) + perm32(R & 31)) : R;
        voffA[i] = (unsigned)(R * K + C) * 2u; voffB[i] = (unsigned)(Rb * K + C) * 2u; }
    const size_t kstep = (size_t)(BK * 2);
    const size_t hstep = (size_t)HALF * K * 2;
    const size_t tstep = 2 * hstep;
    const unsigned ldsw = (unsigned)wid * 1024u;
    const int aoff = lds_byte(wr * 64 + fr, fq * 8), boff = lds_byte(wc * 32 + fr, fq * 8);
#define PG8_SA(b, h) (((b) * 2 + (h)) * HTB)
#define PG8_SB(b, h) ((4 + (b) * 2 + (h)) * HTB)
#define PG8_STAGE(bufoff, gbase, voff) do { _Pragma("unroll") for (int _i = 0; _i < 2; ++_i) \
        __builtin_amdgcn_global_load_lds((const unsigned*)((const char*)(gbase) + (voff)[_i]), (LAS unsigned*)(lds + (bufoff) + ldsw + _i * 8192), 16, 0, 0); } while (0)
#define PG8_LDA(dst, b, h) do { _Pragma("unroll") for (int m = 0; m < 4; ++m) _Pragma("unroll") for (int k = 0; k < 2; ++k) dst[m][k] = *(const LAS bf16x8*)(lds + PG8_SA(b, h) + aoff + m * 2048 + k * 1024); } while (0)
#define PG8_LDB(dst, b, h) do { _Pragma("unroll") for (int n = 0; n < 2; ++n) _Pragma("unroll") for (int k = 0; k < 2; ++k) dst[n][k] = *(const LAS bf16x8*)(lds + PG8_SB(b, h) + boff + n * 2048 + k * 1024); } while (0)
#define PG8_MMA(ai, bj, At, Bt) do { __builtin_amdgcn_s_setprio(1); _Pragma("unroll") for (int m = 0; m < 4; ++m) _Pragma("unroll") for (int n = 0; n < 2; ++n) _Pragma("unroll") for (int k = 0; k < 2; ++k) \
        acc[ai][bj][m][n] = __builtin_amdgcn_mfma_f32_16x16x32_bf16(Bt[n][k], At[m][k], acc[ai][bj][m][n], 0, 0, 0); __builtin_amdgcn_s_setprio(0); } while (0)
#define PG8_WAIT_V(n) asm volatile("s_waitcnt vmcnt(" #n ")" ::: "memory")
#define PG8_WAIT_L(n) asm volatile("s_waitcnt lgkmcnt(" #n ")" ::: "memory")
#define PG8_BAR __builtin_amdgcn_s_barrier()
#define PG8_SCHED __builtin_amdgcn_sched_barrier(0)
    Unit cur, nxt; int ui = 0;
    if (S.next(0, cur)) {
    f32x4 acc[2][2][4][2];
#pragma unroll
    for (int a = 0; a < 2; ++a)
#pragma unroll
        for (int b = 0; b < 2; ++b)
#pragma unroll
            for (int m = 0; m < 4; ++m)
#pragma unroll
                for (int n = 0; n < 2; ++n) acc[a][b][m][n] = (f32x4){0.f, 0.f, 0.f, 0.f};
    bf16x8 At[4][2], B0[2][2], B1[2][2];
    const char* cA = (const char*)(g.A + (size_t)cur.as * g.astride) + (size_t)cur.pm * tstep; const char* cB = (const char*)(g.Bt + (size_t)cur.bs * g.bstride) + (size_t)cur.pn * tstep;
    PG8_STAGE(PG8_SB(0, 0), cB, voffB); PG8_STAGE(PG8_SA(0, 0), cA, voffA); PG8_STAGE(PG8_SB(0, 1), cB + hstep, voffB); PG8_STAGE(PG8_SA(0, 1), cA + hstep, voffA);
    if (wr == 1) PG8_BAR;
    PG8_WAIT_V(4); PG8_BAR;
    PG8_STAGE(PG8_SB(1, 0), cB + kstep, voffB); PG8_STAGE(PG8_SA(1, 0), cA + kstep, voffA); PG8_STAGE(PG8_SB(1, 1), cB + hstep + kstep, voffB);
    PG8_WAIT_V(6); PG8_BAR;
    for (;;) {
        const bool has_next = S.next(ui + 1, nxt);
        const char* nA = has_next ? (const char*)(g.A + (size_t)nxt.as * g.astride) + (size_t)nxt.pm * tstep : cA; const char* nB = has_next ? (const char*)(g.Bt + (size_t)nxt.bs * g.bstride) + (size_t)nxt.pn * tstep : cB;
        for (int t = 0; t < nt; t += 2) {
            const bool last = (t == nt - 2);
            const char* a1 = cA + (size_t)(t + 1) * kstep;
            const char* a2 = last ? nA : cA + (size_t)(t + 2) * kstep; const char* b2 = last ? nB : cB + (size_t)(t + 2) * kstep;
            const char* a3 = a2 + kstep; const char* b3 = b2 + kstep;
            PG8_LDB(B0, 0, 0); PG8_SCHED; PG8_LDA(At, 0, 0); PG8_STAGE(PG8_SA(1, 1), a1 + hstep, voffA);
            PG8_WAIT_L(8); PG8_BAR; PG8_WAIT_L(0); PG8_MMA(0, 0, At, B0); PG8_BAR; PG8_SCHED;
            PG8_LDB(B1, 0, 1); PG8_STAGE(PG8_SB(0, 0), b2, voffB);
            PG8_BAR; PG8_WAIT_L(0); PG8_MMA(0, 1, At, B1); PG8_BAR;
            PG8_LDA(At, 0, 1); PG8_STAGE(PG8_SA(0, 0), a2, voffA);
            PG8_BAR; PG8_WAIT_L(0); PG8_MMA(1, 0, At, B0); PG8_BAR; PG8_SCHED;
            PG8_STAGE(PG8_SB(0, 1), b2 + hstep, voffB);
            PG8_WAIT_V(6); PG8_BAR; PG8_MMA(1, 1, At, B1); PG8_BAR;
            PG8_LDB(B0, 1, 0); PG8_SCHED; PG8_LDA(At, 1, 0); PG8_STAGE(PG8_SA(0, 1), a2 + hstep, voffA);
            PG8_WAIT_L(8); PG8_BAR; PG8_WAIT_L(0); PG8_MMA(0, 0, At, B0); PG8_BAR; PG8_SCHED;
            PG8_LDB(B1, 1, 1); PG8_STAGE(PG8_SB(1, 0), b3, voffB);
            PG8_BAR; PG8_WAIT_L(0); PG8_MMA(0, 1, At, B1); PG8_BAR;
            PG8_LDA(At, 1, 1); PG8_STAGE(PG8_SA(1, 0), a3, voffA);
            PG8_BAR; PG8_WAIT_L(0); PG8_MMA(1, 0, At, B0); PG8_BAR; PG8_SCHED;
            PG8_STAGE(PG8_SB(1, 1), b3 + hstep, voffB);
            PG8_WAIT_V(6); PG8_BAR; PG8_MMA(1, 1, At, B1); PG8_BAR;
        }
        bool keep = false;
        {
            const int row0 = cur.pm * 256 + wr * 64 + fr;
            if constexpr (Epi::TWO_PART) keep = (cur.as == 0);
            if constexpr (Epi::PERM) {
                const int col0 = cur.pn * 256 + wc * 32 + 8 * fq;
#pragma unroll
                for (int ai = 0; ai < 2; ++ai)
#pragma unroll
                    for (int m = 0; m < 4; ++m)
#pragma unroll
                        for (int bj = 0; bj < 2; ++bj) {
                            if constexpr (Epi::TWO_PART) { if (keep) E.mid8(row0 + ai * 128 + m * 16, col0 + bj * 128, acc[ai][bj][m][0], acc[ai][bj][m][1]); else E.elem8(row0 + ai * 128 + m * 16, col0 + bj * 128, acc[ai][bj][m][0], acc[ai][bj][m][1]); }
                            else E.elem8(row0 + ai * 128 + m * 16, col0 + bj * 128, acc[ai][bj][m][0], acc[ai][bj][m][1]);
                        }
            } else {
                const int col0 = cur.pn * 256 + wc * 32 + 4 * fq;
#pragma unroll
                for (int ai = 0; ai < 2; ++ai)
#pragma unroll
                    for (int m = 0; m < 4; ++m)
#pragma unroll
                        for (int bj = 0; bj < 2; ++bj)
#pragma unroll
                            for (int n = 0; n < 2; ++n) E.elem4(row0 + ai * 128 + m * 16, col0 + bj * 128 + n * 16, acc[ai][bj][m][n]);
            }
        }
        if (!has_next) break;
        if (!keep) {
#pragma unroll
        for (int a = 0; a < 2; ++a)
#pragma unroll
            for (int b = 0; b < 2; ++b)
#pragma unroll
                for (int m = 0; m < 4; ++m)
#pragma unroll
                    for (int n = 0; n < 2; ++n) acc[a][b][m][n] = (f32x4){0.f, 0.f, 0.f, 0.f};
        }
        cur = nxt; cA = nA; cB = nB; ++ui;
    }
    PG8_WAIT_V(0);
    if (wr == 0) PG8_BAR;
    PG8_BAR;
    }
#undef PG8_SA
#undef PG8_SB
#undef PG8_STAGE
#undef PG8_LDA
#undef PG8_LDB
#undef PG8_MMA
#undef PG8_WAIT_V
#undef PG8_WAIT_L
#undef PG8_BAR
#undef PG8_SCHED
    __syncthreads();
}
#endif

__device__ __forceinline__ u32x4 pack8v(const f32x4 a, const f32x4 b) { u32x4 r; r.x = pk2(a[0], a[1]); r.y = pk2(a[2], a[3]); r.z = pk2(b[0], b[1]); r.w = pk2(b[2], b[3]); return r; }
struct EpiStoreBf16 {
    static constexpr bool TWO_PART = false, PERM = true;
    bf16_t* O; int ldc;
    __device__ __forceinline__ void elem8(int row, int col, f32x4 v0, f32x4 v1) const { *(u32x4*)(O + (size_t)row * ldc + col) = pack8v(v0, v1); }
};
struct EpiMerge {
    static constexpr bool TWO_PART = true, PERM = true;
    bf16_t* MG; const bf16_t* Z;
    __device__ __forceinline__ void mid8(int row, int col, f32x4& v0, f32x4& v1) const {
        const u32x4 ga = *(const u32x4*)(Z + (size_t)row * ZLD + ZC_GA + col), gb = *(const u32x4*)(Z + (size_t)row * ZLD + ZC_GB + col);
#pragma unroll
        for (int e = 0; e < 4; ++e) { const float al = bf2f(ga[e] & 0xffffu), ah = bf2f(ga[e] >> 16), bl = bf2f(gb[e] & 0xffffu), bh = bf2f(gb[e] >> 16);
            const float rl = (1.0f + fexp(-bl)) * __builtin_amdgcn_rcpf(1.0f + fexp(-al)), rh = (1.0f + fexp(-bh)) * __builtin_amdgcn_rcpf(1.0f + fexp(-ah));
            if (e < 2) { v0[2 * e] *= rl; v0[2 * e + 1] *= rh; } else { v1[2 * e - 4] *= rl; v1[2 * e - 3] *= rh; } }
    }
    __device__ __forceinline__ void elem8(int row, int col, f32x4 v0, f32x4 v1) const {
        const u32x4 gb = *(const u32x4*)(Z + (size_t)row * ZLD + ZC_GB + col);
#pragma unroll
        for (int e = 0; e < 4; ++e) { const float sl = sigmoidf_(bf2f(gb[e] & 0xffffu)), sh = sigmoidf_(bf2f(gb[e] >> 16));
            if (e < 2) { v0[2 * e] *= sl; v0[2 * e + 1] *= sh; } else { v1[2 * e - 4] *= sl; v1[2 * e - 3] *= sh; } }
        *(u32x4*)(MG + (size_t)row * D + col) = pack8v(v0, v1);
    }
};
struct EpiResid {
    static constexpr bool TWO_PART = false, PERM = false;
    float* X; const float* modg;
    __device__ __forceinline__ void elem4(int row, int col, f32x4 v) const {
        const int mj = row < NCTX ? 16 : ((row - NCTX) >> 11);
        const f32x4 gv = *(const f32x4*)(modg + (size_t)mj * NMOD + col);
        f32x4* p = (f32x4*)(X + (size_t)row * D + col);
        f32x4 x = *p; x[0] += gv[0] * v[0]; x[1] += gv[1] * v[1]; x[2] += gv[2] * v[2]; x[3] += gv[3] * v[3]; *p = x;
    }
};
struct EpiSwiGLU {
    static constexpr bool TWO_PART = false, PERM = true;
    bf16_t* HID;
    __device__ __forceinline__ void elem8(int row, int col, f32x4 v0, f32x4 v1) const {
        u32x2 w; w.x = pk2(siluf_(v0[0]) * v1[0], siluf_(v0[1]) * v1[1]); w.y = pk2(siluf_(v0[2]) * v1[2], siluf_(v0[3]) * v1[3]);
        *(u32x2*)(HID + (size_t)row * DFF + (col >> 1)) = w;
    }
};

struct Args { const float* in[32]; float* out; unsigned char* ws; int ph_lo, ph_hi; };
typedef const __attribute__((address_space(4))) Args* KArgs;
__device__ __forceinline__ KArgs kargs() { KArgs p = (KArgs)__builtin_amdgcn_kernarg_segment_ptr(); asm volatile("" : "+s"(p)); return p; }
struct Frame {
    LAS unsigned char* lds;
    int tid, lane, wave, G, bid;
    KArgs ka; float* out; unsigned char* ws;
    __device__ __forceinline__ const float* inp(int i) const { return ka->in[i]; }
};
__device__ __forceinline__ Frame make_frame() {
    extern __shared__ __attribute__((aligned(16))) unsigned char lds_raw[];
    Frame F; F.lds = (LAS unsigned char*)lds_raw; { int t = threadIdx.x; asm volatile("" : "+v"(t)); F.tid = t; } F.lane = F.tid & 63; F.wave = __builtin_amdgcn_readfirstlane(F.tid >> 6);
    { int g_ = gridDim.x, b_ = blockIdx.x; asm volatile("" : "+s"(g_), "+s"(b_)); F.G = g_; F.bid = b_; } F.ka = kargs(); F.out = F.ka->out; F.ws = F.ka->ws; return F;
}
#define IN_X 0
#define IN_C 1
#define IN_CTX 2
#define IN_CCTX 3
#define IN_WMOD 4
#define IN_BMOD 5
#define IN_N1G 6
#define IN_N2G 7
#define IN_WIN 8
#define IN_SHMU 9
#define IN_CONVW 10
#define IN_WUP 11
#define IN_W0 12
#define IN_AUP 13
#define IN_A0 14
#define IN_GUP 15
#define IN_KK 16
#define IN_KA 17
#define IN_RK 18
#define IN_LNG 19
#define IN_LNB 20
#define IN_WAO 21
#define IN_WBO 22
#define IN_WO 23
#define IN_RG 24
#define IN_RGB 25
#define IN_RE 26
#define IN_REB 27
#define IN_W1 28
#define IN_W3 29
#define IN_W2 30
#define IN_FG 31

__device__ __forceinline__ void convert_layer_weights(Frame& F, int l, int part, int widx, int nworkers);
__device__ __forceinline__ void phase_prologue() {
    Frame F = make_frame();
    convert_layer_weights(F, 0, 0, F.bid * 8 + F.wave, F.G * 8);
    {
        const f32x4* sc = (const f32x4*)F.inp(IN_CTX); const f32x4* sx = (const f32x4*)F.inp(IN_X); f32x4* X = (f32x4*)(F.ws + WS_X);
        const size_t n4c = (size_t)NCTX * D / 4, n4 = (size_t)NT * D / 4;
        for (size_t i = (size_t)F.bid * 512 + F.tid; i < n4; i += (size_t)F.G * 512) X[i] = i < n4c ? sc[i] : sx[i - n4c];
    }
    {
        float* WC = (float*)(F.ws + WS_WC); float* RB = (float*)(F.ws + WS_RB);
        for (int i = F.bid * 512 + F.tid; i < DEPTH * 1024 * 48; i += F.G * 512) { const int c = i % 48, lk = i / 48;
            WC[i] = c < 32 ? F.inp(IN_RE)[(size_t)lk * 32 + c] : (c < 36 ? F.inp(IN_RG)[(size_t)lk * 4 + (c - 32)] : 0.f); }
        if (F.bid == 0 && F.tid < DEPTH * 48) { const int c = F.tid % 48, l = F.tid / 48; RB[F.tid] = c < 32 ? F.inp(IN_REB)[l * 32 + c] : (c < 36 ? F.inp(IN_RGB)[l * 4 + (c - 32)] : 0.f); }
    }
    {
        LAS float* st = (LAS float*)F.lds;
        LAS float* red = (LAS float*)(F.lds + 1024 * 20 * 4);
        __syncthreads();
        for (int i = F.tid; i < 17 * 1024; i += 512) { const int j = i >> 10, k = i & 1023; const float cv = j < 16 ? F.inp(IN_C)[j * 1024 + k] : F.inp(IN_CCTX)[k]; st[k * 20 + j] = siluf_(cv); }
        __syncthreads();
        for (int cb0 = F.bid * 96; cb0 < DEPTH * NMOD; cb0 += F.G * 96) {
            const int c = F.tid % 96, kg = F.tid / 96, cidx = cb0 + c;
            if (kg < 4 && cidx < DEPTH * NMOD) {
                const int l = cidx / NMOD, n = cidx % NMOD;
                const float* w = F.inp(IN_WMOD) + (size_t)l * D * NMOD + n + (size_t)(256 * kg) * NMOD;
                float acc[17];
#pragma unroll
                for (int j = 0; j < 17; ++j) acc[j] = 0.f;
#pragma unroll 8
                for (int k = 0; k < 256; ++k) {
                    const float wv = w[(size_t)k * NMOD];
                    const LAS float* sp = st + (256 * kg + k) * 20;
#pragma unroll
                    for (int j = 0; j < 17; ++j) acc[j] = fmaf(sp[j], wv, acc[j]);
                }
#pragma unroll
                for (int j = 0; j < 17; ++j) red[(kg * 96 + c) * 17 + j] = acc[j];
            }
            __syncthreads();
            for (int i = F.tid; i < 96 * 17; i += 512) { const int c2 = i / 17, j = i % 17, cidx2 = cb0 + c2;
                if (cidx2 < DEPTH * NMOD) { const int l = cidx2 / NMOD, n = cidx2 % NMOD;
                    ((float*)(F.ws + WS_MOD))[((size_t)l * 17 + j) * NMOD + n] = red[c2 * 17 + j] + red[(96 + c2) * 17 + j] + red[(192 + c2) * 17 + j] + red[(288 + c2) * 17 + j] + F.inp(IN_BMOD)[l * NMOD + n]; } }
            __syncthreads();
        }
    }
}

__device__ __forceinline__ void conv_item(const float* src0, const float* src1, int ldsrc, int nvalid, int mode, bf16_t* dst, int K, int item, LAS float* scr, int lane) {
    const int nkb = K / 64, kb = item % nkb, jb = item / nkb, k0 = 64 * kb, j0 = 32 * jb;
    const int jj = j0 + (lane & 31);
    const float* colp;
    if (mode == 0) colp = jj < nvalid ? src0 + jj : nullptr;
    else colp = ((jj & 4) ? src1 : src0) + 4 * (jj >> 3) + (jj & 3);
    float cv[32];
#pragma unroll
    for (int i = 0; i < 32; ++i) { const int kk = 2 * i + (lane >> 5); cv[i] = colp ? colp[(size_t)(k0 + kk) * ldsrc] : 0.f; }
#pragma unroll
    for (int i = 0; i < 32; ++i) { const int kk = 2 * i + (lane >> 5); scr[kk * 33 + (lane & 31)] = cv[i]; }
    asm volatile("s_waitcnt lgkmcnt(0)" ::: "memory");
    const int c = lane & 7;
#pragma unroll
    for (int j = 0; j < 4; ++j) { const int n = (lane >> 3) + 8 * j; const LAS float* s = scr + (8 * c) * 33 + n;
        u32x4 o; o.x = pk2(s[0 * 33], s[1 * 33]); o.y = pk2(s[2 * 33], s[3 * 33]); o.z = pk2(s[4 * 33], s[5 * 33]); o.w = pk2(s[6 * 33], s[7 * 33]);
        *(u32x4*)(dst + (size_t)(j0 + n) * K + k0 + 8 * c) = o; }
    asm volatile("s_waitcnt lgkmcnt(0)" ::: "memory");
}
__device__ __forceinline__ void convert_layer_weights(Frame& F, int l, int part, int widx, int nworkers) {
    LAS float* scr = (LAS float*)(F.lds + F.wave * 8704);
    constexpr int I_IN = (1024 / 64) * (ZLD / 32), I_A = (512 / 64) * (1024 / 32), I_O = (1024 / 64) * (1024 / 32), I_13 = (1024 / 64) * (1024 / 32), I_2 = (512 / 64) * (1024 / 32);
    constexpr int NITEMS = I_IN + 2 * I_A + I_O + NE * I_13 + NE * I_2;
    constexpr int N_PART0 = I_IN + 2 * I_A + I_O;
    const int it_lo = part == 0 ? 0 : N_PART0, it_hi = part == 0 ? N_PART0 : NITEMS;
    for (int it = it_lo + widx; it < it_hi; it += nworkers) {
        int r = it;
        if (r < I_IN) { conv_item(F.inp(IN_WIN) + (size_t)l * D * NIN, nullptr, NIN, NIN, 0, (bf16_t*)(F.ws + WS_WIN), 1024, r, scr, F.lane); continue; } r -= I_IN;
        if (r < I_A) { conv_item(F.inp(IN_WAO) + (size_t)l * DH * D, nullptr, D, D, 0, (bf16_t*)(F.ws + WS_WA), 512, r, scr, F.lane); continue; } r -= I_A;
        if (r < I_A) { conv_item(F.inp(IN_WBO) + (size_t)l * DH * D, nullptr, D, D, 0, (bf16_t*)(F.ws + WS_WB), 512, r, scr, F.lane); continue; } r -= I_A;
        if (r < I_O) { conv_item(F.inp(IN_WO) + (size_t)l * D * D, nullptr, D, D, 0, (bf16_t*)(F.ws + WS_WO), 1024, r, scr, F.lane); continue; } r -= I_O;
        if (r < NE * I_13) { const int e = r / I_13, ri = r % I_13; const size_t so = ((size_t)l * NE + e) * D * DFF;
            conv_item(F.inp(IN_W1) + so, F.inp(IN_W3) + so, DFF, 0, 1, (bf16_t*)(F.ws + WS_W13) + (size_t)e * 1024 * 1024, 1024, ri, scr, F.lane); continue; } r -= NE * I_13;
        { const int e = r / I_2, ri = r % I_2; const size_t so = ((size_t)l * NE + e) * DFF * D;
            conv_item(F.inp(IN_W2) + so, nullptr, D, D, 0, (bf16_t*)(F.ws + WS_W2) + (size_t)e * 1024 * 512, 512, ri, scr, F.lane); }
    }
}

__device__ __forceinline__ void combine_row(Frame& F, int lprev, int row, f32x4 (&v)[4]) {
    const bf16_t* YS = (const bf16_t*)(F.ws + WS_YS); const int* RS = (const int*)(F.ws + WS_RS); const float* RG = (const float*)(F.ws + WS_RG);
    const int mj = row < NCTX ? 16 : ((row - NCTX) >> 11);
    const float* g2 = (const float*)(F.ws + WS_MOD) + ((size_t)lprev * 17 + mj) * NMOD + 5120;
    const int s0 = RS[2 * row], s1 = RS[2 * row + 1]; const float ga = RG[2 * row], gb = RG[2 * row + 1];
#pragma unroll
    for (int j = 0; j < 4; ++j) {
        const int c = 4 * F.lane + 256 * j;
        const u32x2 y0 = *(const u32x2*)(YS + (size_t)s0 * D + c), y1 = *(const u32x2*)(YS + (size_t)s1 * D + c);
        const f32x4 gg = *(const f32x4*)(g2 + c);
        v[j][0] += gg[0] * (ga * bf2f(y0.x & 0xffffu) + gb * bf2f(y1.x & 0xffffu));
        v[j][1] += gg[1] * (ga * bf2f(y0.x >> 16) + gb * bf2f(y1.x >> 16));
        v[j][2] += gg[2] * (ga * bf2f(y0.y & 0xffffu) + gb * bf2f(y1.y & 0xffffu));
        v[j][3] += gg[3] * (ga * bf2f(y0.y >> 16) + gb * bf2f(y1.y >> 16));
    }
}
__device__ __forceinline__ void phase_norm1(int l, int rep_ = 0) {
    asm volatile("" : "+s"(l)); Frame F = make_frame();
    if (l > 0) convert_layer_weights(F, l, 0, F.bid * 8 + F.wave, F.G * 8);
    const int gw = F.bid * 8 + F.wave, NGW = F.G * 8;
    const float* X = (const float*)(F.ws + WS_X); float* XW = rep_ ? (float*)(F.ws + WS_Z) : (float*)(F.ws + WS_X);
    bf16_t* H = rep_ ? (bf16_t*)(F.ws + WS_Z + 160 * MiB) : (bf16_t*)((unsigned char*)F.out + DO_H);
    const float* g1n = F.inp(IN_N1G) + l * D;
    for (int row = gw; row < NT; row += NGW) {
        const int mj = row < NCTX ? 16 : ((row - NCTX) >> 11);
        const float* mod = (const float*)(F.ws + WS_MOD) + ((size_t)l * 17 + mj) * NMOD;
        f32x4 v[4];
#pragma unroll
        for (int j = 0; j < 4; ++j) v[j] = *(const f32x4*)(X + (size_t)row * D + 4 * F.lane + 256 * j);
        if (l > 0) {
            combine_row(F, l - 1, row, v);
#pragma unroll
            for (int j = 0; j < 4; ++j) *(f32x4*)(XW + (size_t)row * D + 4 * F.lane + 256 * j) = v[j];
        }
        float ss = 0.f;
#pragma unroll
        for (int j = 0; j < 4; ++j) ss += v[j][0] * v[j][0] + v[j][1] * v[j][1] + v[j][2] * v[j][2] + v[j][3] * v[j][3];
        const float rs = rsqrtf(wave_sum(ss) * (1.0f / D) + NORM_EPS);
#pragma unroll
        for (int j = 0; j < 4; ++j) {
            const int c = 4 * F.lane + 256 * j;
            const f32x4 gg = *(const f32x4*)(g1n + c), sh = *(const f32x4*)(mod + c), sc = *(const f32x4*)(mod + 1024 + c);
            float o[4];
#pragma unroll
            for (int q = 0; q < 4; ++q) o[q] = v[j][q] * rs * gg[q] * (1.0f + sc[q]) + sh[q];
            u32x2 w; w.x = pk2(o[0], o[1]); w.y = pk2(o[2], o[3]);
            *(u32x2*)(H + (size_t)row * D + c) = w;
        }
    }
}

constexpr int PW_S64 = 144, PW_S128 = 272;
constexpr int PW_G = 4 * 64 * PW_S64;
constexpr int PA_OFF = PW_G + 64 * PW_S128;
constexpr int PA_STRIDE = 784;
static_assert(PA_OFF + 128 * PA_STRIDE <= LDS_CTL, "prep LDS map");
__device__ __forceinline__ float tanh_fast(float x) { return 1.0f - 2.0f * __builtin_amdgcn_rcpf(1.0f + fexp(2.0f * x)); }
__device__ __forceinline__ void unpack8(const u32x4 p, float (&o)[8]) {
#pragma unroll
    for (int j = 0; j < 4; ++j) { o[2 * j] = bf2f(p[j] & 0xffffu); o[2 * j + 1] = bf2f(p[j] >> 16); }
}
__device__ __forceinline__ u32x4 pack8(const float (&f)[8]) { u32x4 r; r.x = pk2(f[0], f[1]); r.y = pk2(f[2], f[3]); r.z = pk2(f[4], f[5]); r.w = pk2(f[6], f[7]); return r; }
__device__ __forceinline__ void shifted16(const bf16_t* Z, int row, bool hasp, bool hasn, int col, const float* mu, float (&o)[16]) {
    const bf16_t* p = Z + (size_t)row * ZLD + ZC_RW + col;
    const u32x4 z0 = *(const u32x4*)p, z1 = *(const u32x4*)(p + 8);
    const u32x4 zero = (u32x4){0u, 0u, 0u, 0u};
    const u32x4 m0 = hasp ? *(const u32x4*)(p - ZLD) : zero, m1 = hasp ? *(const u32x4*)(p - ZLD + 8) : zero;
    const u32x4 n0 = hasn ? *(const u32x4*)(p + ZLD) : zero, n1 = hasn ? *(const u32x4*)(p + ZLD + 8) : zero;
    float z[16], zm[16], zn[16];
    { float t[8]; unpack8(z0, t);
#pragma unroll
      for (int j = 0; j < 8; ++j) z[j] = t[j];
      unpack8(z1, t);
#pragma unroll
      for (int j = 0; j < 8; ++j) z[8 + j] = t[j];
      unpack8(m0, t);
#pragma unroll
      for (int j = 0; j < 8; ++j) zm[j] = t[j];
      unpack8(m1, t);
#pragma unroll
      for (int j = 0; j < 8; ++j) zm[8 + j] = t[j];
      unpack8(n0, t);
#pragma unroll
      for (int j = 0; j < 8; ++j) zn[j] = t[j];
      unpack8(n1, t);
#pragma unroll
      for (int j = 0; j < 8; ++j) zn[8 + j] = t[j]; }
#pragma unroll
    for (int q = 0; q < 4; ++q) { const f32x4 m = *(const f32x4*)(mu + col + 4 * q);
#pragma unroll
        for (int e = 0; e < 4; ++e) { const int j = 4 * q + e; o[j] = z[j] + m[e] * (0.5f * (zm[j] + zn[j]) - z[j]); } }
}
__device__ __forceinline__ void store16(bf16_t* dst, const float (&f)[16]) {
    u32x4 a, b; a.x = pk2(f[0], f[1]); a.y = pk2(f[2], f[3]); a.z = pk2(f[4], f[5]); a.w = pk2(f[6], f[7]); b.x = pk2(f[8], f[9]); b.y = pk2(f[10], f[11]); b.z = pk2(f[12], f[13]); b.w = pk2(f[14], f[15]);
    *(u32x4*)dst = a; *(u32x4*)(dst + 8) = b;
}
__device__ __forceinline__ void phase_prep(int l) {
    asm volatile("" : "+s"(l)); Frame F = make_frame();
    const int tid = F.tid, lane = F.lane, w = F.wave, tok = lane & 15, cq = lane >> 4;
    const bf16_t* Z = (const bf16_t*)(F.ws + WS_Z);
    const float* mu = F.inp(IN_SHMU) + l * RWC;
    float* BON = (float*)(F.ws + WS_BONUS);
    for (int unit = F.bid; unit < 256; unit += F.G) {
        const int h = unit & 7, rng = unit >> 3;
        __syncthreads();
#pragma unroll 1
        for (int o = 0; o < 5; ++o) {
            const float* src = o < 2 ? F.inp(IN_WUP) + (size_t)(l * 2 + o) * 64 * DH : (o < 4 ? F.inp(IN_AUP) + (size_t)(l * 2 + (o - 2)) * 64 * DH : F.inp(IN_GUP) + (size_t)l * 128 * DH);
            const int K = o < 4 ? 64 : 128, stride = o < 4 ? PW_S64 : PW_S128, off = o < 4 ? o * 64 * PW_S64 : PW_G;
            for (int idx = tid; idx < K * 64; idx += 512) { const int c = idx & 63, k = idx >> 6; const int rr = 16 * ((c >> 2) & 3) + 4 * (c >> 4) + (c & 3);
                *(LAS unsigned short*)(F.lds + off + rr * stride + 2 * k) = (unsigned short)f2bf(src[(size_t)k * DH + 64 * h + c]); }
        }
        __syncthreads();
#pragma unroll 1
        for (int ti = 0; ti < 9; ++ti) {
            const int row0 = rng * 1152 + ti * 128;
            const bool isctx = row0 < NCTX; const int T = isctx ? CTXL : SEQ; const int t0 = isctx ? (row0 & (CTXL - 1)) : ((row0 - NCTX) & (SEQ - 1));
#pragma unroll 2
            for (int gi = lane; gi < 16 * 48; gi += 64) {
                const int tl = gi / 48, g = gi - tl * 48, t = 16 * w + tl, ts = t0 + t;
                const bf16_t* zp = Z + (size_t)(row0 + t) * ZLD + ZC_RW + 1536 + 8 * g;
                const u32x4 zero = (u32x4){0u, 0u, 0u, 0u};
                const u32x4 zc = *(const u32x4*)zp, zm = ts > 0 ? *(const u32x4*)(zp - ZLD) : zero, zn = ts < T - 1 ? *(const u32x4*)(zp + ZLD) : zero;
                const f32x4 mA = *(const f32x4*)(mu + 1536 + 8 * g), mB = *(const f32x4*)(mu + 1536 + 8 * g + 4);
                float c8[8], m8[8], n8[8], o8[8]; unpack8(zc, c8); unpack8(zm, m8); unpack8(zn, n8);
#pragma unroll
                for (int j = 0; j < 8; ++j) { const float mm = j < 4 ? mA[j] : mB[j - 4]; const float zs = c8[j] + mm * (0.5f * (m8[j] + n8[j]) - c8[j]);
                    o8[j] = g < 16 ? tanh_fast(zs) : (g < 32 ? zs : sigmoidf_(zs)); }
                *(LAS u32x4*)(F.lds + PA_OFF + t * PA_STRIDE + 16 * g) = pack8(o8);
            }
            const int t = 16 * w + tok, row = row0 + t, ts = t0 + t; const bool hasp = ts > 0, hasn = ts < T - 1;
            const int cb = 64 * h + 16 * cq;
            f32x4 acc[5][4];
#pragma unroll
            for (int o = 0; o < 5; ++o)
#pragma unroll
                for (int nt = 0; nt < 4; ++nt) acc[o][nt] = (f32x4){0.f, 0.f, 0.f, 0.f};
            const LAS unsigned char* actp = F.lds + PA_OFF + (16 * w + tok) * PA_STRIDE + 16 * cq;
#pragma unroll
            for (int o = 0; o < 4; ++o)
#pragma unroll
                for (int ks = 0; ks < 2; ++ks) {
                    const bf16x8 bfrag = *(const LAS bf16x8*)(actp + (64 * o + 32 * ks) * 2);
#pragma unroll
                    for (int nt = 0; nt < 4; ++nt) { const bf16x8 afrag = *(const LAS bf16x8*)(F.lds + o * 64 * PW_S64 + (16 * nt + tok) * PW_S64 + (32 * ks + 8 * cq) * 2);
                        acc[o][nt] = __builtin_amdgcn_mfma_f32_16x16x32_bf16(afrag, bfrag, acc[o][nt], 0, 0, 0); }
                }
#pragma unroll
            for (int ks = 0; ks < 4; ++ks) {
                const bf16x8 bfrag = *(const LAS bf16x8*)(actp + (256 + 32 * ks) * 2);
#pragma unroll
                for (int nt = 0; nt < 4; ++nt) { const bf16x8 afrag = *(const LAS bf16x8*)(F.lds + PW_G + (16 * nt + tok) * PW_S128 + (32 * ks + 8 * cq) * 2);
                    acc[4][nt] = __builtin_amdgcn_mfma_f32_16x16x32_bf16(afrag, bfrag, acc[4][nt], 0, 0, 0); }
            }
            float rv[16], kv[16], vv[16];
            shifted16(Z, row, hasp, hasn, 1024 + cb, mu, vv);
            const size_t so = ((size_t)h * NT + row) * 64 + 16 * cq;
            shifted16(Z, row, hasp, hasn, 512 + cb, mu, kv);
            float kkv[16]; float ss = 0.f;
#pragma unroll
            for (int q = 0; q < 4; ++q) { const f32x4 kw = *(const f32x4*)(F.inp(IN_KK) + l * DH + cb + 4 * q);
#pragma unroll
                for (int e = 0; e < 4; ++e) { const float ku = kv[4 * q + e] * kw[e]; kkv[4 * q + e] = ku; ss += ku * ku; } }
            ss += __shfl_xor(ss, 16); ss += __shfl_xor(ss, 32);
            const float rs = rsqrtf(ss + 1e-12f);
#pragma unroll
            for (int j = 0; j < 16; ++j) kkv[j] *= rs;
            store16((bf16_t*)(F.ws + WS_V) + so, vv);
            shifted16(Z, row, hasp, hasn, cb, mu, rv);
            { float gv[16];
#pragma unroll
              for (int j = 0; j < 16; ++j) gv[j] = acc[4][j >> 2][j & 3];
              store16((bf16_t*)((unsigned char*)F.out + DO_G) + so, gv); }
            float bon = 0.f;
#pragma unroll
            for (int d = 0; d < 2; ++d) {
                float* gep = (float*)(F.ws + (d ? WS_GE1 : WS_GE0)) + ((size_t)h * (NT / 16) + (row >> 4)) * 64 + 16 * cq;
#pragma unroll
                for (int qq = 0; qq < 2; ++qq) {
                    float ktv[8], btv[8], kdtv[8], rtv[8], gev[8];
#pragma unroll
                    for (int q2 = 0; q2 < 2; ++q2) {
                        const int q = 2 * qq + q2;
                        const f32x4 w0 = *(const f32x4*)(F.inp(IN_W0) + (l * 2 + d) * DH + cb + 4 * q), a0 = *(const f32x4*)(F.inp(IN_A0) + (l * 2 + d) * DH + cb + 4 * q);
                        const f32x4 ka = *(const f32x4*)(F.inp(IN_KA) + l * DH + cb + 4 * q), rk = *(const f32x4*)(F.inp(IN_RK) + l * DH + cb + 4 * q);
#pragma unroll
                        for (int e = 0; e < 4; ++e) { const int j = 4 * q + e, j8 = 4 * q2 + e;
                            const float lw = -0.6065306597126334f * sigmoidf_(w0[e] + acc[d][q][e]);
                            const float a = sigmoidf_(a0[e] + acc[2 + d][q][e]);
                            const float kd = kv[j] * (1.0f + (a - 1.0f) * ka[e]);
                            bon += rv[j] * kd * rk[e];
                            float ci = lw;
                            if (d == 0) { ci += __int_as_float(__builtin_amdgcn_update_dpp(0, __float_as_int(ci), 0x111, 0xf, 0xf, true)); ci += __int_as_float(__builtin_amdgcn_update_dpp(0, __float_as_int(ci), 0x112, 0xf, 0xf, true));
                                          ci += __int_as_float(__builtin_amdgcn_update_dpp(0, __float_as_int(ci), 0x114, 0xf, 0xf, true)); ci += __int_as_float(__builtin_amdgcn_update_dpp(0, __float_as_int(ci), 0x118, 0xf, 0xf, true)); }
                            else        { ci += __int_as_float(__builtin_amdgcn_update_dpp(0, __float_as_int(ci), 0x101, 0xf, 0xf, true)); ci += __int_as_float(__builtin_amdgcn_update_dpp(0, __float_as_int(ci), 0x102, 0xf, 0xf, true));
                                          ci += __int_as_float(__builtin_amdgcn_update_dpp(0, __float_as_int(ci), 0x104, 0xf, 0xf, true)); ci += __int_as_float(__builtin_amdgcn_update_dpp(0, __float_as_int(ci), 0x108, 0xf, 0xf, true)); }
                            const float gam = fexp(ci), ig = __builtin_amdgcn_rcpf(gam);
                            const float gprev = d == 0 ? __int_as_float(__builtin_amdgcn_update_dpp(0x3f800000, __float_as_int(gam), 0x111, 0xf, 0xf, false)) : __int_as_float(__builtin_amdgcn_update_dpp(0x3f800000, __float_as_int(gam), 0x101, 0xf, 0xf, false));
                            ktv[j8] = gprev * kkv[j]; btv[j8] = kkv[j] * a * ig; kdtv[j8] = kd * ig; rtv[j8] = gam * rv[j]; gev[j8] = gam; }
                    }
                    *(u32x4*)((bf16_t*)(F.ws + (d ? WS_KT1 : WS_KT0)) + so + 8 * qq) = pack8(ktv); *(u32x4*)((bf16_t*)(F.ws + (d ? WS_BT1 : WS_BT0)) + so + 8 * qq) = pack8(btv);
                    *(u32x4*)((bf16_t*)(F.ws + (d ? WS_KDT1 : WS_KDT0)) + so + 8 * qq) = pack8(kdtv); *(u32x4*)((bf16_t*)(F.ws + (d ? WS_RT1 : WS_RT0)) + so + 8 * qq) = pack8(rtv);
                    if (tok == (d ? 0 : 15)) {
                        *(f32x4*)(gep + 8 * qq) = (f32x4){gev[0], gev[1], gev[2], gev[3]}; *(f32x4*)(gep + 8 * qq + 4) = (f32x4){gev[4], gev[5], gev[6], gev[7]};
                    }
                }
            }
            bon += __shfl_xor(bon, 16); bon += __shfl_xor(bon, 32);
            if (cq == 0) BON[(size_t)row * 8 + h] = bon;
        }
    }
    __syncthreads();
}

__device__ __forceinline__ int scan_row(int b, int dir, int i) {
    if (i < CTXL) return b * CTXL + (dir ? CTXL - 1 - i : i);
    const int j = i - CTXL; return NCTX + b * SEQ + (dir ? SEQ - 1 - j : j);
}
template <int CTRL> __device__ __forceinline__ float dpp_add(float x) {
    return x + __int_as_float(__builtin_amdgcn_update_dpp(0, __float_as_int(x), CTRL, 0xf, 0xf, true));
}
__device__ __forceinline__ float reduce16(float x) {
    x = dpp_add<0xB1>(x);
    x = dpp_add<0x4E>(x);
    x = dpp_add<0x141>(x);
    x = dpp_add<0x140>(x);
    return x;
}
constexpr int SC_T = 32, SC_REC = 320, SC_PBUF = SC_T * SC_REC + 128;
constexpr int SC_YOFF = 2 * SC_PBUF * 4;
typedef float f32x2v __attribute__((ext_vector_type(2)));
#define SC_PKMUL_LO(d, a, b)     asm("v_pk_mul_f32 %0, %1, %2 op_sel_hi:[1,0]" : "=v"(d) : "v"(a), "v"(b))
#define SC_PKMUL_HI(d, a, b)     asm("v_pk_mul_f32 %0, %1, %2 op_sel:[0,1] op_sel_hi:[1,1]" : "=v"(d) : "v"(a), "v"(b))
#define SC_PKFMA_LO(d, a, b, c)  asm("v_pk_fma_f32 %0, %1, %2, %3 op_sel_hi:[1,0,1]" : "=v"(d) : "v"(a), "v"(b), "v"(c))
#define SC_PKFMA_HI(d, a, b, c)  asm("v_pk_fma_f32 %0, %1, %2, %3 op_sel:[0,1,0] op_sel_hi:[1,1,1]" : "=v"(d) : "v"(a), "v"(b), "v"(c))
#define SC_PKFMAN_LO(d, a, b, c) asm("v_pk_fma_f32 %0, %1, %2, %3 op_sel_hi:[1,0,1] neg_lo:[1,0,0] neg_hi:[1,0,0]" : "=v"(d) : "v"(a), "v"(b), "v"(c))
#define SC_PKFMAN_HI(d, a, b, c) asm("v_pk_fma_f32 %0, %1, %2, %3 op_sel:[0,1,0] op_sel_hi:[1,1,1] neg_lo:[1,0,0] neg_hi:[1,0,0]" : "=v"(d) : "v"(a), "v"(b), "v"(c))
#define SC_DPP4(a, b, c, d, CTRL) asm("s_nop 1\n\tv_add_f32_dpp %0, %0, %0 " CTRL " row_mask:0xf bank_mask:0xf\n\tv_add_f32_dpp %1, %1, %1 " CTRL " row_mask:0xf bank_mask:0xf\n\t" \
        "v_add_f32_dpp %2, %2, %2 " CTRL " row_mask:0xf bank_mask:0xf\n\tv_add_f32_dpp %3, %3, %3 " CTRL " row_mask:0xf bank_mask:0xf" : "+v"(a), "+v"(b), "+v"(c), "+v"(d))
#define SC_DPP2(a, b, CTRL) asm("s_nop 1\n\tv_add_f32_dpp %0, %0, %0 " CTRL " row_mask:0xf bank_mask:0xf\n\tv_add_f32_dpp %1, %1, %1 " CTRL " row_mask:0xf bank_mask:0xf\n\ts_nop 0" : "+v"(a), "+v"(b))
template <int VAR> __device__ __forceinline__ void phase_scan(int l) {
    asm volatile("" : "+s"(l)); Frame F = make_frame();
    const int tid = F.tid, q = tid & 15, rp = tid >> 4;
    LAS float* P = (LAS float*)F.lds; LAS float* YB = (LAS float*)(F.lds + SC_YOFF);
    const bf16_t* V = (const bf16_t*)(F.ws + WS_V);
    constexpr int NCH = (CTXL + SEQ) / SC_T;
    for (int task = F.bid; task < NBATCH * 8 * 2; task += F.G) {
        const int dir = task & 1, h = (task >> 1) & 7, b = task >> 4;
        const bf16_t* KT = (const bf16_t*)(F.ws + (dir ? WS_KT1 : WS_KT0)); const bf16_t* BT = (const bf16_t*)(F.ws + (dir ? WS_BT1 : WS_BT0));
        const bf16_t* KDT = (const bf16_t*)(F.ws + (dir ? WS_KDT1 : WS_KDT0)); const bf16_t* RT = (const bf16_t*)(F.ws + (dir ? WS_RT1 : WS_RT0));
        const float* GE = (const float*)(F.ws + (dir ? WS_GE1 : WS_GE0)) + (size_t)h * (NT / 16) * 64;
        bf16_t* Y = (bf16_t*)(F.ws + (dir ? WS_Y1 : WS_Y0));
        u32x4 stg[3]; f32x4 gstg;
#define SC_LOAD(c) do { _Pragma("unroll") for (int j = 0; j < 3; ++j) { const int u = tid + 512 * j, a = u >> 8, s_ = (u >> 3) & 31, o = u & 7; \
            const bf16_t* src = a == 0 ? KT : a == 1 ? BT : a == 2 ? KDT : a == 3 ? RT : V; \
            if (u < 1280) stg[j] = *(const u32x4*)(src + ((size_t)h * NT + scan_row(b, dir, (c) * SC_T + s_)) * 64 + 8 * o); } \
            if (tid < 32) gstg = *(const f32x4*)(GE + (size_t)(scan_row(b, dir, (c) * SC_T + 16 * (tid >> 4)) >> 4) * 64 + 4 * (tid & 15)); } while (0)
#define SC_STORE(c) do { _Pragma("unroll") for (int j = 0; j < 3; ++j) { const int u = tid + 512 * j, a = u >> 8, s_ = (u >> 3) & 31, o = u & 7; \
            if (u < 1280) { float f[8]; _Pragma("unroll") for (int e = 0; e < 4; ++e) { f[2 * e] = bf2f(stg[j][e] & 0xffffu); f[2 * e + 1] = bf2f(stg[j][e] >> 16); } \
            LAS float* dst = P + ((c) & 1) * SC_PBUF + s_ * SC_REC + a * 64 + 8 * o; \
            *(LAS f32x4*)dst = (f32x4){f[0], f[1], f[2], f[3]}; *(LAS f32x4*)(dst + 4) = (f32x4){f[4], f[5], f[6], f[7]}; } } \
            if (tid < 32) *(LAS f32x4*)(P + ((c) & 1) * SC_PBUF + SC_T * SC_REC + 4 * tid) = gstg; } while (0)
        f32x2v S[4];
#pragma unroll
        for (int e = 0; e < 4; ++e) S[e] = (f32x2v){0.f, 0.f};
        __syncthreads();
        SC_LOAD(0); SC_STORE(0);
        __syncthreads();
        for (int c = 0; c < NCH; ++c) {
            if (c + 1 < NCH) SC_LOAD(c + 1);
            if (c > 0) {
                const int s_ = tid >> 4, r4 = (tid & 15) * 4;
                const f32x4 yv = *(const LAS f32x4*)(YB + ((c - 1) & 1) * (SC_T * 64) + s_ * 64 + r4);
                u32x2 wv; wv.x = pk2(yv[0], yv[1]); wv.y = pk2(yv[2], yv[3]);
                if (VAR == 0) *(u32x2*)(Y + (size_t)scan_row(b, dir, (c - 1) * SC_T + s_) * DH + 64 * h + r4) = wv;
            }
            const LAS float* pb = P + (c & 1) * SC_PBUF + 4 * q;
            LAS float* yb = YB + (c & 1) * (SC_T * 64) + 2 * rp;
#pragma unroll
            for (int hb = 0; hb < 2; ++hb) {
                const LAS float* ph = pb + hb * 16 * SC_REC;
                f32x4 kt = *(const LAS f32x4*)(ph), bt = *(const LAS f32x4*)(ph + 64), kdt = *(const LAS f32x4*)(ph + 128), rt = *(const LAS f32x4*)(ph + 192);
                f32x2v vv = *(const LAS f32x2v*)(ph + 256 - 4 * q + 2 * rp);
                float y0 = 0.f, y1 = 0.f;
#pragma unroll
                for (int s_ = 0; s_ < 16; ++s_) {
                    const LAS float* pn = ph + (s_ + 1 < 16 ? s_ + 1 : s_) * SC_REC;
                    const f32x4 ktn = *(const LAS f32x4*)(pn), btn = *(const LAS f32x4*)(pn + 64), kdtn = *(const LAS f32x4*)(pn + 128), rtn = *(const LAS f32x4*)(pn + 192);
                    const f32x2v vvn = *(const LAS f32x2v*)(pn + 256 - 4 * q + 2 * rp);
                    const f32x2v kt01 = (f32x2v){kt[0], kt[1]}, kt23 = (f32x2v){kt[2], kt[3]}, bt01 = (f32x2v){bt[0], bt[1]}, bt23 = (f32x2v){bt[2], bt[3]};
                    const f32x2v kd01 = (f32x2v){kdt[0], kdt[1]}, kd23 = (f32x2v){kdt[2], kdt[3]}, rt01 = (f32x2v){rt[0], rt[1]}, rt23 = (f32x2v){rt[2], rt[3]};
                    f32x2v sa;
                    SC_PKMUL_LO(sa, S[0], kt01); SC_PKFMA_HI(sa, S[1], kt01, sa); SC_PKFMA_LO(sa, S[2], kt23, sa); SC_PKFMA_HI(sa, S[3], kt23, sa);
                    float sa0 = sa.x, sa1 = sa.y;
                    if (VAR != 2) {
                    SC_DPP4(sa0, sa1, y0, y1, "quad_perm:[1,0,3,2]");
                    SC_DPP4(sa0, sa1, y0, y1, "quad_perm:[2,3,0,1]");
                    SC_DPP4(sa0, sa1, y0, y1, "row_half_mirror");
                    SC_DPP4(sa0, sa1, y0, y1, "row_mirror"); }
                    if (s_ > 0 && q == 0) { yb[(hb * 16 + s_ - 1) * 64] = y0; yb[(hb * 16 + s_ - 1) * 64 + 1] = y1; }
                    sa = (f32x2v){sa0, sa1};
                    f32x2v yy;
                    if (VAR != 3) {
                    SC_PKFMA_LO(S[0], vv, kd01, S[0]); SC_PKFMA_HI(S[1], vv, kd01, S[1]); SC_PKFMA_LO(S[2], vv, kd23, S[2]); SC_PKFMA_HI(S[3], vv, kd23, S[3]);
                    SC_PKFMAN_LO(S[0], sa, bt01, S[0]); SC_PKFMAN_HI(S[1], sa, bt01, S[1]); SC_PKFMAN_LO(S[2], sa, bt23, S[2]); SC_PKFMAN_HI(S[3], sa, bt23, S[3]);
                    SC_PKMUL_LO(yy, S[0], rt01); SC_PKFMA_HI(yy, S[1], rt01, yy); SC_PKFMA_LO(yy, S[2], rt23, yy); SC_PKFMA_HI(yy, S[3], rt23, yy);
                    } else { SC_PKFMAN_LO(S[0], sa, bt01, S[0]); SC_PKMUL_LO(yy, S[0], rt01); }
                    y0 = yy.x; y1 = yy.y;
                    kt = ktn; bt = btn; kdt = kdtn; rt = rtn; vv = vvn;
                }
                SC_DPP2(y0, y1, "quad_perm:[1,0,3,2]"); SC_DPP2(y0, y1, "quad_perm:[2,3,0,1]"); SC_DPP2(y0, y1, "row_half_mirror"); SC_DPP2(y0, y1, "row_mirror");
                if (q == 0) { yb[(hb * 16 + 15) * 64] = y0; yb[(hb * 16 + 15) * 64 + 1] = y1; }
                const f32x4 ge = *(const LAS f32x4*)(pb + SC_T * SC_REC + hb * 64);
#pragma unroll
                for (int e = 0; e < 4; ++e) S[e] *= ge[e];
            }
            if (c + 1 < NCH) SC_STORE(c + 1);
            __syncthreads();
        }
        {
            const int s_ = tid >> 4, r4 = (tid & 15) * 4;
            const f32x4 yv = *(const LAS f32x4*)(YB + ((NCH - 1) & 1) * (SC_T * 64) + s_ * 64 + r4);
            u32x2 wv; wv.x = pk2(yv[0], yv[1]); wv.y = pk2(yv[2], yv[3]);
            if (VAR == 0) *(u32x2*)(Y + (size_t)scan_row(b, dir, (NCH - 1) * SC_T + s_) * DH + 64 * h + r4) = wv;
        }
#undef SC_LOAD
#undef SC_STORE
    }
    __syncthreads();
}

typedef short bf16x4 __attribute__((ext_vector_type(4)));
__device__ __forceinline__ bf16x4 cvt4(const f32x4 v) { u32x2 r; r.x = pk2(v[0], v[1]); r.y = pk2(v[2], v[3]); return __builtin_bit_cast(bf16x4, r); }
__device__ __forceinline__ f32x4 unpk4(const bf16x4 p) { const u32x2 r = __builtin_bit_cast(u32x2, p); return (f32x4){bf2f(r.x & 0xffffu), bf2f(r.x >> 16), bf2f(r.y & 0xffffu), bf2f(r.y >> 16)}; }
#define MFMA16(a, b, c) __builtin_amdgcn_mfma_f32_16x16x16bf16_1k(a, b, c, 0, 0, 0)
constexpr int CS_RS = 144, CS_ARR = 32 * CS_RS;
constexpr int CS_TS = 40, CS_TBLK = 64 * CS_TS;
constexpr int CS_KDTT = 4 * CS_ARR, CS_BTT = CS_KDTT + 2 * CS_TBLK, CS_VT = CS_BTT + 2 * CS_TBLK, CS_GE = CS_VT + 2 * CS_TBLK, CS_PB = CS_GE + 512;
constexpr int CS_GB0 = 3 * CS_PB;
constexpr int CS_GS = 40, CS_GMAT = 16 * CS_GS, CS_ABT = 4 * CS_GMAT, CS_GBLK = 3840, CS_GB = 2 * CS_GBLK;
constexpr int CS_YB = CS_GB0 + 2 * CS_GB;
static_assert(CS_YB + 2 * 8192 <= LDS_CTL, "chunked scan LDS map");
template <int SDBG> __device__ __forceinline__ void phase_scan_mfma(int l) {
    asm volatile("" : "+s"(l)); Frame F = make_frame();
    const int lane = F.lane, wave = F.wave, c16 = lane & 15, g4 = lane >> 4;
    const bool is_state = wave < 4;
    LAS unsigned char* lds = F.lds; LAS float* YB = (LAS float*)(F.lds + CS_YB);
    constexpr int NCH = (CTXL + SEQ) / 32;
    for (int task = F.bid; task < NBATCH * 8 * 2; task += F.G) {
        const int dir = task & 1, h = (task >> 1) & 7, b = task >> 4;
        const unsigned char* wsb = F.ws;
        const unsigned oKT = (unsigned)(dir ? WS_KT1 : WS_KT0), oBT = (unsigned)(dir ? WS_BT1 : WS_BT0), oKDT = (unsigned)(dir ? WS_KDT1 : WS_KDT0), oRT = (unsigned)(dir ? WS_RT1 : WS_RT0);
        const unsigned oGE = (unsigned)(dir ? WS_GE1 : WS_GE0) + (unsigned)h * (NT / 16) * 256u, oY = (unsigned)(dir ? WS_Y1 : WS_Y0);
        u32x4 stg[10]; f32x4 gstg;
#define CS_LOAD(cc) do { _Pragma("unroll") for (int jj = 0; jj < 10; ++jj) { const int a = jj >> 1, idx = hq * 64 + lane + 128 * (jj & 1), s_ = idx >> 3, o = idx & 7; \
            const unsigned ao = a == 0 ? oKT : a == 1 ? oRT : a == 2 ? oKDT : a == 3 ? oBT : (unsigned)WS_V; \
            stg[jj] = *(const u32x4*)(wsb + (ao + ((unsigned)(h * NT + scan_row(b, dir, (cc) * 32 + s_)) * 128u + 16u * o))); } \
            gstg = *(const f32x4*)(wsb + (oGE + (unsigned)(scan_row(b, dir, (cc) * 32 + 16 * ((lane >> 4) & 1)) >> 4) * 256u + 16u * (lane & 15))); } while (0)
#define CS_STORE(pbi) do { LAS unsigned char* pbs = lds + (pbi) * CS_PB; _Pragma("unroll") for (int jj = 0; jj < 10; ++jj) { const int a = jj >> 1, idx = hq * 64 + lane + 128 * (jj & 1), s_ = idx >> 3, o = idx & 7; \
            if (a < 4) *(LAS u32x4*)(pbs + a * CS_ARR + s_ * CS_RS + 16 * o) = stg[jj]; \
            if (a >= 2) { LAS unsigned char* tb = pbs + (a == 2 ? CS_KDTT : (a == 3 ? CS_BTT : CS_VT)) + (s_ >> 4) * CS_TBLK + (8 * o) * CS_TS + 2 * (s_ & 15); \
                _Pragma("unroll") for (int e = 0; e < 4; ++e) { *(LAS unsigned short*)(tb + (2 * e) * CS_TS) = (unsigned short)(stg[jj][e] & 0xffffu); *(LAS unsigned short*)(tb + (2 * e + 1) * CS_TS) = (unsigned short)(stg[jj][e] >> 16); } } } \
            if (hq == 0 && lane < 32) *(LAS f32x4*)(pbs + CS_GE + (lane >> 4) * 256 + 16 * (lane & 15)) = gstg; } while (0)
#define CS_GRAM(pbi, gbi, bq) do { const LAS unsigned char* pbg = lds + (pbi) * CS_PB; LAS unsigned char* gb = lds + CS_GB0 + (gbi) * CS_GB + (bq) * CS_GBLK; \
            const int rowoff = (16 * (bq) + c16) * CS_RS + 16 * g4; \
            _Pragma("unroll") for (int mat = 0; mat < 4; ++mat) { f32x4 acc = (f32x4){0.f, 0.f, 0.f, 0.f}; \
                _Pragma("unroll") for (int ks = 0; ks < 2; ++ks) { const bf16x8 av = *(const LAS bf16x8*)(pbg + (mat < 2 ? 0 : 1) * CS_ARR + rowoff + 64 * ks); \
                    const bf16x8 bv = *(const LAS bf16x8*)(pbg + ((mat & 1) ? 3 : 2) * CS_ARR + rowoff + 64 * ks); acc = __builtin_amdgcn_mfma_f32_16x16x32_bf16(av, bv, acc, 0, 0, 0); } \
                _Pragma("unroll") for (int rg = 0; rg < 4; ++rg) { const int t = 4 * g4 + rg; const bool keep = mat < 2 ? (c16 < t) : (c16 <= t); const float val = keep ? acc[rg] : 0.f; \
                    if (mat == 1) *(LAS float*)(gb + CS_ABT + (t * 17 + c16) * 4) = val; \
                    else *(LAS unsigned short*)(gb + (mat == 0 ? 0 : (mat == 2 ? 1 : 2)) * CS_GMAT + t * CS_GS + 2 * c16) = (unsigned short)f2bf(val); } } \
            { float colv[16]; const LAS float* abt = (const LAS float*)(gb + CS_ABT); \
              _Pragma("unroll") for (int t = 0; t < 16; ++t) { float a_ = (t == c16) ? 1.f : 0.f; _Pragma("unroll") for (int s2 = 0; s2 < t; ++s2) a_ = fmaf(-abt[t * 17 + s2], colv[s2], a_); colv[t] = a_; } \
              if (lane < 16) { _Pragma("unroll") for (int t = 0; t < 16; ++t) *(LAS unsigned short*)(gb + 3 * CS_GMAT + t * CS_GS + 2 * c16) = (unsigned short)f2bf(colv[t]); } } } while (0)
#define CS_FLUSH(cc) do { _Pragma("unroll") for (int p_ = 0; p_ < 2; ++p_) { const int s_ = (lane >> 3) + 8 * p_ + 16 * hq, r8 = 8 * (lane & 7); const LAS float* yp = YB + ((cc) & 1) * 2048 + s_ * 64 + r8; \
            const f32x4 ya = *(const LAS f32x4*)yp, yb2 = *(const LAS f32x4*)(yp + 4); u32x4 wv; wv.x = pk2(ya[0], ya[1]); wv.y = pk2(ya[2], ya[3]); wv.z = pk2(yb2[0], yb2[1]); wv.w = pk2(yb2[2], yb2[3]); \
            *(u32x4*)(const_cast<unsigned char*>(wsb) + (oY + (unsigned)scan_row(b, dir, (cc) * 32 + s_) * 1024u + 128u * h + 2u * r8)) = wv; } } while (0)
#define CS_STATE(c, P0) do { \
                const int m = wave; \
_Pragma("unroll") \
                for (int blk = 0; blk < 2; ++blk) { \
                    const LAS unsigned char* pb = lds + (P0) * CS_PB; const LAS unsigned char* gb = lds + CS_GB0 + ((c) & 1) * CS_GB + blk * CS_GBLK; \
                    const LAS unsigned char* rowb = pb + (16 * blk + c16) * CS_RS + 8 * g4; \
                    bf16x4 ak[4], ar[4], a1[4], a2[4]; f32x4 ge[4]; \
_Pragma("unroll") \
                    for (int j = 0; j < 4; ++j) { ak[j] = *(const LAS bf16x4*)(rowb + 32 * j); ar[j] = *(const LAS bf16x4*)(rowb + CS_ARR + 32 * j); \
                        a1[j] = *(const LAS bf16x4*)(pb + CS_KDTT + blk * CS_TBLK + (16 * j + c16) * CS_TS + 8 * g4); a2[j] = *(const LAS bf16x4*)(pb + CS_BTT + blk * CS_TBLK + (16 * j + c16) * CS_TS + 8 * g4); \
                        ge[j] = *(const LAS f32x4*)(pb + CS_GE + blk * 256 + (16 * j + 4 * g4) * 4); } \
                    const bf16x4 vt = *(const LAS bf16x4*)(pb + CS_VT + blk * CS_TBLK + (16 * m + c16) * CS_TS + 8 * g4); \
                    const bf16x4 makt = *(const LAS bf16x4*)(gb + c16 * CS_GS + 8 * g4), mmkt = *(const LAS bf16x4*)(gb + CS_GMAT + c16 * CS_GS + 8 * g4); \
                    const bf16x4 mmbt = *(const LAS bf16x4*)(gb + 2 * CS_GMAT + c16 * CS_GS + 8 * g4), mtt = *(const LAS bf16x4*)(gb + 3 * CS_GMAT + c16 * CS_GS + 8 * g4); \
                    asm volatile("s_waitcnt lgkmcnt(0)" ::: "memory"); \
                    bf16x4 hi[4]; \
_Pragma("unroll") \
                    for (int j = 0; j < 4; ++j) hi[j] = cvt4(H[j]); \
                    const f32x4 z4 = (f32x4){0.f, 0.f, 0.f, 0.f}; \
                    f32x4 wa = MFMA16(ak[0], hi[0], z4), wb = MFMA16(ak[2], hi[2], z4), ya = MFMA16(ar[0], hi[0], z4), yb_ = MFMA16(ar[2], hi[2], z4); \
                    wa = MFMA16(ak[1], hi[1], wa); wb = MFMA16(ak[3], hi[3], wb); ya = MFMA16(ar[1], hi[1], ya); yb_ = MFMA16(ar[3], hi[3], yb_); \
                    if (SCAN_HILO) { bf16x4 lo[4]; _Pragma("unroll") for (int j = 0; j < 4; ++j) lo[j] = cvt4(H[j] - unpk4(hi[j])); \
                        wa = MFMA16(ak[0], lo[0], wa); wb = MFMA16(ak[2], lo[2], wb); ya = MFMA16(ar[0], lo[0], ya); yb_ = MFMA16(ar[2], lo[2], yb_); \
                        wa = MFMA16(ak[1], lo[1], wa); wb = MFMA16(ak[3], lo[3], wb); ya = MFMA16(ar[1], lo[1], ya); yb_ = MFMA16(ar[3], lo[3], yb_); } \
                    wb = MFMA16(makt, vt, wb); \
                    ya = MFMA16(mmkt, vt, ya); \
                    const f32x4 wt = wa + wb; \
                    const f32x4 ut = MFMA16(mtt, cvt4(wt), z4); \
                    const bf16x4 utn = cvt4(-ut); \
                    yb_ = MFMA16(mmbt, utn, yb_); \
_Pragma("unroll") \
                    for (int j = 0; j < 4; ++j) { H[j] = MFMA16(a1[j], vt, H[j]); H[j] = MFMA16(a2[j], utn, H[j]); H[j] = H[j] * ge[j]; } \
                    const f32x4 yt = ya + yb_; \
_Pragma("unroll") \
                    for (int rg = 0; rg < 4; ++rg) YB[((c) & 1) * 2048 + (16 * blk + 4 * g4 + rg) * 64 + 16 * m + c16] = yt[rg]; \
                } \
            } while (0)
        f32x4 H[4];
#pragma unroll
        for (int j = 0; j < 4; ++j) H[j] = (f32x4){0.f, 0.f, 0.f, 0.f};
        __syncthreads();
        const int hw = wave - 4, hp = hw >> 1, hq = hw & 1;
        if (!is_state) { CS_LOAD(hp); CS_STORE(hp); CS_LOAD(hp + 2); }
        __syncthreads();
        if (!is_state) { if (!(SDBG & 2)) { if (hp == 1) CS_GRAM(0, 0, hq); } }
        __syncthreads();
#define CS_ITER(c, P0, P1, P2) do { \
            if (is_state) { if (!(SDBG & 1)) { CS_STATE(c, P0); } } \
            else if (hp == ((c) & 1)) { CS_STORE(P2); CS_LOAD(((c) + 4 < NCH ? (c) + 4 : NCH - 1)); if (!(SDBG & 4)) { if ((c) > 0) CS_FLUSH((c) - 1); } } \
            else { if (!(SDBG & 2)) { if ((c) + 1 < NCH) CS_GRAM(P1, ((c) + 1) & 1, hq); } } \
            asm volatile("s_waitcnt lgkmcnt(0)" ::: "memory"); __builtin_amdgcn_s_barrier(); asm volatile("" ::: "memory"); } while (0)
        for (int c3 = 0; c3 < NCH; c3 += 3) { CS_ITER(c3, 0, 1, 2); CS_ITER(c3 + 1, 1, 2, 0); CS_ITER(c3 + 2, 2, 0, 1); }
#undef CS_ITER
        if (!(SDBG & 4)) { if (!is_state && hp == 0) CS_FLUSH(NCH - 1); }
#undef CS_LOAD
#undef CS_STATE
#undef CS_STORE
#undef CS_GRAM
#undef CS_FLUSH
    }
    __syncthreads();
}

__device__ __forceinline__ void phase_mix(int l) {
    asm volatile("" : "+s"(l)); Frame F = make_frame();
    const int lane = F.lane, c0 = 8 * lane, hh = lane >> 3;
    const int gw = F.bid * 8 + F.wave, NGW = F.G * 8;
    const bf16_t* Z = (const bf16_t*)(F.ws + WS_Z);
    const float* cw = F.inp(IN_CONVW) + (size_t)l * 3 * DH;
    float cw0[8], cw1[8], cw2[8], lgv[8], lbv[8];
#pragma unroll
    for (int j = 0; j < 8; ++j) { cw0[j] = cw[c0 + j]; cw1[j] = cw[DH + c0 + j]; cw2[j] = cw[2 * DH + c0 + j]; lgv[j] = F.inp(IN_LNG)[l * DH + c0 + j]; lbv[j] = F.inp(IN_LNB)[l * DH + c0 + j]; }
    const bf16_t* Y0 = (const bf16_t*)(F.ws + WS_Y0); const bf16_t* Y1 = (const bf16_t*)(F.ws + WS_Y1); const bf16_t* V = (const bf16_t*)(F.ws + WS_V);
    const bf16_t* Gi = (const bf16_t*)((unsigned char*)F.out + DO_G); const float* BON = (const float*)(F.ws + WS_BONUS);
    bf16_t* UA = (bf16_t*)(F.ws + WS_UA); bf16_t* UB = (bf16_t*)(F.ws + WS_UB);
    for (int row = gw; row < NT; row += NGW) {
        int delta; bool hasp, hasn;
        if (row < NCTX) { const int t = row & (CTXL - 1); delta = 1; hasp = t > 0; hasn = t < CTXL - 1; }
        else { const int sq = (row - NCTX) & (SEQ - 1);
            if (c0 < 256) { const int gc = sq & 63; delta = 1; hasp = gc > 0; hasn = gc < 63; }
            else { const int gr = sq >> 6; delta = 64; hasp = gr > 0; hasn = gr < 31; } }
        const bf16_t* zr = Z + (size_t)row * ZLD;
        const u32x4 zero = (u32x4){0u, 0u, 0u, 0u};
        const u32x4 bg = *(const u32x4*)(zr + ZC_BG + c0), cg = *(const u32x4*)(zr + ZC_CG + c0), ha = *(const u32x4*)(zr + ZC_HA + c0);
        const u32x4 cgm = hasp ? *(const u32x4*)(zr + ZC_CG + c0 - (ptrdiff_t)delta * ZLD) : zero, ham = hasp ? *(const u32x4*)(zr + ZC_HA + c0 - (ptrdiff_t)delta * ZLD) : zero;
        const u32x4 cgp = hasn ? *(const u32x4*)(zr + ZC_CG + c0 + (ptrdiff_t)delta * ZLD) : zero, hap = hasn ? *(const u32x4*)(zr + ZC_HA + c0 + (ptrdiff_t)delta * ZLD) : zero;
        const size_t o = (size_t)row * DH + c0, oh = ((size_t)hh * NT + row) * 64 + (c0 & 63);
        const u32x4 y0p = *(const u32x4*)(Y0 + o), y1p = *(const u32x4*)(Y1 + o), vp = *(const u32x4*)(V + oh), gp = *(const u32x4*)(Gi + oh);
        const float bon = BON[(size_t)row * 8 + hh];
        float fb[8], fc[8], fh[8], fcm[8], fhm[8], fcp[8], fhp[8], ua[8];
        unpack8(bg, fb); unpack8(cg, fc); unpack8(ha, fh); unpack8(cgm, fcm); unpack8(ham, fhm); unpack8(cgp, fcp); unpack8(hap, fhp);
#pragma unroll
        for (int j = 0; j < 8; ++j) ua[j] = fb[j] * (fcm[j] * fhm[j] * cw0[j] + fc[j] * fh[j] * cw1[j] + fcp[j] * fhp[j] * cw2[j]);
        *(u32x4*)(UA + o) = pack8(ua);
        float ya[8], yb[8], fv[8], fg[8], ub[8]; unpack8(y0p, ya); unpack8(y1p, yb); unpack8(vp, fv); unpack8(gp, fg);
        float sm = 0.f;
#pragma unroll
        for (int j = 0; j < 8; ++j) { ya[j] += yb[j]; sm += ya[j]; }
        sm = dpp_add<0xB1>(sm); sm = dpp_add<0x4E>(sm); sm = dpp_add<0x141>(sm);
        const float mu = sm * (1.0f / 64.0f); float sq2 = 0.f;
#pragma unroll
        for (int j = 0; j < 8; ++j) { ya[j] -= mu; sq2 += ya[j] * ya[j]; }
        sq2 = dpp_add<0xB1>(sq2); sq2 = dpp_add<0x4E>(sq2); sq2 = dpp_add<0x141>(sq2);
        const float rstd = rsqrtf(sq2 * (1.0f / 64.0f) + GN_EPS);
#pragma unroll
        for (int j = 0; j < 8; ++j) ub[j] = (ya[j] * rstd * lgv[j] + lbv[j] + bon * fv[j]) * fg[j];
        *(u32x4*)(UB + o) = pack8(ub);
    }
}

constexpr int N2_STRIDE = 1028;
constexpr int N2_PART = 16 * N2_STRIDE * 4;
constexpr int N2_HIST = N2_PART + 8 * 16 * 48 * 4;
__device__ __forceinline__ void phase_norm2(int l) {
    asm volatile("" : "+s"(l)); Frame F = make_frame();
    const int lane = F.lane, w = F.wave;
    LAS float* HT = (LAS float*)F.lds; LAS float* PART = (LAS float*)(F.lds + N2_PART); LAS int* hist = (LAS int*)(F.lds + N2_HIST);
    const float* X = (const float*)(F.ws + WS_X); bf16_t* H = (bf16_t*)((unsigned char*)F.out + DO_H);
    const float* g2n = F.inp(IN_N2G) + l * D;
    const float* WC = (const float*)(F.ws + WS_WC) + (size_t)l * 1024 * 48; const float* RB = (const float*)(F.ws + WS_RB) + l * 48;
    int* RE = (int*)(F.ws + WS_RE); float* RG = (float*)(F.ws + WS_RG); int* RP = (int*)(F.ws + WS_RP);
    if (F.tid < 32) hist[F.tid] = 0;
    float Bv[32][3];
    { const int kg = lane >> 4, cc = lane & 15;
#pragma unroll
      for (int s_ = 0; s_ < 32; ++s_)
#pragma unroll
          for (int t = 0; t < 3; ++t) Bv[s_][t] = WC[(size_t)(256 * kg + 32 * w + s_) * 48 + 16 * t + cc]; }
    __syncthreads();
    for (int tile = F.bid; tile < NT / 16; tile += F.G) {
        const int row0 = tile * 16;
#pragma unroll
        for (int rr = 0; rr < 2; ++rr) {
            const int lr = 2 * w + rr, row = row0 + lr;
            const int mj = row < NCTX ? 16 : ((row - NCTX) >> 11);
            const float* mod = (const float*)(F.ws + WS_MOD) + ((size_t)l * 17 + mj) * NMOD;
            f32x4 v[4]; float ss = 0.f;
#pragma unroll
            for (int j = 0; j < 4; ++j) { v[j] = *(const f32x4*)(X + (size_t)row * D + 4 * lane + 256 * j); ss += v[j][0] * v[j][0] + v[j][1] * v[j][1] + v[j][2] * v[j][2] + v[j][3] * v[j][3]; }
            const float rs = rsqrtf(wave_sum(ss) * (1.0f / D) + NORM_EPS);
#pragma unroll
            for (int j = 0; j < 4; ++j) {
                const int c = 4 * lane + 256 * j;
                const f32x4 gg = *(const f32x4*)(g2n + c), sh = *(const f32x4*)(mod + 3072 + c), sc = *(const f32x4*)(mod + 4096 + c);
                f32x4 o;
#pragma unroll
                for (int q = 0; q < 4; ++q) o[q] = v[j][q] * rs * gg[q] * (1.0f + sc[q]) + sh[q];
                u32x2 wv; wv.x = pk2(o[0], o[1]); wv.y = pk2(o[2], o[3]);
                *(u32x2*)(H + (size_t)row * D + c) = wv;
                *(LAS f32x4*)(HT + lr * N2_STRIDE + c) = o;
            }
        }
        __syncthreads();
        {
            f32x4 acc[3];
#pragma unroll
            for (int t = 0; t < 3; ++t) acc[t] = (f32x4){0.f, 0.f, 0.f, 0.f};
            const LAS float* ap = HT + (lane & 15) * N2_STRIDE + 256 * (lane >> 4) + 32 * w;
#pragma unroll
            for (int i = 0; i < 8; ++i) {
                const f32x4 a4 = *(const LAS f32x4*)(ap + 4 * i);
#pragma unroll
                for (int e = 0; e < 4; ++e)
#pragma unroll
                    for (int t = 0; t < 3; ++t) acc[t] = __builtin_amdgcn_mfma_f32_16x16x4f32(a4[e], Bv[4 * i + e][t], acc[t], 0, 0, 0);
            }
#pragma unroll
            for (int t = 0; t < 3; ++t)
#pragma unroll
                for (int rg = 0; rg < 4; ++rg) PART[(w * 16 + (lane >> 4) * 4 + rg) * 48 + 16 * t + (lane & 15)] = acc[t][rg];
        }
        __syncthreads();
        if (F.tid < 16) {
            const int r = F.tid, row = row0 + r;
            float lgv[4];
#pragma unroll
            for (int g = 0; g < 4; ++g) { float a = RB[32 + g];
#pragma unroll
                for (int ww = 0; ww < 8; ++ww) a += PART[(ww * 16 + r) * 48 + 32 + g];
                lgv[g] = a; }
            int gs = 0; float lmax = lgv[0];
#pragma unroll
            for (int g = 1; g < 4; ++g) if (lgv[g] > lmax) { lmax = lgv[g]; gs = g; }
            float den = 0.f;
#pragma unroll
            for (int g = 0; g < 4; ++g) den += fexp(lgv[g] - lmax);
            const float pgmax = 1.0f / den;
            float le[8];
#pragma unroll
            for (int e = 0; e < 8; ++e) { float a = RB[gs * 8 + e];
#pragma unroll
                for (int ww = 0; ww < 8; ++ww) a += PART[(ww * 16 + r) * 48 + gs * 8 + e];
                le[e] = a; }
            int i1 = 0; float m1 = le[0];
#pragma unroll
            for (int e = 1; e < 8; ++e) if (le[e] > m1) { m1 = le[e]; i1 = e; }
            int i2 = i1 == 0 ? 1 : 0; float m2 = le[i1 == 0 ? 1 : 0];
#pragma unroll
            for (int e = 0; e < 8; ++e) if (e != i1 && le[e] > m2) { m2 = le[e]; i2 = e; }
            const float dd = fexp(m2 - m1);
            const float gate1 = pgmax / (1.0f + dd), gate2 = pgmax * dd / (1.0f + dd);
            const int e1 = gs * 8 + i1, e2 = gs * 8 + i2;
            const int p1 = __hip_atomic_fetch_add(hist + e1, 1, __ATOMIC_RELAXED, __HIP_MEMORY_SCOPE_WORKGROUP), p2 = __hip_atomic_fetch_add(hist + e2, 1, __ATOMIC_RELAXED, __HIP_MEMORY_SCOPE_WORKGROUP);
            RE[2 * row] = e1; RE[2 * row + 1] = e2; RG[2 * row] = gate1; RG[2 * row + 1] = gate2; RP[2 * row] = p1; RP[2 * row + 1] = p2;
        }
    }
    __syncthreads();
    if (F.tid < 32) ((int*)(F.ws + WS_BH))[F.bid * 32 + F.tid] = hist[F.tid];
    __syncthreads();
}

__device__ __forceinline__ void moe_tables(Frame& F, int l) {
    LAS int* seg = (LAS int*)(F.lds + LC_SEG); LAS int* cnts = (LAS int*)(F.lds + LC_CNTS); LAS int* tile_e = (LAS int*)(F.lds + LC_TILEE);
    LAS int* red = (LAS int*)(F.lds + LC_RED);
    LAS int* bbase = (LAS int*)(F.lds + LC_BBASE);
    const int* BH = (const int*)(F.ws + WS_BH);
    __syncthreads();
    { const int e = F.tid & 31, part = F.tid >> 5; int tot = 0, pre = 0;
      for (int bq = part; bq < F.G; bq += 16) { const int v = BH[bq * 32 + e]; tot += v; if (bq < F.bid) pre += v; }
      red[part * 32 + e] = tot; red[512 + part * 32 + e] = pre; }
    __syncthreads();
    if (F.tid < 32) { int tot = 0, pre = 0;
#pragma unroll 1
        for (int p = 0; p < 16; ++p) { tot += red[p * 32 + F.tid]; pre += red[512 + p * 32 + F.tid]; }
        cnts[F.tid] = tot; bbase[F.tid] = pre; }
    __syncthreads();
    if (F.tid == 0) {
        int s = 0;
#pragma unroll 1
        for (int e = 0; e < NE; ++e) { const int c = cnts[e]; seg[e] = s; const int nt = (c + 255) >> 8;
#pragma unroll 1
            for (int t = 0; t < nt; ++t) tile_e[(s >> 8) + t] = e;
            s += nt << 8; }
        seg[32] = s; seg[33] = s >> 8;
    }
    __syncthreads();
}
__device__ __forceinline__ void phase_dispatch(int l) {
    asm volatile("" : "+s"(l)); Frame F = make_frame();
    moe_tables(F, l);
    const LAS int* seg = (const LAS int*)(F.lds + LC_SEG); const LAS int* cnts = (const LAS int*)(F.lds + LC_CNTS); const LAS int* bbase = (const LAS int*)(F.lds + LC_BBASE);
    const int gw = F.bid * 8 + F.wave, NGW = F.G * 8;
    const int* RE = (const int*)(F.ws + WS_RE); const int* RP = (const int*)(F.ws + WS_RP); int* RS = (int*)(F.ws + WS_RS);
    const bf16_t* H = (const bf16_t*)((unsigned char*)F.out + DO_H); bf16_t* XS = (bf16_t*)(F.ws + WS_XS);
    for (int tile = F.bid; tile < NT / 16; tile += F.G) {
        const int item0 = (tile * 16 + 2 * F.wave) * 2;
        int slot[4]; u32x4 d0[2], d1[2];
#pragma unroll
        for (int q = 0; q < 4; ++q) { const int e = RE[item0 + q], pos = RP[item0 + q]; slot[q] = seg[e] + bbase[e] + pos; }
#pragma unroll
        for (int r = 0; r < 2; ++r) { const u32x4* src = (const u32x4*)(H + (size_t)((item0 >> 1) + r) * D); d0[r] = src[F.lane]; d1[r] = src[64 + F.lane]; }
        if (F.lane < 4) { int sl = slot[0]; sl = F.lane == 1 ? slot[1] : sl; sl = F.lane == 2 ? slot[2] : sl; sl = F.lane == 3 ? slot[3] : sl; RS[item0 + F.lane] = sl; }
#pragma unroll
        for (int q = 0; q < 4; ++q) { u32x4* dst = (u32x4*)(XS + (size_t)slot[q] * D); dst[F.lane] = d0[q >> 1]; dst[64 + F.lane] = d1[q >> 1]; }
    }
#pragma unroll 1
    for (int e = 0; e < NE; ++e) {
        const int c = cnts[e], padded = (c + 255) & ~255;
        for (int p = c + gw; p < padded; p += NGW) { u32x4* dst = (u32x4*)(XS + (size_t)(seg[e] + p) * D); dst[F.lane] = (u32x4){0u, 0u, 0u, 0u}; dst[64 + F.lane] = (u32x4){0u, 0u, 0u, 0u}; }
    }
}

__device__ __forceinline__ void phase_final() {
    Frame F = make_frame();
    const int gw = F.bid * 8 + F.wave, NGW = F.G * 8;
    const float* X = (const float*)(F.ws + WS_X); const float* fg = F.inp(IN_FG);
    for (int r = gw; r < NLAT; r += NGW) {
        const float* xr = X + (size_t)(NCTX + r) * D;
        f32x4 v[4]; float ss = 0.f;
#pragma unroll
        for (int j = 0; j < 4; ++j) v[j] = *(const f32x4*)(xr + 4 * F.lane + 256 * j);
        combine_row(F, DEPTH - 1, NCTX + r, v);
#pragma unroll
        for (int j = 0; j < 4; ++j) ss += v[j][0] * v[j][0] + v[j][1] * v[j][1] + v[j][2] * v[j][2] + v[j][3] * v[j][3];
        const float rs = rsqrtf(wave_sum(ss) * (1.0f / D) + NORM_EPS);
#pragma unroll
        for (int j = 0; j < 4; ++j) { const int c = 4 * F.lane + 256 * j; const f32x4 gg = *(const f32x4*)(fg + c);
            f32x4 o; o[0] = v[j][0] * rs * gg[0]; o[1] = v[j][1] * rs * gg[1]; o[2] = v[j][2] * rs * gg[2]; o[3] = v[j][3] * rs * gg[3];
            *(f32x4*)(F.out + (size_t)r * D + c) = o; }
    }
}

constexpr int NPL = 11;
constexpr int NPH = 1 + DEPTH * NPL + 1;
__device__ __forceinline__ void seam() {
    Frame F = make_frame();
    XcdBarrier bar; bar.bar = (unsigned*)(F.ws + WS_CTL) + CW_BAR; bar.x = xb_xcc_id(); bar.st = (volatile LAS unsigned*)(F.lds + LC_BARW);
    xcd_barrier(bar);
}
__global__ void __launch_bounds__(512, 2) mk_fwd(Args args_unused) {
    {
        Frame F = make_frame();
        for (int u = F.tid; u < (LDS_BYTES - LDS_CTL) / 4; u += 512) ((LAS unsigned*)(F.lds + LDS_CTL))[u] = 0u;
        __syncthreads();
        if (F.ka->ph_hi - F.ka->ph_lo > 1) (void)xcd_barrier_post((unsigned*)(F.ws + WS_CTL) + CW_BAR, (volatile LAS unsigned*)(F.lds + LC_BARW));
    }
#define IN(k) (kargs()->ph_lo <= (k) && (k) < kargs()->ph_hi)
#define SEAM(k) do { if (IN(k) && IN((k) + 1)) seam(); } while (0)
    int ph = 0;
    for (int rep_ = 0; rep_ < DUP_N(13); ++rep_) { if (rep_) seam(); if (PH_EN(13) && IN(ph)) phase_prologue(); }
    SEAM(ph); ++ph;
    for (int l = 0; l < DEPTH; ++l) {
        if (IN(ph) && IN(ph + 1)) { for (int i_ = 0; i_ < EXTRA_SEAMS; ++i_) seam(); }
        for (int rep_ = 0; rep_ < DUP_N(0); ++rep_) { if (rep_) seam(); if (PH_EN(0) && IN(ph)) phase_norm1(l, rep_); }
        SEAM(ph); ++ph;
        for (int rep_ = 0; rep_ < DUP_N(1); ++rep_) { if (rep_) seam(); if (PH_EN(1) && IN(ph)) { Frame F = make_frame(); Gemm g{(const bf16_t*)((unsigned char*)F.out + DO_H), (const bf16_t*)(F.ws + WS_WIN), NT, ZLD, D, 0, 0}; StaticOrder S; S.init(NT, ZLD, F.G, F.bid); EpiStoreBf16 E{(bf16_t*)(F.ws + WS_Z), ZLD}; gemm_phase(F.lds, g, S, E); } }
        SEAM(ph); ++ph;
        for (int rep_ = 0; rep_ < DUP_N(2); ++rep_) { if (rep_) seam(); if (PH_EN(2) && IN(ph)) phase_prep(l); }
        SEAM(ph); ++ph;
        for (int rep_ = 0; rep_ < DUP_N(3); ++rep_) { if (rep_) seam(); if (PH_EN(3) && IN(ph)) { if (SCAN_IMPL == 1) { if (rep_ == 0) phase_scan_mfma<0>(l); else phase_scan_mfma<SCAN_DBG>(l); } else if (rep_ == 0) phase_scan<0>(l); else phase_scan<SCAN_VAR>(l); } }
        SEAM(ph); ++ph;
        for (int rep_ = 0; rep_ < DUP_N(4); ++rep_) { if (rep_) seam(); if (PH_EN(4) && IN(ph)) phase_mix(l); }
        SEAM(ph); ++ph;
        for (int rep_ = 0; rep_ < DUP_N(5); ++rep_) { if (rep_) seam(); if (PH_EN(5) && IN(ph)) { Frame F = make_frame(); Gemm g{(const bf16_t*)(F.ws + WS_UA), (const bf16_t*)(F.ws + WS_WA), NT, D, DH, (size_t)(WS_WB - WS_WA) / 2, (size_t)(WS_UB - WS_UA) / 2}; PairOrder S; S.so.init(NT, D, F.G, F.bid); EpiMerge E{(bf16_t*)((unsigned char*)F.out + DO_H), (const bf16_t*)(F.ws + WS_Z)}; gemm_phase(F.lds, g, S, E);
            { int ll = l; asm volatile("" : "+s"(ll)); const int nwg = (NT / 256) * (D / 256), rem = nwg % F.G; const int nlight = rem ? F.G - rem : F.G, lidx = rem ? F.bid - rem : F.bid;
              if (rep_ == 0 && lidx >= 0) convert_layer_weights(F, ll, 1, lidx * 8 + F.wave, nlight * 8); } } }
        SEAM(ph); ++ph;
        for (int rep_ = 0; rep_ < DUP_N(7); ++rep_) { if (rep_) seam(); if (PH_EN(7) && IN(ph)) { int ll = l; asm volatile("" : "+s"(ll)); Frame F = make_frame(); Gemm g{(const bf16_t*)((unsigned char*)F.out + DO_H), (const bf16_t*)(F.ws + WS_WO), NT, D, D, 0, 0}; StaticOrder S; S.init(NT, D, F.G, F.bid);
            EpiResid E{rep_ ? (float*)(F.ws + WS_Z) : (float*)(F.ws + WS_X), (const float*)(F.ws + WS_MOD) + (size_t)ll * 17 * NMOD + 2048}; gemm_phase(F.lds, g, S, E); } }
        SEAM(ph); ++ph;
        for (int rep_ = 0; rep_ < DUP_N(8); ++rep_) { if (rep_) seam(); if (PH_EN(8) && IN(ph)) phase_norm2(l); }
        SEAM(ph); ++ph;
        for (int rep_ = 0; rep_ < DUP_N(9); ++rep_) { if (rep_) seam(); if (PH_EN(9) && IN(ph)) phase_dispatch(l); }
        SEAM(ph); ++ph;
        for (int rep_ = 0; rep_ < DUP_N(10); ++rep_) { if (rep_) seam(); if (PH_EN(10) && IN(ph)) { int ll = l; asm volatile("" : "+s"(ll)); Frame F = make_frame(); moe_tables(F, ll); MoeOrder S{__builtin_amdgcn_readfirstlane(((const LAS int*)(F.lds + LC_SEG))[33]), F.G, F.bid, (const LAS int*)(F.lds + LC_TILEE)};
            Gemm g{(const bf16_t*)(F.ws + WS_XS), (const bf16_t*)(F.ws + WS_W13), MAXTILES * 256, D, D, (size_t)1024 * 1024, 0}; EpiSwiGLU E{(bf16_t*)(F.ws + WS_HID)}; gemm_phase(F.lds, g, S, E); } }
        SEAM(ph); ++ph;
        for (int rep_ = 0; rep_ < DUP_N(11); ++rep_) { if (rep_) seam(); if (PH_EN(11) && IN(ph)) { int ll = l; asm volatile("" : "+s"(ll)); Frame F = make_frame(); moe_tables(F, ll); MoeOrder S{__builtin_amdgcn_readfirstlane(((const LAS int*)(F.lds + LC_SEG))[33]), F.G, F.bid, (const LAS int*)(F.lds + LC_TILEE)};
            Gemm g{(const bf16_t*)(F.ws + WS_HID), (const bf16_t*)(F.ws + WS_W2), MAXTILES * 256, D, DFF, (size_t)1024 * 512, 0}; EpiStoreBf16 E{(bf16_t*)(F.ws + WS_YS), D}; gemm_phase(F.lds, g, S, E); } }
        SEAM(ph); ++ph;
    }
    if (PH_EN(14) && IN(ph)) phase_final();
#undef IN
#undef SEAM
}

extern "C" void kernel_launch(void* const* d_in, const int* in_sizes, int n_in, void* d_out, int out_size, void* d_ws, size_t ws_size, hipStream_t stream) {
    static int grid = 0;
    if (grid == 0) {
        if (n_in != 32 || out_size != NLAT * D || ws_size < WS_END) { fprintf(stderr, "kernel_launch: unexpected shapes (n_in %d, out %d, ws %zu < %zu)\n", n_in, out_size, ws_size, (size_t)WS_END); grid = -1; return; }
        int dev = 0, cus = 0, per_cu = 0;
        if (hipGetDevice(&dev) != hipSuccess || hipDeviceGetAttribute(&cus, hipDeviceAttributeMultiprocessorCount, dev) != hipSuccess) { grid = -1; return; }
        if (hipFuncSetAttribute((const void*)mk_fwd, hipFuncAttributeMaxDynamicSharedMemorySize, LDS_BYTES) != hipSuccess) { fprintf(stderr, "kernel_launch: hipFuncSetAttribute failed\n"); grid = -1; return; }
        if (hipOccupancyMaxActiveBlocksPerMultiprocessor(&per_cu, (const void*)mk_fwd, 512, LDS_BYTES) != hipSuccess || per_cu < 1) { fprintf(stderr, "kernel_launch: occupancy query says %d\n", per_cu); }
        (void)hipGetLastError();
        grid = cus;
    }
    if (grid < 0) return;
    if (hipMemsetAsync((char*)d_ws + WS_CTL, 0, CTL_ZERO_BYTES, stream) != hipSuccess) return;
    Args a{};
    for (int i = 0; i < 32; ++i) a.in[i] = (const float*)d_in[i];
    a.out = (float*)d_out; a.ws = (unsigned char*)d_ws;
#if MK_ONE_LAUNCH
    a.ph_lo = 0; a.ph_hi = NPH;
    hipLaunchKernelGGL(mk_fwd, dim3(grid), dim3(512), LDS_BYTES, stream, a);
#else
    for (int p = 0; p < NPH; ++p) { a.ph_lo = p; a.ph_hi = p + 1; hipLaunchKernelGGL(mk_fwd, dim3(grid), dim3(512), LDS_BYTES, stream, a); }
#endif
}
```

```cpp
#include <hip/hip_runtime.h>
#include <cstdio>
#include <cstdint>

#ifndef MK_ONE_LAUNCH
#define MK_ONE_LAUNCH 1
#endif
#ifndef GEMM_IMPL
#define GEMM_IMPL 1
#endif

#ifndef PHASE_MASK
#define PHASE_MASK 0xffff
#endif
#define PH_EN(p) (((PHASE_MASK) >> (p)) & 1)
#ifndef DUP_MASK
#define DUP_MASK 0
#endif
#ifndef PROBE_PHASE
#define PROBE_PHASE -1
#endif
#ifndef EXTRA_SEAMS
#define EXTRA_SEAMS 0
#endif
#ifndef SCAN_VAR
#define SCAN_VAR 0
#endif
#ifndef SCAN_DBG
#define SCAN_DBG 0
#endif
#ifndef SCAN_HILO
#define SCAN_HILO 0
#endif
#ifndef SCAN_IMPL
#define SCAN_IMPL 1
#endif
#define DUP_N(p) (1 + (((DUP_MASK) >> (p)) & 1))
#define LAS __attribute__((address_space(3)))
typedef unsigned short bf16_t;
typedef short bf16x8 __attribute__((ext_vector_type(8)));
typedef float f32x4 __attribute__((ext_vector_type(4)));
typedef unsigned u32x4 __attribute__((ext_vector_type(4)));
typedef unsigned u32x2 __attribute__((ext_vector_type(2)));

constexpr int D = 1024, NBATCH = 16, SEQ = 2048, DEPTH = 4, CTXL = 256;
constexpr int NCTX = NBATCH * CTXL;
constexpr int NLAT = NBATCH * SEQ;
constexpr int NT = NCTX + NLAT;
constexpr int DH = 512;
constexpr int NIN = 5504, NINP = 5632, ZLD = 3584;
constexpr int ZC_BG = 0, ZC_CG = 512, ZC_HA = 1024, ZC_RW = 1536, GC_GA = 3584, GC_GB = 4608;
constexpr int RWC = 1920;
constexpr int NE = 32, DFF = 512;
constexpr int MAXTILES = 320;
constexpr int NMOD = 6 * D;
constexpr float NORM_EPS = 1e-6f, GN_EPS = 64e-5f;

constexpr size_t MiB = 1u << 20;
constexpr size_t WS_CTL = 0, CTL_ZERO_BYTES = 1 * MiB;
constexpr size_t WS_MOD = 1 * MiB;
constexpr size_t WS_RE = 3 * MiB;
constexpr size_t WS_RG = WS_RE + (size_t)NT * 8;
constexpr size_t WS_RP = WS_RG + (size_t)NT * 8;
constexpr size_t WS_RS = WS_RP + (size_t)NT * 8;
constexpr size_t WS_BH = 4 * MiB + 256 * 1024;
constexpr size_t WS_RB = 4 * MiB + 384 * 1024;
constexpr size_t WS_WC = 6 * MiB + 256 * 1024;
constexpr size_t WS_BONUS = 5 * MiB;
constexpr size_t WS_X = 8 * MiB;
constexpr size_t WS_WIN = 152 * MiB;
constexpr size_t WS_WA = 163 * MiB;
constexpr size_t WS_WB = 164 * MiB;
constexpr size_t WS_WO = 165 * MiB;
constexpr size_t WS_W13 = 167 * MiB;
constexpr size_t WS_W2 = 231 * MiB;
constexpr size_t WS_Z = 264 * MiB;
constexpr size_t WS_GT = 516 * MiB;
constexpr size_t WS_T = WS_Z;
constexpr size_t WS_XS = WS_Z;
constexpr size_t WS_HID = WS_Z + 160 * MiB;
constexpr size_t WS_SI = 660 * MiB;
constexpr size_t SI_SZ = 36 * MiB;
constexpr size_t WS_V = WS_SI, WS_KT0 = WS_SI + SI_SZ, WS_KT1 = WS_SI + 2 * SI_SZ, WS_BT0 = WS_SI + 3 * SI_SZ, WS_BT1 = WS_SI + 4 * SI_SZ,
                 WS_KDT0 = WS_SI + 5 * SI_SZ, WS_KDT1 = WS_SI + 6 * SI_SZ, WS_RT0 = WS_SI + 7 * SI_SZ, WS_RT1 = WS_SI + 8 * SI_SZ;
constexpr size_t WS_B1 = WS_RT1, WS_KD0 = WS_KDT0;
constexpr size_t WS_UA = WS_KT0, WS_UB = WS_KT1;
constexpr size_t WS_GE0 = 1092 * MiB, WS_GE1 = 1097 * MiB;
constexpr size_t WS_YS = WS_SI;
constexpr size_t WS_Y0 = 984 * MiB, WS_Y1 = 1020 * MiB;
constexpr size_t WS_END = 1102 * MiB;
constexpr size_t DO_H = 0, DO_G = 72 * MiB;
static_assert(WS_Z + (size_t)NT * ZLD * 2 <= WS_GT && WS_GT + (size_t)144 * MiB <= WS_SI && WS_HID + (size_t)MAXTILES * 256 * DFF * 2 <= WS_SI && WS_B1 + SI_SZ <= WS_Y0 && WS_YS + (size_t)MAXTILES * 256 * D * 2 <= WS_Y0, "ws map");
static_assert((size_t)NT * DH * 2 == SI_SZ && WS_X + (size_t)NT * D * 4 <= WS_WIN && WS_W2 + 32 * MiB <= WS_Z, "ws map 2");
constexpr int CW_CNT = 1024;
constexpr int CW_BAR = 4096;

constexpr int LDS_BYTES = 163840;
constexpr int LDS_CTL = 155648;
constexpr int LC_BARW = LDS_CTL;
constexpr int LC_SEG = LDS_CTL + 64;
constexpr int LC_CNTS = LDS_CTL + 256;
constexpr int LC_TILEE = LDS_CTL + 512;
constexpr int LC_BBASE = LDS_CTL + 2048;
constexpr int LC_RED = LDS_CTL + 4096;

__device__ __forceinline__ float bf2f(unsigned b) { return __uint_as_float(b << 16); }
typedef float f32x2c __attribute__((ext_vector_type(2)));
typedef __bf16 bf16v2c __attribute__((ext_vector_type(2)));
__device__ __forceinline__ unsigned pk2(float lo, float hi) { const f32x2c v = {lo, hi}; return __builtin_bit_cast(unsigned, __builtin_convertvector(v, bf16v2c)); }
__device__ __forceinline__ unsigned f2bf(float f) { return pk2(f, 0.f) & 0xffffu; }
__device__ __forceinline__ float wave_sum(float v) {
#pragma unroll
    for (int o = 1; o < 64; o <<= 1) v += __shfl_xor(v, o);
    return v;
}
__device__ __forceinline__ float fexp(float x) { return __builtin_amdgcn_exp2f(x * 1.4426950408889634f); }
__device__ __forceinline__ float sigmoidf_(float x) { return __builtin_amdgcn_rcpf(1.0f + fexp(-x)); }
__device__ __forceinline__ float siluf_(float x) { return x * __builtin_amdgcn_rcpf(1.0f + fexp(-x)); }

#define XB_TMO      128
#define XB_XCNT(j)  (256  + 64 * (j))
#define XB_XSUB(j)  (1280 + 64 * (j))
#define XB_XGEN(j)  (2304 + 64 * (j))
#define XB_TOP      3328
#define XB_TOPGEN   3392
#define XCD_BAR_WORDS 3456
#define XB_SPIN_CAP (1u << 22)

__device__ __forceinline__ unsigned xb_ld(unsigned* p)              { return __hip_atomic_load(p, __ATOMIC_RELAXED, __HIP_MEMORY_SCOPE_AGENT); }
__device__ __forceinline__ unsigned xb_add(unsigned* p, unsigned v) { return __hip_atomic_fetch_add(p, v, __ATOMIC_RELAXED, __HIP_MEMORY_SCOPE_AGENT); }
__device__ __forceinline__ unsigned xb_xcc_id() { return (unsigned)__builtin_amdgcn_s_getreg((3 << 11) | 20) & 0xFu; }
#define XB_SPIN(cond, bar) do { unsigned _sp = 0; while (cond) { __builtin_amdgcn_s_sleep(1); \
    if ((++_sp & 255u) == 0u) { if (xb_ld(&(bar)[XB_TMO])) break; if (_sp > XB_SPIN_CAP) { atomicAdd(&(bar)[XB_TMO], 1u); break; } } } } while (0)

struct XcdBarrier { unsigned* bar; unsigned x; volatile LAS unsigned* st; };

__device__ __forceinline__ XcdBarrier xcd_barrier_post(unsigned* bar, volatile LAS unsigned* st) {
    XcdBarrier b; b.bar = bar; b.x = xb_xcc_id(); b.st = st;
    if (threadIdx.x == 0) (void)xb_add(&bar[XB_XCNT(b.x)], 1u);
    return b;
}
__device__ __forceinline__ void xcd_barrier_complete(unsigned* bar, unsigned x, unsigned& nloc, unsigned& nx) {
    const unsigned G = gridDim.x * gridDim.y * gridDim.z;
    unsigned sum, cnt, mine, sp = 0u;
    for (;;) {
        sum = 0u; cnt = 0u; mine = 0u;
#pragma unroll
        for (unsigned j = 0; j < 16; ++j) { const unsigned c = xb_ld(&bar[XB_XCNT(j)]); sum += c; cnt += (c > 0u) ? 1u : 0u; mine = (j == x) ? c : mine; }
        if (sum == G) break;
        __builtin_amdgcn_s_sleep(1);
        if ((++sp & 255u) == 0u) { if (xb_ld(&bar[XB_TMO])) break; if (sp > XB_SPIN_CAP) { atomicAdd(&bar[XB_TMO], 1u); break; } }
    }
    nloc = mine > 0u ? mine : 1u; nx = cnt > 0u ? cnt : 1u;
}
__device__ __forceinline__ void xcd_barrier(const XcdBarrier& b) {
    asm volatile("s_waitcnt vmcnt(0)" ::: "memory");
    __syncthreads();
    if (threadIdx.x == 0) {
        unsigned* bar = b.bar;
        __builtin_amdgcn_s_waitcnt(0);
        unsigned nloc = b.st[0], nx = b.st[1];
        if (nloc == 0u) { xcd_barrier_complete(bar, b.x, nloc, nx); b.st[0] = nloc; b.st[1] = nx; }
        const unsigned old = xb_add(&bar[XB_XSUB(b.x)], 1u);
        const unsigned gen = old / nloc;
        if (old + 1u == (gen + 1u) * nloc) {
            __builtin_amdgcn_fence(__ATOMIC_RELEASE, "agent");
            asm volatile("s_waitcnt vmcnt(0)" ::: "memory");
            const unsigned og = xb_add(&bar[XB_TOP], 1u);
            const unsigned tg = og / nx;
            if (og + 1u == (tg + 1u) * nx) xb_add(&bar[XB_TOPGEN], 1u);
            else XB_SPIN(xb_ld(&bar[XB_TOPGEN]) == tg, bar);
            __builtin_amdgcn_fence(__ATOMIC_ACQUIRE, "agent");
            xb_add(&bar[XB_XGEN(b.x)], 1u);
            asm volatile("s_waitcnt vmcnt(0)" ::: "memory");
        } else {
            XB_SPIN(xb_ld(&bar[XB_XGEN(b.x)]) == gen, bar);
            __builtin_amdgcn_fence(__ATOMIC_ACQUIRE, "agent");
            asm volatile("s_waitcnt vmcnt(0)" ::: "memory");
        }
    }
    __syncthreads();
}

struct Unit { int pm, pn, bs, as; };
struct Gemm { const bf16_t* A; const bf16_t* Bt; int M, N, K; size_t bstride; size_t astride; };
constexpr int NXCD = 8, WGM = 8;
struct StaticOrder {
    int nM, nN, nwg, G, c;
    __device__ __forceinline__ void init(int M, int N, int G_, int c_) { nM = M / 256; nN = N / 256; nwg = nM * nN; G = G_; c = c_; }
    __device__ __forceinline__ bool next(int i, Unit& u) const {
        const long L = (long)i * G + c; if (L >= nwg) return false;
        int wgid = (int)L; { const int q = nwg / NXCD, r = nwg % NXCD, xcd = wgid % NXCD, off = wgid / NXCD; wgid = (xcd < r ? xcd * (q + 1) : r * (q + 1) + (xcd - r) * q) + off; }
        const int nig = WGM * nN, gid = wgid / nig, fm = gid * WGM, gsz = (nM - fm) < WGM ? (nM - fm) : WGM;
        u.pm = fm + ((wgid % nig) % gsz); u.pn = (wgid % nig) / gsz; u.bs = 0; u.as = 0; return true;
    }
};
struct PairOrder {
    StaticOrder so;
    __device__ __forceinline__ bool next(int i, Unit& u) const { if (!so.next(i >> 1, u)) return false; u.bs = i & 1; u.as = i & 1; return true; }
};
struct MoeOrder {
    int ntiles, G, c; const LAS int* tile_e;
    __device__ __forceinline__ bool next(int i, Unit& u) const {
        const int L = i * G + c; if (L >= ntiles * 4) return false;
        u.pm = L >> 2; u.pn = L & 3; u.bs = __builtin_amdgcn_readfirstlane(tile_e[u.pm]); u.as = 0; return true;
    }
};

#if GEMM_IMPL == 0
template <class Epi, class Sched>
__device__ __forceinline__ void gemm_phase(LAS unsigned char* lds, const Gemm g, const Sched& S, const Epi& E) {
    LAS float* As = (LAS float*)lds;
    LAS float* Bs = As + 16 * 260;
    const int tid = threadIdx.x, ty = tid >> 4, tx = tid & 15, lr = tid >> 1, lh = tid & 1;
    Unit u;
    for (int it = 0; S.next(it, u); ++it) {
        float acc[8][16];
#pragma unroll
        for (int i = 0; i < 8; ++i)
#pragma unroll
            for (int j = 0; j < 16; ++j) acc[i][j] = 0.f;
        const bf16_t* Ap = g.A + ((size_t)u.pm * 256 + lr) * g.K + lh * 8;
        const bf16_t* Bp = g.Bt + (size_t)u.bs * g.bstride + ((size_t)u.pn * 256 + lr) * g.K + lh * 8;
        for (int k0 = 0; k0 < g.K; k0 += 16) {
            const u32x4 av = *(const u32x4*)(Ap + k0), bv = *(const u32x4*)(Bp + k0);
            __syncthreads();
#pragma unroll
            for (int j = 0; j < 4; ++j) {
                As[(lh * 8 + 2 * j) * 260 + lr] = bf2f(av[j] & 0xffffu); As[(lh * 8 + 2 * j + 1) * 260 + lr] = bf2f(av[j] >> 16);
                Bs[(lh * 8 + 2 * j) * 260 + lr] = bf2f(bv[j] & 0xffffu); Bs[(lh * 8 + 2 * j + 1) * 260 + lr] = bf2f(bv[j] >> 16);
            }
            __syncthreads();
#pragma unroll 4
            for (int kk = 0; kk < 16; ++kk) {
                float a[8], b[16];
                const f32x4 a0 = *(const LAS f32x4*)(As + kk * 260 + ty * 8), a1 = *(const LAS f32x4*)(As + kk * 260 + ty * 8 + 4);
                a[0] = a0[0]; a[1] = a0[1]; a[2] = a0[2]; a[3] = a0[3]; a[4] = a1[0]; a[5] = a1[1]; a[6] = a1[2]; a[7] = a1[3];
#pragma unroll
                for (int q = 0; q < 4; ++q) { const f32x4 bq = *(const LAS f32x4*)(Bs + kk * 260 + tx * 4 + 64 * q); b[4 * q] = bq[0]; b[4 * q + 1] = bq[1]; b[4 * q + 2] = bq[2]; b[4 * q + 3] = bq[3]; }
#pragma unroll
                for (int i = 0; i < 8; ++i)
#pragma unroll
                    for (int j = 0; j < 16; ++j) acc[i][j] = fmaf(a[i], b[j], acc[i][j]);
            }
        }
#pragma unroll
        for (int i = 0; i < 8; ++i)
#pragma unroll
            for (int q = 0; q < 4; ++q)
                E.elem4(u.pm * 256 + ty * 8 + i, u.pn * 256 + tx * 4 + 64 * q, (f32x4){acc[i][4 * q], acc[i][4 * q + 1], acc[i][4 * q + 2], acc[i][4 * q + 3]});
    }
    __syncthreads();
}
#else
namespace pg8 {
constexpr int BM = 256, BK = 64, HALF = 128, HTB = HALF * BK * 2, STAGE_BYTES = 8 * HTB;
__device__ __forceinline__ int lds_byte(int r, int c) { const int st = (r >> 4) * 2 + (c >> 5), rr = r & 15, cc = c & 31, ob = rr * 64 + cc * 2; return st * 1024 + (ob ^ (((ob >> 9) & 1) << 5)); }
__device__ __forceinline__ int perm32(int rho) { const int n = rho >> 4, i = rho & 15; return 8 * (i >> 2) + 4 * n + (i & 3); }
__device__ __forceinline__ void stage_rc(int b, int& R, int& C) { const int st = b / 1024, sb = b % 1024, swz = sb ^ (((sb >> 9) & 1) << 5); R = (st >> 1) * 16 + swz / 64; C = (st & 1) * 32 + (swz % 64) / 2; }
}
template <class Epi, class Sched>
__device__ __forceinline__ void gemm_phase(LAS unsigned char* lds, const Gemm g, const Sched& S, const Epi& E) {
    using namespace pg8;
    int tid_ = threadIdx.x; asm volatile("" : "+v"(tid_));
    const int tid = tid_, wid = __builtin_amdgcn_readfirstlane(tid >> 6), lane = tid & 63, wr = wid >> 2, wc = wid & 3, fr = lane & 15, fq = lane >> 4;
    const int K = g.K, nt = K / BK;
    unsigned voffA[2], voffB[2];
#pragma unroll
    for (int i = 0; i < 2; ++i) { int R, C; stage_rc(tid * 16 + i * 8192, R, C); const int Rb = Epi::PERM ? ((R & ~31) + perm32(R & 31)) : R;
        voffA[i] = (unsigned)(R * K + C) * 2u; voffB[i] = (unsigned)(Rb * K + C) * 2u; }
    const size_t kstep = (size_t)(BK * 2);
    const size_t hstep = (size_t)HALF * K * 2;
    const size_t tstep = 2 * hstep;
    const unsigned ldsw = (unsigned)wid * 1024u;
    const int aoff = lds_byte(wr * 64 + fr, fq * 8), boff = lds_byte(wc * 32 + fr, fq * 8);
#define PG8_SA(b, h) (((b) * 2 + (h)) * HTB)
#define PG8_SB(b, h) ((4 + (b) * 2 + (h)) * HTB)
#define PG8_STAGE(bufoff, gbase, voff) do { _Pragma("unroll") for (int _i = 0; _i < 2; ++_i) \
        __builtin_amdgcn_global_load_lds((const unsigned*)((const char*)(gbase) + (voff)[_i]), (LAS unsigned*)(lds + (bufoff) + ldsw + _i * 8192), 16, 0, 0); } while (0)
#define PG8_LDA(dst, b, h) do { _Pragma("unroll") for (int m = 0; m < 4; ++m) _Pragma("unroll") for (int k = 0; k < 2; ++k) dst[m][k] = *(const LAS bf16x8*)(lds + PG8_SA(b, h) + aoff + m * 2048 + k * 1024); } while (0)
#define PG8_LDB(dst, b, h) do { _Pragma("unroll") for (int n = 0; n < 2; ++n) _Pragma("unroll") for (int k = 0; k < 2; ++k) dst[n][k] = *(const LAS bf16x8*)(lds + PG8_SB(b, h) + boff + n * 2048 + k * 1024); } while (0)
#define PG8_MMA(ai, bj, At, Bt) do { __builtin_amdgcn_s_setprio(1); _Pragma("unroll") for (int m = 0; m < 4; ++m) _Pragma("unroll") for (int n = 0; n < 2; ++n) _Pragma("unroll") for (int k = 0; k < 2; ++k) \
        acc[ai][bj][m][n] = __builtin_amdgcn_mfma_f32_16x16x32_bf16(Bt[n][k], At[m][k], acc[ai][bj][m][n], 0, 0, 0); __builtin_amdgcn_s_setprio(0); } while (0)
#define PG8_WAIT_V(n) asm volatile("s_waitcnt vmcnt(" #n ")" ::: "memory")
#define PG8_WAIT_L(n) asm volatile("s_waitcnt lgkmcnt(" #n ")" ::: "memory")
#define PG8_BAR __builtin_amdgcn_s_barrier()
#define PG8_SCHED __builtin_amdgcn_sched_barrier(0)
    Unit cur, nxt; int ui = 0;
    if (S.next(0, cur)) {
    f32x4 acc[2][2][4][2];
#pragma unroll
    for (int a = 0; a < 2; ++a)
#pragma unroll
        for (int b = 0; b < 2; ++b)
#pragma unroll
            for (int m = 0; m < 4; ++m)
#pragma unroll
                for (int n = 0; n < 2; ++n) acc[a][b][m][n] = (f32x4){0.f, 0.f, 0.f, 0.f};
    bf16x8 At[4][2], B0[2][2], B1[2][2];
    const char* cA = (const char*)(g.A + (size_t)cur.as * g.astride) + (size_t)cur.pm * tstep; const char* cB = (const char*)(g.Bt + (size_t)cur.bs * g.bstride) + (size_t)cur.pn * tstep;
    PG8_STAGE(PG8_SB(0, 0), cB, voffB); PG8_STAGE(PG8_SA(0, 0), cA, voffA); PG8_STAGE(PG8_SB(0, 1), cB + hstep, voffB); PG8_STAGE(PG8_SA(0, 1), cA + hstep, voffA);
    if (wr == 1) PG8_BAR;
    PG8_WAIT_V(4); PG8_BAR;
    PG8_STAGE(PG8_SB(1, 0), cB + kstep, voffB); PG8_STAGE(PG8_SA(1, 0), cA + kstep, voffA); PG8_STAGE(PG8_SB(1, 1), cB + hstep + kstep, voffB);
    PG8_WAIT_V(6); PG8_BAR;
    for (;;) {
        const bool has_next = S.next(ui + 1, nxt);
        const char* nA = has_next ? (const char*)(g.A + (size_t)nxt.as * g.astride) + (size_t)nxt.pm * tstep : cA; const char* nB = has_next ? (const char*)(g.Bt + (size_t)nxt.bs * g.bstride) + (size_t)nxt.pn * tstep : cB;
        for (int t = 0; t < nt; t += 2) {
            const bool last = (t == nt - 2);
            const char* a1 = cA + (size_t)(t + 1) * kstep;
            const char* a2 = last ? nA : cA + (size_t)(t + 2) * kstep; const char* b2 = last ? nB : cB + (size_t)(t + 2) * kstep;
            const char* a3 = a2 + kstep; const char* b3 = b2 + kstep;
            PG8_LDB(B0, 0, 0); PG8_SCHED; PG8_LDA(At, 0, 0); PG8_STAGE(PG8_SA(1, 1), a1 + hstep, voffA);
            PG8_WAIT_L(8); PG8_BAR; PG8_WAIT_L(0); PG8_MMA(0, 0, At, B0); PG8_BAR; PG8_SCHED;
            PG8_LDB(B1, 0, 1); PG8_STAGE(PG8_SB(0, 0), b2, voffB);
            PG8_BAR; PG8_WAIT_L(0); PG8_MMA(0, 1, At, B1); PG8_BAR;
            PG8_LDA(At, 0, 1); PG8_STAGE(PG8_SA(0, 0), a2, voffA);
            PG8_BAR; PG8_WAIT_L(0); PG8_MMA(1, 0, At, B0); PG8_BAR; PG8_SCHED;
            PG8_STAGE(PG8_SB(0, 1), b2 + hstep, voffB);
            PG8_WAIT_V(6); PG8_BAR; PG8_MMA(1, 1, At, B1); PG8_BAR;
            PG8_LDB(B0, 1, 0); PG8_SCHED; PG8_LDA(At, 1, 0); PG8_STAGE(PG8_SA(0, 1), a2 + hstep, voffA);
            PG8_WAIT_L(8); PG8_BAR; PG8_WAIT_L(0); PG8_MMA(0, 0, At, B0); PG8_BAR; PG8_SCHED;
            PG8_LDB(B1, 1, 1); PG8_STAGE(PG8_SB(1, 0), b3, voffB);
            PG8_BAR; PG8_WAIT_L(0); PG8_MMA(0, 1, At, B1); PG8_BAR;
            PG8_LDA(At, 1, 1); PG8_STAGE(PG8_SA(1, 0), a3, voffA);
            PG8_BAR; PG8_WAIT_L(0); PG8_MMA(1, 0, At, B0); PG8_BAR; PG8_SCHED;
            PG8_STAGE(PG8_SB(1, 1), b3 + hstep, voffB);
            PG8_WAIT_V(6); PG8_BAR; PG8_MMA(1, 1, At, B1); PG8_BAR;
        }
        bool keep = false;
        {
            const int row0 = cur.pm * 256 + wr * 64 + fr;
            if constexpr (Epi::TWO_PART) keep = (cur.as == 0);
            if constexpr (Epi::TWO_PART) {
                const int col0 = cur.pn * 256 + wc * 32 + 8 * fq;
                u32x4 gv[2][4][2];
#pragma unroll
                for (int ai = 0; ai < 2; ++ai)
#pragma unroll
                    for (int m = 0; m < 4; ++m)
#pragma unroll
                        for (int bj = 0; bj < 2; ++bj) gv[ai][m][bj] = E.gload(row0 + ai * 128 + m * 16, col0 + bj * 128, keep ? 0 : 1);
#pragma unroll
                for (int ai = 0; ai < 2; ++ai)
#pragma unroll
                    for (int m = 0; m < 4; ++m)
#pragma unroll
                        for (int bj = 0; bj < 2; ++bj) E.scale8(gv[ai][m][bj], acc[ai][bj][m][0], acc[ai][bj][m][1]);
                if (!keep) {
#pragma unroll
                    for (int ai = 0; ai < 2; ++ai)
#pragma unroll
                        for (int m = 0; m < 4; ++m)
#pragma unroll
                            for (int bj = 0; bj < 2; ++bj) E.store8(row0 + ai * 128 + m * 16, col0 + bj * 128, acc[ai][bj][m][0], acc[ai][bj][m][1]);
                }
            } else if constexpr (Epi::PERM) {
                const int col0 = cur.pn * 256 + wc * 32 + 8 * fq;
#pragma unroll
                for (int ai = 0; ai < 2; ++ai)
#pragma unroll
                    for (int m = 0; m < 4; ++m)
                    {
                        if constexpr (Epi::PAIRED) E.pair8(row0 + ai * 128 + m * 16, col0, acc[ai][0][m][0], acc[ai][0][m][1], acc[ai][1][m][0], acc[ai][1][m][1]);
                        else {
#pragma unroll
                        for (int bj = 0; bj < 2; ++bj) E.elem8(row0 + ai * 128 + m * 16, col0 + bj * 128, acc[ai][bj][m][0], acc[ai][bj][m][1]);
                        }
                    }
            } else {
                const int col0 = cur.pn * 256 + wc * 32 + 4 * fq;
#pragma unroll
                for (int ai = 0; ai < 2; ++ai)
#pragma unroll
                    for (int m = 0; m < 4; ++m)
#pragma unroll
                        for (int bj = 0; bj < 2; ++bj)
#pragma unroll
                            for (int n = 0; n < 2; ++n) E.elem4(row0 + ai * 128 + m * 16, col0 + bj * 128 + n * 16, acc[ai][bj][m][n]);
            }
        }
        if (!has_next) break;
        if (!keep) {
#pragma unroll
        for (int a = 0; a < 2; ++a)
#pragma unroll
            for (int b = 0; b < 2; ++b)
#pragma unroll
                for (int m = 0; m < 4; ++m)
#pragma unroll
                    for (int n = 0; n < 2; ++n) acc[a][b][m][n] = (f32x4){0.f, 0.f, 0.f, 0.f};
        }
        cur = nxt; cA = nA; cB = nB; ++ui;
    }
    PG8_WAIT_V(0);
    if (wr == 0) PG8_BAR;
    PG8_BAR;
    }
#undef PG8_SA
#undef PG8_SB
#undef PG8_STAGE
#undef PG8_LDA
#undef PG8_LDB
#undef PG8_MMA
#undef PG8_WAIT_V
#undef PG8_WAIT_L
#undef PG8_BAR
#undef PG8_SCHED
    __syncthreads();
}
#endif

__device__ __forceinline__ u32x4 pack8v(const f32x4 a, const f32x4 b) { u32x4 r; r.x = pk2(a[0], a[1]); r.y = pk2(a[2], a[3]); r.z = pk2(b[0], b[1]); r.w = pk2(b[2], b[3]); return r; }
struct EpiStoreBf16 {
    static constexpr bool TWO_PART = false, PERM = true, PAIRED = false;
    bf16_t* O; int ldc;
    __device__ __forceinline__ void elem8(int row, int col, f32x4 v0, f32x4 v1) const { *(u32x4*)(O + (size_t)row * ldc + col) = pack8v(v0, v1); }
};
__device__ __forceinline__ size_t gate_slot(int row, int cc  ) {
    const int rr = row & 255;
    const int oct = (rr >> 7) * 4 + ((rr >> 4) & 3), tid = ((((rr >> 6) & 1) * 4 + ((cc >> 5) & 3)) << 6) + (((cc >> 3) & 3) << 4) + (rr & 15);
    return (size_t)(oct * 512 + tid) * 8;
}
constexpr size_t GT_HALF = (size_t)8 * 512 * 8;
struct EpiZ {
    static constexpr bool TWO_PART = false, PERM = true, PAIRED = true;
    bf16_t* Z; bf16_t* GT;
    __device__ __forceinline__ void pair8(int row, int col, f32x4 a0, f32x4 a1, f32x4 b0, f32x4 b1) const {
        if (col < GC_GA) { *(u32x4*)(Z + (size_t)row * ZLD + col) = pack8v(a0, a1); *(u32x4*)(Z + (size_t)row * ZLD + col + 128) = pack8v(b0, b1); }
        else {
            f32x4 r0, r1, s0, s1;
#pragma unroll
            for (int e = 0; e < 4; ++e) { const float ea0 = fexp(-a0[e]), ea1 = fexp(-a1[e]), eb0 = fexp(-b0[e]), eb1 = fexp(-b1[e]);
                s0[e] = __builtin_amdgcn_rcpf(1.0f + eb0); s1[e] = __builtin_amdgcn_rcpf(1.0f + eb1);
                r0[e] = (1.0f + eb0) * __builtin_amdgcn_rcpf(1.0f + ea0); r1[e] = (1.0f + eb1) * __builtin_amdgcn_rcpf(1.0f + ea1); }
            bf16_t* gp = GT + (size_t)((row >> 8) * 8 + ((col - GC_GA) >> 8)) * (2 * GT_HALF) + gate_slot(row, col & 127);
            *(u32x4*)gp = pack8v(r0, r1); *(u32x4*)(gp + GT_HALF) = pack8v(s0, s1);
        }
    }
};
struct EpiMerge {
    static constexpr bool TWO_PART = true, PERM = true, PAIRED = false;
    bf16_t* MG; const bf16_t* GT;
    __device__ __forceinline__ u32x4 gload(int row, int col, int which) const {
        return *(const u32x4*)(GT + (size_t)((row >> 8) * 8 + (col >> 7)) * (2 * GT_HALF) + (size_t)which * GT_HALF + gate_slot(row, col & 127)); }
    __device__ __forceinline__ void scale8(const u32x4 r, f32x4& v0, f32x4& v1) const {
        v0[0] *= bf2f(r[0] & 0xffffu); v0[1] *= bf2f(r[0] >> 16); v0[2] *= bf2f(r[1] & 0xffffu); v0[3] *= bf2f(r[1] >> 16);
        v1[0] *= bf2f(r[2] & 0xffffu); v1[1] *= bf2f(r[2] >> 16); v1[2] *= bf2f(r[3] & 0xffffu); v1[3] *= bf2f(r[3] >> 16);
    }
    __device__ __forceinline__ void store8(int row, int col, const f32x4 v0, const f32x4 v1) const { *(u32x4*)(MG + (size_t)row * D + col) = pack8v(v0, v1); }
};
struct EpiResid {
    static constexpr bool TWO_PART = false, PERM = false, PAIRED = false;
    float* X; const float* modg;
    __device__ __forceinline__ void elem4(int row, int col, f32x4 v) const {
        const int mj = row < NCTX ? 16 : ((row - NCTX) >> 11);
        const f32x4 gv = *(const f32x4*)(modg + (size_t)mj * NMOD + col);
        f32x4* p = (f32x4*)(X + (size_t)row * D + col);
        f32x4 x = *p; x[0] += gv[0] * v[0]; x[1] += gv[1] * v[1]; x[2] += gv[2] * v[2]; x[3] += gv[3] * v[3]; *p = x;
    }
};
struct EpiSwiGLU {
    static constexpr bool TWO_PART = false, PERM = true, PAIRED = false;
    bf16_t* HID;
    __device__ __forceinline__ void elem8(int row, int col, f32x4 v0, f32x4 v1) const {
        u32x2 w; w.x = pk2(siluf_(v0[0]) * v1[0], siluf_(v0[1]) * v1[1]); w.y = pk2(siluf_(v0[2]) * v1[2], siluf_(v0[3]) * v1[3]);
        *(u32x2*)(HID + (size_t)row * DFF + (col >> 1)) = w;
    }
};

struct Args { const float* in[32]; float* out; unsigned char* ws; int ph_lo, ph_hi; };
typedef const __attribute__((address_space(4))) Args* KArgs;
__device__ __forceinline__ KArgs kargs() { KArgs p = (KArgs)__builtin_amdgcn_kernarg_segment_ptr(); asm volatile("" : "+s"(p)); return p; }
struct Frame {
    LAS unsigned char* lds;
    int tid, lane, wave, G, bid;
    KArgs ka; float* out; unsigned char* ws;
    __device__ __forceinline__ const float* inp(int i) const { return ka->in[i]; }
};
__device__ __forceinline__ Frame make_frame() {
    extern __shared__ __attribute__((aligned(16))) unsigned char lds_raw[];
    Frame F; F.lds = (LAS unsigned char*)lds_raw; { int t = threadIdx.x; asm volatile("" : "+v"(t)); F.tid = t; } F.lane = F.tid & 63; F.wave = __builtin_amdgcn_readfirstlane(F.tid >> 6);
    { int g_ = gridDim.x, b_ = blockIdx.x; asm volatile("" : "+s"(g_), "+s"(b_)); F.G = g_; F.bid = b_; } F.ka = kargs(); F.out = F.ka->out; F.ws = F.ka->ws; return F;
}
#define IN_X 0
#define IN_C 1
#define IN_CTX 2
#define IN_CCTX 3
#define IN_WMOD 4
#define IN_BMOD 5
#define IN_N1G 6
#define IN_N2G 7
#define IN_WIN 8
#define IN_SHMU 9
#define IN_CONVW 10
#define IN_WUP 11
#define IN_W0 12
#define IN_AUP 13
#define IN_A0 14
#define IN_GUP 15
#define IN_KK 16
#define IN_KA 17
#define IN_RK 18
#define IN_LNG 19
#define IN_LNB 20
#define IN_WAO 21
#define IN_WBO 22
#define IN_WO 23
#define IN_RG 24
#define IN_RGB 25
#define IN_RE 26
#define IN_REB 27
#define IN_W1 28
#define IN_W3 29
#define IN_W2 30
#define IN_FG 31

__device__ __forceinline__ void convert_layer_weights(Frame& F, int l, int part, int widx, int nworkers);
__device__ __forceinline__ void phase_prologue() {
    Frame F = make_frame();
    convert_layer_weights(F, 0, 0, F.bid * 8 + F.wave, F.G * 8);
    {
        const f32x4* sc = (const f32x4*)F.inp(IN_CTX); const f32x4* sx = (const f32x4*)F.inp(IN_X); f32x4* X = (f32x4*)(F.ws + WS_X);
        const size_t n4c = (size_t)NCTX * D / 4, n4 = (size_t)NT * D / 4;
        for (size_t i = (size_t)F.bid * 512 + F.tid; i < n4; i += (size_t)F.G * 512) X[i] = i < n4c ? sc[i] : sx[i - n4c];
    }
    {
        float* WC = (float*)(F.ws + WS_WC); float* RB = (float*)(F.ws + WS_RB);
        for (int i = F.bid * 512 + F.tid; i < DEPTH * 1024 * 48; i += F.G * 512) { const int c = i % 48, lk = i / 48;
            WC[i] = c < 32 ? F.inp(IN_RE)[(size_t)lk * 32 + c] : (c < 36 ? F.inp(IN_RG)[(size_t)lk * 4 + (c - 32)] : 0.f); }
        if (F.bid == 0 && F.tid < DEPTH * 48) { const int c = F.tid % 48, l = F.tid / 48; RB[F.tid] = c < 32 ? F.inp(IN_REB)[l * 32 + c] : (c < 36 ? F.inp(IN_RGB)[l * 4 + (c - 32)] : 0.f); }
    }
    {
        LAS float* st = (LAS float*)F.lds;
        LAS float* red = (LAS float*)(F.lds + 1024 * 20 * 4);
        __syncthreads();
        for (int i = F.tid; i < 17 * 1024; i += 512) { const int j = i >> 10, k = i & 1023; const float cv = j < 16 ? F.inp(IN_C)[j * 1024 + k] : F.inp(IN_CCTX)[k]; st[k * 20 + j] = siluf_(cv); }
        __syncthreads();
        for (int cb0 = F.bid * 96; cb0 < DEPTH * NMOD; cb0 += F.G * 96) {
            const int c = F.tid % 96, kg = F.tid / 96, cidx = cb0 + c;
            if (kg < 4 && cidx < DEPTH * NMOD) {
                const int l = cidx / NMOD, n = cidx % NMOD;
                const float* w = F.inp(IN_WMOD) + (size_t)l * D * NMOD + n + (size_t)(256 * kg) * NMOD;
                float acc[17];
#pragma unroll
                for (int j = 0; j < 17; ++j) acc[j] = 0.f;
#pragma unroll 8
                for (int k = 0; k < 256; ++k) {
                    const float wv = w[(size_t)k * NMOD];
                    const LAS float* sp = st + (256 * kg + k) * 20;
#pragma unroll
                    for (int j = 0; j < 17; ++j) acc[j] = fmaf(sp[j], wv, acc[j]);
                }
#pragma unroll
                for (int j = 0; j < 17; ++j) red[(kg * 96 + c) * 17 + j] = acc[j];
            }
            __syncthreads();
            for (int i = F.tid; i < 96 * 17; i += 512) { const int c2 = i / 17, j = i % 17, cidx2 = cb0 + c2;
                if (cidx2 < DEPTH * NMOD) { const int l = cidx2 / NMOD, n = cidx2 % NMOD;
                    ((float*)(F.ws + WS_MOD))[((size_t)l * 17 + j) * NMOD + n] = red[c2 * 17 + j] + red[(96 + c2) * 17 + j] + red[(192 + c2) * 17 + j] + red[(288 + c2) * 17 + j] + F.inp(IN_BMOD)[l * NMOD + n]; } }
            __syncthreads();
        }
    }
}

__device__ __forceinline__ void conv_item(const float* src0, const float* src1, int ldsrc, int nvalid, int mode, bf16_t* dst, int K, int item, LAS float* scr, int lane) {
    const int nkb = K / 64, kb = item % nkb, jb = item / nkb, k0 = 64 * kb, j0 = 32 * jb;
    const int jj = j0 + (lane & 31);
    const float* colp;
    if (mode == 0) colp = jj < nvalid ? src0 + jj : nullptr;
    else if (mode == 2) { const int q_ = jj - GC_GA; colp = jj < 3456 ? src0 + jj : (jj < GC_GA ? nullptr : src0 + (((q_ >> 7) & 1) ? 4480 : 3456) + 128 * (q_ >> 8) + (q_ & 127)); }
    else colp = ((jj & 4) ? src1 : src0) + 4 * (jj >> 3) + (jj & 3);
    float cv[32];
#pragma unroll
    for (int i = 0; i < 32; ++i) { const int kk = 2 * i + (lane >> 5); cv[i] = colp ? colp[(size_t)(k0 + kk) * ldsrc] : 0.f; }
#pragma unroll
    for (int i = 0; i < 32; ++i) { const int kk = 2 * i + (lane >> 5); scr[kk * 33 + (lane & 31)] = cv[i]; }
    asm volatile("s_waitcnt lgkmcnt(0)" ::: "memory");
    const int c = lane & 7;
#pragma unroll
    for (int j = 0; j < 4; ++j) { const int n = (lane >> 3) + 8 * j; const LAS float* s = scr + (8 * c) * 33 + n;
        u32x4 o; o.x = pk2(s[0 * 33], s[1 * 33]); o.y = pk2(s[2 * 33], s[3 * 33]); o.z = pk2(s[4 * 33], s[5 * 33]); o.w = pk2(s[6 * 33], s[7 * 33]);
        *(u32x4*)(dst + (size_t)(j0 + n) * K + k0 + 8 * c) = o; }
    asm volatile("s_waitcnt lgkmcnt(0)" ::: "memory");
}
__device__ __forceinline__ void convert_layer_weights(Frame& F, int l, int part, int widx, int nworkers) {
    LAS float* scr = (LAS float*)(F.lds + F.wave * 8704);
    constexpr int I_IN = (1024 / 64) * (NINP / 32), I_A = (512 / 64) * (1024 / 32), I_O = (1024 / 64) * (1024 / 32), I_13 = (1024 / 64) * (1024 / 32), I_2 = (512 / 64) * (1024 / 32);
    constexpr int NITEMS = I_IN + 2 * I_A + I_O + NE * I_13 + NE * I_2;
    constexpr int N_PART0 = I_IN + 2 * I_A + I_O;
    const int it_lo = part == 0 ? 0 : N_PART0, it_hi = part == 0 ? N_PART0 : NITEMS;
    for (int it = it_lo + widx; it < it_hi; it += nworkers) {
        int r = it;
        if (r < I_IN) { conv_item(F.inp(IN_WIN) + (size_t)l * D * NIN, nullptr, NIN, NIN, 2, (bf16_t*)(F.ws + WS_WIN), 1024, r, scr, F.lane); continue; } r -= I_IN;
        if (r < I_A) { conv_item(F.inp(IN_WAO) + (size_t)l * DH * D, nullptr, D, D, 0, (bf16_t*)(F.ws + WS_WA), 512, r, scr, F.lane); continue; } r -= I_A;
        if (r < I_A) { conv_item(F.inp(IN_WBO) + (size_t)l * DH * D, nullptr, D, D, 0, (bf16_t*)(F.ws + WS_WB), 512, r, scr, F.lane); continue; } r -= I_A;
        if (r < I_O) { conv_item(F.inp(IN_WO) + (size_t)l * D * D, nullptr, D, D, 0, (bf16_t*)(F.ws + WS_WO), 1024, r, scr, F.lane); continue; } r -= I_O;
        if (r < NE * I_13) { const int e = r / I_13, ri = r % I_13; const size_t so = ((size_t)l * NE + e) * D * DFF;
            conv_item(F.inp(IN_W1) + so, F.inp(IN_W3) + so, DFF, 0, 1, (bf16_t*)(F.ws + WS_W13) + (size_t)e * 1024 * 1024, 1024, ri, scr, F.lane); continue; } r -= NE * I_13;
        { const int e = r / I_2, ri = r % I_2; const size_t so = ((size_t)l * NE + e) * DFF * D;
            conv_item(F.inp(IN_W2) + so, nullptr, D, D, 0, (bf16_t*)(F.ws + WS_W2) + (size_t)e * 1024 * 512, 512, ri, scr, F.lane); }
    }
}

__device__ __forceinline__ void combine_row(Frame& F, int lprev, int row, f32x4 (&v)[4]) {
    const bf16_t* YS = (const bf16_t*)(F.ws + WS_YS); const int* RS = (const int*)(F.ws + WS_RS); const float* RG = (const float*)(F.ws + WS_RG);
    const int mj = row < NCTX ? 16 : ((row - NCTX) >> 11);
    const float* g2 = (const float*)(F.ws + WS_MOD) + ((size_t)lprev * 17 + mj) * NMOD + 5120;
    const int s0 = RS[2 * row], s1 = RS[2 * row + 1]; const float ga = RG[2 * row], gb = RG[2 * row + 1];
#pragma unroll
    for (int j = 0; j < 4; ++j) {
        const int c = 4 * F.lane + 256 * j;
        const u32x2 y0 = *(const u32x2*)(YS + (size_t)s0 * D + c), y1 = *(const u32x2*)(YS + (size_t)s1 * D + c);
        const f32x4 gg = *(const f32x4*)(g2 + c);
        v[j][0] += gg[0] * (ga * bf2f(y0.x & 0xffffu) + gb * bf2f(y1.x & 0xffffu));
        v[j][1] += gg[1] * (ga * bf2f(y0.x >> 16) + gb * bf2f(y1.x >> 16));
        v[j][2] += gg[2] * (ga * bf2f(y0.y & 0xffffu) + gb * bf2f(y1.y & 0xffffu));
        v[j][3] += gg[3] * (ga * bf2f(y0.y >> 16) + gb * bf2f(y1.y >> 16));
    }
}
__device__ __forceinline__ void phase_norm1(int l, int rep_ = 0) {
    asm volatile("" : "+s"(l)); Frame F = make_frame();
    if (l > 0) convert_layer_weights(F, l, 0, F.bid * 8 + F.wave, F.G * 8);
    const int gw = F.bid * 8 + F.wave, NGW = F.G * 8;
    const float* X = (const float*)(F.ws + WS_X); float* XW = rep_ ? (float*)(F.ws + WS_Z) : (float*)(F.ws + WS_X);
    bf16_t* H = rep_ ? (bf16_t*)(F.ws + WS_Z + 160 * MiB) : (bf16_t*)((unsigned char*)F.out + DO_H);
    const float* g1n = F.inp(IN_N1G) + l * D;
    for (int row = gw; row < NT; row += NGW) {
        const int mj = row < NCTX ? 16 : ((row - NCTX) >> 11);
        const float* mod = (const float*)(F.ws + WS_MOD) + ((size_t)l * 17 + mj) * NMOD;
        f32x4 v[4];
#pragma unroll
        for (int j = 0; j < 4; ++j) v[j] = *(const f32x4*)(X + (size_t)row * D + 4 * F.lane + 256 * j);
        if (l > 0) {
            combine_row(F, l - 1, row, v);
#pragma unroll
            for (int j = 0; j < 4; ++j) *(f32x4*)(XW + (size_t)row * D + 4 * F.lane + 256 * j) = v[j];
        }
        float ss = 0.f;
#pragma unroll
        for (int j = 0; j < 4; ++j) ss += v[j][0] * v[j][0] + v[j][1] * v[j][1] + v[j][2] * v[j][2] + v[j][3] * v[j][3];
        const float rs = rsqrtf(wave_sum(ss) * (1.0f / D) + NORM_EPS);
#pragma unroll
        for (int j = 0; j < 4; ++j) {
            const int c = 4 * F.lane + 256 * j;
            const f32x4 gg = *(const f32x4*)(g1n + c), sh = *(const f32x4*)(mod + c), sc = *(const f32x4*)(mod + 1024 + c);
            float o[4];
#pragma unroll
            for (int q = 0; q < 4; ++q) o[q] = v[j][q] * rs * gg[q] * (1.0f + sc[q]) + sh[q];
            u32x2 w; w.x = pk2(o[0], o[1]); w.y = pk2(o[2], o[3]);
            *(u32x2*)(H + (size_t)row * D + c) = w;
        }
    }
}

constexpr int PW_S64 = 144, PW_S128 = 272;
constexpr int PW_G = 4 * 64 * PW_S64;
constexpr int PA_OFF = PW_G + 64 * PW_S128;
constexpr int PA_STRIDE = 784;
static_assert(PA_OFF + 128 * PA_STRIDE <= LDS_CTL, "prep LDS map");
__device__ __forceinline__ float tanh_fast(float x) { return 1.0f - 2.0f * __builtin_amdgcn_rcpf(1.0f + fexp(2.0f * x)); }
__device__ __forceinline__ void unpack8(const u32x4 p, float (&o)[8]) {
#pragma unroll
    for (int j = 0; j < 4; ++j) { o[2 * j] = bf2f(p[j] & 0xffffu); o[2 * j + 1] = bf2f(p[j] >> 16); }
}
__device__ __forceinline__ u32x4 pack8(const float (&f)[8]) { u32x4 r; r.x = pk2(f[0], f[1]); r.y = pk2(f[2], f[3]); r.z = pk2(f[4], f[5]); r.w = pk2(f[6], f[7]); return r; }
__device__ __forceinline__ void shifted16(const bf16_t* Z, int row, bool hasp, bool hasn, int col, const float* mu, float (&o)[16]) {
    const bf16_t* p = Z + (size_t)row * ZLD + ZC_RW + col;
    const u32x4 z0 = *(const u32x4*)p, z1 = *(const u32x4*)(p + 8);
    const u32x4 zero = (u32x4){0u, 0u, 0u, 0u};
    const u32x4 m0 = hasp ? *(const u32x4*)(p - ZLD) : zero, m1 = hasp ? *(const u32x4*)(p - ZLD + 8) : zero;
    const u32x4 n0 = hasn ? *(const u32x4*)(p + ZLD) : zero, n1 = hasn ? *(const u32x4*)(p + ZLD + 8) : zero;
    float z[16], zm[16], zn[16];
    { float t[8]; unpack8(z0, t);
#pragma unroll
      for (int j = 0; j < 8; ++j) z[j] = t[j];
      unpack8(z1, t);
#pragma unroll
      for (int j = 0; j < 8; ++j) z[8 + j] = t[j];
      unpack8(m0, t);
#pragma unroll
      for (int j = 0; j < 8; ++j) zm[j] = t[j];
      unpack8(m1, t);
#pragma unroll
      for (int j = 0; j < 8; ++j) zm[8 + j] = t[j];
      unpack8(n0, t);
#pragma unroll
      for (int j = 0; j < 8; ++j) zn[j] = t[j];
      unpack8(n1, t);
#pragma unroll
      for (int j = 0; j < 8; ++j) zn[8 + j] = t[j]; }
#pragma unroll
    for (int q = 0; q < 4; ++q) { const f32x4 m = *(const f32x4*)(mu + col + 4 * q);
#pragma unroll
        for (int e = 0; e < 4; ++e) { const int j = 4 * q + e; o[j] = z[j] + m[e] * (0.5f * (zm[j] + zn[j]) - z[j]); } }
}
__device__ __forceinline__ void store16(bf16_t* dst, const float (&f)[16]) {
    u32x4 a, b; a.x = pk2(f[0], f[1]); a.y = pk2(f[2], f[3]); a.z = pk2(f[4], f[5]); a.w = pk2(f[6], f[7]); b.x = pk2(f[8], f[9]); b.y = pk2(f[10], f[11]); b.z = pk2(f[12], f[13]); b.w = pk2(f[14], f[15]);
    *(u32x4*)dst = a; *(u32x4*)(dst + 8) = b;
}
__device__ __forceinline__ void phase_prep(int l) {
    asm volatile("" : "+s"(l)); Frame F = make_frame();
    const int tid = F.tid, lane = F.lane, w = F.wave, tok = lane & 15, cq = lane >> 4;
    const bf16_t* Z = (const bf16_t*)(F.ws + WS_Z);
    const float* mu = F.inp(IN_SHMU) + l * RWC;
    float* BON = (float*)(F.ws + WS_BONUS);
    for (int unit = F.bid; unit < 256; unit += F.G) {
        const int h = unit & 7, rng = unit >> 3;
        __syncthreads();
#pragma unroll 1
        for (int o = 0; o < 5; ++o) {
            const float* src = o < 2 ? F.inp(IN_WUP) + (size_t)(l * 2 + o) * 64 * DH : (o < 4 ? F.inp(IN_AUP) + (size_t)(l * 2 + (o - 2)) * 64 * DH : F.inp(IN_GUP) + (size_t)l * 128 * DH);
            const int K = o < 4 ? 64 : 128, stride = o < 4 ? PW_S64 : PW_S128, off = o < 4 ? o * 64 * PW_S64 : PW_G;
            for (int idx = tid; idx < K * 64; idx += 512) { const int c = idx & 63, k = idx >> 6; const int rr = 16 * ((c >> 2) & 3) + 4 * (c >> 4) + (c & 3);
                *(LAS unsigned short*)(F.lds + off + rr * stride + 2 * k) = (unsigned short)f2bf(src[(size_t)k * DH + 64 * h + c]); }
        }
        __syncthreads();
#pragma unroll 1
        for (int ti = 0; ti < 9; ++ti) {
            const int row0 = rng * 1152 + ti * 128;
            const bool isctx = row0 < NCTX; const int T = isctx ? CTXL : SEQ; const int t0 = isctx ? (row0 & (CTXL - 1)) : ((row0 - NCTX) & (SEQ - 1));
#pragma unroll 2
            for (int gi = lane; gi < 16 * 48; gi += 64) {
                const int tl = gi / 48, g = gi - tl * 48, t = 16 * w + tl, ts = t0 + t;
                const bf16_t* zp = Z + (size_t)(row0 + t) * ZLD + ZC_RW + 1536 + 8 * g;
                const u32x4 zero = (u32x4){0u, 0u, 0u, 0u};
                const u32x4 zc = *(const u32x4*)zp, zm = ts > 0 ? *(const u32x4*)(zp - ZLD) : zero, zn = ts < T - 1 ? *(const u32x4*)(zp + ZLD) : zero;
                const f32x4 mA = *(const f32x4*)(mu + 1536 + 8 * g), mB = *(const f32x4*)(mu + 1536 + 8 * g + 4);
                float c8[8], m8[8], n8[8], o8[8]; unpack8(zc, c8); unpack8(zm, m8); unpack8(zn, n8);
#pragma unroll
                for (int j = 0; j < 8; ++j) { const float mm = j < 4 ? mA[j] : mB[j - 4]; const float zs = c8[j] + mm * (0.5f * (m8[j] + n8[j]) - c8[j]);
                    o8[j] = g < 16 ? tanh_fast(zs) : (g < 32 ? zs : sigmoidf_(zs)); }
                *(LAS u32x4*)(F.lds + PA_OFF + t * PA_STRIDE + 16 * g) = pack8(o8);
            }
            const int t = 16 * w + tok, row = row0 + t, ts = t0 + t; const bool hasp = ts > 0, hasn = ts < T - 1;
            const int cb = 64 * h + 16 * cq;
            f32x4 acc[5][4];
#pragma unroll
            for (int o = 0; o < 5; ++o)
#pragma unroll
                for (int nt = 0; nt < 4; ++nt) acc[o][nt] = (f32x4){0.f, 0.f, 0.f, 0.f};
            const LAS unsigned char* actp = F.lds + PA_OFF + (16 * w + tok) * PA_STRIDE + 16 * cq;
#pragma unroll
            for (int o = 0; o < 4; ++o)
#pragma unroll
                for (int ks = 0; ks < 2; ++ks) {
                    const bf16x8 bfrag = *(const LAS bf16x8*)(actp + (64 * o + 32 * ks) * 2);
#pragma unroll
                    for (int nt = 0; nt < 4; ++nt) { const bf16x8 afrag = *(const LAS bf16x8*)(F.lds + o * 64 * PW_S64 + (16 * nt + tok) * PW_S64 + (32 * ks + 8 * cq) * 2);
                        acc[o][nt] = __builtin_amdgcn_mfma_f32_16x16x32_bf16(afrag, bfrag, acc[o][nt], 0, 0, 0); }
                }
#pragma unroll
            for (int ks = 0; ks < 4; ++ks) {
                const bf16x8 bfrag = *(const LAS bf16x8*)(actp + (256 + 32 * ks) * 2);
#pragma unroll
                for (int nt = 0; nt < 4; ++nt) { const bf16x8 afrag = *(const LAS bf16x8*)(F.lds + PW_G + (16 * nt + tok) * PW_S128 + (32 * ks + 8 * cq) * 2);
                    acc[4][nt] = __builtin_amdgcn_mfma_f32_16x16x32_bf16(afrag, bfrag, acc[4][nt], 0, 0, 0); }
            }
            float rv[16], kv[16], vv[16];
            shifted16(Z, row, hasp, hasn, 1024 + cb, mu, vv);
            const size_t so = ((size_t)h * NT + row) * 64 + 16 * cq;
            shifted16(Z, row, hasp, hasn, 512 + cb, mu, kv);
            float kkv[16]; float ss = 0.f;
#pragma unroll
            for (int q = 0; q < 4; ++q) { const f32x4 kw = *(const f32x4*)(F.inp(IN_KK) + l * DH + cb + 4 * q);
#pragma unroll
                for (int e = 0; e < 4; ++e) { const float ku = kv[4 * q + e] * kw[e]; kkv[4 * q + e] = ku; ss += ku * ku; } }
            ss += __shfl_xor(ss, 16); ss += __shfl_xor(ss, 32);
            const float rs = rsqrtf(ss + 1e-12f);
#pragma unroll
            for (int j = 0; j < 16; ++j) kkv[j] *= rs;
            store16((bf16_t*)(F.ws + WS_V) + so, vv);
            shifted16(Z, row, hasp, hasn, cb, mu, rv);
            { float gv[16];
#pragma unroll
              for (int j = 0; j < 16; ++j) gv[j] = acc[4][j >> 2][j & 3];
              store16((bf16_t*)((unsigned char*)F.out + DO_G) + so, gv); }
            float bon = 0.f;
#pragma unroll
            for (int d = 0; d < 2; ++d) {
                float* gep = (float*)(F.ws + (d ? WS_GE1 : WS_GE0)) + ((size_t)h * (NT / 16) + (row >> 4)) * 64 + 16 * cq;
#pragma unroll
                for (int qq = 0; qq < 2; ++qq) {
                    float ktv[8], btv[8], kdtv[8], rtv[8], gev[8];
#pragma unroll
                    for (int q2 = 0; q2 < 2; ++q2) {
                        const int q = 2 * qq + q2;
                        const f32x4 w0 = *(const f32x4*)(F.inp(IN_W0) + (l * 2 + d) * DH + cb + 4 * q), a0 = *(const f32x4*)(F.inp(IN_A0) + (l * 2 + d) * DH + cb + 4 * q);
                        const f32x4 ka = *(const f32x4*)(F.inp(IN_KA) + l * DH + cb + 4 * q), rk = *(const f32x4*)(F.inp(IN_RK) + l * DH + cb + 4 * q);
#pragma unroll
                        for (int e = 0; e < 4; ++e) { const int j = 4 * q + e, j8 = 4 * q2 + e;
                            const float lw = -0.6065306597126334f * sigmoidf_(w0[e] + acc[d][q][e]);
                            const float a = sigmoidf_(a0[e] + acc[2 + d][q][e]);
                            const float kd = kv[j] * (1.0f + (a - 1.0f) * ka[e]);
                            bon += rv[j] * kd * rk[e];
                            float ci = lw;
                            if (d == 0) { ci += __int_as_float(__builtin_amdgcn_update_dpp(0, __float_as_int(ci), 0x111, 0xf, 0xf, true)); ci += __int_as_float(__builtin_amdgcn_update_dpp(0, __float_as_int(ci), 0x112, 0xf, 0xf, true));
                                          ci += __int_as_float(__builtin_amdgcn_update_dpp(0, __float_as_int(ci), 0x114, 0xf, 0xf, true)); ci += __int_as_float(__builtin_amdgcn_update_dpp(0, __float_as_int(ci), 0x118, 0xf, 0xf, true)); }
                            else        { ci += __int_as_float(__builtin_amdgcn_update_dpp(0, __float_as_int(ci), 0x101, 0xf, 0xf, true)); ci += __int_as_float(__builtin_amdgcn_update_dpp(0, __float_as_int(ci), 0x102, 0xf, 0xf, true));
                                          ci += __int_as_float(__builtin_amdgcn_update_dpp(0, __float_as_int(ci), 0x104, 0xf, 0xf, true)); ci += __int_as_float(__builtin_amdgcn_update_dpp(0, __float_as_int(ci), 0x108, 0xf, 0xf, true)); }
                            const float gam = fexp(ci), ig = __builtin_amdgcn_rcpf(gam);
                            const float gprev = d == 0 ? __int_as_float(__builtin_amdgcn_update_dpp(0x3f800000, __float_as_int(gam), 0x111, 0xf, 0xf, false)) : __int_as_float(__builtin_amdgcn_update_dpp(0x3f800000, __float_as_int(gam), 0x101, 0xf, 0xf, false));
                            ktv[j8] = gprev * kkv[j]; btv[j8] = kkv[j] * a * ig; kdtv[j8] = kd * ig; rtv[j8] = gam * rv[j]; gev[j8] = gam; }
                    }
                    *(u32x4*)((bf16_t*)(F.ws + (d ? WS_KT1 : WS_KT0)) + so + 8 * qq) = pack8(ktv); *(u32x4*)((bf16_t*)(F.ws + (d ? WS_BT1 : WS_BT0)) + so + 8 * qq) = pack8(btv);
                    *(u32x4*)((bf16_t*)(F.ws + (d ? WS_KDT1 : WS_KDT0)) + so + 8 * qq) = pack8(kdtv); *(u32x4*)((bf16_t*)(F.ws + (d ? WS_RT1 : WS_RT0)) + so + 8 * qq) = pack8(rtv);
                    if (tok == (d ? 0 : 15)) {
                        *(f32x4*)(gep + 8 * qq) = (f32x4){gev[0], gev[1], gev[2], gev[3]}; *(f32x4*)(gep + 8 * qq + 4) = (f32x4){gev[4], gev[5], gev[6], gev[7]};
                    }
                }
            }
            bon += __shfl_xor(bon, 16); bon += __shfl_xor(bon, 32);
            if (cq == 0) BON[(size_t)row * 8 + h] = bon;
        }
    }
    __syncthreads();
}

__device__ __forceinline__ int scan_row(int b, int dir, int i) {
    if (i < CTXL) return b * CTXL + (dir ? CTXL - 1 - i : i);
    const int j = i - CTXL; return NCTX + b * SEQ + (dir ? SEQ - 1 - j : j);
}
template <int CTRL> __device__ __forceinline__ float dpp_add(float x) {
    return x + __int_as_float(__builtin_amdgcn_update_dpp(0, __float_as_int(x), CTRL, 0xf, 0xf, true));
}
__device__ __forceinline__ float reduce16(float x) {
    x = dpp_add<0xB1>(x);
    x = dpp_add<0x4E>(x);
    x = dpp_add<0x141>(x);
    x = dpp_add<0x140>(x);
    return x;
}
constexpr int SC_T = 32, SC_REC = 320, SC_PBUF = SC_T * SC_REC + 128;
constexpr int SC_YOFF = 2 * SC_PBUF * 4;
typedef float f32x2v __attribute__((ext_vector_type(2)));
#define SC_PKMUL_LO(d, a, b)     asm("v_pk_mul_f32 %0, %1, %2 op_sel_hi:[1,0]" : "=v"(d) : "v"(a), "v"(b))
#define SC_PKMUL_HI(d, a, b)     asm("v_pk_mul_f32 %0, %1, %2 op_sel:[0,1] op_sel_hi:[1,1]" : "=v"(d) : "v"(a), "v"(b))
#define SC_PKFMA_LO(d, a, b, c)  asm("v_pk_fma_f32 %0, %1, %2, %3 op_sel_hi:[1,0,1]" : "=v"(d) : "v"(a), "v"(b), "v"(c))
#define SC_PKFMA_HI(d, a, b, c)  asm("v_pk_fma_f32 %0, %1, %2, %3 op_sel:[0,1,0] op_sel_hi:[1,1,1]" : "=v"(d) : "v"(a), "v"(b), "v"(c))
#define SC_PKFMAN_LO(d, a, b, c) asm("v_pk_fma_f32 %0, %1, %2, %3 op_sel_hi:[1,0,1] neg_lo:[1,0,0] neg_hi:[1,0,0]" : "=v"(d) : "v"(a), "v"(b), "v"(c))
#define SC_PKFMAN_HI(d, a, b, c) asm("v_pk_fma_f32 %0, %1, %2, %3 op_sel:[0,1,0] op_sel_hi:[1,1,1] neg_lo:[1,0,0] neg_hi:[1,0,0]" : "=v"(d) : "v"(a), "v"(b), "v"(c))
#define SC_DPP4(a, b, c, d, CTRL) asm("s_nop 1\n\tv_add_f32_dpp %0, %0, %0 " CTRL " row_mask:0xf bank_mask:0xf\n\tv_add_f32_dpp %1, %1, %1 " CTRL " row_mask:0xf bank_mask:0xf\n\t" \
        "v_add_f32_dpp %2, %2, %2 " CTRL " row_mask:0xf bank_mask:0xf\n\tv_add_f32_dpp %3, %3, %3 " CTRL " row_mask:0xf bank_mask:0xf" : "+v"(a), "+v"(b), "+v"(c), "+v"(d))
#define SC_DPP2(a, b, CTRL) asm("s_nop 1\n\tv_add_f32_dpp %0, %0, %0 " CTRL " row_mask:0xf bank_mask:0xf\n\tv_add_f32_dpp %1, %1, %1 " CTRL " row_mask:0xf bank_mask:0xf\n\ts_nop 0" : "+v"(a), "+v"(b))
template <int VAR> __device__ __forceinline__ void phase_scan(int l) {
    asm volatile("" : "+s"(l)); Frame F = make_frame();
    const int tid = F.tid, q = tid & 15, rp = tid >> 4;
    LAS float* P = (LAS float*)F.lds; LAS float* YB = (LAS float*)(F.lds + SC_YOFF);
    const bf16_t* V = (const bf16_t*)(F.ws + WS_V);
    constexpr int NCH = (CTXL + SEQ) / SC_T;
    for (int task = F.bid; task < NBATCH * 8 * 2; task += F.G) {
        const int dir = task & 1, h = (task >> 1) & 7, b = task >> 4;
        const bf16_t* KT = (const bf16_t*)(F.ws + (dir ? WS_KT1 : WS_KT0)); const bf16_t* BT = (const bf16_t*)(F.ws + (dir ? WS_BT1 : WS_BT0));
        const bf16_t* KDT = (const bf16_t*)(F.ws + (dir ? WS_KDT1 : WS_KDT0)); const bf16_t* RT = (const bf16_t*)(F.ws + (dir ? WS_RT1 : WS_RT0));
        const float* GE = (const float*)(F.ws + (dir ? WS_GE1 : WS_GE0)) + (size_t)h * (NT / 16) * 64;
        bf16_t* Y = (bf16_t*)(F.ws + (dir ? WS_Y1 : WS_Y0));
        u32x4 stg[3]; f32x4 gstg;
#define SC_LOAD(c) do { _Pragma("unroll") for (int j = 0; j < 3; ++j) { const int u = tid + 512 * j, a = u >> 8, s_ = (u >> 3) & 31, o = u & 7; \
            const bf16_t* src = a == 0 ? KT : a == 1 ? BT : a == 2 ? KDT : a == 3 ? RT : V; \
            if (u < 1280) stg[j] = *(const u32x4*)(src + ((size_t)h * NT + scan_row(b, dir, (c) * SC_T + s_)) * 64 + 8 * o); } \
            if (tid < 32) gstg = *(const f32x4*)(GE + (size_t)(scan_row(b, dir, (c) * SC_T + 16 * (tid >> 4)) >> 4) * 64 + 4 * (tid & 15)); } while (0)
#define SC_STORE(c) do { _Pragma("unroll") for (int j = 0; j < 3; ++j) { const int u = tid + 512 * j, a = u >> 8, s_ = (u >> 3) & 31, o = u & 7; \
            if (u < 1280) { float f[8]; _Pragma("unroll") for (int e = 0; e < 4; ++e) { f[2 * e] = bf2f(stg[j][e] & 0xffffu); f[2 * e + 1] = bf2f(stg[j][e] >> 16); } \
            LAS float* dst = P + ((c) & 1) * SC_PBUF + s_ * SC_REC + a * 64 + 8 * o; \
            *(LAS f32x4*)dst = (f32x4){f[0], f[1], f[2], f[3]}; *(LAS f32x4*)(dst + 4) = (f32x4){f[4], f[5], f[6], f[7]}; } } \
            if (tid < 32) *(LAS f32x4*)(P + ((c) & 1) * SC_PBUF + SC_T * SC_REC + 4 * tid) = gstg; } while (0)
        f32x2v S[4];
#pragma unroll
        for (int e = 0; e < 4; ++e) S[e] = (f32x2v){0.f, 0.f};
        __syncthreads();
        SC_LOAD(0); SC_STORE(0);
        __syncthreads();
        for (int c = 0; c < NCH; ++c) {
            if (c + 1 < NCH) SC_LOAD(c + 1);
            if (c > 0) {
                const int s_ = tid >> 4, r4 = (tid & 15) * 4;
                const f32x4 yv = *(const LAS f32x4*)(YB + ((c - 1) & 1) * (SC_T * 64) + s_ * 64 + r4);
                u32x2 wv; wv.x = pk2(yv[0], yv[1]); wv.y = pk2(yv[2], yv[3]);
                if (VAR == 0) *(u32x2*)(Y + (size_t)scan_row(b, dir, (c - 1) * SC_T + s_) * DH + 64 * h + r4) = wv;
            }
            const LAS float* pb = P + (c & 1) * SC_PBUF + 4 * q;
            LAS float* yb = YB + (c & 1) * (SC_T * 64) + 2 * rp;
#pragma unroll
            for (int hb = 0; hb < 2; ++hb) {
                const LAS float* ph = pb + hb * 16 * SC_REC;
                f32x4 kt = *(const LAS f32x4*)(ph), bt = *(const LAS f32x4*)(ph + 64), kdt = *(const LAS f32x4*)(ph + 128), rt = *(const LAS f32x4*)(ph + 192);
                f32x2v vv = *(const LAS f32x2v*)(ph + 256 - 4 * q + 2 * rp);
                float y0 = 0.f, y1 = 0.f;
#pragma unroll
                for (int s_ = 0; s_ < 16; ++s_) {
                    const LAS float* pn = ph + (s_ + 1 < 16 ? s_ + 1 : s_) * SC_REC;
                    const f32x4 ktn = *(const LAS f32x4*)(pn), btn = *(const LAS f32x4*)(pn + 64), kdtn = *(const LAS f32x4*)(pn + 128), rtn = *(const LAS f32x4*)(pn + 192);
                    const f32x2v vvn = *(const LAS f32x2v*)(pn + 256 - 4 * q + 2 * rp);
                    const f32x2v kt01 = (f32x2v){kt[0], kt[1]}, kt23 = (f32x2v){kt[2], kt[3]}, bt01 = (f32x2v){bt[0], bt[1]}, bt23 = (f32x2v){bt[2], bt[3]};
                    const f32x2v kd01 = (f32x2v){kdt[0], kdt[1]}, kd23 = (f32x2v){kdt[2], kdt[3]}, rt01 = (f32x2v){rt[0], rt[1]}, rt23 = (f32x2v){rt[2], rt[3]};
                    f32x2v sa;
                    SC_PKMUL_LO(sa, S[0], kt01); SC_PKFMA_HI(sa, S[1], kt01, sa); SC_PKFMA_LO(sa, S[2], kt23, sa); SC_PKFMA_HI(sa, S[3], kt23, sa);
                    float sa0 = sa.x, sa1 = sa.y;
                    if (VAR != 2) {
                    SC_DPP4(sa0, sa1, y0, y1, "quad_perm:[1,0,3,2]");
                    SC_DPP4(sa0, sa1, y0, y1, "quad_perm:[2,3,0,1]");
                    SC_DPP4(sa0, sa1, y0, y1, "row_half_mirror");
                    SC_DPP4(sa0, sa1, y0, y1, "row_mirror"); }
                    if (s_ > 0 && q == 0) { yb[(hb * 16 + s_ - 1) * 64] = y0; yb[(hb * 16 + s_ - 1) * 64 + 1] = y1; }
                    sa = (f32x2v){sa0, sa1};
                    f32x2v yy;
                    if (VAR != 3) {
                    SC_PKFMA_LO(S[0], vv, kd01, S[0]); SC_PKFMA_HI(S[1], vv, kd01, S[1]); SC_PKFMA_LO(S[2], vv, kd23, S[2]); SC_PKFMA_HI(S[3], vv, kd23, S[3]);
                    SC_PKFMAN_LO(S[0], sa, bt01, S[0]); SC_PKFMAN_HI(S[1], sa, bt01, S[1]); SC_PKFMAN_LO(S[2], sa, bt23, S[2]); SC_PKFMAN_HI(S[3], sa, bt23, S[3]);
                    SC_PKMUL_LO(yy, S[0], rt01); SC_PKFMA_HI(yy, S[1], rt01, yy); SC_PKFMA_LO(yy, S[2], rt23, yy); SC_PKFMA_HI(yy, S[3], rt23, yy);
                    } else { SC_PKFMAN_LO(S[0], sa, bt01, S[0]); SC_PKMUL_LO(yy, S[0], rt01); }
                    y0 = yy.x; y1 = yy.y;
                    kt = ktn; bt = btn; kdt = kdtn; rt = rtn; vv = vvn;
                }
                SC_DPP2(y0, y1, "quad_perm:[1,0,3,2]"); SC_DPP2(y0, y1, "quad_perm:[2,3,0,1]"); SC_DPP2(y0, y1, "row_half_mirror"); SC_DPP2(y0, y1, "row_mirror");
                if (q == 0) { yb[(hb * 16 + 15) * 64] = y0; yb[(hb * 16 + 15) * 64 + 1] = y1; }
                const f32x4 ge = *(const LAS f32x4*)(pb + SC_T * SC_REC + hb * 64);
#pragma unroll
                for (int e = 0; e < 4; ++e) S[e] *= ge[e];
            }
            if (c + 1 < NCH) SC_STORE(c + 1);
            __syncthreads();
        }
        {
            const int s_ = tid >> 4, r4 = (tid & 15) * 4;
            const f32x4 yv = *(const LAS f32x4*)(YB + ((NCH - 1) & 1) * (SC_T * 64) + s_ * 64 + r4);
            u32x2 wv; wv.x = pk2(yv[0], yv[1]); wv.y = pk2(yv[2], yv[3]);
            if (VAR == 0) *(u32x2*)(Y + (size_t)scan_row(b, dir, (NCH - 1) * SC_T + s_) * DH + 64 * h + r4) = wv;
        }
#undef SC_LOAD
#undef SC_STORE
    }
    __syncthreads();
}

typedef short bf16x4 __attribute__((ext_vector_type(4)));
__device__ __forceinline__ bf16x4 cvt4(const f32x4 v) { u32x2 r; r.x = pk2(v[0], v[1]); r.y = pk2(v[2], v[3]); return __builtin_bit_cast(bf16x4, r); }
__device__ __forceinline__ f32x4 unpk4(const bf16x4 p) { const u32x2 r = __builtin_bit_cast(u32x2, p); return (f32x4){bf2f(r.x & 0xffffu), bf2f(r.x >> 16), bf2f(r.y & 0xffffu), bf2f(r.y >> 16)}; }
#define MFMA16(a, b, c) __builtin_amdgcn_mfma_f32_16x16x16bf16_1k(a, b, c, 0, 0, 0)
constexpr int CS_RS = 144, CS_ARR = 32 * CS_RS;
constexpr int CS_TS = 40, CS_TBLK = 64 * CS_TS;
constexpr int CS_KDTT = 4 * CS_ARR, CS_BTT = CS_KDTT + 2 * CS_TBLK, CS_VT = CS_BTT + 2 * CS_TBLK, CS_GE = CS_VT + 2 * CS_TBLK, CS_PB = CS_GE + 512;
constexpr int CS_GB0 = 3 * CS_PB;
constexpr int CS_GS = 40, CS_GMAT = 16 * CS_GS, CS_ABT = 4 * CS_GMAT, CS_GBLK = 3840, CS_GB = 2 * CS_GBLK;
constexpr int CS_YB = CS_GB0 + 2 * CS_GB;
static_assert(CS_YB + 2 * 8192 <= LDS_CTL, "chunked scan LDS map");
template <int SDBG> __device__ __forceinline__ void phase_scan_mfma(int l) {
    asm volatile("" : "+s"(l)); Frame F = make_frame();
    const int lane = F.lane, wave = F.wave, c16 = lane & 15, g4 = lane >> 4;
    const bool is_state = wave < 4;
    LAS unsigned char* lds = F.lds; LAS float* YB = (LAS float*)(F.lds + CS_YB);
    constexpr int NCH = (CTXL + SEQ) / 32;
    for (int task = F.bid; task < NBATCH * 8 * 2; task += F.G) {
        const int dir = task & 1, h = (task >> 1) & 7, b = task >> 4;
        const unsigned char* wsb = F.ws;
        const unsigned oKT = (unsigned)(dir ? WS_KT1 : WS_KT0), oBT = (unsigned)(dir ? WS_BT1 : WS_BT0), oKDT = (unsigned)(dir ? WS_KDT1 : WS_KDT0), oRT = (unsigned)(dir ? WS_RT1 : WS_RT0);
        const unsigned oGE = (unsigned)(dir ? WS_GE1 : WS_GE0) + (unsigned)h * (NT / 16) * 256u, oY = (unsigned)(dir ? WS_Y1 : WS_Y0);
        u32x4 stg[10]; f32x4 gstg;
#define CS_LOAD(cc) do { _Pragma("unroll") for (int jj = 0; jj < 10; ++jj) { const int a = jj >> 1, idx = hq * 64 + lane + 128 * (jj & 1), s_ = idx >> 3, o = idx & 7; \
            const unsigned ao = a == 0 ? oKT : a == 1 ? oRT : a == 2 ? oKDT : a == 3 ? oBT : (unsigned)WS_V; \
            stg[jj] = *(const u32x4*)(wsb + (ao + ((unsigned)(h * NT + scan_row(b, dir, (cc) * 32 + s_)) * 128u + 16u * o))); } \
            gstg = *(const f32x4*)(wsb + (oGE + (unsigned)(scan_row(b, dir, (cc) * 32 + 16 * ((lane >> 4) & 1)) >> 4) * 256u + 16u * (lane & 15))); } while (0)
#define CS_STORE(pbi) do { LAS unsigned char* pbs = lds + (pbi) * CS_PB; _Pragma("unroll") for (int jj = 0; jj < 10; ++jj) { const int a = jj >> 1, idx = hq * 64 + lane + 128 * (jj & 1), s_ = idx >> 3, o = idx & 7; \
            if (a < 4) *(LAS u32x4*)(pbs + a * CS_ARR + s_ * CS_RS + 16 * o) = stg[jj]; \
            if (a >= 2) { LAS unsigned char* tb = pbs + (a == 2 ? CS_KDTT : (a == 3 ? CS_BTT : CS_VT)) + (s_ >> 4) * CS_TBLK + (8 * o) * CS_TS + 2 * (s_ & 15); \
                _Pragma("unroll") for (int e = 0; e < 4; ++e) { *(LAS unsigned short*)(tb + (2 * e) * CS_TS) = (unsigned short)(stg[jj][e] & 0xffffu); *(LAS unsigned short*)(tb + (2 * e + 1) * CS_TS) = (unsigned short)(stg[jj][e] >> 16); } } } \
            if (hq == 0 && lane < 32) *(LAS f32x4*)(pbs + CS_GE + (lane >> 4) * 256 + 16 * (lane & 15)) = gstg; } while (0)
#define CS_GRAM(pbi, gbi, bq) do { const LAS unsigned char* pbg = lds + (pbi) * CS_PB; LAS unsigned char* gb = lds + CS_GB0 + (gbi) * CS_GB + (bq) * CS_GBLK; \
            const int rowoff = (16 * (bq) + c16) * CS_RS + 16 * g4; \
            _Pragma("unroll") for (int mat = 0; mat < 4; ++mat) { f32x4 acc = (f32x4){0.f, 0.f, 0.f, 0.f}; \
                _Pragma("unroll") for (int ks = 0; ks < 2; ++ks) { const bf16x8 av = *(const LAS bf16x8*)(pbg + (mat < 2 ? 0 : 1) * CS_ARR + rowoff + 64 * ks); \
                    const bf16x8 bv = *(const LAS bf16x8*)(pbg + ((mat & 1) ? 3 : 2) * CS_ARR + rowoff + 64 * ks); acc = __builtin_amdgcn_mfma_f32_16x16x32_bf16(av, bv, acc, 0, 0, 0); } \
                _Pragma("unroll") for (int rg = 0; rg < 4; ++rg) { const int t = 4 * g4 + rg; const bool keep = mat < 2 ? (c16 < t) : (c16 <= t); const float val = keep ? acc[rg] : 0.f; \
                    if (mat == 1) *(LAS float*)(gb + CS_ABT + (t * 17 + c16) * 4) = val; \
                    else *(LAS unsigned short*)(gb + (mat == 0 ? 0 : (mat == 2 ? 1 : 2)) * CS_GMAT + t * CS_GS + 2 * c16) = (unsigned short)f2bf(val); } } \
            { float colv[16]; const LAS float* abt = (const LAS float*)(gb + CS_ABT); \
              _Pragma("unroll") for (int t = 0; t < 16; ++t) { float a_ = (t == c16) ? 1.f : 0.f; _Pragma("unroll") for (int s2 = 0; s2 < t; ++s2) a_ = fmaf(-abt[t * 17 + s2], colv[s2], a_); colv[t] = a_; } \
              if (lane < 16) { _Pragma("unroll") for (int t = 0; t < 16; ++t) *(LAS unsigned short*)(gb + 3 * CS_GMAT + t * CS_GS + 2 * c16) = (unsigned short)f2bf(colv[t]); } } } while (0)
#define CS_FLUSH(cc) do { _Pragma("unroll") for (int p_ = 0; p_ < 2; ++p_) { const int s_ = (lane >> 3) + 8 * p_ + 16 * hq, r8 = 8 * (lane & 7); const LAS float* yp = YB + ((cc) & 1) * 2048 + s_ * 64 + r8; \
            const f32x4 ya = *(const LAS f32x4*)yp, yb2 = *(const LAS f32x4*)(yp + 4); u32x4 wv; wv.x = pk2(ya[0], ya[1]); wv.y = pk2(ya[2], ya[3]); wv.z = pk2(yb2[0], yb2[1]); wv.w = pk2(yb2[2], yb2[3]); \
            *(u32x4*)(const_cast<unsigned char*>(wsb) + (oY + (unsigned)scan_row(b, dir, (cc) * 32 + s_) * 1024u + 128u * h + 2u * r8)) = wv; } } while (0)
#define CS_STATE(c, P0) do { \
                const int m = wave; \
_Pragma("unroll") \
                for (int blk = 0; blk < 2; ++blk) { \
                    const LAS unsigned char* pb = lds + (P0) * CS_PB; const LAS unsigned char* gb = lds + CS_GB0 + ((c) & 1) * CS_GB + blk * CS_GBLK; \
                    const LAS unsigned char* rowb = pb + (16 * blk + c16) * CS_RS + 8 * g4; \
                    bf16x4 ak[4], ar[4], a1[4], a2[4]; f32x4 ge[4]; \
_Pragma("unroll") \
                    for (int j = 0; j < 4; ++j) { ak[j] = *(const LAS bf16x4*)(rowb + 32 * j); ar[j] = *(const LAS bf16x4*)(rowb + CS_ARR + 32 * j); \
                        a1[j] = *(const LAS bf16x4*)(pb + CS_KDTT + blk * CS_TBLK + (16 * j + c16) * CS_TS + 8 * g4); a2[j] = *(const LAS bf16x4*)(pb + CS_BTT + blk * CS_TBLK + (16 * j + c16) * CS_TS + 8 * g4); \
                        ge[j] = *(const LAS f32x4*)(pb + CS_GE + blk * 256 + (16 * j + 4 * g4) * 4); } \
                    const bf16x4 vt = *(const LAS bf16x4*)(pb + CS_VT + blk * CS_TBLK + (16 * m + c16) * CS_TS + 8 * g4); \
                    const bf16x4 makt = *(const LAS bf16x4*)(gb + c16 * CS_GS + 8 * g4), mmkt = *(const LAS bf16x4*)(gb + CS_GMAT + c16 * CS_GS + 8 * g4); \
                    const bf16x4 mmbt = *(const LAS bf16x4*)(gb + 2 * CS_GMAT + c16 * CS_GS + 8 * g4), mtt = *(const LAS bf16x4*)(gb + 3 * CS_GMAT + c16 * CS_GS + 8 * g4); \
                    asm volatile("s_waitcnt lgkmcnt(0)" ::: "memory"); \
                    bf16x4 hi[4]; \
_Pragma("unroll") \
                    for (int j = 0; j < 4; ++j) hi[j] = cvt4(H[j]); \
                    const f32x4 z4 = (f32x4){0.f, 0.f, 0.f, 0.f}; \
                    f32x4 wa = MFMA16(ak[0], hi[0], z4), wb = MFMA16(ak[2], hi[2], z4), ya = MFMA16(ar[0], hi[0], z4), yb_ = MFMA16(ar[2], hi[2], z4); \
                    wa = MFMA16(ak[1], hi[1], wa); wb = MFMA16(ak[3], hi[3], wb); ya = MFMA16(ar[1], hi[1], ya); yb_ = MFMA16(ar[3], hi[3], yb_); \
                    if (SCAN_HILO) { bf16x4 lo[4]; _Pragma("unroll") for (int j = 0; j < 4; ++j) lo[j] = cvt4(H[j] - unpk4(hi[j])); \
                        wa = MFMA16(ak[0], lo[0], wa); wb = MFMA16(ak[2], lo[2], wb); ya = MFMA16(ar[0], lo[0], ya); yb_ = MFMA16(ar[2], lo[2], yb_); \
                        wa = MFMA16(ak[1], lo[1], wa); wb = MFMA16(ak[3], lo[3], wb); ya = MFMA16(ar[1], lo[1], ya); yb_ = MFMA16(ar[3], lo[3], yb_); } \
                    wb = MFMA16(makt, vt, wb); \
                    ya = MFMA16(mmkt, vt, ya); \
                    const f32x4 wt = wa + wb; \
                    const f32x4 ut = MFMA16(mtt, cvt4(wt), z4); \
                    const bf16x4 utn = cvt4(-ut); \
                    yb_ = MFMA16(mmbt, utn, yb_); \
_Pragma("unroll") \
                    for (int j = 0; j < 4; ++j) { H[j] = MFMA16(a1[j], vt, H[j]); H[j] = MFMA16(a2[j], utn, H[j]); H[j] = H[j] * ge[j]; } \
                    const f32x4 yt = ya + yb_; \
_Pragma("unroll") \
                    for (int rg = 0; rg < 4; ++rg) YB[((c) & 1) * 2048 + (16 * blk + 4 * g4 + rg) * 64 + 16 * m + c16] = yt[rg]; \
                } \
            } while (0)
        f32x4 H[4];
#pragma unroll
        for (int j = 0; j < 4; ++j) H[j] = (f32x4){0.f, 0.f, 0.f, 0.f};
        __syncthreads();
        const int hw = wave - 4, hp = hw >> 1, hq = hw & 1;
        if (!is_state) { CS_LOAD(hp); CS_STORE(hp); CS_LOAD(hp + 2); }
        __syncthreads();
        if (!is_state) { if (!(SDBG & 2)) { if (hp == 1) CS_GRAM(0, 0, hq); } }
        __syncthreads();
#define CS_ITER(c, P0, P1, P2) do { \
            if (is_state) { if (!(SDBG & 1)) { CS_STATE(c, P0); } } \
            else if (hp == ((c) & 1)) { CS_STORE(P2); CS_LOAD(((c) + 4 < NCH ? (c) + 4 : NCH - 1)); if (!(SDBG & 4)) { if ((c) > 0) CS_FLUSH((c) - 1); } } \
            else { if (!(SDBG & 2)) { if ((c) + 1 < NCH) CS_GRAM(P1, ((c) + 1) & 1, hq); } } \
            asm volatile("s_waitcnt lgkmcnt(0)" ::: "memory"); __builtin_amdgcn_s_barrier(); asm volatile("" ::: "memory"); } while (0)
        for (int c3 = 0; c3 < NCH; c3 += 3) { CS_ITER(c3, 0, 1, 2); CS_ITER(c3 + 1, 1, 2, 0); CS_ITER(c3 + 2, 2, 0, 1); }
#undef CS_ITER
        if (!(SDBG & 4)) { if (!is_state && hp == 0) CS_FLUSH(NCH - 1); }
#undef CS_LOAD
#undef CS_STATE
#undef CS_STORE
#undef CS_GRAM
#undef CS_FLUSH
    }
    __syncthreads();
}

__device__ __forceinline__ void phase_mix(int l) {
    asm volatile("" : "+s"(l)); Frame F = make_frame();
    const int lane = F.lane, c0 = 8 * lane, hh = lane >> 3;
    const int gw = F.bid * 8 + F.wave, NGW = F.G * 8;
    const bf16_t* Z = (const bf16_t*)(F.ws + WS_Z);
    const float* cw = F.inp(IN_CONVW) + (size_t)l * 3 * DH;
    float cw0[8], cw1[8], cw2[8], lgv[8], lbv[8];
#pragma unroll
    for (int j = 0; j < 8; ++j) { cw0[j] = cw[c0 + j]; cw1[j] = cw[DH + c0 + j]; cw2[j] = cw[2 * DH + c0 + j]; lgv[j] = F.inp(IN_LNG)[l * DH + c0 + j]; lbv[j] = F.inp(IN_LNB)[l * DH + c0 + j]; }
    const bf16_t* Y0 = (const bf16_t*)(F.ws + WS_Y0); const bf16_t* Y1 = (const bf16_t*)(F.ws + WS_Y1); const bf16_t* V = (const bf16_t*)(F.ws + WS_V);
    const bf16_t* Gi = (const bf16_t*)((unsigned char*)F.out + DO_G); const float* BON = (const float*)(F.ws + WS_BONUS);
    bf16_t* UA = (bf16_t*)(F.ws + WS_UA); bf16_t* UB = (bf16_t*)(F.ws + WS_UB);
    for (int row = gw; row < NT; row += NGW) {
        int delta; bool hasp, hasn;
        if (row < NCTX) { const int t = row & (CTXL - 1); delta = 1; hasp = t > 0; hasn = t < CTXL - 1; }
        else { const int sq = (row - NCTX) & (SEQ - 1);
            if (c0 < 256) { const int gc = sq & 63; delta = 1; hasp = gc > 0; hasn = gc < 63; }
            else { const int gr = sq >> 6; delta = 64; hasp = gr > 0; hasn = gr < 31; } }
        const bf16_t* zr = Z + (size_t)row * ZLD;
        const u32x4 zero = (u32x4){0u, 0u, 0u, 0u};
        const u32x4 bg = *(const u32x4*)(zr + ZC_BG + c0), cg = *(const u32x4*)(zr + ZC_CG + c0), ha = *(const u32x4*)(zr + ZC_HA + c0);
        const u32x4 cgm = hasp ? *(const u32x4*)(zr + ZC_CG + c0 - (ptrdiff_t)delta * ZLD) : zero, ham = hasp ? *(const u32x4*)(zr + ZC_HA + c0 - (ptrdiff_t)delta * ZLD) : zero;
        const u32x4 cgp = hasn ? *(const u32x4*)(zr + ZC_CG + c0 + (ptrdiff_t)delta * ZLD) : zero, hap = hasn ? *(const u32x4*)(zr + ZC_HA + c0 + (ptrdiff_t)delta * ZLD) : zero;
        const size_t o = (size_t)row * DH + c0, oh = ((size_t)hh * NT + row) * 64 + (c0 & 63);
        const u32x4 y0p = *(const u32x4*)(Y0 + o), y1p = *(const u32x4*)(Y1 + o), vp = *(const u32x4*)(V + oh), gp = *(const u32x4*)(Gi + oh);
        const float bon = BON[(size_t)row * 8 + hh];
        float fb[8], fc[8], fh[8], fcm[8], fhm[8], fcp[8], fhp[8], ua[8];
        unpack8(bg, fb); unpack8(cg, fc); unpack8(ha, fh); unpack8(cgm, fcm); unpack8(ham, fhm); unpack8(cgp, fcp); unpack8(hap, fhp);
#pragma unroll
        for (int j = 0; j < 8; ++j) ua[j] = fb[j] * (fcm[j] * fhm[j] * cw0[j] + fc[j] * fh[j] * cw1[j] + fcp[j] * fhp[j] * cw2[j]);
        *(u32x4*)(UA + o) = pack8(ua);
        float ya[8], yb[8], fv[8], fg[8], ub[8]; unpack8(y0p, ya); unpack8(y1p, yb); unpack8(vp, fv); unpack8(gp, fg);
        float sm = 0.f;
#pragma unroll
        for (int j = 0; j < 8; ++j) { ya[j] += yb[j]; sm += ya[j]; }
        sm = dpp_add<0xB1>(sm); sm = dpp_add<0x4E>(sm); sm = dpp_add<0x141>(sm);
        const float mu = sm * (1.0f / 64.0f); float sq2 = 0.f;
#pragma unroll
        for (int j = 0; j < 8; ++j) { ya[j] -= mu; sq2 += ya[j] * ya[j]; }
        sq2 = dpp_add<0xB1>(sq2); sq2 = dpp_add<0x4E>(sq2); sq2 = dpp_add<0x141>(sq2);
        const float rstd = rsqrtf(sq2 * (1.0f / 64.0f) + GN_EPS);
#pragma unroll
        for (int j = 0; j < 8; ++j) ub[j] = (ya[j] * rstd * lgv[j] + lbv[j] + bon * fv[j]) * fg[j];
        *(u32x4*)(UB + o) = pack8(ub);
    }
}

constexpr int N2_STRIDE = 1028;
constexpr int N2_PART = 16 * N2_STRIDE * 4;
constexpr int N2_HIST = N2_PART + 8 * 16 * 48 * 4;
__device__ __forceinline__ void phase_norm2(int l) {
    asm volatile("" : "+s"(l)); Frame F = make_frame();
    const int lane = F.lane, w = F.wave;
    LAS float* HT = (LAS float*)F.lds; LAS float* PART = (LAS float*)(F.lds + N2_PART); LAS int* hist = (LAS int*)(F.lds + N2_HIST);
    float* X = (float*)(F.ws + WS_X); bf16_t* H = (bf16_t*)((unsigned char*)F.out + DO_H); const bf16_t* Tm = (const bf16_t*)(F.ws + WS_T);
    const float* g2n = F.inp(IN_N2G) + l * D;
    const float* WC = (const float*)(F.ws + WS_WC) + (size_t)l * 1024 * 48; const float* RB = (const float*)(F.ws + WS_RB) + l * 48;
    int* RE = (int*)(F.ws + WS_RE); float* RG = (float*)(F.ws + WS_RG); int* RP = (int*)(F.ws + WS_RP);
    if (F.tid < 32) hist[F.tid] = 0;
    float Bv[32][3];
    { const int kg = lane >> 4, cc = lane & 15;
#pragma unroll
      for (int s_ = 0; s_ < 32; ++s_)
#pragma unroll
          for (int t = 0; t < 3; ++t) Bv[s_][t] = WC[(size_t)(256 * kg + 32 * w + s_) * 48 + 16 * t + cc]; }
    __syncthreads();
    for (int tile = F.bid; tile < NT / 16; tile += F.G) {
        const int row0 = tile * 16;
#pragma unroll
        for (int rr = 0; rr < 2; ++rr) {
            const int lr = 2 * w + rr, row = row0 + lr;
            const int mj = row < NCTX ? 16 : ((row - NCTX) >> 11);
            const float* mod = (const float*)(F.ws + WS_MOD) + ((size_t)l * 17 + mj) * NMOD;
            f32x4 v[4]; float ss = 0.f;
#pragma unroll
            for (int j = 0; j < 4; ++j) {
                const int c = 4 * lane + 256 * j;
                v[j] = *(const f32x4*)(X + (size_t)row * D + c);
                const u32x2 tv = *(const u32x2*)(Tm + (size_t)row * D + c); const f32x4 g1 = *(const f32x4*)(mod + 2048 + c);
                v[j][0] += g1[0] * bf2f(tv.x & 0xffffu); v[j][1] += g1[1] * bf2f(tv.x >> 16); v[j][2] += g1[2] * bf2f(tv.y & 0xffffu); v[j][3] += g1[3] * bf2f(tv.y >> 16);
                *(f32x4*)(X + (size_t)row * D + c) = v[j];
                ss += v[j][0] * v[j][0] + v[j][1] * v[j][1] + v[j][2] * v[j][2] + v[j][3] * v[j][3]; }
            const float rs = rsqrtf(wave_sum(ss) * (1.0f / D) + NORM_EPS);
#pragma unroll
            for (int j = 0; j < 4; ++j) {
                const int c = 4 * lane + 256 * j;
                const f32x4 gg = *(const f32x4*)(g2n + c), sh = *(const f32x4*)(mod + 3072 + c), sc = *(const f32x4*)(mod + 4096 + c);
                f32x4 o;
#pragma unroll
                for (int q = 0; q < 4; ++q) o[q] = v[j][q] * rs * gg[q] * (1.0f + sc[q]) + sh[q];
                u32x2 wv; wv.x = pk2(o[0], o[1]); wv.y = pk2(o[2], o[3]);
                *(u32x2*)(H + (size_t)row * D + c) = wv;
                *(LAS f32x4*)(HT + lr * N2_STRIDE + c) = o;
            }
        }
        __syncthreads();
        {
            f32x4 acc[3];
#pragma unroll
            for (int t = 0; t < 3; ++t) acc[t] = (f32x4){0.f, 0.f, 0.f, 0.f};
            const LAS float* ap = HT + (lane & 15) * N2_STRIDE + 256 * (lane >> 4) + 32 * w;
#pragma unroll
            for (int i = 0; i < 8; ++i) {
                const f32x4 a4 = *(const LAS f32x4*)(ap + 4 * i);
#pragma unroll
                for (int e = 0; e < 4; ++e)
#pragma unroll
                    for (int t = 0; t < 3; ++t) acc[t] = __builtin_amdgcn_mfma_f32_16x16x4f32(a4[e], Bv[4 * i + e][t], acc[t], 0, 0, 0);
            }
#pragma unroll
            for (int t = 0; t < 3; ++t)
#pragma unroll
                for (int rg = 0; rg < 4; ++rg) PART[(w * 16 + (lane >> 4) * 4 + rg) * 48 + 16 * t + (lane & 15)] = acc[t][rg];
        }
        __syncthreads();
        if (F.tid < 16) {
            const int r = F.tid, row = row0 + r;
            float lgv[4];
#pragma unroll
            for (int g = 0; g < 4; ++g) { float a = RB[32 + g];
#pragma unroll
                for (int ww = 0; ww < 8; ++ww) a += PART[(ww * 16 + r) * 48 + 32 + g];
                lgv[g] = a; }
            int gs = 0; float lmax = lgv[0];
#pragma unroll
            for (int g = 1; g < 4; ++g) if (lgv[g] > lmax) { lmax = lgv[g]; gs = g; }
            float den = 0.f;
#pragma unroll
            for (int g = 0; g < 4; ++g) den += fexp(lgv[g] - lmax);
            const float pgmax = 1.0f / den;
            float le[8];
#pragma unroll
            for (int e = 0; e < 8; ++e) { float a = RB[gs * 8 + e];
#pragma unroll
                for (int ww = 0; ww < 8; ++ww) a += PART[(ww * 16 + r) * 48 + gs * 8 + e];
                le[e] = a; }
            int i1 = 0; float m1 = le[0];
#pragma unroll
            for (int e = 1; e < 8; ++e) if (le[e] > m1) { m1 = le[e]; i1 = e; }
            int i2 = i1 == 0 ? 1 : 0; float m2 = le[i1 == 0 ? 1 : 0];
#pragma unroll
            for (int e = 0; e < 8; ++e) if (e != i1 && le[e] > m2) { m2 = le[e]; i2 = e; }
            const float dd = fexp(m2 - m1);
            const float gate1 = pgmax / (1.0f + dd), gate2 = pgmax * dd / (1.0f + dd);
            const int e1 = gs * 8 + i1, e2 = gs * 8 + i2;
            const int p1 = __hip_atomic_fetch_add(hist + e1, 1, __ATOMIC_RELAXED, __HIP_MEMORY_SCOPE_WORKGROUP), p2 = __hip_atomic_fetch_add(hist + e2, 1, __ATOMIC_RELAXED, __HIP_MEMORY_SCOPE_WORKGROUP);
            RE[2 * row] = e1; RE[2 * row + 1] = e2; RG[2 * row] = gate1; RG[2 * row + 1] = gate2; RP[2 * row] = p1; RP[2 * row + 1] = p2;
        }
    }
    __syncthreads();
    if (F.tid < 32) ((int*)(F.ws + WS_BH))[F.bid * 32 + F.tid] = hist[F.tid];
    __syncthreads();
}

__device__ __forceinline__ void moe_tables(Frame& F, int l) {
    LAS int* seg = (LAS int*)(F.lds + LC_SEG); LAS int* cnts = (LAS int*)(F.lds + LC_CNTS); LAS int* tile_e = (LAS int*)(F.lds + LC_TILEE);
    LAS int* red = (LAS int*)(F.lds + LC_RED);
    LAS int* bbase = (LAS int*)(F.lds + LC_BBASE);
    const int* BH = (const int*)(F.ws + WS_BH);
    __syncthreads();
    { const int e = F.tid & 31, part = F.tid >> 5; int tot = 0, pre = 0;
      for (int bq = part; bq < F.G; bq += 16) { const int v = BH[bq * 32 + e]; tot += v; if (bq < F.bid) pre += v; }
      red[part * 32 + e] = tot; red[512 + part * 32 + e] = pre; }
    __syncthreads();
    if (F.tid < 32) { int tot = 0, pre = 0;
#pragma unroll 1
        for (int p = 0; p < 16; ++p) { tot += red[p * 32 + F.tid]; pre += red[512 + p * 32 + F.tid]; }
        cnts[F.tid] = tot; bbase[F.tid] = pre; }
    __syncthreads();
    if (F.tid == 0) {
        int s = 0;
#pragma unroll 1
        for (int e = 0; e < NE; ++e) { const int c = cnts[e]; seg[e] = s; const int nt = (c + 255) >> 8;
#pragma unroll 1
            for (int t = 0; t < nt; ++t) tile_e[(s >> 8) + t] = e;
            s += nt << 8; }
        seg[32] = s; seg[33] = s >> 8;
    }
    __syncthreads();
}
__device__ __forceinline__ void phase_dispatch(int l) {
    asm volatile("" : "+s"(l)); Frame F = make_frame();
    moe_tables(F, l);
    const LAS int* seg = (const LAS int*)(F.lds + LC_SEG); const LAS int* cnts = (const LAS int*)(F.lds + LC_CNTS); const LAS int* bbase = (const LAS int*)(F.lds + LC_BBASE);
    const int gw = F.bid * 8 + F.wave, NGW = F.G * 8;
    const int* RE = (const int*)(F.ws + WS_RE); const int* RP = (const int*)(F.ws + WS_RP); int* RS = (int*)(F.ws + WS_RS);
    const bf16_t* H = (const bf16_t*)((unsigned char*)F.out + DO_H); bf16_t* XS = (bf16_t*)(F.ws + WS_XS);
    for (int tile = F.bid; tile < NT / 16; tile += F.G) {
        const int item0 = (tile * 16 + 2 * F.wave) * 2;
        int slot[4]; u32x4 d0[2], d1[2];
#pragma unroll
        for (int q = 0; q < 4; ++q) { const int e = RE[item0 + q], pos = RP[item0 + q]; slot[q] = seg[e] + bbase[e] + pos; }
#pragma unroll
        for (int r = 0; r < 2; ++r) { const u32x4* src = (const u32x4*)(H + (size_t)((item0 >> 1) + r) * D); d0[r] = src[F.lane]; d1[r] = src[64 + F.lane]; }
        if (F.lane < 4) { int sl = slot[0]; sl = F.lane == 1 ? slot[1] : sl; sl = F.lane == 2 ? slot[2] : sl; sl = F.lane == 3 ? slot[3] : sl; RS[item0 + F.lane] = sl; }
#pragma unroll
        for (int q = 0; q < 4; ++q) { u32x4* dst = (u32x4*)(XS + (size_t)slot[q] * D); dst[F.lane] = d0[q >> 1]; dst[64 + F.lane] = d1[q >> 1]; }
    }
#pragma unroll 1
    for (int e = 0; e < NE; ++e) {
        const int c = cnts[e], padded = (c + 255) & ~255;
        for (int p = c + gw; p < padded; p += NGW) { u32x4* dst = (u32x4*)(XS + (size_t)(seg[e] + p) * D); dst[F.lane] = (u32x4){0u, 0u, 0u, 0u}; dst[64 + F.lane] = (u32x4){0u, 0u, 0u, 0u}; }
    }
}

__device__ __forceinline__ void phase_final() {
    Frame F = make_frame();
    const int gw = F.bid * 8 + F.wave, NGW = F.G * 8;
    const float* X = (const float*)(F.ws + WS_X); const float* fg = F.inp(IN_FG);
    for (int r = gw; r < NLAT; r += NGW) {
        const float* xr = X + (size_t)(NCTX + r) * D;
        f32x4 v[4]; float ss = 0.f;
#pragma unroll
        for (int j = 0; j < 4; ++j) v[j] = *(const f32x4*)(xr + 4 * F.lane + 256 * j);
        combine_row(F, DEPTH - 1, NCTX + r, v);
#pragma unroll
        for (int j = 0; j < 4; ++j) ss += v[j][0] * v[j][0] + v[j][1] * v[j][1] + v[j][2] * v[j][2] + v[j][3] * v[j][3];
        const float rs = rsqrtf(wave_sum(ss) * (1.0f / D) + NORM_EPS);
#pragma unroll
        for (int j = 0; j < 4; ++j) { const int c = 4 * F.lane + 256 * j; const f32x4 gg = *(const f32x4*)(fg + c);
            f32x4 o; o[0] = v[j][0] * rs * gg[0]; o[1] = v[j][1] * rs * gg[1]; o[2] = v[j][2] * rs * gg[2]; o[3] = v[j][3] * rs * gg[3];
            *(f32x4*)(F.out + (size_t)r * D + c) = o; }
    }
}

constexpr int NPL = 11;
constexpr int NPH = 1 + DEPTH * NPL + 1;
__device__ __forceinline__ void seam() {
    Frame F = make_frame();
    XcdBarrier bar; bar.bar = (unsigned*)(F.ws + WS_CTL) + CW_BAR; bar.x = xb_xcc_id(); bar.st = (volatile LAS unsigned*)(F.lds + LC_BARW);
    xcd_barrier(bar);
}
__global__ void __launch_bounds__(512, 2) mk_fwd(Args args_unused) {
    {
        Frame F = make_frame();
        for (int u = F.tid; u < (LDS_BYTES - LDS_CTL) / 4; u += 512) ((LAS unsigned*)(F.lds + LDS_CTL))[u] = 0u;
        __syncthreads();
        if (F.ka->ph_hi - F.ka->ph_lo > 1) (void)xcd_barrier_post((unsigned*)(F.ws + WS_CTL) + CW_BAR, (volatile LAS unsigned*)(F.lds + LC_BARW));
    }
#define IN(k) (kargs()->ph_lo <= (k) && (k) < kargs()->ph_hi)
#define SEAM(k) do { if (IN(k) && IN((k) + 1)) seam(); } while (0)
    int ph = 0;
    for (int rep_ = 0; rep_ < DUP_N(13); ++rep_) { if (rep_) seam(); if (PH_EN(13) && IN(ph)) phase_prologue(); }
    SEAM(ph); ++ph;
    unsigned long long pb_t0 = 0, pb_acc = 0;
    for (int l = 0; l < DEPTH; ++l) {
        if (IN(ph) && IN(ph + 1)) { for (int i_ = 0; i_ < EXTRA_SEAMS; ++i_) seam(); }
        if (PROBE_PHASE == 0) pb_t0 = __builtin_amdgcn_s_memrealtime();
        for (int rep_ = 0; rep_ < DUP_N(0); ++rep_) { if (rep_) seam(); if (PH_EN(0) && IN(ph)) phase_norm1(l, rep_); }
        SEAM(ph); ++ph;
        if (PROBE_PHASE == 0) pb_acc += __builtin_amdgcn_s_memrealtime() - pb_t0;
        if (PROBE_PHASE == 1) pb_t0 = __builtin_amdgcn_s_memrealtime();
        for (int rep_ = 0; rep_ < DUP_N(1); ++rep_) { if (rep_) seam(); if (PH_EN(1) && IN(ph)) { Frame F = make_frame(); Gemm g{(const bf16_t*)((unsigned char*)F.out + DO_H), (const bf16_t*)(F.ws + WS_WIN), NT, NINP, D, 0, 0}; StaticOrder S; S.init(NT, NINP, F.G, F.bid); EpiZ E{(bf16_t*)(F.ws + WS_Z), (bf16_t*)(F.ws + WS_GT)}; gemm_phase(F.lds, g, S, E); } }
        SEAM(ph); ++ph;
        if (PROBE_PHASE == 1) pb_acc += __builtin_amdgcn_s_memrealtime() - pb_t0;
        if (PROBE_PHASE == 2) pb_t0 = __builtin_amdgcn_s_memrealtime();
        for (int rep_ = 0; rep_ < DUP_N(2); ++rep_) { if (rep_) seam(); if (PH_EN(2) && IN(ph)) phase_prep(l); }
        SEAM(ph); ++ph;
        if (PROBE_PHASE == 2) pb_acc += __builtin_amdgcn_s_memrealtime() - pb_t0;
        if (PROBE_PHASE == 3) pb_t0 = __builtin_amdgcn_s_memrealtime();
        for (int rep_ = 0; rep_ < DUP_N(3); ++rep_) { if (rep_) seam(); if (PH_EN(3) && IN(ph)) { if (SCAN_IMPL == 1) { if (rep_ == 0) phase_scan_mfma<0>(l); else phase_scan_mfma<SCAN_DBG>(l); } else if (rep_ == 0) phase_scan<0>(l); else phase_scan<SCAN_VAR>(l); } }
        SEAM(ph); ++ph;
        if (PROBE_PHASE == 3) pb_acc += __builtin_amdgcn_s_memrealtime() - pb_t0;
        if (PROBE_PHASE == 4) pb_t0 = __builtin_amdgcn_s_memrealtime();
        for (int rep_ = 0; rep_ < DUP_N(4); ++rep_) { if (rep_) seam(); if (PH_EN(4) && IN(ph)) phase_mix(l); }
        SEAM(ph); ++ph;
        if (PROBE_PHASE == 4) pb_acc += __builtin_amdgcn_s_memrealtime() - pb_t0;
        if (PROBE_PHASE == 5) pb_t0 = __builtin_amdgcn_s_memrealtime();
        for (int rep_ = 0; rep_ < DUP_N(5); ++rep_) { if (rep_) seam(); if (PH_EN(5) && IN(ph)) { Frame F = make_frame(); Gemm g{(const bf16_t*)(F.ws + WS_UA), (const bf16_t*)(F.ws + WS_WA), NT, D, DH, (size_t)(WS_WB - WS_WA) / 2, (size_t)(WS_UB - WS_UA) / 2}; PairOrder S; S.so.init(NT, D, F.G, F.bid); EpiMerge E{(bf16_t*)((unsigned char*)F.out + DO_H), (const bf16_t*)(F.ws + WS_GT)}; gemm_phase(F.lds, g, S, E);
            { int ll = l; asm volatile("" : "+s"(ll)); const int nwg = (NT / 256) * (D / 256), rem = nwg % F.G; const int nlight = rem ? F.G - rem : F.G, lidx = rem ? F.bid - rem : F.bid;
              if (rep_ == 0 && lidx >= 0) convert_layer_weights(F, ll, 1, lidx * 8 + F.wave, nlight * 8); } } }
        SEAM(ph); ++ph;
        if (PROBE_PHASE == 5) pb_acc += __builtin_amdgcn_s_memrealtime() - pb_t0;
        if (PROBE_PHASE == 6) pb_t0 = __builtin_amdgcn_s_memrealtime();
        for (int rep_ = 0; rep_ < DUP_N(7); ++rep_) { if (rep_) seam(); if (PH_EN(7) && IN(ph)) { Frame F = make_frame(); Gemm g{(const bf16_t*)((unsigned char*)F.out + DO_H), (const bf16_t*)(F.ws + WS_WO), NT, D, D, 0, 0}; StaticOrder S; S.init(NT, D, F.G, F.bid);
            EpiStoreBf16 E{(bf16_t*)(F.ws + WS_T), D}; gemm_phase(F.lds, g, S, E); } }
        SEAM(ph); ++ph;
        if (PROBE_PHASE == 6) pb_acc += __builtin_amdgcn_s_memrealtime() - pb_t0;
        if (PROBE_PHASE == 7) pb_t0 = __builtin_amdgcn_s_memrealtime();
        for (int rep_ = 0; rep_ < DUP_N(8); ++rep_) { if (rep_) seam(); if (PH_EN(8) && IN(ph)) phase_norm2(l); }
        SEAM(ph); ++ph;
        if (PROBE_PHASE == 7) pb_acc += __builtin_amdgcn_s_memrealtime() - pb_t0;
        if (PROBE_PHASE == 8) pb_t0 = __builtin_amdgcn_s_memrealtime();
        for (int rep_ = 0; rep_ < DUP_N(9); ++rep_) { if (rep_) seam(); if (PH_EN(9) && IN(ph)) phase_dispatch(l); }
        SEAM(ph); ++ph;
        if (PROBE_PHASE == 8) pb_acc += __builtin_amdgcn_s_memrealtime() - pb_t0;
        if (PROBE_PHASE == 9) pb_t0 = __builtin_amdgcn_s_memrealtime();
        for (int rep_ = 0; rep_ < DUP_N(10); ++rep_) { if (rep_) seam(); if (PH_EN(10) && IN(ph)) { int ll = l; asm volatile("" : "+s"(ll)); Frame F = make_frame(); moe_tables(F, ll); MoeOrder S{__builtin_amdgcn_readfirstlane(((const LAS int*)(F.lds + LC_SEG))[33]), F.G, F.bid, (const LAS int*)(F.lds + LC_TILEE)};
            Gemm g{(const bf16_t*)(F.ws + WS_XS), (const bf16_t*)(F.ws + WS_W13), MAXTILES * 256, D, D, (size_t)1024 * 1024, 0}; EpiSwiGLU E{(bf16_t*)(F.ws + WS_HID)}; gemm_phase(F.lds, g, S, E); } }
        SEAM(ph); ++ph;
        if (PROBE_PHASE == 9) pb_acc += __builtin_amdgcn_s_memrealtime() - pb_t0;
        if (PROBE_PHASE == 10) pb_t0 = __builtin_amdgcn_s_memrealtime();
        for (int rep_ = 0; rep_ < DUP_N(11); ++rep_) { if (rep_) seam(); if (PH_EN(11) && IN(ph)) { int ll = l; asm volatile("" : "+s"(ll)); Frame F = make_frame(); moe_tables(F, ll); MoeOrder S{__builtin_amdgcn_readfirstlane(((const LAS int*)(F.lds + LC_SEG))[33]), F.G, F.bid, (const LAS int*)(F.lds + LC_TILEE)};
            Gemm g{(const bf16_t*)(F.ws + WS_HID), (const bf16_t*)(F.ws + WS_W2), MAXTILES * 256, D, DFF, (size_t)1024 * 512, 0}; EpiStoreBf16 E{(bf16_t*)(F.ws + WS_YS), D}; gemm_phase(F.lds, g, S, E); } }
        SEAM(ph); ++ph;
        if (PROBE_PHASE == 10) pb_acc += __builtin_amdgcn_s_memrealtime() - pb_t0;
    }
    if (PH_EN(14) && IN(ph)) phase_final();
    if (PROBE_PHASE >= 0 && blockIdx.x == 0) { const unsigned long long t_ = __builtin_amdgcn_s_memrealtime(); while (__builtin_amdgcn_s_memrealtime() - t_ < 9ull * pb_acc) __builtin_amdgcn_s_sleep(8); }
#undef IN
#undef SEAM
}

extern "C" void kernel_launch(void* const* d_in, const int* in_sizes, int n_in, void* d_out, int out_size, void* d_ws, size_t ws_size, hipStream_t stream) {
    static int grid = 0;
    if (grid == 0) {
        if (n_in != 32 || out_size != NLAT * D || ws_size < WS_END) { fprintf(stderr, "kernel_launch: unexpected shapes (n_in %d, out %d, ws %zu < %zu)\n", n_in, out_size, ws_size, (size_t)WS_END); grid = -1; return; }
        int dev = 0, cus = 0, per_cu = 0;
        if (hipGetDevice(&dev) != hipSuccess || hipDeviceGetAttribute(&cus, hipDeviceAttributeMultiprocessorCount, dev) != hipSuccess) { grid = -1; return; }
        if (hipFuncSetAttribute((const void*)mk_fwd, hipFuncAttributeMaxDynamicSharedMemorySize, LDS_BYTES) != hipSuccess) { fprintf(stderr, "kernel_launch: hipFuncSetAttribute failed\n"); grid = -1; return; }
        if (hipOccupancyMaxActiveBlocksPerMultiprocessor(&per_cu, (const void*)mk_fwd, 512, LDS_BYTES) != hipSuccess || per_cu < 1) { fprintf(stderr, "kernel_launch: occupancy query says %d\n", per_cu); }
        (void)hipGetLastError();
        grid = cus;
    }
    if (grid < 0) return;
    if (hipMemsetAsync((char*)d_ws + WS_CTL, 0, CTL_ZERO_BYTES, stream) != hipSuccess) return;
    Args a{};
    for (int i = 0; i < 32; ++i) a.in[i] = (const float*)d_in[i];
    a.out = (float*)d_out; a.ws = (unsigned char*)d_ws;
#if MK_ONE_LAUNCH
    a.ph_lo = 0; a.ph_hi = NPH;
    hipLaunchKernelGGL(mk_fwd, dim3(grid), dim3(512), LDS_BYTES, stream, a);
#else
    for (int p = 0; p < NPH; ++p) { a.ph_lo = p; a.ph_hi = p + 1; hipLaunchKernelGGL(mk_fwd, dim3(grid), dim3(512), LDS_BYTES, stream, a); }
#endif
}
```

```cpp
#include <hip/hip_runtime.h>
#include <cstdio>
#include <cstdint>

#ifndef MK_ONE_LAUNCH
#define MK_ONE_LAUNCH 1
#endif

#ifndef PHASE_MASK
#define PHASE_MASK 0xffff
#endif
#define PH_EN(p) (((PHASE_MASK) >> (p)) & 1)
#ifndef DUP_MASK
#define DUP_MASK 0
#endif
#ifndef PROBE_PHASE
#define PROBE_PHASE -1
#endif
#ifndef EXTRA_SEAMS
#define EXTRA_SEAMS 0
#endif
#ifndef SCAN_DBG
#define SCAN_DBG 0
#endif
#ifndef SCAN_HILO
#define SCAN_HILO 0
#endif
#define DUP_N(p) (1 + (((DUP_MASK) >> (p)) & 1))
#define LAS __attribute__((address_space(3)))
typedef unsigned short bf16_t;
typedef short bf16x8 __attribute__((ext_vector_type(8)));
typedef float f32x4 __attribute__((ext_vector_type(4)));
typedef unsigned u32x4 __attribute__((ext_vector_type(4)));
typedef unsigned u32x2 __attribute__((ext_vector_type(2)));

constexpr int D = 1024, NBATCH = 16, SEQ = 2048, DEPTH = 4, CTXL = 256;
constexpr int NCTX = NBATCH * CTXL;
constexpr int NLAT = NBATCH * SEQ;
constexpr int NT = NCTX + NLAT;
constexpr int DH = 512;
constexpr int NIN = 5504, NINP = 5632, ZLD = 3584;
constexpr int ZC_BG = 0, ZC_U = 512  , ZC_RW = 1536, GC_GA = 3584, GC_GB = 4608;
constexpr int RWC = 1920;
constexpr int NE = 32, DFF = 512;
constexpr int MAXTILES = 320;
constexpr int NMOD = 6 * D;
constexpr float NORM_EPS = 1e-6f, GN_EPS = 64e-5f;

constexpr size_t MiB = 1u << 20;
constexpr size_t WS_CTL = 0, CTL_ZERO_BYTES = 1 * MiB;
constexpr size_t WS_MOD = 1 * MiB;
constexpr size_t WS_RE = 3 * MiB;
constexpr size_t WS_RG = WS_RE + (size_t)NT * 8;
constexpr size_t WS_RP = WS_RG + (size_t)NT * 8;
constexpr size_t WS_RS = WS_RP + (size_t)NT * 8;
constexpr size_t WS_BH = 4 * MiB + 256 * 1024;
constexpr size_t WS_MT = 4 * MiB + 320 * 1024;
constexpr size_t WS_RB = 4 * MiB + 384 * 1024;
constexpr size_t WS_WC = 6 * MiB + 256 * 1024;
constexpr size_t WS_STOK = 7 * MiB;
constexpr size_t WS_BONUS = 5 * MiB;
constexpr size_t WS_X = 8 * MiB;
constexpr size_t WS_WIN = 152 * MiB;
constexpr size_t WS_WA = 163 * MiB;
constexpr size_t WS_WB = 164 * MiB;
constexpr size_t WS_WO = 165 * MiB;
constexpr size_t WS_W13 = 167 * MiB;
constexpr size_t WS_W2 = 231 * MiB;
constexpr size_t WS_Z = 264 * MiB;
constexpr size_t WS_GT = 516 * MiB;
constexpr size_t WS_T = WS_Z;
constexpr size_t WS_XS = WS_Z;
constexpr size_t WS_HID = WS_Z + 160 * MiB;
constexpr size_t WS_SI = 660 * MiB;
constexpr size_t SI_SZ = 36 * MiB;
constexpr size_t WS_V = WS_SI, WS_KT0 = WS_SI + SI_SZ, WS_KT1 = WS_SI + 2 * SI_SZ, WS_BT0 = WS_SI + 3 * SI_SZ, WS_BT1 = WS_SI + 4 * SI_SZ,
                 WS_KDT0 = WS_SI + 5 * SI_SZ, WS_KDT1 = WS_SI + 6 * SI_SZ, WS_RT0 = WS_SI + 7 * SI_SZ, WS_RT1 = WS_SI + 8 * SI_SZ;
constexpr size_t WS_B1 = WS_RT1, WS_KD0 = WS_KDT0;
constexpr size_t WS_UA = WS_KT0, WS_UB = WS_KT1;
constexpr size_t WS_GE0 = 1092 * MiB, WS_GE1 = 1097 * MiB;
constexpr size_t WS_YS = WS_SI;
constexpr size_t WS_Y0 = 984 * MiB, WS_Y1 = 1020 * MiB;
constexpr size_t WS_END = 1102 * MiB;
constexpr size_t DO_H = 0, DO_G = 72 * MiB;
static_assert(WS_Z + (size_t)NT * ZLD * 2 <= WS_GT && WS_GT + (size_t)144 * MiB <= WS_SI && WS_HID + (size_t)MAXTILES * 256 * DFF * 2 <= WS_SI && WS_B1 + SI_SZ <= WS_Y0 && WS_YS + (size_t)MAXTILES * 256 * D * 2 <= WS_Y0, "ws map");
static_assert((size_t)NT * DH * 2 == SI_SZ && WS_X + (size_t)NT * D * 4 <= WS_WIN && WS_W2 + 32 * MiB <= WS_Z, "ws map 2");
constexpr int CW_CNT = 1024;
constexpr int CW_BAR = 4096;

constexpr int LDS_BYTES = 163840;
constexpr int LDS_CTL = 155648;
constexpr int LC_BARW = LDS_CTL;
constexpr int LC_SEG = LDS_CTL + 64;
constexpr int LC_CNTS = LDS_CTL + 256;
constexpr int LC_TILEE = LDS_CTL + 512;
constexpr int LC_BBASE = LDS_CTL + 2048;
constexpr int LC_RED = LDS_CTL + 4096;

__device__ __forceinline__ float bf2f(unsigned b) { return __uint_as_float(b << 16); }
typedef float f32x2c __attribute__((ext_vector_type(2)));
typedef __bf16 bf16v2c __attribute__((ext_vector_type(2)));
__device__ __forceinline__ unsigned pk2(float lo, float hi) { const f32x2c v = {lo, hi}; return __builtin_bit_cast(unsigned, __builtin_convertvector(v, bf16v2c)); }
__device__ __forceinline__ unsigned f2bf(float f) { return pk2(f, 0.f) & 0xffffu; }
__device__ __forceinline__ float wave_sum(float v) {
#pragma unroll
    for (int o = 1; o < 64; o <<= 1) v += __shfl_xor(v, o);
    return v;
}
__device__ __forceinline__ float fexp(float x) { return __builtin_amdgcn_exp2f(x * 1.4426950408889634f); }
__device__ __forceinline__ float sigmoidf_(float x) { return __builtin_amdgcn_rcpf(1.0f + fexp(-x)); }
__device__ __forceinline__ float siluf_(float x) { return x * __builtin_amdgcn_rcpf(1.0f + fexp(-x)); }

#define XB_TMO      128
#define XB_XCNT(j)  (256  + 64 * (j))
#define XB_XSUB(j)  (1280 + 64 * (j))
#define XB_XGEN(j)  (2304 + 64 * (j))
#define XB_TOP      3328
#define XB_TOPGEN   3392
#define XCD_BAR_WORDS 3456
#define XB_SPIN_CAP (1u << 22)

__device__ __forceinline__ unsigned xb_ld(unsigned* p)              { return __hip_atomic_load(p, __ATOMIC_RELAXED, __HIP_MEMORY_SCOPE_AGENT); }
__device__ __forceinline__ unsigned xb_add(unsigned* p, unsigned v) { return __hip_atomic_fetch_add(p, v, __ATOMIC_RELAXED, __HIP_MEMORY_SCOPE_AGENT); }
__device__ __forceinline__ unsigned xb_xcc_id() { return (unsigned)__builtin_amdgcn_s_getreg((3 << 11) | 20) & 0xFu; }
#define XB_SPIN(cond, bar) do { unsigned _sp = 0; while (cond) { __builtin_amdgcn_s_sleep(1); \
    if ((++_sp & 255u) == 0u) { if (xb_ld(&(bar)[XB_TMO])) break; if (_sp > XB_SPIN_CAP) { atomicAdd(&(bar)[XB_TMO], 1u); break; } } } } while (0)

struct XcdBarrier { unsigned* bar; unsigned x; volatile LAS unsigned* st; };

__device__ __forceinline__ XcdBarrier xcd_barrier_post(unsigned* bar, volatile LAS unsigned* st) {
    XcdBarrier b; b.bar = bar; b.x = xb_xcc_id(); b.st = st;
    if (threadIdx.x == 0) (void)xb_add(&bar[XB_XCNT(b.x)], 1u);
    return b;
}
__device__ __forceinline__ void xcd_barrier_complete(unsigned* bar, unsigned x, unsigned& nloc, unsigned& nx) {
    const unsigned G = gridDim.x * gridDim.y * gridDim.z;
    unsigned sum, cnt, mine, sp = 0u;
    for (;;) {
        sum = 0u; cnt = 0u; mine = 0u;
#pragma unroll
        for (unsigned j = 0; j < 16; ++j) { const unsigned c = xb_ld(&bar[XB_XCNT(j)]); sum += c; cnt += (c > 0u) ? 1u : 0u; mine = (j == x) ? c : mine; }
        if (sum == G) break;
        __builtin_amdgcn_s_sleep(1);
        if ((++sp & 255u) == 0u) { if (xb_ld(&bar[XB_TMO])) break; if (sp > XB_SPIN_CAP) { atomicAdd(&bar[XB_TMO], 1u); break; } }
    }
    nloc = mine > 0u ? mine : 1u; nx = cnt > 0u ? cnt : 1u;
}
__device__ __forceinline__ void xcd_barrier(const XcdBarrier& b) {
    asm volatile("s_waitcnt vmcnt(0)" ::: "memory");
    __syncthreads();
    if (threadIdx.x == 0) {
        unsigned* bar = b.bar;
        __builtin_amdgcn_s_waitcnt(0);
        unsigned nloc = b.st[0], nx = b.st[1];
        if (nloc == 0u) { xcd_barrier_complete(bar, b.x, nloc, nx); b.st[0] = nloc; b.st[1] = nx; }
        const unsigned old = xb_add(&bar[XB_XSUB(b.x)], 1u);
        const unsigned gen = old / nloc;
        if (old + 1u == (gen + 1u) * nloc) {
            __builtin_amdgcn_fence(__ATOMIC_RELEASE, "agent");
            asm volatile("s_waitcnt vmcnt(0)" ::: "memory");
            const unsigned og = xb_add(&bar[XB_TOP], 1u);
            const unsigned tg = og / nx;
            if (og + 1u == (tg + 1u) * nx) xb_add(&bar[XB_TOPGEN], 1u);
            else XB_SPIN(xb_ld(&bar[XB_TOPGEN]) == tg, bar);
            __builtin_amdgcn_fence(__ATOMIC_ACQUIRE, "agent");
            xb_add(&bar[XB_XGEN(b.x)], 1u);
            asm volatile("s_waitcnt vmcnt(0)" ::: "memory");
        } else {
            XB_SPIN(xb_ld(&bar[XB_XGEN(b.x)]) == gen, bar);
            __builtin_amdgcn_fence(__ATOMIC_ACQUIRE, "agent");
            asm volatile("s_waitcnt vmcnt(0)" ::: "memory");
        }
    }
    __syncthreads();
}

struct Unit { int pm, pn, bs, as; };
struct Gemm { const bf16_t* A; const bf16_t* Bt; int M, N, K; size_t bstride; size_t astride; };
constexpr int NXCD = 8, WGM = 8;
struct StaticOrder {
    int nM, nN, nwg, G, c;
    __device__ __forceinline__ void init(int M, int N, int G_, int c_) { nM = M / 256; nN = N / 256; nwg = nM * nN; G = G_; c = c_; }
    __device__ __forceinline__ bool next(int i, Unit& u) const {
        const long L = (long)i * G + c; if (L >= nwg) return false;
        int wgid = (int)L; { const int q = nwg / NXCD, r = nwg % NXCD, xcd = wgid % NXCD, off = wgid / NXCD; wgid = (xcd < r ? xcd * (q + 1) : r * (q + 1) + (xcd - r) * q) + off; }
        const int nig = WGM * nN, gid = wgid / nig, fm = gid * WGM, gsz = (nM - fm) < WGM ? (nM - fm) : WGM;
        u.pm = fm + ((wgid % nig) % gsz); u.pn = (wgid % nig) / gsz; u.bs = 0; u.as = 0; return true;
    }
};
struct PairOrder {
    StaticOrder so;
    __device__ __forceinline__ bool next(int i, Unit& u) const { if (!so.next(i >> 1, u)) return false; u.bs = i & 1; u.as = i & 1; return true; }
};
struct LastLayerOrder {
    StaticOrder so; int G, c;
    __device__ __forceinline__ void init(int G_, int c_) { so.init(NLAT, NINP, G_, c_); G = G_; c = c_; }
    __device__ __forceinline__ bool next(int i, Unit& u) const {
        const long L = (long)i * G + c;
        if (L < so.nwg) { so.next(i, u); u.pm += NCTX / 256; return true; }
        const int x = (int)(L - so.nwg); if (x >= (NCTX / 256) * 8) return false;
        u.pm = x >> 3; u.pn = 6 + (x & 7); u.bs = 0; u.as = 0; return true;
    }
};
struct MoeOrder {
    int ntiles, G, c; const LAS int* tile_e;
    __device__ __forceinline__ bool next(int i, Unit& u) const {
        const int nun = ntiles * 4; int L;
        if ((G & 7) == 0) { const int x = c & 7, lb = c >> 3, nb = G >> 3, q = nun >> 3, r = nun & 7; const int cnt = q + (x < r ? 1 : 0), j = i * nb + lb;
            if (j >= cnt) return false; L = x * q + (x < r ? x : r) + j; }
        else { L = i * G + c; if (L >= nun) return false; }
        u.pm = L >> 2; u.pn = L & 3; u.bs = __builtin_amdgcn_readfirstlane(tile_e[u.pm]); u.as = 0; return true;
    }
};

namespace pg8 {
constexpr int BM = 256, BK = 64, HALF = 128, HTB = HALF * BK * 2, STAGE_BYTES = 8 * HTB;
__device__ __forceinline__ int lds_byte(int r, int c) { const int st = (r >> 4) * 2 + (c >> 5), rr = r & 15, cc = c & 31, ob = rr * 64 + cc * 2; return st * 1024 + (ob ^ (((ob >> 9) & 1) << 5)); }
__device__ __forceinline__ int perm32(int rho) { const int n = rho >> 4, i = rho & 15; return 8 * (i >> 2) + 4 * n + (i & 3); }
__device__ __forceinline__ void stage_rc(int b, int& R, int& C) { const int st = b / 1024, sb = b % 1024, swz = sb ^ (((sb >> 9) & 1) << 5); R = (st >> 1) * 16 + swz / 64; C = (st & 1) * 32 + (swz % 64) / 2; }
}
template <class Epi, class Sched, bool GATHER = false>
__device__ __forceinline__ void gemm_phase(LAS unsigned char* lds, const Gemm g, const Sched& S, const Epi& E, const int* slot_tok = nullptr) {
    using namespace pg8;
    int tid_ = threadIdx.x; asm volatile("" : "+v"(tid_));
    const int tid = tid_, wid = __builtin_amdgcn_readfirstlane(tid >> 6), lane = tid & 63, wr = wid >> 2, wc = wid & 3, fr = lane & 15, fq = lane >> 4;
    const int K = g.K, nt = K / BK;
    int gR[2]; unsigned gC2[2];
    unsigned voffA[2], voffB[2];
#pragma unroll
    for (int i = 0; i < 2; ++i) { int R, C; stage_rc(tid * 16 + i * 8192, R, C); const int Rb = Epi::PERM ? ((R & ~31) + perm32(R & 31)) : R;
        voffA[i] = (unsigned)(R * K + C) * 2u; voffB[i] = (unsigned)(Rb * K + C) * 2u; gR[i] = R; gC2[i] = (unsigned)C * 2u; }
    unsigned gcur[2][2], gnxt[2][2];
#define PG8_GOFF(u_, g_) do { _Pragma("unroll") for (int h_ = 0; h_ < 2; ++h_) _Pragma("unroll") for (int i_ = 0; i_ < 2; ++i_) \
        g_[h_][i_] = (unsigned)slot_tok[(u_).pm * 256 + h_ * 128 + gR[i_]] * (unsigned)(K * 2) + gC2[i_]; } while (0)
    const size_t kstep = (size_t)(BK * 2);
    const size_t hstep = (size_t)HALF * K * 2;
    const size_t tstep = 2 * hstep;
    const unsigned ldsw = (unsigned)wid * 1024u;
    const int aoff = lds_byte(wr * 64 + fr, fq * 8), boff = lds_byte(wc * 32 + fr, fq * 8);
#define PG8_SA(b, h) (((b) * 2 + (h)) * HTB)
#define PG8_SB(b, h) ((4 + (b) * 2 + (h)) * HTB)
#define PG8_STAGE(bufoff, gbase, voff) do { _Pragma("unroll") for (int _i = 0; _i < 2; ++_i) \
        __builtin_amdgcn_global_load_lds((const unsigned*)((const char*)(gbase) + (voff)[_i]), (LAS unsigned*)(lds + (bufoff) + ldsw + _i * 8192), 16, 0, 0); } while (0)
#define PG8_LDA(dst, b, h) do { _Pragma("unroll") for (int m = 0; m < 4; ++m) _Pragma("unroll") for (int k = 0; k < 2; ++k) dst[m][k] = *(const LAS bf16x8*)(lds + PG8_SA(b, h) + aoff + m * 2048 + k * 1024); } while (0)
#define PG8_LDB(dst, b, h) do { _Pragma("unroll") for (int n = 0; n < 2; ++n) _Pragma("unroll") for (int k = 0; k < 2; ++k) dst[n][k] = *(const LAS bf16x8*)(lds + PG8_SB(b, h) + boff + n * 2048 + k * 1024); } while (0)
#define PG8_MMA(ai, bj, At, Bt) do { __builtin_amdgcn_s_setprio(1); _Pragma("unroll") for (int m = 0; m < 4; ++m) _Pragma("unroll") for (int n = 0; n < 2; ++n) _Pragma("unroll") for (int k = 0; k < 2; ++k) \
        acc[ai][bj][m][n] = __builtin_amdgcn_mfma_f32_16x16x32_bf16(Bt[n][k], At[m][k], acc[ai][bj][m][n], 0, 0, 0); __builtin_amdgcn_s_setprio(0); } while (0)
#define PG8_WAIT_V(n) asm volatile("s_waitcnt vmcnt(" #n ")" ::: "memory")
#define PG8_WAIT_L(n) asm volatile("s_waitcnt lgkmcnt(" #n ")" ::: "memory")
#define PG8_BAR __builtin_amdgcn_s_barrier()
#define PG8_SCHED __builtin_amdgcn_sched_barrier(0)
    Unit cur, nxt; int ui = 0;
    if (S.next(0, cur)) {
    f32x4 acc[2][2][4][2];
#pragma unroll
    for (int a = 0; a < 2; ++a)
#pragma unroll
        for (int b = 0; b < 2; ++b)
#pragma unroll
            for (int m = 0; m < 4; ++m)
#pragma unroll
                for (int n = 0; n < 2; ++n) acc[a][b][m][n] = (f32x4){0.f, 0.f, 0.f, 0.f};
    bf16x8 At[4][2], B0[2][2], B1[2][2];
    const char* cA = (const char*)(g.A + (size_t)cur.as * g.astride) + (size_t)cur.pm * tstep; const char* cB = (const char*)(g.Bt + (size_t)cur.bs * g.bstride) + (size_t)cur.pn * tstep;
    const char* Ab = (const char*)g.A;
    if constexpr (GATHER) { PG8_GOFF(cur, gcur); }
    if constexpr (GATHER) { PG8_STAGE(PG8_SB(0, 0), cB, voffB); PG8_STAGE(PG8_SA(0, 0), Ab, gcur[0]); PG8_STAGE(PG8_SB(0, 1), cB + hstep, voffB); PG8_STAGE(PG8_SA(0, 1), Ab, gcur[1]); }
    else { PG8_STAGE(PG8_SB(0, 0), cB, voffB); PG8_STAGE(PG8_SA(0, 0), cA, voffA); PG8_STAGE(PG8_SB(0, 1), cB + hstep, voffB); PG8_STAGE(PG8_SA(0, 1), cA + hstep, voffA); }
    if (wr == 1) PG8_BAR;
    PG8_WAIT_V(4); PG8_BAR;
    PG8_STAGE(PG8_SB(1, 0), cB + kstep, voffB); if constexpr (GATHER) PG8_STAGE(PG8_SA(1, 0), Ab + kstep, gcur[0]); else PG8_STAGE(PG8_SA(1, 0), cA + kstep, voffA); PG8_STAGE(PG8_SB(1, 1), cB + hstep + kstep, voffB);
    PG8_WAIT_V(6); PG8_BAR;
    for (;;) {
        const bool has_next = S.next(ui + 1, nxt);
        const char* nA = has_next ? (const char*)(g.A + (size_t)nxt.as * g.astride) + (size_t)nxt.pm * tstep : cA; const char* nB = has_next ? (const char*)(g.Bt + (size_t)nxt.bs * g.bstride) + (size_t)nxt.pn * tstep : cB;
        if constexpr (GATHER) { if (has_next) { PG8_GOFF(nxt, gnxt); } else { _Pragma("unroll") for (int h_ = 0; h_ < 2; ++h_) _Pragma("unroll") for (int i_ = 0; i_ < 2; ++i_) gnxt[h_][i_] = gcur[h_][i_]; } }
        for (int t = 0; t < nt; t += 2) {
            const bool last = (t == nt - 2);
            unsigned gsel[2][2]; const char* ga2 = Ab;
            if constexpr (GATHER) { _Pragma("unroll") for (int h_ = 0; h_ < 2; ++h_) _Pragma("unroll") for (int i_ = 0; i_ < 2; ++i_) gsel[h_][i_] = last ? gnxt[h_][i_] : gcur[h_][i_]; ga2 = Ab + (last ? (size_t)0 : (size_t)(t + 2) * kstep); }
            const char* a1 = cA + (size_t)(t + 1) * kstep;
            const char* a2 = last ? nA : cA + (size_t)(t + 2) * kstep; const char* b2 = last ? nB : cB + (size_t)(t + 2) * kstep;
            const char* a3 = a2 + kstep; const char* b3 = b2 + kstep;
            PG8_LDB(B0, 0, 0); PG8_SCHED; PG8_LDA(At, 0, 0); if constexpr (GATHER) PG8_STAGE(PG8_SA(1, 1), Ab + (size_t)(t + 1) * kstep, gcur[1]); else PG8_STAGE(PG8_SA(1, 1), a1 + hstep, voffA);
            PG8_WAIT_L(8); PG8_BAR; PG8_WAIT_L(0); PG8_MMA(0, 0, At, B0); PG8_BAR; PG8_SCHED;
            PG8_LDB(B1, 0, 1); PG8_STAGE(PG8_SB(0, 0), b2, voffB);
            PG8_BAR; PG8_WAIT_L(0); PG8_MMA(0, 1, At, B1); PG8_BAR;
            PG8_LDA(At, 0, 1); if constexpr (GATHER) PG8_STAGE(PG8_SA(0, 0), ga2, gsel[0]); else PG8_STAGE(PG8_SA(0, 0), a2, voffA);
            PG8_BAR; PG8_WAIT_L(0); PG8_MMA(1, 0, At, B0); PG8_BAR; PG8_SCHED;
            PG8_STAGE(PG8_SB(0, 1), b2 + hstep, voffB);
            PG8_WAIT_V(6); PG8_BAR; PG8_MMA(1, 1, At, B1); PG8_BAR;
            PG8_LDB(B0, 1, 0); PG8_SCHED; PG8_LDA(At, 1, 0); if constexpr (GATHER) PG8_STAGE(PG8_SA(0, 1), ga2, gsel[1]); else PG8_STAGE(PG8_SA(0, 1), a2 + hstep, voffA);
            PG8_WAIT_L(8); PG8_BAR; PG8_WAIT_L(0); PG8_MMA(0, 0, At, B0); PG8_BAR; PG8_SCHED;
            PG8_LDB(B1, 1, 1); PG8_STAGE(PG8_SB(1, 0), b3, voffB);
            PG8_BAR; PG8_WAIT_L(0); PG8_MMA(0, 1, At, B1); PG8_BAR;
            PG8_LDA(At, 1, 1); if constexpr (GATHER) PG8_STAGE(PG8_SA(1, 0), ga2 + kstep, gsel[0]); else PG8_STAGE(PG8_SA(1, 0), a3, voffA);
            PG8_BAR; PG8_WAIT_L(0); PG8_MMA(1, 0, At, B0); PG8_BAR; PG8_SCHED;
            PG8_STAGE(PG8_SB(1, 1), b3 + hstep, voffB);
            PG8_WAIT_V(6); PG8_BAR; PG8_MMA(1, 1, At, B1); PG8_BAR;
        }
        bool keep = false;
        {
            const int row0 = cur.pm * 256 + wr * 64 + fr;
            if constexpr (Epi::TWO_PART) keep = (cur.as == 0);
            if constexpr (Epi::TWO_PART) {
                const int col0 = cur.pn * 256 + wc * 32 + 8 * fq;
                u32x4 gv[2][4][2];
#pragma unroll
                for (int ai = 0; ai < 2; ++ai)
#pragma unroll
                    for (int m = 0; m < 4; ++m)
#pragma unroll
                        for (int bj = 0; bj < 2; ++bj) gv[ai][m][bj] = E.gload(row0 + ai * 128 + m * 16, col0 + bj * 128, keep ? 0 : 1);
#pragma unroll
                for (int ai = 0; ai < 2; ++ai)
#pragma unroll
                    for (int m = 0; m < 4; ++m)
#pragma unroll
                        for (int bj = 0; bj < 2; ++bj) E.scale8(gv[ai][m][bj], acc[ai][bj][m][0], acc[ai][bj][m][1]);
                if (!keep) {
#pragma unroll
                    for (int ai = 0; ai < 2; ++ai)
#pragma unroll
                        for (int m = 0; m < 4; ++m)
#pragma unroll
                            for (int bj = 0; bj < 2; ++bj) E.store8(row0 + ai * 128 + m * 16, col0 + bj * 128, acc[ai][bj][m][0], acc[ai][bj][m][1]);
                }
            } else if constexpr (Epi::PERM) {
                const int col0 = cur.pn * 256 + wc * 32 + 8 * fq;
#pragma unroll
                for (int ai = 0; ai < 2; ++ai)
#pragma unroll
                    for (int m = 0; m < 4; ++m)
                    {
                        if constexpr (Epi::PAIRED) E.pair8(row0 + ai * 128 + m * 16, col0, acc[ai][0][m][0], acc[ai][0][m][1], acc[ai][1][m][0], acc[ai][1][m][1]);
                        else if constexpr (Epi::PAIRM) {
                            if ((m & 1) == 0) {
#pragma unroll
                            for (int bj = 0; bj < 2; ++bj) E.elem8m(row0 + ai * 128 + m * 16, col0 + bj * 128, fq, acc[ai][bj][m][0], acc[ai][bj][m][1], acc[ai][bj][m + 1][0], acc[ai][bj][m + 1][1]);
                            }
                        } else {
#pragma unroll
                        for (int bj = 0; bj < 2; ++bj) E.elem8(row0 + ai * 128 + m * 16, col0 + bj * 128, acc[ai][bj][m][0], acc[ai][bj][m][1]);
                        }
                    }
            } else {
                const int col0 = cur.pn * 256 + wc * 32 + 4 * fq;
#pragma unroll
                for (int ai = 0; ai < 2; ++ai)
#pragma unroll
                    for (int m = 0; m < 4; ++m)
#pragma unroll
                        for (int bj = 0; bj < 2; ++bj)
#pragma unroll
                            for (int n = 0; n < 2; ++n) E.elem4(row0 + ai * 128 + m * 16, col0 + bj * 128 + n * 16, acc[ai][bj][m][n]);
            }
        }
        if (!has_next) break;
        if (!keep) {
#pragma unroll
        for (int a = 0; a < 2; ++a)
#pragma unroll
            for (int b = 0; b < 2; ++b)
#pragma unroll
                for (int m = 0; m < 4; ++m)
#pragma unroll
                    for (int n = 0; n < 2; ++n) acc[a][b][m][n] = (f32x4){0.f, 0.f, 0.f, 0.f};
        }
        if constexpr (GATHER) { _Pragma("unroll") for (int h_ = 0; h_ < 2; ++h_) _Pragma("unroll") for (int i_ = 0; i_ < 2; ++i_) gcur[h_][i_] = gnxt[h_][i_]; }
        cur = nxt; cA = nA; cB = nB; ++ui;
    }
    PG8_WAIT_V(0);
    if (wr == 0) PG8_BAR;
    PG8_BAR;
    }
#undef PG8_GOFF
#undef PG8_SA
#undef PG8_SB
#undef PG8_STAGE
#undef PG8_LDA
#undef PG8_LDB
#undef PG8_MMA
#undef PG8_WAIT_V
#undef PG8_WAIT_L
#undef PG8_BAR
#undef PG8_SCHED
    __syncthreads();
}

__device__ __forceinline__ u32x4 pack8v(const f32x4 a, const f32x4 b) { u32x4 r; r.x = pk2(a[0], a[1]); r.y = pk2(a[2], a[3]); r.z = pk2(b[0], b[1]); r.w = pk2(b[2], b[3]); return r; }
struct EpiStoreBf16 {
    static constexpr bool TWO_PART = false, PERM = true, PAIRED = false, PAIRM = false;
    bf16_t* O; int ldc;
    __device__ __forceinline__ void elem8(int row, int col, f32x4 v0, f32x4 v1) const { *(u32x4*)(O + (size_t)row * ldc + col) = pack8v(v0, v1); }
};
__device__ __forceinline__ size_t gate_slot(int row, int cc  ) {
    const int rr = row & 255;
    const int oct = (rr >> 7) * 4 + ((rr >> 4) & 3), tid = ((((rr >> 6) & 1) * 4 + ((cc >> 5) & 3)) << 6) + (((cc >> 3) & 3) << 4) + (rr & 15);
    return (size_t)(oct * 512 + tid) * 8;
}
constexpr size_t GT_HALF = (size_t)8 * 512 * 8;
struct EpiZ {
    static constexpr bool TWO_PART = false, PERM = true, PAIRED = true, PAIRM = false;
    bf16_t* Z; bf16_t* GT;
    __device__ __forceinline__ void pair8(int row, int col, f32x4 a0, f32x4 a1, f32x4 b0, f32x4 b1) const {
        if (col >= 512 && col < 1536) {
            *(u32x4*)(Z + (size_t)row * ZLD + ZC_U + 128 * ((col - 512) >> 8) + (col & 127)) = pack8v(a0 * b0, a1 * b1); }
        else if (col < GC_GA) { *(u32x4*)(Z + (size_t)row * ZLD + col) = pack8v(a0, a1); *(u32x4*)(Z + (size_t)row * ZLD + col + 128) = pack8v(b0, b1); }
        else {
            f32x4 r0, r1, s0, s1;
#pragma unroll
            for (int e = 0; e < 4; ++e) { const float ea0 = fexp(-a0[e]), ea1 = fexp(-a1[e]), eb0 = fexp(-b0[e]), eb1 = fexp(-b1[e]);
                s0[e] = __builtin_amdgcn_rcpf(1.0f + eb0); s1[e] = __builtin_amdgcn_rcpf(1.0f + eb1);
                r0[e] = (1.0f + eb0) * __builtin_amdgcn_rcpf(1.0f + ea0); r1[e] = (1.0f + eb1) * __builtin_amdgcn_rcpf(1.0f + ea1); }
            bf16_t* gp = GT + (size_t)((row >> 8) * 8 + ((col - GC_GA) >> 8)) * (2 * GT_HALF) + gate_slot(row, col & 127);
            *(u32x4*)gp = pack8v(r0, r1); *(u32x4*)(gp + GT_HALF) = pack8v(s0, s1);
        }
    }
};
struct EpiMerge {
    static constexpr bool TWO_PART = true, PERM = true, PAIRED = false, PAIRM = false;
    bf16_t* MG; const bf16_t* GT;
    __device__ __forceinline__ u32x4 gload(int row, int col, int which) const {
        return *(const u32x4*)(GT + (size_t)((row >> 8) * 8 + (col >> 7)) * (2 * GT_HALF) + (size_t)which * GT_HALF + gate_slot(row, col & 127)); }
    __device__ __forceinline__ void scale8(const u32x4 r, f32x4& v0, f32x4& v1) const {
        v0[0] *= bf2f(r[0] & 0xffffu); v0[1] *= bf2f(r[0] >> 16); v0[2] *= bf2f(r[1] & 0xffffu); v0[3] *= bf2f(r[1] >> 16);
        v1[0] *= bf2f(r[2] & 0xffffu); v1[1] *= bf2f(r[2] >> 16); v1[2] *= bf2f(r[3] & 0xffffu); v1[3] *= bf2f(r[3] >> 16);
    }
    __device__ __forceinline__ void store8(int row, int col, const f32x4 v0, const f32x4 v1) const { *(u32x4*)(MG + (size_t)row * D + col) = pack8v(v0, v1); }
};
struct EpiResid {
    static constexpr bool TWO_PART = false, PERM = false, PAIRED = false, PAIRM = false;
    float* X; const float* modg;
    __device__ __forceinline__ void elem4(int row, int col, f32x4 v) const {
        const int mj = row < NCTX ? 16 : ((row - NCTX) >> 11);
        const f32x4 gv = *(const f32x4*)(modg + (size_t)mj * NMOD + col);
        f32x4* p = (f32x4*)(X + (size_t)row * D + col);
        f32x4 x = *p; x[0] += gv[0] * v[0]; x[1] += gv[1] * v[1]; x[2] += gv[2] * v[2]; x[3] += gv[3] * v[3]; *p = x;
    }
};
struct EpiSwiGLU {
    static constexpr bool TWO_PART = false, PERM = true, PAIRED = false, PAIRM = true;
    __device__ __forceinline__ void elem8m(int row, int col, int fq, f32x4 a0, f32x4 a1, f32x4 b0, f32x4 b1) const {
        unsigned ax = pk2(siluf_(a0[0]) * a1[0], siluf_(a0[1]) * a1[1]), ay = pk2(siluf_(a0[2]) * a1[2], siluf_(a0[3]) * a1[3]);
        unsigned bx = pk2(siluf_(b0[0]) * b1[0], siluf_(b0[1]) * b1[1]), by = pk2(siluf_(b0[2]) * b1[2], siluf_(b0[3]) * b1[3]);
        const auto sx = __builtin_amdgcn_permlane16_swap(ax, bx, false, false), sy = __builtin_amdgcn_permlane16_swap(ay, by, false, false);
        u32x4 o; o.x = sx[0]; o.y = sy[0]; o.z = sx[1]; o.w = sy[1];
        const int odd = fq & 1;
        *(u32x4*)(HID + (size_t)(row + 16 * odd) * DFF + (col >> 1) - 4 * odd) = o;
    }
    bf16_t* HID;
    __device__ __forceinline__ void elem8(int row, int col, f32x4 v0, f32x4 v1) const {
        u32x2 w; w.x = pk2(siluf_(v0[0]) * v1[0], siluf_(v0[1]) * v1[1]); w.y = pk2(siluf_(v0[2]) * v1[2], siluf_(v0[3]) * v1[3]);
        *(u32x2*)(HID + (size_t)row * DFF + (col >> 1)) = w;
    }
};

struct Args { const float* in[32]; float* out; unsigned char* ws; int ph_lo, ph_hi; };
typedef const __attribute__((address_space(4))) Args* KArgs;
__device__ __forceinline__ KArgs kargs() { KArgs p = (KArgs)__builtin_amdgcn_kernarg_segment_ptr(); asm volatile("" : "+s"(p)); return p; }
struct Frame {
    LAS unsigned char* lds;
    int tid, lane, wave, G, bid;
    KArgs ka; float* out; unsigned char* ws;
    __device__ __forceinline__ const float* inp(int i) const { return ka->in[i]; }
};
__device__ __forceinline__ Frame make_frame() {
    extern __shared__ __attribute__((aligned(16))) unsigned char lds_raw[];
    Frame F; F.lds = (LAS unsigned char*)lds_raw; { int t = threadIdx.x; asm volatile("" : "+v"(t)); F.tid = t; } F.lane = F.tid & 63; F.wave = __builtin_amdgcn_readfirstlane(F.tid >> 6);
    { int g_ = gridDim.x, b_ = blockIdx.x; asm volatile("" : "+s"(g_), "+s"(b_)); F.G = g_; F.bid = b_; } F.ka = kargs(); F.out = F.ka->out; F.ws = F.ka->ws; return F;
}
#define IN_X 0
#define IN_C 1
#define IN_CTX 2
#define IN_CCTX 3
#define IN_WMOD 4
#define IN_BMOD 5
#define IN_N1G 6
#define IN_N2G 7
#define IN_WIN 8
#define IN_SHMU 9
#define IN_CONVW 10
#define IN_WUP 11
#define IN_W0 12
#define IN_AUP 13
#define IN_A0 14
#define IN_GUP 15
#define IN_KK 16
#define IN_KA 17
#define IN_RK 18
#define IN_LNG 19
#define IN_LNB 20
#define IN_WAO 21
#define IN_WBO 22
#define IN_WO 23
#define IN_RG 24
#define IN_RGB 25
#define IN_RE 26
#define IN_REB 27
#define IN_W1 28
#define IN_W3 29
#define IN_W2 30
#define IN_FG 31

__device__ __forceinline__ void convert_layer_weights(Frame& F, int l, int part, int widx, int nworkers);
__device__ __forceinline__ void phase_prologue() {
    Frame F = make_frame();
    convert_layer_weights(F, 0, 0, F.bid * 8 + F.wave, F.G * 8);
    {
        float* WC = (float*)(F.ws + WS_WC); float* RB = (float*)(F.ws + WS_RB);
        for (int i = F.bid * 512 + F.tid; i < DEPTH * 1024 * 48; i += F.G * 512) { const int c = i % 48, lk = i / 48;
            WC[i] = c < 32 ? F.inp(IN_RE)[(size_t)lk * 32 + c] : (c < 36 ? F.inp(IN_RG)[(size_t)lk * 4 + (c - 32)] : 0.f); }
        if (F.bid == 0 && F.tid < DEPTH * 48) { const int c = F.tid % 48, l = F.tid / 48; RB[F.tid] = c < 32 ? F.inp(IN_REB)[l * 32 + c] : (c < 36 ? F.inp(IN_RGB)[l * 4 + (c - 32)] : 0.f); }
    }
    {
        LAS float* st = (LAS float*)F.lds;
        LAS float* red = (LAS float*)(F.lds + 1024 * 20 * 4);
        __syncthreads();
        {
            float cv_[17][2];
#pragma unroll
            for (int j = 0; j < 17; ++j)
#pragma unroll
                for (int m = 0; m < 2; ++m) { const int k = F.tid + 512 * m; cv_[j][m] = j < 16 ? F.inp(IN_C)[j * 1024 + k] : F.inp(IN_CCTX)[k]; }
#pragma unroll
            for (int j = 0; j < 17; ++j)
#pragma unroll
                for (int m = 0; m < 2; ++m) st[(F.tid + 512 * m) * 20 + j] = siluf_(cv_[j][m]);
        }
        __syncthreads();
        for (int cb0 = F.bid * 96; cb0 < DEPTH * NMOD; cb0 += F.G * 96) {
            const int c = F.tid % 96, kg = F.tid / 96, cidx = cb0 + c;
            if (kg < 4 && cidx < DEPTH * NMOD) {
                const int l = cidx / NMOD, n = cidx % NMOD;
                const float* w = F.inp(IN_WMOD) + (size_t)l * D * NMOD + n + (size_t)(256 * kg) * NMOD;
                float acc[17];
#pragma unroll
                for (int j = 0; j < 17; ++j) acc[j] = 0.f;
#pragma unroll 16
                for (int k = 0; k < 256; ++k) {
                    const float wv = w[(size_t)k * NMOD];
                    const LAS float* sp = st + (256 * kg + k) * 20;
#pragma unroll
                    for (int j = 0; j < 17; ++j) acc[j] = fmaf(sp[j], wv, acc[j]);
                }
#pragma unroll
                for (int j = 0; j < 17; ++j) red[(kg * 96 + c) * 17 + j] = acc[j];
            }
            __syncthreads();
            for (int i = F.tid; i < 96 * 17; i += 512) { const int c2 = i / 17, j = i % 17, cidx2 = cb0 + c2;
                if (cidx2 < DEPTH * NMOD) { const int l = cidx2 / NMOD, n = cidx2 % NMOD;
                    ((float*)(F.ws + WS_MOD))[((size_t)l * 17 + j) * NMOD + n] = red[c2 * 17 + j] + red[(96 + c2) * 17 + j] + red[(192 + c2) * 17 + j] + red[(288 + c2) * 17 + j] + F.inp(IN_BMOD)[l * NMOD + n]; } }
            __syncthreads();
        }
    }
}

__device__ __forceinline__ void conv_item(const float* src0, const float* src1, int ldsrc, int nvalid, int mode, bf16_t* dst, int K, int item, LAS float* scr, int lane) {
    const int nkb = K / 64, kb = item % nkb, jb = item / nkb, k0 = 64 * kb, j0 = 32 * jb;
    const int jj = j0 + (lane & 31);
    const float* colp;
    if (mode == 0) colp = jj < nvalid ? src0 + jj : nullptr;
    else if (mode == 2) { const int q_ = jj - GC_GA, u_ = jj - 512; colp = jj < 512 ? src0 + jj : (jj < 1536 ? src0 + (((u_ >> 7) & 1) ? 1024 : 512) + 128 * (u_ >> 8) + (u_ & 127) : (jj < 3456 ? src0 + jj : (jj < GC_GA ? nullptr : src0 + (((q_ >> 7) & 1) ? 4480 : 3456) + 128 * (q_ >> 8) + (q_ & 127)))); }
    else colp = ((jj & 4) ? src1 : src0) + 4 * (jj >> 3) + (jj & 3);
    float cv[32];
#pragma unroll
    for (int i = 0; i < 32; ++i) { const int kk = 2 * i + (lane >> 5); cv[i] = colp ? colp[(size_t)(k0 + kk) * ldsrc] : 0.f; }
#pragma unroll
    for (int i = 0; i < 32; ++i) { const int kk = 2 * i + (lane >> 5); scr[kk * 33 + (lane & 31)] = cv[i]; }
    asm volatile("s_waitcnt lgkmcnt(0)" ::: "memory");
    const int c = lane & 7;
#pragma unroll
    for (int j = 0; j < 4; ++j) { const int n = (lane >> 3) + 8 * j; const LAS float* s = scr + (8 * c) * 33 + n;
        u32x4 o; o.x = pk2(s[0 * 33], s[1 * 33]); o.y = pk2(s[2 * 33], s[3 * 33]); o.z = pk2(s[4 * 33], s[5 * 33]); o.w = pk2(s[6 * 33], s[7 * 33]);
        *(u32x4*)(dst + (size_t)(j0 + n) * K + k0 + 8 * c) = o; }
    asm volatile("s_waitcnt lgkmcnt(0)" ::: "memory");
}
__device__ __forceinline__ void convert_layer_weights(Frame& F, int l, int part, int widx, int nworkers) {
    LAS float* scr = (LAS float*)(F.lds + F.wave * 8704);
    constexpr int I_IN = (1024 / 64) * (NINP / 32), I_A = (512 / 64) * (1024 / 32), I_O = (1024 / 64) * (1024 / 32), I_13 = (1024 / 64) * (1024 / 32), I_2 = (512 / 64) * (1024 / 32);
    constexpr int NITEMS = I_IN + 2 * I_A + I_O + NE * I_13 + NE * I_2;
    constexpr int N_PART0 = I_IN + 2 * I_A + I_O;
    constexpr int N_EXP = NITEMS - N_PART0, N_T3 = (N_EXP + 2) / 3;
    const int it_lo = part == 0 ? 0 : (part == 1 ? N_PART0 : N_PART0 + (part - 4) * N_T3);
    const int it_hi = part == 0 ? N_PART0 : (part == 1 ? NITEMS : (N_PART0 + (part - 3) * N_T3 < NITEMS ? N_PART0 + (part - 3) * N_T3 : NITEMS));
    for (int it = it_lo + widx; it < it_hi; it += nworkers) {
        int r = it;
        if (r < I_IN) { conv_item(F.inp(IN_WIN) + (size_t)l * D * NIN, nullptr, NIN, NIN, 2, (bf16_t*)(F.ws + WS_WIN), 1024, r, scr, F.lane); continue; } r -= I_IN;
        if (r < I_A) { conv_item(F.inp(IN_WAO) + (size_t)l * DH * D, nullptr, D, D, 0, (bf16_t*)(F.ws + WS_WA), 512, r, scr, F.lane); continue; } r -= I_A;
        if (r < I_A) { conv_item(F.inp(IN_WBO) + (size_t)l * DH * D, nullptr, D, D, 0, (bf16_t*)(F.ws + WS_WB), 512, r, scr, F.lane); continue; } r -= I_A;
        if (r < I_O) { conv_item(F.inp(IN_WO) + (size_t)l * D * D, nullptr, D, D, 0, (bf16_t*)(F.ws + WS_WO), 1024, r, scr, F.lane); continue; } r -= I_O;
        if (r < NE * I_13) { const int e = r / I_13, ri = r % I_13; const size_t so = ((size_t)l * NE + e) * D * DFF;
            conv_item(F.inp(IN_W1) + so, F.inp(IN_W3) + so, DFF, 0, 1, (bf16_t*)(F.ws + WS_W13) + (size_t)e * 1024 * 1024, 1024, ri, scr, F.lane); continue; } r -= NE * I_13;
        { const int e = r / I_2, ri = r % I_2; const size_t so = ((size_t)l * NE + e) * DFF * D;
            conv_item(F.inp(IN_W2) + so, nullptr, D, D, 0, (bf16_t*)(F.ws + WS_W2) + (size_t)e * 1024 * 512, 512, ri, scr, F.lane); }
    }
}

__device__ __forceinline__ int col4(int lane, int j) { return 8 * lane + 512 * (j >> 1) + 4 * (j & 1); }
__device__ __forceinline__ void unpk8(const u32x4 p, f32x4& a, f32x4& b) { a[0] = bf2f(p.x & 0xffffu); a[1] = bf2f(p.x >> 16); a[2] = bf2f(p.y & 0xffffu); a[3] = bf2f(p.y >> 16); b[0] = bf2f(p.z & 0xffffu); b[1] = bf2f(p.z >> 16); b[2] = bf2f(p.w & 0xffffu); b[3] = bf2f(p.w >> 16); }
__device__ __forceinline__ void combine_row(Frame& F, int lprev, int row, f32x4 (&v)[4]) {
    const bf16_t* YS = (const bf16_t*)(F.ws + WS_YS); const int* RS = (const int*)(F.ws + WS_RS); const float* RG = (const float*)(F.ws + WS_RG);
    const int mj = row < NCTX ? 16 : ((row - NCTX) >> 11);
    const float* g2 = (const float*)(F.ws + WS_MOD) + ((size_t)lprev * 17 + mj) * NMOD + 5120; const float* g1p = g2 - 5120 + 2048;
    const bf16_t* Tm = (const bf16_t*)(F.ws + WS_T);
    const int s0 = RS[2 * row], s1 = RS[2 * row + 1]; const float ga = RG[2 * row], gb = RG[2 * row + 1];
#pragma unroll
    for (int jj = 0; jj < 2; ++jj) {
        const int c8 = 8 * F.lane + 512 * jj;
        const u32x4 y0p = *(const u32x4*)(YS + (size_t)s0 * D + c8), y1p = *(const u32x4*)(YS + (size_t)s1 * D + c8), tp = *(const u32x4*)(Tm + (size_t)row * D + c8);
        f32x4 y0[2], y1[2], tv[2]; unpk8(y0p, y0[0], y0[1]); unpk8(y1p, y1[0], y1[1]); unpk8(tp, tv[0], tv[1]);
#pragma unroll
        for (int hh = 0; hh < 2; ++hh) { const int j = 2 * jj + hh, c = c8 + 4 * hh;
            const f32x4 g1 = *(const f32x4*)(g1p + c), gg = *(const f32x4*)(g2 + c);
#pragma unroll
            for (int q = 0; q < 4; ++q) v[j][q] += g1[q] * tv[hh][q] + gg[q] * (ga * y0[hh][q] + gb * y1[hh][q]); }
    }
}
__device__ __forceinline__ f32x4 ld_x4(const bf16_t* p) { const u32x2 t = *(const u32x2*)p; f32x4 r; r[0] = bf2f(t.x & 0xffffu); r[1] = bf2f(t.x >> 16); r[2] = bf2f(t.y & 0xffffu); r[3] = bf2f(t.y >> 16); return r; }
__device__ __forceinline__ void phase_norm1(int l, int rep_ = 0) {
    asm volatile("" : "+s"(l)); Frame F = make_frame();
    if (l > 0) convert_layer_weights(F, l, 0, F.bid * 8 + F.wave, F.G * 8);
    const int gw = F.bid * 8 + F.wave, NGW = F.G * 8;
    const bf16_t* X = (const bf16_t*)(F.ws + WS_X); bf16_t* XW = rep_ ? (bf16_t*)(F.ws + WS_Z) : (bf16_t*)(F.ws + WS_X);
    bf16_t* H = rep_ ? (bf16_t*)(F.ws + WS_Z + 160 * MiB) : (bf16_t*)((unsigned char*)F.out + DO_H);
    const float* g1n = F.inp(IN_N1G) + l * D;
    for (int row = gw; row < NT; row += NGW) {
        const int mj = row < NCTX ? 16 : ((row - NCTX) >> 11);
        const float* mod = (const float*)(F.ws + WS_MOD) + ((size_t)l * 17 + mj) * NMOD;
        f32x4 v[4];
        if (l > 0) {
#pragma unroll
            for (int jj = 0; jj < 2; ++jj) unpk8(*(const u32x4*)(X + (size_t)row * D + 8 * F.lane + 512 * jj), v[2 * jj], v[2 * jj + 1]);
            combine_row(F, l - 1, row, v);
        } else {
            const float* xsrc = row < NCTX ? F.inp(IN_CTX) + (size_t)row * D : F.inp(IN_X) + (size_t)(row - NCTX) * D;
#pragma unroll
            for (int j = 0; j < 4; ++j) v[j] = *(const f32x4*)(xsrc + col4(F.lane, j));
        }
#pragma unroll
        for (int jj = 0; jj < 2; ++jj) *(u32x4*)(XW + (size_t)row * D + 8 * F.lane + 512 * jj) = pack8v(v[2 * jj], v[2 * jj + 1]);
        float ss = 0.f;
#pragma unroll
        for (int j = 0; j < 4; ++j) ss += v[j][0] * v[j][0] + v[j][1] * v[j][1] + v[j][2] * v[j][2] + v[j][3] * v[j][3];
        const float rs = rsqrtf(wave_sum(ss) * (1.0f / D) + NORM_EPS);
#pragma unroll
        for (int jj = 0; jj < 2; ++jj) {
            f32x4 o[2];
#pragma unroll
            for (int hh = 0; hh < 2; ++hh) { const int j = 2 * jj + hh, c = col4(F.lane, j);
                const f32x4 gg = *(const f32x4*)(g1n + c), sh = *(const f32x4*)(mod + c), sc = *(const f32x4*)(mod + 1024 + c);
#pragma unroll
                for (int q = 0; q < 4; ++q) o[hh][q] = v[j][q] * rs * gg[q] * (1.0f + sc[q]) + sh[q]; }
            *(u32x4*)(H + (size_t)row * D + 8 * F.lane + 512 * jj) = pack8v(o[0], o[1]);
        }
    }
}

constexpr int PW_S64 = 144, PW_S128 = 272;
constexpr int PW_G = 4 * 64 * PW_S64;
constexpr int PA_OFF = PW_G + 64 * PW_S128;
constexpr int PA_STRIDE = 784;
static_assert(PA_OFF + 128 * PA_STRIDE <= LDS_CTL, "prep LDS map");
__device__ __forceinline__ float tanh_fast(float x) { return 1.0f - 2.0f * __builtin_amdgcn_rcpf(1.0f + fexp(2.0f * x)); }
__device__ __forceinline__ void unpack8(const u32x4 p, float (&o)[8]) {
#pragma unroll
    for (int j = 0; j < 4; ++j) { o[2 * j] = bf2f(p[j] & 0xffffu); o[2 * j + 1] = bf2f(p[j] >> 16); }
}
__device__ __forceinline__ u32x4 pack8(const float (&f)[8]) { u32x4 r; r.x = pk2(f[0], f[1]); r.y = pk2(f[2], f[3]); r.z = pk2(f[4], f[5]); r.w = pk2(f[6], f[7]); return r; }
struct Raw16 { u32x4 z0, z1, m0, m1, n0, n1; };
__device__ __forceinline__ Raw16 raw16(const bf16_t* Z, int row, int offm, int offn, int col) {
    const bf16_t* p = Z + (size_t)row * ZLD + ZC_RW + col;
    Raw16 r; r.z0 = *(const u32x4*)p; r.z1 = *(const u32x4*)(p + 8);
    r.m0 = *(const u32x4*)(p + offm); r.m1 = *(const u32x4*)(p + offm + 8);
    r.n0 = *(const u32x4*)(p + offn); r.n1 = *(const u32x4*)(p + offn + 8);
    return r;
}
__device__ __forceinline__ void shifted16(const Raw16& r_, bool bnd, bool hasp, bool hasn, const LAS float* mu16, float (&o)[16]) {
    float z[16], zm[16], zn[16];
    Raw16 r = r_; const u32x4 zero = (u32x4){0u, 0u, 0u, 0u};
    if (bnd) { if (!hasp) { r.m0 = zero; r.m1 = zero; } if (!hasn) { r.n0 = zero; r.n1 = zero; } }
    { float t[8]; unpack8(r.z0, t);
#pragma unroll
      for (int j = 0; j < 8; ++j) z[j] = t[j];
      unpack8(r.z1, t);
#pragma unroll
      for (int j = 0; j < 8; ++j) z[8 + j] = t[j];
      unpack8(r.m0, t);
#pragma unroll
      for (int j = 0; j < 8; ++j) zm[j] = t[j];
      unpack8(r.m1, t);
#pragma unroll
      for (int j = 0; j < 8; ++j) zm[8 + j] = t[j];
      unpack8(r.n0, t);
#pragma unroll
      for (int j = 0; j < 8; ++j) zn[j] = t[j];
      unpack8(r.n1, t);
#pragma unroll
      for (int j = 0; j < 8; ++j) zn[8 + j] = t[j]; }
#pragma unroll
    for (int q = 0; q < 4; ++q) { const f32x4 m = *(const LAS f32x4*)(mu16 + 4 * q);
#pragma unroll
        for (int e = 0; e < 4; ++e) { const int j = 4 * q + e; o[j] = z[j] + m[e] * (0.5f * (zm[j] + zn[j]) - z[j]); } }
}
struct RawC { u32x4 z0, m0, n0, z1, m1, n1; };
__device__ __forceinline__ RawC rawc(const bf16_t* p0, int offm0, int offn1) {
    RawC r; r.z0 = *(const u32x4*)p0; r.m0 = *(const u32x4*)(p0 + offm0); r.n0 = *(const u32x4*)(p0 + ZLD);
    const bf16_t* p1 = p0 + 8 * ZLD; r.z1 = *(const u32x4*)p1; r.m1 = *(const u32x4*)(p1 - ZLD); r.n1 = *(const u32x4*)(p1 + offn1);
    return r;
}
__device__ __forceinline__ void shiftedc(const RawC& r_, bool bnd, bool hasp0, bool hasn1, const LAS float* mu8, float (&o0)[8], float (&o1)[8]) {
    RawC r = r_; const u32x4 zero = (u32x4){0u, 0u, 0u, 0u};
    if (bnd) { if (!hasp0) r.m0 = zero; if (!hasn1) r.n1 = zero; }
    const f32x4 mA = *(const LAS f32x4*)mu8, mB = *(const LAS f32x4*)(mu8 + 4);
    float z[8], zm[8], zn[8];
    unpack8(r.z0, z); unpack8(r.m0, zm); unpack8(r.n0, zn);
#pragma unroll
    for (int j = 0; j < 8; ++j) { const float mm = j < 4 ? mA[j] : mB[j - 4]; o0[j] = z[j] + mm * (0.5f * (zm[j] + zn[j]) - z[j]); }
    unpack8(r.z1, z); unpack8(r.m1, zm); unpack8(r.n1, zn);
#pragma unroll
    for (int j = 0; j < 8; ++j) { const float mm = j < 4 ? mA[j] : mB[j - 4]; o1[j] = z[j] + mm * (0.5f * (zm[j] + zn[j]) - z[j]); }
}
__device__ __forceinline__ void store16(bf16_t* dst, const float (&f)[16]) {
    u32x4 a, b; a.x = pk2(f[0], f[1]); a.y = pk2(f[2], f[3]); a.z = pk2(f[4], f[5]); a.w = pk2(f[6], f[7]); b.x = pk2(f[8], f[9]); b.y = pk2(f[10], f[11]); b.z = pk2(f[12], f[13]); b.w = pk2(f[14], f[15]);
    *(u32x4*)dst = a; *(u32x4*)(dst + 8) = b;
}
__device__ __forceinline__ void phase_prep(int l) {
    asm volatile("" : "+s"(l)); Frame F = make_frame();
    const int tid = F.tid, lane = F.lane, w = F.wave, tok = lane & 15, cq = lane >> 4;
    const bf16_t* Z = (const bf16_t*)(F.ws + WS_Z);
    const float* mu = F.inp(IN_SHMU) + l * RWC;
    float* BON = (float*)(F.ws + WS_BONUS);
    for (int unit = F.bid; unit < 256; unit += F.G) {
        const int h = (unit >> 3) & 7, rng = (unit & 7) + 8 * (unit >> 6);
        __syncthreads();
#pragma unroll 1
        for (int o = 0; o < 6; ++o) {
            const float* src = o < 2 ? F.inp(IN_WUP) + (size_t)(l * 2 + o) * 64 * DH : (o < 4 ? F.inp(IN_AUP) + (size_t)(l * 2 + (o - 2)) * 64 * DH : F.inp(IN_GUP) + (size_t)l * 128 * DH + (size_t)(o - 4) * 64 * DH);
            const int stride = o < 4 ? PW_S64 : PW_S128, off = o < 4 ? o * 64 * PW_S64 : PW_G + 128 * (o - 4);
            const int c = tid & 63, k0 = tid >> 6, rr = 16 * ((c >> 2) & 3) + 4 * (c >> 4) + (c & 3);
            float t8[8];
#pragma unroll
            for (int i = 0; i < 8; ++i) t8[i] = src[(size_t)(k0 + 8 * i) * DH + 64 * h + c];
#pragma unroll
            for (int i = 0; i < 8; ++i) *(LAS unsigned short*)(F.lds + off + rr * stride + 2 * (k0 + 8 * i)) = (unsigned short)f2bf(t8[i]);
        }
        {
            LAS float* ctab = (LAS float*)(F.lds + LC_RED);
            for (int i = tid; i < 640 + 384; i += 512) {
                float v;
                if (i < 640) { const int a = i >> 6, c = 64 * h + (i & 63);
                    v = a == 0 ? F.inp(IN_KK)[l * DH + c] : a == 1 ? F.inp(IN_KA)[l * DH + c] : a == 2 ? F.inp(IN_RK)[l * DH + c] : a == 3 ? F.inp(IN_W0)[(l * 2 + 0) * DH + c] : a == 4 ? F.inp(IN_W0)[(l * 2 + 1) * DH + c]
                      : a == 5 ? F.inp(IN_A0)[(l * 2 + 0) * DH + c] : a == 6 ? F.inp(IN_A0)[(l * 2 + 1) * DH + c] : a == 7 ? mu[c] : a == 8 ? mu[512 + c] : mu[1024 + c]; }
                else v = mu[1536 + (i - 640)];
                ctab[i] = v; }
        }
        __syncthreads();
        const LAS float* ctab = (const LAS float*)(F.lds + LC_RED);
#pragma unroll 1
        for (int ti = 0; ti < 9; ++ti) {
            const int row0 = rng * 1152 + ti * 128;
            const bool isctx = row0 < NCTX; const int T = isctx ? CTXL : SEQ; const int t0 = isctx ? (row0 & (CTXL - 1)) : ((row0 - NCTX) & (SEQ - 1));
            const int tq_ = 16 * w + tok, rowq_ = row0 + tq_, tsq_ = t0 + tq_; const bool hpq_ = tsq_ > 0, hnq_ = tsq_ < T - 1; const int cbq_ = 64 * h + 16 * cq;
            const int offm_ = hpq_ ? -ZLD : 0, offn_ = hnq_ ? ZLD : 0; const bool bnd_ = __builtin_amdgcn_readfirstlane((int)((w == 0 && t0 == 0) || (w == 7 && t0 + 128 == T))) != 0;
            const int p8_ = lane & 7, tA0_ = 16 * w + (lane >> 3), tA1_ = tA0_ + 8;
            const bool hpA0_ = t0 + tA0_ > 0, hnA1_ = t0 + tA1_ < T - 1;
            const int offmA0_ = hpA0_ ? -ZLD : 0, offnA1_ = hnA1_ ? ZLD : 0;
            const bf16_t* zrA0_ = Z + (size_t)(row0 + tA0_) * ZLD + ZC_RW + 1536 + 8 * p8_; const bf16_t* zrA1_ = zrA0_ + 8 * ZLD; const u32x4 zero4 = (u32x4){0u, 0u, 0u, 0u};
            u32x4 b0c, b0m, b0n, b1c, b1m, b1n, b2c, b2m, b2n, b3c, b3m, b3n, b4c, b4m, b4n, b5c, b5m, b5n;
#define ACT_LD(IT, B) { const bf16_t* zp = (((IT) & 1) ? zrA1_ : zrA0_) + 64 * ((IT) >> 1); B##c = *(const u32x4*)zp; \
                B##m = *(const u32x4*)(zp + (((IT) & 1) ? -ZLD : offmA0_)); B##n = *(const u32x4*)(zp + (((IT) & 1) ? offnA1_ : ZLD)); }
#define ACT_CP(IT, B, ACTEXPR) { const int g = 8 * ((IT) >> 1) + p8_; \
                const f32x4 mA = *(const LAS f32x4*)(ctab + 640 + 8 * g), mB = *(const LAS f32x4*)(ctab + 640 + 8 * g + 4); \
                if (bnd_) { if (((IT) & 1) == 0 && !hpA0_) B##m = zero4; if (((IT) & 1) == 1 && !hnA1_) B##n = zero4; } \
                float c8[8], m8[8], n8[8], o8[8]; unpack8(B##c, c8); unpack8(B##m, m8); unpack8(B##n, n8); \
                _Pragma("unroll") for (int j = 0; j < 8; ++j) { const float mm = j < 4 ? mA[j] : mB[j - 4]; const float zs = c8[j] + mm * (0.5f * (m8[j] + n8[j]) - c8[j]); o8[j] = ACTEXPR; } \
                *(LAS u32x4*)(F.lds + PA_OFF + (((IT) & 1) ? tA1_ : tA0_) * PA_STRIDE + 16 * g) = pack8(o8); }
#define ACT_FENCE asm volatile("" ::: "memory");
            ACT_LD(0, b0) ACT_LD(1, b1) ACT_LD(2, b2) ACT_LD(3, b3) ACT_LD(4, b4) ACT_LD(5, b5) ACT_FENCE
            ACT_CP(0, b0, tanh_fast(zs)) ACT_CP(1, b1, tanh_fast(zs)) ACT_FENCE ACT_LD(6, b0) ACT_LD(7, b1) ACT_FENCE
            ACT_CP(2, b2, tanh_fast(zs)) ACT_CP(3, b3, tanh_fast(zs)) ACT_FENCE ACT_LD(8, b2) ACT_LD(9, b3) ACT_FENCE
            ACT_CP(4, b4, zs) ACT_CP(5, b5, zs) ACT_FENCE ACT_LD(10, b4) ACT_LD(11, b5) ACT_FENCE
            ACT_CP(6, b0, zs) ACT_CP(7, b1, zs) ACT_FENCE
            const bf16_t* zrw_ = Z + (size_t)(row0 + tA0_) * ZLD + ZC_RW + 64 * h + 8 * p8_;
            const RawC rawV = rawc(zrw_ + 1024, offmA0_, offnA1_), rawR = rawc(zrw_, offmA0_, offnA1_), rawK = rawc(zrw_ + 512, offmA0_, offnA1_);
            ACT_FENCE
            ACT_CP(8, b2, sigmoidf_(zs)) ACT_CP(9, b3, sigmoidf_(zs)) ACT_CP(10, b4, sigmoidf_(zs)) ACT_CP(11, b5, sigmoidf_(zs))
#undef ACT_LD
#undef ACT_CP
#undef ACT_FENCE
            const int t = 16 * w + tok, row = row0 + t, ts = t0 + t; const bool hasp = ts > 0, hasn = ts < T - 1;
            const int cb = 64 * h + 16 * cq;
            f32x4 acc[5][4];
#pragma unroll
            for (int o = 0; o < 5; ++o)
#pragma unroll
                for (int nt = 0; nt < 4; ++nt) acc[o][nt] = (f32x4){0.f, 0.f, 0.f, 0.f};
            const LAS unsigned char* actp = F.lds + PA_OFF + (16 * w + tok) * PA_STRIDE + 16 * cq;
#pragma unroll
            for (int o = 0; o < 4; ++o)
#pragma unroll
                for (int ks = 0; ks < 2; ++ks) {
                    const bf16x8 bfrag = *(const LAS bf16x8*)(actp + (64 * o + 32 * ks) * 2);
#pragma unroll
                    for (int nt = 0; nt < 4; ++nt) { const bf16x8 afrag = *(const LAS bf16x8*)(F.lds + o * 64 * PW_S64 + (16 * nt + tok) * PW_S64 + (32 * ks + 8 * cq) * 2);
                        acc[o][nt] = __builtin_amdgcn_mfma_f32_16x16x32_bf16(afrag, bfrag, acc[o][nt], 0, 0, 0); }
                }
#pragma unroll
            for (int ks = 0; ks < 4; ++ks) {
                const bf16x8 bfrag = *(const LAS bf16x8*)(actp + (256 + 32 * ks) * 2);
#pragma unroll
                for (int nt = 0; nt < 4; ++nt) { const bf16x8 afrag = *(const LAS bf16x8*)(F.lds + PW_G + (16 * nt + tok) * PW_S128 + (32 * ks + 8 * cq) * 2);
                    acc[4][nt] = __builtin_amdgcn_mfma_f32_16x16x32_bf16(afrag, bfrag, acc[4][nt], 0, 0, 0); }
            }
            float rv[16], kv[16];
            LAS unsigned char* stw = F.lds + PA_OFF + (16 * w) * PA_STRIDE; const int st_wr = tok * 144 + 32 * cq, st_rd = (lane >> 3) * 144 + 16 * (lane & 7);
            const size_t so_rd = ((size_t)h * NT + row0 + 16 * w + (lane >> 3)) * 64 + 8 * (lane & 7);
#define STAGE16(slot, f) { const u32x4 a_ = pack8((const float (&)[8])(f)[0]), b_ = pack8((const float (&)[8])(f)[8]); *(LAS u32x4*)(stw + (slot) * 2304 + st_wr) = a_; *(LAS u32x4*)(stw + (slot) * 2304 + st_wr + 16) = b_; }
#define STAGE_OUT(slot, arr) { const u32x4 v0_ = *(const LAS u32x4*)(stw + (slot) * 2304 + st_rd), v1_ = *(const LAS u32x4*)(stw + (slot) * 2304 + 8 * 144 + st_rd); \
                *(u32x4*)((arr) + so_rd) = v0_; *(u32x4*)((arr) + so_rd + 512) = v1_; }
            { float v0[8], v1[8]; shiftedc(rawV, bnd_, hpA0_, hnA1_, ctab + 9 * 64 + 8 * p8_, v0, v1);
              *(u32x4*)((bf16_t*)(F.ws + WS_V) + so_rd) = pack8(v0); *(u32x4*)((bf16_t*)(F.ws + WS_V) + so_rd + 512) = pack8(v1); }
            {
                const int sw_ = (lane >> 3) * 272 + 32 * p8_, sr_ = tok * 272 + 64 * cq;
                float a0[8], a1[8];
                shiftedc(rawK, bnd_, hpA0_, hnA1_, ctab + 8 * 64 + 8 * p8_, a0, a1);
                *(LAS f32x4*)(stw + sw_) = (f32x4){a0[0], a0[1], a0[2], a0[3]}; *(LAS f32x4*)(stw + sw_ + 16) = (f32x4){a0[4], a0[5], a0[6], a0[7]};
                *(LAS f32x4*)(stw + 8 * 272 + sw_) = (f32x4){a1[0], a1[1], a1[2], a1[3]}; *(LAS f32x4*)(stw + 8 * 272 + sw_ + 16) = (f32x4){a1[4], a1[5], a1[6], a1[7]};
                shiftedc(rawR, bnd_, hpA0_, hnA1_, ctab + 7 * 64 + 8 * p8_, a0, a1);
                *(LAS f32x4*)(stw + 4352 + sw_) = (f32x4){a0[0], a0[1], a0[2], a0[3]}; *(LAS f32x4*)(stw + 4352 + sw_ + 16) = (f32x4){a0[4], a0[5], a0[6], a0[7]};
                *(LAS f32x4*)(stw + 4352 + 8 * 272 + sw_) = (f32x4){a1[0], a1[1], a1[2], a1[3]}; *(LAS f32x4*)(stw + 4352 + 8 * 272 + sw_ + 16) = (f32x4){a1[4], a1[5], a1[6], a1[7]};
#pragma unroll
                for (int q = 0; q < 4; ++q) { const f32x4 kq = *(const LAS f32x4*)(stw + sr_ + 16 * q), rq = *(const LAS f32x4*)(stw + 4352 + sr_ + 16 * q);
#pragma unroll
                    for (int e = 0; e < 4; ++e) { kv[4 * q + e] = kq[e]; rv[4 * q + e] = rq[e]; } }
            }
            float kkv[16]; float ss = 0.f;
#pragma unroll
            for (int q = 0; q < 4; ++q) { const f32x4 kw = *(const LAS f32x4*)(ctab + 0 * 64 + 16 * cq + 4 * q);
#pragma unroll
                for (int e = 0; e < 4; ++e) { const float ku = kv[4 * q + e] * kw[e]; kkv[4 * q + e] = ku; ss += ku * ku; } }
            ss += __shfl_xor(ss, 16); ss += __shfl_xor(ss, 32);
            const float rs = rsqrtf(ss + 1e-12f);
#pragma unroll
            for (int j = 0; j < 16; ++j) kkv[j] *= rs;
            { float gv[16];
#pragma unroll
              for (int j = 0; j < 16; ++j) gv[j] = acc[4][j >> 2][j & 3];
              STAGE16(1, gv) }
            STAGE_OUT(1, (bf16_t*)((unsigned char*)F.out + DO_G))
            float bon = 0.f;
#pragma unroll
            for (int d = 0; d < 2; ++d) {
                float* gep = (float*)(F.ws + (d ? WS_GE1 : WS_GE0)) + ((size_t)h * (NT / 16) + (row >> 4)) * 64 + 16 * cq;
#pragma unroll
                for (int qq = 0; qq < 2; ++qq) {
                    float ktv[8], btv[8], kdtv[8], rtv[8], gev[8];
#pragma unroll
                    for (int q2 = 0; q2 < 2; ++q2) {
                        const int q = 2 * qq + q2;
                        const f32x4 w0 = *(const LAS f32x4*)(ctab + (3 + d) * 64 + 16 * cq + 4 * q), a0 = *(const LAS f32x4*)(ctab + (5 + d) * 64 + 16 * cq + 4 * q);
                        const f32x4 ka = *(const LAS f32x4*)(ctab + 1 * 64 + 16 * cq + 4 * q), rk = *(const LAS f32x4*)(ctab + 2 * 64 + 16 * cq + 4 * q);
#pragma unroll
                        for (int e = 0; e < 4; ++e) { const int j = 4 * q + e, j8 = 4 * q2 + e;
                            const float lw = -0.6065306597126334f * sigmoidf_(w0[e] + acc[d][q][e]);
                            const float a = sigmoidf_(a0[e] + acc[2 + d][q][e]);
                            const float kd = kv[j] * (1.0f + (a - 1.0f) * ka[e]);
                            bon += rv[j] * kd * rk[e];
                            float ci = lw;
                            if (d == 0) { ci += __int_as_float(__builtin_amdgcn_update_dpp(0, __float_as_int(ci), 0x111, 0xf, 0xf, true)); ci += __int_as_float(__builtin_amdgcn_update_dpp(0, __float_as_int(ci), 0x112, 0xf, 0xf, true));
                                          ci += __int_as_float(__builtin_amdgcn_update_dpp(0, __float_as_int(ci), 0x114, 0xf, 0xf, true)); ci += __int_as_float(__builtin_amdgcn_update_dpp(0, __float_as_int(ci), 0x118, 0xf, 0xf, true)); }
                            else        { ci += __int_as_float(__builtin_amdgcn_update_dpp(0, __float_as_int(ci), 0x101, 0xf, 0xf, true)); ci += __int_as_float(__builtin_amdgcn_update_dpp(0, __float_as_int(ci), 0x102, 0xf, 0xf, true));
                                          ci += __int_as_float(__builtin_amdgcn_update_dpp(0, __float_as_int(ci), 0x104, 0xf, 0xf, true)); ci += __int_as_float(__builtin_amdgcn_update_dpp(0, __float_as_int(ci), 0x108, 0xf, 0xf, true)); }
                            const float gam = fexp(ci), ig = __builtin_amdgcn_rcpf(gam);
                            const float gprev = d == 0 ? __int_as_float(__builtin_amdgcn_update_dpp(0x3f800000, __float_as_int(gam), 0x111, 0xf, 0xf, false)) : __int_as_float(__builtin_amdgcn_update_dpp(0x3f800000, __float_as_int(gam), 0x101, 0xf, 0xf, false));
                            ktv[j8] = gprev * kkv[j]; btv[j8] = kkv[j] * a * ig; kdtv[j8] = kd * ig; rtv[j8] = gam * rv[j]; gev[j8] = gam; }
                    }
                    *(LAS u32x4*)(stw + 0 * 2304 + st_wr + 16 * qq) = pack8(ktv); *(LAS u32x4*)(stw + 1 * 2304 + st_wr + 16 * qq) = pack8(btv);
                    *(LAS u32x4*)(stw + 2 * 2304 + st_wr + 16 * qq) = pack8(kdtv); *(LAS u32x4*)(stw + 3 * 2304 + st_wr + 16 * qq) = pack8(rtv);
                    if (tok == (d ? 0 : 15)) {
                        *(f32x4*)(gep + 8 * qq) = (f32x4){gev[0], gev[1], gev[2], gev[3]}; *(f32x4*)(gep + 8 * qq + 4) = (f32x4){gev[4], gev[5], gev[6], gev[7]};
                    }
                }
                STAGE_OUT(0, (bf16_t*)(F.ws + (d ? WS_KT1 : WS_KT0))) STAGE_OUT(1, (bf16_t*)(F.ws + (d ? WS_BT1 : WS_BT0)))
                STAGE_OUT(2, (bf16_t*)(F.ws + (d ? WS_KDT1 : WS_KDT0))) STAGE_OUT(3, (bf16_t*)(F.ws + (d ? WS_RT1 : WS_RT0)))
            }
#undef STAGE16
#undef STAGE_OUT
            bon += __shfl_xor(bon, 16); bon += __shfl_xor(bon, 32);
            if (cq == 0) BON[(size_t)row * 8 + h] = bon;
        }
    }
    __syncthreads();
}

__device__ __forceinline__ int scan_row(int b, int dir, int i) {
    if (i < CTXL) return b * CTXL + (dir ? CTXL - 1 - i : i);
    const int j = i - CTXL; return NCTX + b * SEQ + (dir ? SEQ - 1 - j : j);
}
template <int CTRL> __device__ __forceinline__ float dpp_add(float x) {
    return x + __int_as_float(__builtin_amdgcn_update_dpp(0, __float_as_int(x), CTRL, 0xf, 0xf, true));
}
typedef short bf16x4 __attribute__((ext_vector_type(4)));
__device__ __forceinline__ bf16x4 cvt4(const f32x4 v) { u32x2 r; r.x = pk2(v[0], v[1]); r.y = pk2(v[2], v[3]); return __builtin_bit_cast(bf16x4, r); }
__device__ __forceinline__ f32x4 unpk4(const bf16x4 p) { const u32x2 r = __builtin_bit_cast(u32x2, p); return (f32x4){bf2f(r.x & 0xffffu), bf2f(r.x >> 16), bf2f(r.y & 0xffffu), bf2f(r.y >> 16)}; }
#define MFMA16(a, b, c) __builtin_amdgcn_mfma_f32_16x16x16bf16_1k(a, b, c, 0, 0, 0)
constexpr int CS_RS = 144, CS_ARR = 32 * CS_RS;
constexpr int CS_TS = 40, CS_TBLK = 64 * CS_TS;
constexpr int CS_KDTT = 4 * CS_ARR, CS_BTT = CS_KDTT + 2 * CS_TBLK, CS_VT = CS_BTT + 2 * CS_TBLK, CS_GE = CS_VT + 2 * CS_TBLK, CS_PB = CS_GE + 512;
constexpr int CS_GB0 = 3 * CS_PB;
constexpr int CS_GS = 40, CS_GMAT = 16 * CS_GS, CS_ABT = 4 * CS_GMAT, CS_GBLK = 3840, CS_GB = 2 * CS_GBLK;
constexpr int CS_YB = CS_GB0 + 2 * CS_GB;
static_assert(CS_YB + 2 * 8192 <= LDS_CTL, "chunked scan LDS map");
template <int SDBG> __device__ __forceinline__ void phase_scan_mfma(int l) {
    asm volatile("" : "+s"(l)); Frame F = make_frame();
    const int lane = F.lane, wave = F.wave, c16 = lane & 15, g4 = lane >> 4;
    const bool is_state = wave < 4;
    LAS unsigned char* lds = F.lds; LAS float* YB = (LAS float*)(F.lds + CS_YB);
    constexpr int NCH = (CTXL + SEQ) / 32;
    for (int task = F.bid; task < NBATCH * 8 * 2; task += F.G) {
        const int dir = task & 1, h = (task >> 1) & 7, b = task >> 4;
        const unsigned char* wsb = F.ws;
        const unsigned oKT = (unsigned)(dir ? WS_KT1 : WS_KT0), oBT = (unsigned)(dir ? WS_BT1 : WS_BT0), oKDT = (unsigned)(dir ? WS_KDT1 : WS_KDT0), oRT = (unsigned)(dir ? WS_RT1 : WS_RT0);
        const unsigned oGE = (unsigned)(dir ? WS_GE1 : WS_GE0) + (unsigned)h * (NT / 16) * 256u, oY = (unsigned)(dir ? WS_Y1 : WS_Y0);
        u32x4 stg[10]; f32x4 gstg;
#define CS_LOAD(cc) do { _Pragma("unroll") for (int jj = 0; jj < 10; ++jj) { const int a = jj >> 1, s_ = 16 * hq + 2 * (((lane >> 2) & 1) | ((lane >> 4) << 1)) + ((lane >> 3) & 1), o = (lane & 3) + 4 * (jj & 1); \
            const unsigned ao = a == 0 ? oKT : a == 1 ? oRT : a == 2 ? oKDT : a == 3 ? oBT : (unsigned)WS_V; \
            stg[jj] = *(const u32x4*)(wsb + (ao + ((unsigned)(h * NT + scan_row(b, dir, (cc) * 32 + s_)) * 128u + 16u * o))); } \
            gstg = *(const f32x4*)(wsb + (oGE + (unsigned)(scan_row(b, dir, (cc) * 32 + 16 * ((lane >> 4) & 1)) >> 4) * 256u + 16u * (lane & 15))); } while (0)
#define CS_STORE(pbi) do { LAS unsigned char* pbs = lds + (pbi) * CS_PB; _Pragma("unroll") for (int jj = 0; jj < 10; ++jj) { const int a = jj >> 1, s_ = 16 * hq + 2 * (((lane >> 2) & 1) | ((lane >> 4) << 1)) + ((lane >> 3) & 1), o = (lane & 3) + 4 * (jj & 1); \
            if (a < 4) *(LAS u32x4*)(pbs + a * CS_ARR + s_ * CS_RS + 16 * o) = stg[jj]; \
            if (a >= 2) {        \
                LAS unsigned char* tb = pbs + (a == 2 ? CS_KDTT : (a == 3 ? CS_BTT : CS_VT)) + (s_ >> 4) * CS_TBLK + (8 * o + (s_ & 1)) * CS_TS + 2 * (s_ & 14); \
                const unsigned sel = (s_ & 1) ? 0x03020706u : 0x05040100u; \
                _Pragma("unroll") for (int e = 0; e < 4; ++e) { const unsigned pw = (unsigned)__builtin_amdgcn_update_dpp(0, (int)stg[jj][e], 0x128, 0xf, 0xf, false); \
                    *(LAS unsigned*)(tb + (2 * e) * CS_TS) = __builtin_amdgcn_perm(pw, stg[jj][e], sel); } } } \
            if (hq == 0 && lane < 32) *(LAS f32x4*)(pbs + CS_GE + (lane >> 4) * 256 + 16 * (lane & 15)) = gstg; } while (0)
#define CS_GRAM(pbi, gbi, bq) do { const LAS unsigned char* pbg = lds + (pbi) * CS_PB; LAS unsigned char* gb = lds + CS_GB0 + (gbi) * CS_GB + (bq) * CS_GBLK; \
            const int rowoff = (16 * (bq) + c16) * CS_RS + 16 * g4; \
            float abv[4]; \
            _Pragma("unroll") for (int mat = 0; mat < 4; ++mat) { f32x4 acc = (f32x4){0.f, 0.f, 0.f, 0.f}; \
                _Pragma("unroll") for (int ks = 0; ks < 2; ++ks) { const bf16x8 av = *(const LAS bf16x8*)(pbg + (mat < 2 ? 0 : 1) * CS_ARR + rowoff + 64 * ks); \
                    const bf16x8 bv = *(const LAS bf16x8*)(pbg + ((mat & 1) ? 3 : 2) * CS_ARR + rowoff + 64 * ks); acc = __builtin_amdgcn_mfma_f32_16x16x32_bf16(av, bv, acc, 0, 0, 0); } \
                _Pragma("unroll") for (int rg = 0; rg < 4; ++rg) { const int t = 4 * g4 + rg; const bool keep = mat < 2 ? (c16 < t) : (c16 <= t); const float val = keep ? acc[rg] : 0.f; \
                    if (mat == 1) abv[rg] = val; \
                    else *(LAS unsigned short*)(gb + (mat == 0 ? 0 : (mat == 2 ? 1 : 2)) * CS_GMAT + t * CS_GS + 2 * c16) = (unsigned short)f2bf(val); } } \
            { float colv[16];        \
              _Pragma("unroll") for (int t = 0; t < 16; ++t) colv[t] = (t == c16) ? 1.f : 0.f; \
              _Pragma("unroll") for (int s2 = 0; s2 < 15; ++s2) {        \
                  _Pragma("unroll") for (int t = s2 + 1; t < 16; ++t) colv[t] = fmaf(-__int_as_float(__builtin_amdgcn_readlane(__float_as_int(abv[t & 3]), 16 * (t >> 2) + s2)), colv[s2], colv[t]); } \
              if (lane < 16) { _Pragma("unroll") for (int t = 0; t < 16; ++t) *(LAS unsigned short*)(gb + 3 * CS_GMAT + t * CS_GS + 2 * c16) = (unsigned short)f2bf(colv[t]); } } } while (0)
#define CS_FLUSH(cc) do { _Pragma("unroll") for (int p_ = 0; p_ < 2; ++p_) { const int s_ = (lane >> 3) + 8 * p_ + 16 * hq, r8 = 8 * (lane & 7); const LAS float* yp = YB + ((cc) & 1) * 2048 + s_ * 64 + r8; \
            const f32x4 ya = *(const LAS f32x4*)yp, yb2 = *(const LAS f32x4*)(yp + 4); u32x4 wv; wv.x = pk2(ya[0], ya[1]); wv.y = pk2(ya[2], ya[3]); wv.z = pk2(yb2[0], yb2[1]); wv.w = pk2(yb2[2], yb2[3]); \
            *(u32x4*)(const_cast<unsigned char*>(wsb) + (oY + (unsigned)scan_row(b, dir, (cc) * 32 + s_) * 1024u + 128u * h + 2u * r8)) = wv; } } while (0)
#define CS_STATE(c, P0) do { \
                const int m = wave; \
_Pragma("unroll") \
                for (int blk = 0; blk < 2; ++blk) { \
                    const LAS unsigned char* pb = lds + (P0) * CS_PB; const LAS unsigned char* gb = lds + CS_GB0 + ((c) & 1) * CS_GB + blk * CS_GBLK; \
                    const LAS unsigned char* rowb = pb + (16 * blk + c16) * CS_RS + 8 * g4; \
                    bf16x4 ak[4], ar[4], a1[4], a2[4]; f32x4 ge[4]; \
_Pragma("unroll") \
                    for (int j = 0; j < 4; ++j) { ak[j] = *(const LAS bf16x4*)(rowb + 32 * j); ar[j] = *(const LAS bf16x4*)(rowb + CS_ARR + 32 * j); \
                        a1[j] = *(const LAS bf16x4*)(pb + CS_KDTT + blk * CS_TBLK + (16 * j + c16) * CS_TS + 8 * g4); a2[j] = *(const LAS bf16x4*)(pb + CS_BTT + blk * CS_TBLK + (16 * j + c16) * CS_TS + 8 * g4); \
                        ge[j] = *(const LAS f32x4*)(pb + CS_GE + blk * 256 + (16 * j + 4 * g4) * 4); } \
                    const bf16x4 vt = *(const LAS bf16x4*)(pb + CS_VT + blk * CS_TBLK + (16 * m + c16) * CS_TS + 8 * g4); \
                    const bf16x4 makt = *(const LAS bf16x4*)(gb + c16 * CS_GS + 8 * g4), mmkt = *(const LAS bf16x4*)(gb + CS_GMAT + c16 * CS_GS + 8 * g4); \
                    const bf16x4 mmbt = *(const LAS bf16x4*)(gb + 2 * CS_GMAT + c16 * CS_GS + 8 * g4), mtt = *(const LAS bf16x4*)(gb + 3 * CS_GMAT + c16 * CS_GS + 8 * g4); \
                    asm volatile("s_waitcnt lgkmcnt(0)" ::: "memory"); \
                    bf16x4 hi[4]; \
_Pragma("unroll") \
                    for (int j = 0; j < 4; ++j) hi[j] = cvt4(H[j]); \
                    const f32x4 z4 = (f32x4){0.f, 0.f, 0.f, 0.f}; \
                    f32x4 wa = MFMA16(ak[0], hi[0], z4), wb = MFMA16(ak[2], hi[2], z4), ya = MFMA16(ar[0], hi[0], z4), yb_ = MFMA16(ar[2], hi[2], z4); \
                    wa = MFMA16(ak[1], hi[1], wa); wb = MFMA16(ak[3], hi[3], wb); ya = MFMA16(ar[1], hi[1], ya); yb_ = MFMA16(ar[3], hi[3], yb_); \
                    if (SCAN_HILO) { bf16x4 lo[4]; _Pragma("unroll") for (int j = 0; j < 4; ++j) lo[j] = cvt4(H[j] - unpk4(hi[j])); \
                        wa = MFMA16(ak[0], lo[0], wa); wb = MFMA16(ak[2], lo[2], wb); ya = MFMA16(ar[0], lo[0], ya); yb_ = MFMA16(ar[2], lo[2], yb_); \
                        wa = MFMA16(ak[1], lo[1], wa); wb = MFMA16(ak[3], lo[3], wb); ya = MFMA16(ar[1], lo[1], ya); yb_ = MFMA16(ar[3], lo[3], yb_); } \
                    wb = MFMA16(makt, vt, wb); \
                    ya = MFMA16(mmkt, vt, ya); \
                    const f32x4 wt = wa + wb; \
                    const f32x4 ut = MFMA16(mtt, cvt4(wt), z4); \
                    const bf16x4 utn = cvt4(-ut); \
                    yb_ = MFMA16(mmbt, utn, yb_); \
_Pragma("unroll") \
                    for (int j = 0; j < 4; ++j) { H[j] = MFMA16(a1[j], vt, H[j]); H[j] = MFMA16(a2[j], utn, H[j]); H[j] = H[j] * ge[j]; } \
                    const f32x4 yt = ya + yb_; \
_Pragma("unroll") \
                    for (int rg = 0; rg < 4; ++rg) YB[((c) & 1) * 2048 + (16 * blk + 4 * g4 + rg) * 64 + 16 * m + c16] = yt[rg]; \
                } \
            } while (0)
        f32x4 H[4];
#pragma unroll
        for (int j = 0; j < 4; ++j) H[j] = (f32x4){0.f, 0.f, 0.f, 0.f};
        __syncthreads();
        const int hw = wave - 4, hp = hw >> 1, hq = hw & 1;
        if (!is_state) { CS_LOAD(hp); CS_STORE(hp); CS_LOAD(hp + 2); }
        __syncthreads();
        if (!is_state) { if (!(SDBG & 2)) { if (hp == 1) CS_GRAM(0, 0, hq); } }
        __syncthreads();
#define CS_ITER(c, P0, P1, P2) do { \
            if (is_state) { if (!(SDBG & 1)) { CS_STATE(c, P0); } } \
            else if (hp == ((c) & 1)) { CS_STORE(P2); CS_LOAD(((c) + 4 < NCH ? (c) + 4 : NCH - 1)); if (!(SDBG & 4)) { if ((c) > 0) CS_FLUSH((c) - 1); } } \
            else { if (!(SDBG & 2)) { if ((c) + 1 < NCH) CS_GRAM(P1, ((c) + 1) & 1, hq); } } \
            asm volatile("s_waitcnt lgkmcnt(0)" ::: "memory"); __builtin_amdgcn_s_barrier(); asm volatile("" ::: "memory"); } while (0)
        for (int c3 = 0; c3 < NCH; c3 += 3) { CS_ITER(c3, 0, 1, 2); CS_ITER(c3 + 1, 1, 2, 0); CS_ITER(c3 + 2, 2, 0, 1); }
#undef CS_ITER
        if (!(SDBG & 4)) { if (!is_state && hp == 0) CS_FLUSH(NCH - 1); }
#undef CS_LOAD
#undef CS_STATE
#undef CS_STORE
#undef CS_GRAM
#undef CS_FLUSH
    }
    __syncthreads();
}

__device__ __forceinline__ void phase_mix(int l) {
    asm volatile("" : "+s"(l)); Frame F = make_frame();
    const int lane = F.lane, c0 = 8 * lane, hh = lane >> 3;
    const int gw = F.bid * 8 + F.wave, NGW = F.G * 8;
    const bf16_t* Z = (const bf16_t*)(F.ws + WS_Z);
    const float* cw = F.inp(IN_CONVW) + (size_t)l * 3 * DH;
    float cw0[8], cw1[8], cw2[8], lgv[8], lbv[8];
#pragma unroll
    for (int j = 0; j < 8; ++j) { cw0[j] = cw[c0 + j]; cw1[j] = cw[DH + c0 + j]; cw2[j] = cw[2 * DH + c0 + j]; lgv[j] = F.inp(IN_LNG)[l * DH + c0 + j]; lbv[j] = F.inp(IN_LNB)[l * DH + c0 + j]; }
    const bf16_t* Y0 = (const bf16_t*)(F.ws + WS_Y0); const bf16_t* Y1 = (const bf16_t*)(F.ws + WS_Y1); const bf16_t* V = (const bf16_t*)(F.ws + WS_V);
    const bf16_t* Gi = (const bf16_t*)((unsigned char*)F.out + DO_G); const float* BON = (const float*)(F.ws + WS_BONUS);
    bf16_t* UA = (bf16_t*)(F.ws + WS_UA); bf16_t* UB = (bf16_t*)(F.ws + WS_UB);
    for (int row = (l == DEPTH - 1 ? NCTX : 0) + gw; row < NT; row += NGW) {
        int delta; bool hasp, hasn;
        if (row < NCTX) { const int t = row & (CTXL - 1); delta = 1; hasp = t > 0; hasn = t < CTXL - 1; }
        else { const int sq = (row - NCTX) & (SEQ - 1);
            if (c0 < 256) { const int gc = sq & 63; delta = 1; hasp = gc > 0; hasn = gc < 63; }
            else { const int gr = sq >> 6; delta = 64; hasp = gr > 0; hasn = gr < 31; } }
        const bf16_t* zr = Z + (size_t)row * ZLD;
        const u32x4 zero = (u32x4){0u, 0u, 0u, 0u};
        const u32x4 bg = *(const u32x4*)(zr + ZC_BG + c0), uc = *(const u32x4*)(zr + ZC_U + c0);
        const u32x4 um_ = hasp ? *(const u32x4*)(zr + ZC_U + c0 - (ptrdiff_t)delta * ZLD) : zero, up_ = hasn ? *(const u32x4*)(zr + ZC_U + c0 + (ptrdiff_t)delta * ZLD) : zero;
        const size_t o = (size_t)row * DH + c0, oh = ((size_t)hh * NT + row) * 64 + (c0 & 63);
        const u32x4 y0p = *(const u32x4*)(Y0 + o), y1p = *(const u32x4*)(Y1 + o), vp = *(const u32x4*)(V + oh), gp = *(const u32x4*)(Gi + oh);
        const float bon = BON[(size_t)row * 8 + hh];
        float fb[8], fu[8], fum[8], fup[8], ua[8];
        unpack8(bg, fb); unpack8(uc, fu); unpack8(um_, fum); unpack8(up_, fup);
#pragma unroll
        for (int j = 0; j < 8; ++j) ua[j] = fb[j] * (fum[j] * cw0[j] + fu[j] * cw1[j] + fup[j] * cw2[j]);
        *(u32x4*)(UA + o) = pack8(ua);
        float ya[8], yb[8], fv[8], fg[8], ub[8]; unpack8(y0p, ya); unpack8(y1p, yb); unpack8(vp, fv); unpack8(gp, fg);
        float sm = 0.f;
#pragma unroll
        for (int j = 0; j < 8; ++j) { ya[j] += yb[j]; sm += ya[j]; }
        sm = dpp_add<0xB1>(sm); sm = dpp_add<0x4E>(sm); sm = dpp_add<0x141>(sm);
        const float mu = sm * (1.0f / 64.0f); float sq2 = 0.f;
#pragma unroll
        for (int j = 0; j < 8; ++j) { ya[j] -= mu; sq2 += ya[j] * ya[j]; }
        sq2 = dpp_add<0xB1>(sq2); sq2 = dpp_add<0x4E>(sq2); sq2 = dpp_add<0x141>(sq2);
        const float rstd = rsqrtf(sq2 * (1.0f / 64.0f) + GN_EPS);
#pragma unroll
        for (int j = 0; j < 8; ++j) ub[j] = (ya[j] * rstd * lgv[j] + lbv[j] + bon * fv[j]) * fg[j];
        *(u32x4*)(UB + o) = pack8(ub);
    }
}

constexpr int N2_STRIDE = 1028;
constexpr int N2_PART = 16 * N2_STRIDE * 4;
constexpr int N2_HIST = N2_PART + 8 * 16 * 48 * 4;
__device__ __forceinline__ void phase_norm2(int l) {
    asm volatile("" : "+s"(l)); Frame F = make_frame();
    const int lane = F.lane, w = F.wave;
    LAS float* HT = (LAS float*)F.lds; LAS float* PART = (LAS float*)(F.lds + N2_PART); LAS int* hist = (LAS int*)(F.lds + N2_HIST);
    const bf16_t* X = (const bf16_t*)(F.ws + WS_X); bf16_t* H = (bf16_t*)((unsigned char*)F.out + DO_H); const bf16_t* Tm = (const bf16_t*)(F.ws + WS_T);
    const float* g2n = F.inp(IN_N2G) + l * D;
    const float* WC = (const float*)(F.ws + WS_WC) + (size_t)l * 1024 * 48; const float* RB = (const float*)(F.ws + WS_RB) + l * 48;
    int* RE = (int*)(F.ws + WS_RE); float* RG = (float*)(F.ws + WS_RG); int* RP = (int*)(F.ws + WS_RP);
    if (F.tid < 32) hist[F.tid] = 0;
    bf16x8 Bhi[4][3], Blo[4][3];
    { const int kg = lane >> 4, cc = lane & 15;
#pragma unroll
      for (int ks = 0; ks < 4; ++ks)
#pragma unroll
          for (int t = 0; t < 3; ++t) { float f[8], r[8];
#pragma unroll
              for (int i = 0; i < 8; ++i) f[i] = WC[(size_t)(128 * w + 32 * ks + 8 * kg + i) * 48 + 16 * t + cc];
              const u32x4 hp = pack8(f); float hb[8]; unpack8(hp, hb);
#pragma unroll
              for (int i = 0; i < 8; ++i) r[i] = f[i] - hb[i];
              Bhi[ks][t] = __builtin_bit_cast(bf16x8, hp); Blo[ks][t] = __builtin_bit_cast(bf16x8, pack8(r)); } }
    __syncthreads();
    u32x2 cxr[2][4], ctr[2][4], nxr[2][4], ntr[2][4];
#define N2_LOADROWS(TILE, XR, TR) { _Pragma("unroll") for (int rr = 0; rr < 2; ++rr) _Pragma("unroll") for (int j = 0; j < 4; ++j) { const size_t o_ = (size_t)((TILE) * 16 + 2 * w + rr) * D + 4 * lane + 256 * j; \
            XR[rr][j] = *(const u32x2*)(X + o_); TR[rr][j] = *(const u32x2*)(Tm + o_); } }
    { const int t0_ = (l == DEPTH - 1 ? NCTX / 16 : 0) + F.bid; if (t0_ < NT / 16) N2_LOADROWS(t0_, cxr, ctr) }
    for (int tile = (l == DEPTH - 1 ? NCTX / 16 : 0) + F.bid; tile < NT / 16; tile += F.G) {
        const int row0 = tile * 16;
        { const int tn_ = tile + F.G < NT / 16 ? tile + F.G : tile; N2_LOADROWS(tn_, nxr, ntr) }
#pragma unroll
        for (int rr = 0; rr < 2; ++rr) {
            const int lr = 2 * w + rr, row = row0 + lr;
            const int mj = row < NCTX ? 16 : ((row - NCTX) >> 11);
            const float* mod = (const float*)(F.ws + WS_MOD) + ((size_t)l * 17 + mj) * NMOD;
            f32x4 v[4]; float ss = 0.f;
#pragma unroll
            for (int j = 0; j < 4; ++j) {
                const int c = 4 * lane + 256 * j;
                { const u32x2 xv_ = cxr[rr][j]; v[j][0] = bf2f(xv_.x & 0xffffu); v[j][1] = bf2f(xv_.x >> 16); v[j][2] = bf2f(xv_.y & 0xffffu); v[j][3] = bf2f(xv_.y >> 16); }
                const u32x2 tv = ctr[rr][j]; const f32x4 g1 = *(const f32x4*)(mod + 2048 + c);
                v[j][0] += g1[0] * bf2f(tv.x & 0xffffu); v[j][1] += g1[1] * bf2f(tv.x >> 16); v[j][2] += g1[2] * bf2f(tv.y & 0xffffu); v[j][3] += g1[3] * bf2f(tv.y >> 16);
                ss += v[j][0] * v[j][0] + v[j][1] * v[j][1] + v[j][2] * v[j][2] + v[j][3] * v[j][3]; }
            const float rs = rsqrtf(wave_sum(ss) * (1.0f / D) + NORM_EPS);
#pragma unroll
            for (int j = 0; j < 4; ++j) {
                const int c = 4 * lane + 256 * j;
                const f32x4 gg = *(const f32x4*)(g2n + c), sh = *(const f32x4*)(mod + 3072 + c), sc = *(const f32x4*)(mod + 4096 + c);
                f32x4 o;
#pragma unroll
                for (int q = 0; q < 4; ++q) o[q] = v[j][q] * rs * gg[q] * (1.0f + sc[q]) + sh[q];
                u32x2 wv; wv.x = pk2(o[0], o[1]); wv.y = pk2(o[2], o[3]);
                *(u32x2*)(H + (size_t)row * D + c) = wv;
                *(LAS f32x4*)(HT + lr * N2_STRIDE + c) = o;
            }
        }
        __syncthreads();
        {
            f32x4 acc[3];
#pragma unroll
            for (int t = 0; t < 3; ++t) acc[t] = (f32x4){0.f, 0.f, 0.f, 0.f};
            const LAS float* ap = HT + (lane & 15) * N2_STRIDE + 128 * w + 8 * (lane >> 4);
#pragma unroll
            for (int ks = 0; ks < 4; ++ks) {
                const f32x4 a0 = *(const LAS f32x4*)(ap + 32 * ks), a1 = *(const LAS f32x4*)(ap + 32 * ks + 4);
                float f[8] = {a0[0], a0[1], a0[2], a0[3], a1[0], a1[1], a1[2], a1[3]}, r[8], hb[8];
                const u32x4 hp = pack8(f); unpack8(hp, hb);
#pragma unroll
                for (int i = 0; i < 8; ++i) r[i] = f[i] - hb[i];
                const bf16x8 ahi = __builtin_bit_cast(bf16x8, hp), alo = __builtin_bit_cast(bf16x8, pack8(r));
#pragma unroll
                for (int t = 0; t < 3; ++t) {
                    acc[t] = __builtin_amdgcn_mfma_f32_16x16x32_bf16(ahi, Bhi[ks][t], acc[t], 0, 0, 0);
                    acc[t] = __builtin_amdgcn_mfma_f32_16x16x32_bf16(ahi, Blo[ks][t], acc[t], 0, 0, 0);
                    acc[t] = __builtin_amdgcn_mfma_f32_16x16x32_bf16(alo, Bhi[ks][t], acc[t], 0, 0, 0); }
            }
#pragma unroll
            for (int t = 0; t < 3; ++t)
#pragma unroll
                for (int rg = 0; rg < 4; ++rg) PART[(w * 16 + (lane >> 4) * 4 + rg) * 48 + 16 * t + (lane & 15)] = acc[t][rg];
        }
        __syncthreads();
        if (F.tid < 16) {
            const int r = F.tid, row = row0 + r;
            float lgv[4];
#pragma unroll
            for (int g = 0; g < 4; ++g) { float a = RB[32 + g];
#pragma unroll
                for (int ww = 0; ww < 8; ++ww) a += PART[(ww * 16 + r) * 48 + 32 + g];
                lgv[g] = a; }
            int gs = 0; float lmax = lgv[0];
#pragma unroll
            for (int g = 1; g < 4; ++g) if (lgv[g] > lmax) { lmax = lgv[g]; gs = g; }
            float den = 0.f;
#pragma unroll
            for (int g = 0; g < 4; ++g) den += fexp(lgv[g] - lmax);
            const float pgmax = 1.0f / den;
            float le[8];
#pragma unroll
            for (int e = 0; e < 8; ++e) { float a = RB[gs * 8 + e];
#pragma unroll
                for (int ww = 0; ww < 8; ++ww) a += PART[(ww * 16 + r) * 48 + gs * 8 + e];
                le[e] = a; }
            int i1 = 0; float m1 = le[0];
#pragma unroll
            for (int e = 1; e < 8; ++e) if (le[e] > m1) { m1 = le[e]; i1 = e; }
            int i2 = i1 == 0 ? 1 : 0; float m2 = le[i1 == 0 ? 1 : 0];
#pragma unroll
            for (int e = 0; e < 8; ++e) if (e != i1 && le[e] > m2) { m2 = le[e]; i2 = e; }
            const float dd = fexp(m2 - m1);
            const float gate1 = pgmax / (1.0f + dd), gate2 = pgmax * dd / (1.0f + dd);
            const int e1 = gs * 8 + i1, e2 = gs * 8 + i2;
            const int p1 = __hip_atomic_fetch_add(hist + e1, 1, __ATOMIC_RELAXED, __HIP_MEMORY_SCOPE_WORKGROUP), p2 = __hip_atomic_fetch_add(hist + e2, 1, __ATOMIC_RELAXED, __HIP_MEMORY_SCOPE_WORKGROUP);
            RE[2 * row] = e1; RE[2 * row + 1] = e2; RG[2 * row] = gate1; RG[2 * row + 1] = gate2; RP[2 * row] = p1; RP[2 * row + 1] = p2;
        }
#pragma unroll
        for (int rr = 0; rr < 2; ++rr)
#pragma unroll
            for (int j = 0; j < 4; ++j) { cxr[rr][j] = nxr[rr][j]; ctr[rr][j] = ntr[rr][j]; }
    }
#undef N2_LOADROWS
    __syncthreads();
    if (F.tid < 32) ((int*)(F.ws + WS_BH))[F.bid * 32 + F.tid] = hist[F.tid];
    __syncthreads();
}

__device__ __forceinline__ void moe_tables(Frame& F, int l) {
    LAS int* seg = (LAS int*)(F.lds + LC_SEG); LAS int* cnts = (LAS int*)(F.lds + LC_CNTS); LAS int* tile_e = (LAS int*)(F.lds + LC_TILEE);
    LAS int* red = (LAS int*)(F.lds + LC_RED);
    LAS int* bbase = (LAS int*)(F.lds + LC_BBASE);
    const int* BH = (const int*)(F.ws + WS_BH);
    __syncthreads();
    { const int e = F.tid & 31, part = F.tid >> 5; int tot = 0, pre = 0;
#pragma unroll 16
      for (int bq = part; bq < F.G; bq += 16) { const int v = BH[bq * 32 + e]; tot += v; if (bq < F.bid) pre += v; }
      red[part * 32 + e] = tot; red[512 + part * 32 + e] = pre; }
    __syncthreads();
    if (F.tid < 32) { int tot = 0, pre = 0;
#pragma unroll 1
        for (int p = 0; p < 16; ++p) { tot += red[p * 32 + F.tid]; pre += red[512 + p * 32 + F.tid]; }
        cnts[F.tid] = tot; bbase[F.tid] = pre; }
    __syncthreads();
    if (F.tid == 0) {
        int s = 0;
#pragma unroll 1
        for (int e = 0; e < NE; ++e) { seg[e] = s; s += ((cnts[e] + 255) >> 8) << 8; }
        seg[32] = s; seg[33] = s >> 8;
    }
    __syncthreads();
    if (F.tid < NE) { const int nt = (cnts[F.tid] + 255) >> 8, t0 = seg[F.tid] >> 8;
#pragma unroll 1
        for (int t = 0; t < nt; ++t) tile_e[t0 + t] = F.tid; }
    __syncthreads();
}
__device__ __forceinline__ void moe_tables_load(Frame& F) {
    LAS int* seg = (LAS int*)(F.lds + LC_SEG); LAS int* tile_e = (LAS int*)(F.lds + LC_TILEE); const int* MT = (const int*)(F.ws + WS_MT);
    __syncthreads();
    if (F.tid < 34) seg[F.tid] = MT[F.tid];
    if (F.tid < MAXTILES) tile_e[F.tid] = MT[34 + F.tid];
    __syncthreads();
}
__device__ __forceinline__ void phase_dispatch(int l) {
    asm volatile("" : "+s"(l)); Frame F = make_frame();
    moe_tables(F, l);
    if (F.bid == 0) { int* MT = (int*)(F.ws + WS_MT); if (F.tid < 34) MT[F.tid] = ((const LAS int*)(F.lds + LC_SEG))[F.tid]; if (F.tid < MAXTILES) MT[34 + F.tid] = ((const LAS int*)(F.lds + LC_TILEE))[F.tid]; }
    const LAS int* seg = (const LAS int*)(F.lds + LC_SEG); const LAS int* cnts = (const LAS int*)(F.lds + LC_CNTS); const LAS int* bbase = (const LAS int*)(F.lds + LC_BBASE);
    const int gw = F.bid * 8 + F.wave, NGW = F.G * 8;
    const int* RE = (const int*)(F.ws + WS_RE); const int* RP = (const int*)(F.ws + WS_RP); int* RS = (int*)(F.ws + WS_RS);
    const bf16_t* H = (const bf16_t*)((unsigned char*)F.out + DO_H); bf16_t* XS = (bf16_t*)(F.ws + WS_XS);
    int* STOK = (int*)(F.ws + WS_STOK);
    {
        for (int tile = (l == DEPTH - 1 ? NCTX / 16 : 0) + F.bid + (F.tid >> 5) * F.G; tile < NT / 16; tile += 16 * F.G) {
            const int item = tile * 32 + (F.tid & 31); const int e = RE[item], pos = RP[item]; const int slot = seg[e] + bbase[e] + pos; RS[item] = slot; STOK[slot] = item >> 1; }
    }
#pragma unroll 1
    for (int e = 0; e < NE; ++e) {
        const int c = cnts[e], padded = (c + 255) & ~255;
        for (int p = c + F.bid * 512 + F.tid; p < padded; p += F.G * 512) STOK[seg[e] + p] = 0;
    }
}

__device__ __forceinline__ void phase_final() {
    Frame F = make_frame();
    const int gw = F.bid * 8 + F.wave, NGW = F.G * 8;
    const bf16_t* X = (const bf16_t*)(F.ws + WS_X); const float* fg = F.inp(IN_FG);
    for (int r = gw; r < NLAT; r += NGW) {
        const bf16_t* xr = X + (size_t)(NCTX + r) * D;
        f32x4 v[4]; float ss = 0.f;
#pragma unroll
        for (int jj = 0; jj < 2; ++jj) unpk8(*(const u32x4*)(xr + 8 * F.lane + 512 * jj), v[2 * jj], v[2 * jj + 1]);
        if (false) for (int j = 0; j < 4; ++j) v[j] = v[j];
        combine_row(F, DEPTH - 1, NCTX + r, v);
#pragma unroll
        for (int j = 0; j < 4; ++j) ss += v[j][0] * v[j][0] + v[j][1] * v[j][1] + v[j][2] * v[j][2] + v[j][3] * v[j][3];
        const float rs = rsqrtf(wave_sum(ss) * (1.0f / D) + NORM_EPS);
#pragma unroll
        for (int j = 0; j < 4; ++j) { const int c = col4(F.lane, j); const f32x4 gg = *(const f32x4*)(fg + c);
            f32x4 o; o[0] = v[j][0] * rs * gg[0]; o[1] = v[j][1] * rs * gg[1]; o[2] = v[j][2] * rs * gg[2]; o[3] = v[j][3] * rs * gg[3];
            *(f32x4*)(F.out + (size_t)r * D + c) = o; }
    }
}

constexpr int NPL = 11;
constexpr int NPH = 1 + DEPTH * NPL + 1;
__device__ __forceinline__ void seam() {
    Frame F = make_frame();
    XcdBarrier bar; bar.bar = (unsigned*)(F.ws + WS_CTL) + CW_BAR; bar.x = xb_xcc_id(); bar.st = (volatile LAS unsigned*)(F.lds + LC_BARW);
    xcd_barrier(bar);
}
__global__ void __launch_bounds__(512, 2) mk_fwd(Args args_unused) {
    {
        Frame F = make_frame();
        for (int u = F.tid; u < (LDS_BYTES - LDS_CTL) / 4; u += 512) ((LAS unsigned*)(F.lds + LDS_CTL))[u] = 0u;
        __syncthreads();
        if (F.ka->ph_hi - F.ka->ph_lo > 1) (void)xcd_barrier_post((unsigned*)(F.ws + WS_CTL) + CW_BAR, (volatile LAS unsigned*)(F.lds + LC_BARW));
    }
#define IN(k) (kargs()->ph_lo <= (k) && (k) < kargs()->ph_hi)
#define SEAM(k) do { if (IN(k) && IN((k) + 1)) seam(); } while (0)
    int ph = 0;
    for (int rep_ = 0; rep_ < DUP_N(13); ++rep_) { if (rep_) seam(); if (PH_EN(13) && IN(ph)) phase_prologue(); }
    SEAM(ph); ++ph;
    unsigned long long pb_t0 = 0, pb_acc = 0;
    for (int l = 0; l < DEPTH; ++l) {
        if (IN(ph) && IN(ph + 1)) { for (int i_ = 0; i_ < EXTRA_SEAMS; ++i_) seam(); }
        if (PROBE_PHASE == 0) pb_t0 = __builtin_amdgcn_s_memrealtime();
        for (int rep_ = 0; rep_ < DUP_N(0); ++rep_) { if (rep_) seam(); if (PH_EN(0) && IN(ph)) phase_norm1(l, rep_); }
        SEAM(ph); ++ph;
        if (PROBE_PHASE == 0) pb_acc += __builtin_amdgcn_s_memrealtime() - pb_t0;
        if (PROBE_PHASE == 1) pb_t0 = __builtin_amdgcn_s_memrealtime();
        for (int rep_ = 0; rep_ < DUP_N(1); ++rep_) { if (rep_) seam(); if (PH_EN(1) && IN(ph)) { Frame F = make_frame(); Gemm g{(const bf16_t*)((unsigned char*)F.out + DO_H), (const bf16_t*)(F.ws + WS_WIN), NT, NINP, D, 0, 0}; EpiZ E{(bf16_t*)(F.ws + WS_Z), (bf16_t*)(F.ws + WS_GT)};
            { int lq = l; asm volatile("" : "+s"(lq));
              if (lq == DEPTH - 1) { LastLayerOrder S; S.init(F.G, F.bid); gemm_phase(F.lds, g, S, E); }
              else { StaticOrder S; S.init(NT, NINP, F.G, F.bid); gemm_phase(F.lds, g, S, E); } }
            { int ll = l; asm volatile("" : "+s"(ll)); const int nwg = ll == DEPTH - 1 ? (NLAT / 256) * (NINP / 256) + (NCTX / 256) * 8 : (NT / 256) * (NINP / 256), rem = nwg % F.G; const int nlight = rem ? F.G - rem : F.G, lidx = rem ? F.bid - rem : F.bid;
              if (rep_ == 0 && lidx >= 0) convert_layer_weights(F, ll, 4, lidx * 8 + F.wave, nlight * 8); } } }
        SEAM(ph); ++ph;
        if (PROBE_PHASE == 1) pb_acc += __builtin_amdgcn_s_memrealtime() - pb_t0;
        if (PROBE_PHASE == 2) pb_t0 = __builtin_amdgcn_s_memrealtime();
        for (int rep_ = 0; rep_ < DUP_N(2); ++rep_) { if (rep_) seam(); if (PH_EN(2) && IN(ph)) phase_prep(l); }
        SEAM(ph); ++ph;
        if (PROBE_PHASE == 2) pb_acc += __builtin_amdgcn_s_memrealtime() - pb_t0;
        if (PROBE_PHASE == 3) pb_t0 = __builtin_amdgcn_s_memrealtime();
        for (int rep_ = 0; rep_ < DUP_N(3); ++rep_) { if (rep_) seam(); if (PH_EN(3) && IN(ph)) { if (rep_ == 0) phase_scan_mfma<0>(l); else phase_scan_mfma<SCAN_DBG>(l); } }
        SEAM(ph); ++ph;
        if (PROBE_PHASE == 3) pb_acc += __builtin_amdgcn_s_memrealtime() - pb_t0;
        if (PROBE_PHASE == 4) pb_t0 = __builtin_amdgcn_s_memrealtime();
        for (int rep_ = 0; rep_ < DUP_N(4); ++rep_) { if (rep_) seam(); if (PH_EN(4) && IN(ph)) phase_mix(l); }
        SEAM(ph); ++ph;
        if (PROBE_PHASE == 4) pb_acc += __builtin_amdgcn_s_memrealtime() - pb_t0;
        if (PROBE_PHASE == 5) pb_t0 = __builtin_amdgcn_s_memrealtime();
        for (int rep_ = 0; rep_ < DUP_N(5); ++rep_) { if (rep_) seam(); if (PH_EN(5) && IN(ph)) { Frame F = make_frame(); int lq = l; asm volatile("" : "+s"(lq)); const int r0 = lq == DEPTH - 1 ? NCTX : 0;
            Gemm g{(const bf16_t*)(F.ws + WS_UA) + (size_t)r0 * DH, (const bf16_t*)(F.ws + WS_WA), NT - r0, D, DH, (size_t)(WS_WB - WS_WA) / 2, (size_t)(WS_UB - WS_UA) / 2}; PairOrder S; S.so.init(NT - r0, D, F.G, F.bid);
            EpiMerge E{(bf16_t*)((unsigned char*)F.out + DO_H) + (size_t)r0 * D, (const bf16_t*)(F.ws + WS_GT) + (size_t)(r0 >> 8) * 8 * (2 * GT_HALF)}; gemm_phase(F.lds, g, S, E);
            { int ll = l; asm volatile("" : "+s"(ll)); const int nwg = ((NT - r0) / 256) * (D / 256), rem = nwg % F.G; const int nlight = rem ? F.G - rem : F.G, lidx = rem ? F.bid - rem : F.bid;
              if (rep_ == 0 && lidx >= 0) convert_layer_weights(F, ll, 5, lidx * 8 + F.wave, nlight * 8); } } }
        SEAM(ph); ++ph;
        if (PROBE_PHASE == 5) pb_acc += __builtin_amdgcn_s_memrealtime() - pb_t0;
        if (PROBE_PHASE == 6) pb_t0 = __builtin_amdgcn_s_memrealtime();
        for (int rep_ = 0; rep_ < DUP_N(7); ++rep_) { if (rep_) seam(); if (PH_EN(7) && IN(ph)) { Frame F = make_frame(); int lq = l; asm volatile("" : "+s"(lq)); const int r0 = lq == DEPTH - 1 ? NCTX : 0;
            Gemm g{(const bf16_t*)((unsigned char*)F.out + DO_H) + (size_t)r0 * D, (const bf16_t*)(F.ws + WS_WO), NT - r0, D, D, 0, 0}; StaticOrder S; S.init(NT - r0, D, F.G, F.bid);
            EpiStoreBf16 E{(bf16_t*)(F.ws + WS_T) + (size_t)r0 * D, D}; gemm_phase(F.lds, g, S, E);
            { int ll = l; asm volatile("" : "+s"(ll)); const int nwg = ((NT - r0) / 256) * (D / 256), rem = nwg % F.G; const int nlight = rem ? F.G - rem : F.G, lidx = rem ? F.bid - rem : F.bid;
              if (rep_ == 0 && lidx >= 0) convert_layer_weights(F, ll, 6, lidx * 8 + F.wave, nlight * 8); } } }
        SEAM(ph); ++ph;
        if (PROBE_PHASE == 6) pb_acc += __builtin_amdgcn_s_memrealtime() - pb_t0;
        if (PROBE_PHASE == 7) pb_t0 = __builtin_amdgcn_s_memrealtime();
        for (int rep_ = 0; rep_ < DUP_N(8); ++rep_) { if (rep_) seam(); if (PH_EN(8) && IN(ph)) phase_norm2(l); }
        SEAM(ph); ++ph;
        if (PROBE_PHASE == 7) pb_acc += __builtin_amdgcn_s_memrealtime() - pb_t0;
        if (PROBE_PHASE == 8) pb_t0 = __builtin_amdgcn_s_memrealtime();
        for (int rep_ = 0; rep_ < DUP_N(9); ++rep_) { if (rep_) seam(); if (PH_EN(9) && IN(ph)) phase_dispatch(l); }
        SEAM(ph); ++ph;
        if (PROBE_PHASE == 8) pb_acc += __builtin_amdgcn_s_memrealtime() - pb_t0;
        if (PROBE_PHASE == 9) pb_t0 = __builtin_amdgcn_s_memrealtime();
        for (int rep_ = 0; rep_ < DUP_N(10); ++rep_) { if (rep_) seam(); if (PH_EN(10) && IN(ph)) { int ll = l; asm volatile("" : "+s"(ll)); Frame F = make_frame(); moe_tables_load(F); MoeOrder S{__builtin_amdgcn_readfirstlane(((const LAS int*)(F.lds + LC_SEG))[33]), F.G, F.bid, (const LAS int*)(F.lds + LC_TILEE)};
            Gemm g{(const bf16_t*)((unsigned char*)F.out + DO_H), (const bf16_t*)(F.ws + WS_W13), MAXTILES * 256, D, D, (size_t)1024 * 1024, 0}; EpiSwiGLU E{(bf16_t*)(F.ws + WS_HID)}; gemm_phase<EpiSwiGLU, MoeOrder, true>(F.lds, g, S, E, (const int*)(F.ws + WS_STOK)); } }
        SEAM(ph); ++ph;
        if (PROBE_PHASE == 9) pb_acc += __builtin_amdgcn_s_memrealtime() - pb_t0;
        if (PROBE_PHASE == 10) pb_t0 = __builtin_amdgcn_s_memrealtime();
        for (int rep_ = 0; rep_ < DUP_N(11); ++rep_) { if (rep_) seam(); if (PH_EN(11) && IN(ph)) { int ll = l; asm volatile("" : "+s"(ll)); Frame F = make_frame(); moe_tables_load(F); MoeOrder S{__builtin_amdgcn_readfirstlane(((const LAS int*)(F.lds + LC_SEG))[33]), F.G, F.bid, (const LAS int*)(F.lds + LC_TILEE)};
            Gemm g{(const bf16_t*)(F.ws + WS_HID), (const bf16_t*)(F.ws + WS_W2), MAXTILES * 256, D, DFF, (size_t)1024 * 512, 0}; EpiStoreBf16 E{(bf16_t*)(F.ws + WS_YS), D}; gemm_phase(F.lds, g, S, E); } }
        SEAM(ph); ++ph;
        if (PROBE_PHASE == 10) pb_acc += __builtin_amdgcn_s_memrealtime() - pb_t0;
    }
    if (PH_EN(14) && IN(ph)) phase_final();
    if (PROBE_PHASE >= 0 && blockIdx.x == 0) { const unsigned long long t_ = __builtin_amdgcn_s_memrealtime(); while (__builtin_amdgcn_s_memrealtime() - t_ < 9ull * pb_acc) __builtin_amdgcn_s_sleep(8); }
#undef IN
#undef SEAM
}

extern "C" void kernel_launch(void* const* d_in, const int* in_sizes, int n_in, void* d_out, int out_size, void* d_ws, size_t ws_size, hipStream_t stream) {
    static int grid = 0;
    if (grid == 0) {
        if (n_in != 32 || out_size != NLAT * D || ws_size < WS_END) { fprintf(stderr, "kernel_launch: unexpected shapes (n_in %d, out %d, ws %zu < %zu)\n", n_in, out_size, ws_size, (size_t)WS_END); grid = -1; return; }
        int dev = 0, cus = 0, per_cu = 0;
        if (hipGetDevice(&dev) != hipSuccess || hipDeviceGetAttribute(&cus, hipDeviceAttributeMultiprocessorCount, dev) != hipSuccess) { grid = -1; return; }
        if (hipFuncSetAttribute((const void*)mk_fwd, hipFuncAttributeMaxDynamicSharedMemorySize, LDS_BYTES) != hipSuccess) { fprintf(stderr, "kernel_launch: hipFuncSetAttribute failed\n"); grid = -1; return; }
        if (hipOccupancyMaxActiveBlocksPerMultiprocessor(&per_cu, (const void*)mk_fwd, 512, LDS_BYTES) != hipSuccess || per_cu < 1) { fprintf(stderr, "kernel_launch: occupancy query says %d\n", per_cu); }
        (void)hipGetLastError();
        grid = cus;
    }
    if (grid < 0) return;
    if (hipMemsetAsync((char*)d_ws + WS_CTL, 0, CTL_ZERO_BYTES, stream) != hipSuccess) return;
    Args a{};
    for (int i = 0; i < 32; ++i) a.in[i] = (const float*)d_in[i];
    a.out = (float*)d_out; a.ws = (unsigned char*)d_ws;
#if MK_ONE_LAUNCH
    a.ph_lo = 0; a.ph_hi = NPH;
    hipLaunchKernelGGL(mk_fwd, dim3(grid), dim3(512), LDS_BYTES, stream, a);
#else
    for (int p = 0; p < NPH; ++p) { a.ph_lo = p; a.ph_hi = p + 1; hipLaunchKernelGGL(mk_fwd, dim3(grid), dim3(512), LDS_BYTES, stream, a); }
#endif
}
```
